# Optimizing an MI355X kernel written in HIP

```python
import math
import jax, jax.numpy as jnp
from jax import lax
import numpy as np

D_MODEL = 1024
BATCH = 8
SEQ = 4096
DEPTH = 1

HEAD_DIM = 64
N_HEADS_MOBA = 8
N_HEADS_SB = 8
W_MOBA = N_HEADS_MOBA * HEAD_DIM
W_SB = N_HEADS_SB * HEAD_DIM
MOBA_BLOCK = 256
MOBA_TOPK = 3
MOBA_QCHUNK = 32
SB_QBLOCK = 128
REL_BUCKETS = 32
REL_MAX_DIST = 1024
N_GROUPS = 4
EXPERTS_PER_GROUP = 8
N_EXPERTS = N_GROUPS * EXPERTS_PER_GROUP
EXPERT_TOPK = 2
D_EXPERT = 512
MOE_ROW_BLOCK = 256
N_MOD = 6
RMS_EPS = 1e-6
IN_COLS = 3 * W_MOBA + 3 * W_SB + 2 * D_MODEL

kernel_name = "hybrid_moba_stickbreak_hmoe_block"


def rmsnorm(x, g):
    xf = x.astype(jnp.float32)
    y = xf * lax.rsqrt(jnp.mean(xf * xf, axis=-1, keepdims=True) + RMS_EPS)
    return (y * g.astype(jnp.float32)).astype(x.dtype)


def modulate(h, shift, scale):
    return h * (1 + scale) + shift


def rel_bucket(dist):
    n = jnp.maximum(dist, 0)
    max_exact = REL_BUCKETS // 2
    nf = jnp.maximum(n, 1).astype(jnp.float32)
    large = max_exact + (jnp.log(nf / max_exact) / math.log(REL_MAX_DIST / max_exact)
                         * (REL_BUCKETS - max_exact)).astype(jnp.int32)
    large = jnp.minimum(large, REL_BUCKETS - 1)
    return jnp.where(n < max_exact, n, large)


def moba_attention(q, k, v, rel_bias):
    B, H, S, Dh = q.shape
    n_blk = -(-S // MOBA_BLOCK)
    s_pad = n_blk * MOBA_BLOCK
    n_sel = min(MOBA_TOPK, n_blk)
    pad = ((0, 0), (0, 0), (0, s_pad - S), (0, 0))
    q, k, v = jnp.pad(q, pad), jnp.pad(k, pad), jnp.pad(v, pad)
    kb = k.reshape(B, H, n_blk, MOBA_BLOCK, Dh)
    vb = v.reshape(B, H, n_blk, MOBA_BLOCK, Dh)
    k_mean = jnp.mean(kb, axis=3)
    scale = Dh ** -0.5
    bi = jnp.arange(B)[:, None, None, None]
    hi = jnp.arange(H)[None, :, None, None]
    blk_ids = jnp.arange(n_blk)
    j_ids = jnp.arange(MOBA_BLOCK)

    def chunk(ci):
        q0 = ci * MOBA_QCHUNK
        own = q0 // MOBA_BLOCK
        qc = lax.dynamic_slice_in_dim(q, q0, MOBA_QCHUNK, axis=2)
        t = q0 + jnp.arange(MOBA_QCHUNK)
        gate = jnp.einsum('bhqd,bhnd->bhqn', qc, k_mean).astype(jnp.float32)
        gate = jnp.where(blk_ids < own, gate, -jnp.inf)
        _, sel = lax.top_k(gate, n_sel)
        slot_ok = jnp.arange(n_sel) < own
        k_sel = kb[bi, hi, sel]
        v_sel = vb[bi, hi, sel]
        s_sel = sel[..., None] * MOBA_BLOCK + j_ids
        bias_sel = rel_bias[hi[..., None], rel_bucket(t[None, None, :, None, None] - s_sel)]
        l_sel = jnp.einsum('bhqd,bhqkjd->bhqkj', qc, k_sel).astype(jnp.float32) * scale + bias_sel
        l_sel = jnp.where(slot_ok[:, None], l_sel, -jnp.inf)
        k_own = lax.dynamic_slice_in_dim(k, own * MOBA_BLOCK, MOBA_BLOCK, axis=2)
        v_own = lax.dynamic_slice_in_dim(v, own * MOBA_BLOCK, MOBA_BLOCK, axis=2)
        dist_own = t[:, None] - (own * MOBA_BLOCK + j_ids)[None, :]
        bias_own = rel_bias[:, rel_bucket(dist_own)]
        l_own = jnp.einsum('bhqd,bhjd->bhqj', qc, k_own).astype(jnp.float32) * scale + bias_own
        l_own = jnp.where(dist_own >= 0, l_own, -jnp.inf)
        logits = jnp.concatenate([l_sel.reshape(B, H, MOBA_QCHUNK, n_sel * MOBA_BLOCK), l_own], axis=-1)
        p = jax.nn.softmax(logits, axis=-1)
        p_sel = p[..., :n_sel * MOBA_BLOCK].reshape(B, H, MOBA_QCHUNK, n_sel, MOBA_BLOCK).astype(v.dtype)
        p_own = p[..., n_sel * MOBA_BLOCK:].astype(v.dtype)
        return (jnp.einsum('bhqkj,bhqkjd->bhqd', p_sel, v_sel)
                + jnp.einsum('bhqj,bhjd->bhqd', p_own, v_own))

    outs = lax.map(chunk, jnp.arange(s_pad // MOBA_QCHUNK))
    return outs.transpose(1, 2, 0, 3, 4).reshape(B, H, s_pad, Dh)[:, :, :S]


def stick_breaking_attention(q, k, v):
    B, H, S, Dh = q.shape
    scale = Dh ** -0.5
    s_pos = jnp.arange(S)

    def block(bq):
        q0 = bq * SB_QBLOCK
        qc = lax.dynamic_slice_in_dim(q, q0, SB_QBLOCK, axis=2)
        t = q0 + jnp.arange(SB_QBLOCK)
        z = jnp.einsum('bhqd,bhsd->bhqs', qc, k).astype(jnp.float32) * scale
        past = s_pos[None, :] < t[:, None]
        log_1m = jnp.where(past, jax.nn.log_sigmoid(-z), 0.0)
        after = lax.cumsum(log_1m, axis=3, reverse=True) - log_1m
        a = jnp.where(past, jnp.exp(jax.nn.log_sigmoid(z) + after), 0.0)
        return jnp.einsum('bhqs,bhsd->bhqd', a.astype(v.dtype), v)

    outs = lax.map(block, jnp.arange(S // SB_QBLOCK))
    return outs.transpose(1, 2, 0, 3, 4).reshape(B, H, S, Dh)


def hierarchical_moe(h, w_rg, b_rg, w_re, b_re, w_gate, w_up, w_down):
    B, S, D = h.shape
    N = B * S
    hf = h.reshape(N, D)
    g_prob = jax.nn.softmax((hf @ w_rg + b_rg).astype(jnp.float32), axis=-1)
    g_w, g_idx = lax.top_k(g_prob, 1)
    e_logits = (hf @ w_re + b_re).astype(jnp.float32).reshape(N, N_GROUPS, EXPERTS_PER_GROUP)
    e_logits = jnp.take_along_axis(e_logits, g_idx[:, :, None], axis=1)[:, 0]
    e_top, e_local = lax.top_k(e_logits, EXPERT_TOPK)
    e_w = jax.nn.softmax(e_top, axis=-1) * g_w
    e_id = g_idx * EXPERTS_PER_GROUP + e_local
    n_asg = N * EXPERT_TOPK
    flat_e = e_id.reshape(-1)
    flat_w = e_w.reshape(-1)
    flat_tok = jnp.repeat(jnp.arange(N, dtype=jnp.int32), EXPERT_TOPK)
    order = jnp.argsort(flat_e)
    se, stok, sw = flat_e[order], flat_tok[order], flat_w[order]
    counts = jnp.zeros(N_EXPERTS, jnp.int32).at[flat_e].add(1)
    start = jnp.cumsum(counts) - counts
    padded = (counts + MOE_ROW_BLOCK - 1) // MOE_ROW_BLOCK * MOE_ROW_BLOCK
    pend = jnp.cumsum(padded)
    pstart = pend - padded
    n_blocks = -(-n_asg // MOE_ROW_BLOCK) + N_EXPERTS
    n_rows = n_blocks * MOE_ROW_BLOCK
    dest = pstart[se] + jnp.arange(n_asg, dtype=jnp.int32) - start[se]
    row_tok = jnp.zeros(n_rows, jnp.int32).at[dest].set(stok)
    row_w = jnp.zeros(n_rows, jnp.float32).at[dest].set(sw)
    blk_e = jnp.minimum(jnp.searchsorted(pend, jnp.arange(n_blocks) * MOE_ROW_BLOCK, side='right'),
                        N_EXPERTS - 1)

    def expert_block(args):
        tok, w, e = args
        xb = hf[tok]
        hid = jax.nn.silu(xb @ w_gate[e]) * (xb @ w_up[e])
        return (hid @ w_down[e]) * w[:, None].astype(xb.dtype)

    y = lax.map(expert_block, (row_tok.reshape(n_blocks, MOE_ROW_BLOCK),
                               row_w.reshape(n_blocks, MOE_ROW_BLOCK), blk_e))
    out = jnp.zeros((N, D), h.dtype).at[row_tok].add(y.reshape(n_rows, D))
    return out.reshape(B, S, D)


def split_heads(t, n_heads):
    B, S, _ = t.shape
    return t.reshape(B, S, n_heads, HEAD_DIM).transpose(0, 2, 1, 3)


def merge_heads(t):
    B, H, S, Dh = t.shape
    return t.transpose(0, 2, 1, 3).reshape(B, S, H * Dh)


def setup_inputs(seed: int = 0) -> dict:
    key = jax.random.key(seed)
    ks = jax.random.split(key, 20)
    f = jnp.float32
    D = D_MODEL
    nrm = lambda k, shape, s: jax.random.normal(k, shape, f) * s
    return {
        "x": nrm(ks[0], (BATCH, SEQ, D), 1.0),
        "c": nrm(ks[1], (BATCH, D), 1.0),
        "w_ada": nrm(ks[2], (DEPTH, D, N_MOD * D), 0.5 * D ** -0.5),
        "b_ada": nrm(ks[3], (DEPTH, N_MOD * D), 0.01),
        "g_mix": 1.0 + nrm(ks[4], (DEPTH, D), 0.02),
        "w_in": nrm(ks[5], (DEPTH, D, IN_COLS), D ** -0.5),
        "g_q": 1.0 + nrm(ks[6], (DEPTH, HEAD_DIM), 0.02),
        "g_k": 1.0 + nrm(ks[7], (DEPTH, HEAD_DIM), 0.02),
        "rel_bias": nrm(ks[8], (N_HEADS_MOBA, REL_BUCKETS), 0.5),
        "w_br_moba": nrm(ks[9], (DEPTH, W_MOBA, D), W_MOBA ** -0.5),
        "w_br_sb": nrm(ks[10], (DEPTH, W_SB, D), W_SB ** -0.5),
        "w_out": nrm(ks[11], (DEPTH, D, D), D ** -0.5),
        "g_ffn": 1.0 + nrm(ks[12], (DEPTH, D), 0.02),
        "w_rg": nrm(ks[13], (DEPTH, D, N_GROUPS), D ** -0.5),
        "b_rg": nrm(ks[14], (DEPTH, N_GROUPS), 0.01),
        "w_re": nrm(ks[15], (DEPTH, D, N_EXPERTS), D ** -0.5),
        "b_re": nrm(ks[16], (DEPTH, N_EXPERTS), 0.01),
        "w_gate": nrm(ks[17], (DEPTH, N_EXPERTS, D, D_EXPERT), D ** -0.5),
        "w_up": nrm(ks[18], (DEPTH, N_EXPERTS, D, D_EXPERT), D ** -0.5),
        "w_down": nrm(ks[19], (DEPTH, N_EXPERTS, D_EXPERT, D), D_EXPERT ** -0.5),
    }


def reference(x, c, w_ada, b_ada, g_mix, w_in, g_q, g_k, rel_bias, w_br_moba, w_br_sb, w_out,
              g_ffn, w_rg, b_rg, w_re, b_re, w_gate, w_up, w_down):
    B, S, D = x.shape
    splits = list(np.cumsum([W_MOBA, W_MOBA, W_MOBA, W_SB, W_SB, W_SB, D_MODEL]))
    for l in range(DEPTH):
        mod = (jax.nn.silu(c) @ w_ada[l] + b_ada[l]).reshape(B, N_MOD, 1, D)
        sh_a, sc_a, gt_a, sh_f, sc_f, gt_f = (mod[:, i] for i in range(N_MOD))
        h = modulate(rmsnorm(x, g_mix[l]), sh_a, sc_a)
        proj = h @ w_in[l]
        qa, ka, va, qb, kb, vb, gate_a, gate_b = jnp.split(proj, splits, axis=-1)
        qa = rmsnorm(split_heads(qa, N_HEADS_MOBA), g_q[l])
        ka = rmsnorm(split_heads(ka, N_HEADS_MOBA), g_k[l])
        o_a = merge_heads(moba_attention(qa, ka, split_heads(va, N_HEADS_MOBA), rel_bias))
        o_b = merge_heads(stick_breaking_attention(split_heads(qb, N_HEADS_SB),
                                                   split_heads(kb, N_HEADS_SB),
                                                   split_heads(vb, N_HEADS_SB)))
        merged = (jax.nn.sigmoid(gate_a) * (o_a @ w_br_moba[l])
                  + jax.nn.sigmoid(gate_b) * (o_b @ w_br_sb[l]))
        x = x + gt_a * (merged @ w_out[l])
        h2 = modulate(rmsnorm(x, g_ffn[l]), sh_f, sc_f)
        x = x + gt_f * hierarchical_moe(h2, w_rg[l], b_rg[l], w_re[l], b_re[l],
                                        w_gate[l], w_up[l], w_down[l])
    return x
```

```cpp
#include <hip/hip_runtime.h>
#include <cstdio>
#include <cstdint>
#include <cmath>
namespace pg8 {
#define PG8_LAS __attribute__((address_space(3)))
typedef unsigned short bf16_t;
typedef short bf16x8 __attribute__((ext_vector_type(8)));
typedef float f32x4 __attribute__((ext_vector_type(4)));
typedef unsigned u32x4 __attribute__((ext_vector_type(4)));
constexpr int BM = 256, BK = 64, HALF = 128, HTB = HALF * BK * 2  , STAGE_BYTES = 8 * HTB, NXCD = 8, WGM = 8;

__host__ __device__ __forceinline__ int lds_byte(int r, int c) { const int st = (r >> 4) * 2 + (c >> 5), rr = r & 15, cc = c & 31, ob = rr * 64 + cc * 2; return st * 1024 + (ob ^ (((ob >> 9) & 1) << 5)); }
__host__ __device__ __forceinline__ void stage_rc(int b, int& R, int& C) { const int st = b / 1024, sb = b % 1024, swz = sb ^ (((sb >> 9) & 1) << 5); R = (st >> 1) * 16 + swz / 64; C = (st & 1) * 32 + (swz % 64) / 2; }
__host__ __device__ __forceinline__ int perm32(int rho) { const int n = rho >> 4, i = rho & 15; return 8 * (i >> 2) + 4 * n + (i & 3); }

struct Unit { int arow, brow, pm, pn, x0, x1; };
struct Gemm { const bf16_t* A; const bf16_t* Bt; int K; };

struct DenseOrder {
    int nM, nN, nwg, G, c;
    __device__ void init(int M, int N, int G_, int c_) { nM = M / BM; nN = N / BM; nwg = nM * nN; G = G_; c = c_; }
    __device__ bool next(int i, Unit& u) const {
        const long L = (long)i * G + c; if (L >= nwg) return false;
        int wgid = (int)L; { const int q = nwg / NXCD, r = nwg % NXCD, xcd = wgid % NXCD, off = wgid / NXCD; wgid = (xcd < r ? xcd * (q + 1) : r * (q + 1) + (xcd - r) * q) + off; }
        const int nig = WGM * nN, gid = wgid / nig, fm = gid * WGM, gsz = (nM - fm) < WGM ? (nM - fm) : WGM;
        u.pm = fm + ((wgid % nig) % gsz); u.pn = (wgid % nig) / gsz; u.arow = u.pm * BM; u.brow = u.pn * BM; u.x0 = 0; u.x1 = 0; return true;
    }
    __device__ __forceinline__ int arow_of(const Unit&, int) const { return 0; }
};

__device__ __forceinline__ unsigned cvt_pk_bf16(float lo, float hi) { unsigned r; asm volatile("v_cvt_pk_bf16_f32 %0, %1, %2" : "=v"(r) : "v"(lo), "v"(hi)); return r; }

template <class Epi, class Sched, bool GATHER, bool ALIGN_EPI = true, bool SP2 = true>
__device__ __forceinline__ void gemm_phase(PG8_LAS unsigned char* lds, const Gemm g, const Sched& S, const Epi& E) {
    const int tid = threadIdx.x, wid = __builtin_amdgcn_readfirstlane(tid >> 6), lane = tid & 63, wr = wid >> 2, wc = wid & 3, fr = lane & 15, fq = lane >> 4;
    const int K = g.K, nt = K / BK;
    unsigned voffA[2], voffB[2]; int stR[2], stC[2];
#pragma unroll
    for (int i = 0; i < 2; ++i) { int R, C; stage_rc(tid * 16 + i * 8192, R, C); const int Rb = Epi::PERM ? ((R & ~31) + perm32(R & 31)) : R;
        stR[i] = R; stC[i] = C; voffA[i] = (unsigned)(R * K + C) * 2u; voffB[i] = (unsigned)(Rb * K + C) * 2u; }
    const size_t kstep = (size_t)(BK * 2);
    const size_t hstep = (size_t)HALF * K * 2;
    const size_t rstep = (size_t)K * 2;
    const unsigned ldsw = (unsigned)wid * 1024u;
    const int aoff = lds_byte(wr * 64 + fr, fq * 8), boff = lds_byte(wc * 32 + fr, fq * 8);
#define PG8_SA(b, h) (((b) * 2 + (h)) * HTB)
#define PG8_SB(b, h) ((4 + (b) * 2 + (h)) * HTB)
#define PG8_STAGE(bufoff, gbase, voff) do { _Pragma("unroll") for (int _i = 0; _i < 2; ++_i) \
        __builtin_amdgcn_global_load_lds((const unsigned*)((const char*)(gbase) + (voff)[_i]), (PG8_LAS unsigned*)(lds + (bufoff) + ldsw + _i * 8192), 16, 0, 0); } while (0)
#define PG8_STAGE_A(bufoff, ub, h, VS) do { if constexpr (GATHER) { PG8_STAGE(bufoff, ub, VS[h]); } else { PG8_STAGE(bufoff, (ub) + (h) * hstep, voffA); } } while (0)
#define PG8_VOFFS(dst, U) do { _Pragma("unroll") for (int h_ = 0; h_ < 2; ++h_) _Pragma("unroll") for (int i_ = 0; i_ < 2; ++i_) \
        dst[h_][i_] = (unsigned)(S.arow_of(U, h_ * HALF + stR[i_]) * K + stC[i_]) * 2u; } while (0)
#define PG8_LDA(dst, b, h) do { _Pragma("unroll") for (int m = 0; m < 4; ++m) _Pragma("unroll") for (int k = 0; k < 2; ++k) dst[m][k] = *(const PG8_LAS bf16x8*)(lds + PG8_SA(b, h) + aoff + m * 2048 + k * 1024); } while (0)
#define PG8_LDB(dst, b, h) do { _Pragma("unroll") for (int n = 0; n < 2; ++n) _Pragma("unroll") for (int k = 0; k < 2; ++k) dst[n][k] = *(const PG8_LAS bf16x8*)(lds + PG8_SB(b, h) + boff + n * 2048 + k * 1024); } while (0)
#define PG8_MMA(ai, bj, At, Bt) do { __builtin_amdgcn_s_setprio(1); _Pragma("unroll") for (int m = 0; m < 4; ++m) _Pragma("unroll") for (int n = 0; n < 2; ++n) _Pragma("unroll") for (int k = 0; k < 2; ++k) \
        acc[ai][bj][m][n] = __builtin_amdgcn_mfma_f32_16x16x32_bf16(Bt[n][k], At[m][k], acc[ai][bj][m][n], 0, 0, 0); __builtin_amdgcn_s_setprio(0); } while (0)
#define PG8_WAIT_V(n) asm volatile("s_waitcnt vmcnt(" #n ")" ::: "memory")
#define PG8_WAIT_L(n) asm volatile("s_waitcnt lgkmcnt(" #n ")" ::: "memory")
#define PG8_BAR __builtin_amdgcn_s_barrier()
#define PG8_SCHED __builtin_amdgcn_sched_barrier(0)
    Unit cur, nxt; int ui = 0;
    if (!S.next(0, cur)) return;
    bool has_next = S.next(1, nxt);
    unsigned vAc[2][2], vAn[2][2];
    if constexpr (GATHER) { PG8_VOFFS(vAc, cur); if (has_next) { PG8_VOFFS(vAn, nxt); } else {
#pragma unroll
        for (int h_ = 0; h_ < 2; ++h_) { vAn[h_][0] = vAc[h_][0]; vAn[h_][1] = vAc[h_][1]; } } }
    else {
#pragma unroll
        for (int h_ = 0; h_ < 2; ++h_) { vAc[h_][0] = 0u; vAc[h_][1] = 0u; vAn[h_][0] = 0u; vAn[h_][1] = 0u; } }
    f32x4 acc[2][2][4][2];
#pragma unroll
    for (int a = 0; a < 2; ++a)
#pragma unroll
        for (int b = 0; b < 2; ++b)
#pragma unroll
            for (int m = 0; m < 4; ++m)
#pragma unroll
                for (int n = 0; n < 2; ++n) acc[a][b][m][n] = (f32x4){0.f, 0.f, 0.f, 0.f};
    bf16x8 At[4][2], B0[2][2], B1[2][2];
    const char* const A0 = (const char*)g.A;
    const char* cA = GATHER ? A0 : A0 + (size_t)cur.arow * rstep; const char* cB = (const char*)g.Bt + (size_t)cur.brow * rstep;
    if constexpr (SP2) {
        PG8_STAGE(PG8_SB(0, 0), cB, voffB); PG8_STAGE(PG8_SB(0, 1), cB + hstep, voffB); PG8_STAGE_A(PG8_SA(0, 0), cA, 0, vAc); PG8_STAGE_A(PG8_SA(0, 1), cA, 1, vAc);
        if (wr == 1) PG8_BAR;
        PG8_WAIT_V(2); PG8_BAR;
        PG8_STAGE(PG8_SB(1, 0), cB + kstep, voffB); PG8_STAGE_A(PG8_SA(1, 0), cA + kstep, 0, vAc); PG8_STAGE(PG8_SB(1, 1), cB + hstep + kstep, voffB);
        PG8_WAIT_V(6); PG8_BAR;
    } else {
        PG8_STAGE(PG8_SB(0, 0), cB, voffB); PG8_STAGE_A(PG8_SA(0, 0), cA, 0, vAc); PG8_STAGE(PG8_SB(0, 1), cB + hstep, voffB); PG8_STAGE_A(PG8_SA(0, 1), cA, 1, vAc);
        if (wr == 1) PG8_BAR;
        PG8_WAIT_V(4); PG8_BAR;
        PG8_STAGE(PG8_SB(1, 0), cB + kstep, voffB); PG8_STAGE_A(PG8_SA(1, 0), cA + kstep, 0, vAc); PG8_STAGE(PG8_SB(1, 1), cB + hstep + kstep, voffB);
        PG8_WAIT_V(6); PG8_BAR;
    }
    for (;;) {
        const char* nA = GATHER ? A0 : (has_next ? A0 + (size_t)nxt.arow * rstep : cA); const char* nB = has_next ? (const char*)g.Bt + (size_t)nxt.brow * rstep : cB;
        for (int t = 0; t < nt; t += 2) {
            const bool last = (t == nt - 2);
            const char* a1 = cA + (size_t)(t + 1) * kstep;
            const char* a2 = last ? nA : cA + (size_t)(t + 2) * kstep; const char* b2 = last ? nB : cB + (size_t)(t + 2) * kstep;
            const char* a3 = a2 + kstep; const char* b3 = b2 + kstep;
            unsigned vS[2][2];
#pragma unroll
            for (int h_ = 0; h_ < 2; ++h_) { vS[h_][0] = last ? vAn[h_][0] : vAc[h_][0]; vS[h_][1] = last ? vAn[h_][1] : vAc[h_][1]; }
            if constexpr (SP2) {
            PG8_LDB(B0, 0, 0); PG8_LDB(B1, 0, 1); PG8_SCHED; PG8_LDA(At, 0, 0); PG8_STAGE_A(PG8_SA(1, 1), a1, 1, vAc);
            PG8_WAIT_V(8); PG8_WAIT_L(0); PG8_BAR; PG8_MMA(0, 0, At, B0); PG8_MMA(0, 1, At, B1); PG8_BAR; PG8_SCHED;
            PG8_LDA(At, 0, 1); PG8_STAGE(PG8_SB(0, 0), b2, voffB); PG8_STAGE(PG8_SB(0, 1), b2 + hstep, voffB); PG8_STAGE_A(PG8_SA(0, 0), a2, 0, vS);
            PG8_WAIT_V(8); PG8_WAIT_L(0); PG8_BAR; PG8_MMA(1, 0, At, B0); PG8_MMA(1, 1, At, B1); PG8_BAR; PG8_SCHED;
            PG8_LDB(B0, 1, 0); PG8_LDB(B1, 1, 1); PG8_SCHED; PG8_LDA(At, 1, 0); PG8_STAGE_A(PG8_SA(0, 1), a2, 1, vS);
            PG8_WAIT_V(8); PG8_WAIT_L(0); PG8_BAR; PG8_MMA(0, 0, At, B0); PG8_MMA(0, 1, At, B1); PG8_BAR; PG8_SCHED;
            PG8_LDA(At, 1, 1); PG8_STAGE(PG8_SB(1, 0), b3, voffB); PG8_STAGE(PG8_SB(1, 1), b3 + hstep, voffB); PG8_STAGE_A(PG8_SA(1, 0), a3, 0, vS);
            PG8_WAIT_V(8); PG8_WAIT_L(0); PG8_BAR; PG8_MMA(1, 0, At, B0); PG8_MMA(1, 1, At, B1); PG8_BAR; PG8_SCHED;
            } else {
            PG8_LDB(B0, 0, 0); PG8_SCHED; PG8_LDA(At, 0, 0); PG8_STAGE_A(PG8_SA(1, 1), a1, 1, vAc);
            PG8_WAIT_L(8); PG8_BAR; PG8_WAIT_L(0); PG8_MMA(0, 0, At, B0); PG8_BAR; PG8_SCHED;
            PG8_LDB(B1, 0, 1); PG8_STAGE(PG8_SB(0, 0), b2, voffB);
            PG8_BAR; PG8_WAIT_L(0); PG8_MMA(0, 1, At, B1); PG8_BAR;
            PG8_LDA(At, 0, 1); PG8_STAGE_A(PG8_SA(0, 0), a2, 0, vS);
            PG8_BAR; PG8_WAIT_L(0); PG8_MMA(1, 0, At, B0); PG8_BAR; PG8_SCHED;
            PG8_STAGE(PG8_SB(0, 1), b2 + hstep, voffB);
            PG8_WAIT_V(6); PG8_BAR; PG8_MMA(1, 1, At, B1); PG8_BAR;
            PG8_LDB(B0, 1, 0); PG8_SCHED; PG8_LDA(At, 1, 0); PG8_STAGE_A(PG8_SA(0, 1), a2, 1, vS);
            PG8_WAIT_L(8); PG8_BAR; PG8_WAIT_L(0); PG8_MMA(0, 0, At, B0); PG8_BAR; PG8_SCHED;
            PG8_LDB(B1, 1, 1); PG8_STAGE(PG8_SB(1, 0), b3, voffB);
            PG8_BAR; PG8_WAIT_L(0); PG8_MMA(0, 1, At, B1); PG8_BAR;
            PG8_LDA(At, 1, 1); PG8_STAGE_A(PG8_SA(1, 0), a3, 0, vS);
            PG8_BAR; PG8_WAIT_L(0); PG8_MMA(1, 0, At, B0); PG8_BAR; PG8_SCHED;
            PG8_STAGE(PG8_SB(1, 1), b3 + hstep, voffB);
            PG8_WAIT_V(6); PG8_BAR; PG8_MMA(1, 1, At, B1); PG8_BAR;
            }
        }
        if constexpr (ALIGN_EPI) { if (wr == 0) PG8_BAR; }
        E(acc, cur, wr, wc, fr, fq);
        if (!has_next) break;
#pragma unroll
        for (int a = 0; a < 2; ++a)
#pragma unroll
            for (int b = 0; b < 2; ++b)
#pragma unroll
                for (int m = 0; m < 4; ++m)
#pragma unroll
                    for (int n = 0; n < 2; ++n) acc[a][b][m][n] = (f32x4){0.f, 0.f, 0.f, 0.f};
        cur = nxt; cA = nA; cB = nB; ++ui;
        has_next = S.next(ui + 1, nxt);
        if constexpr (GATHER) {
#pragma unroll
            for (int h_ = 0; h_ < 2; ++h_) { vAc[h_][0] = vAn[h_][0]; vAc[h_][1] = vAn[h_][1]; }
            if (has_next) { PG8_VOFFS(vAn, nxt); }
        }
        if constexpr (ALIGN_EPI) { if (wr == 1) PG8_BAR; }
    }
    PG8_WAIT_V(0);
    if constexpr (!ALIGN_EPI) { if (wr == 0) PG8_BAR; }
    PG8_BAR;
#undef PG8_SA
#undef PG8_SB
#undef PG8_STAGE
#undef PG8_STAGE_A
#undef PG8_VOFFS
#undef PG8_LDA
#undef PG8_LDB
#undef PG8_MMA
#undef PG8_WAIT_V
#undef PG8_WAIT_L
#undef PG8_BAR
#undef PG8_SCHED
}
}
constexpr int NWAVES = 8;
constexpr int BATCH = 8, SEQ = 4096, D = 1024, NTOK = BATCH * SEQ;
constexpr int HD = 64, NH = 8, WATT = NH * HD;
constexpr int INCOLS = 5120, NMOD = 6;
constexpr int MBLK = 256, NBLK = SEQ / MBLK;
constexpr int NEXP = 32, EPG = 8, NGRP = 4, DEXP = 512;
constexpr float RMS_EPS = 1e-6f;
constexpr float LOG2E = 1.4426950408889634f;
constexpr float C2 = 0.125f * 1.4426950408889634f;
constexpr int LCAP = NTOK;
constexpr int HROWS = 2 * NTOK + NEXP * 256 + 256;

constexpr size_t MiB = 1u << 20;
constexpr size_t WS_CTL = 0, CTL_ZERO_BYTES = 1 * MiB;
constexpr size_t WS_MOD = 1 * MiB;
constexpr size_t WS_BIAS = 1 * MiB + 256 * 1024;
constexpr size_t WS_STATS = 2 * MiB;
constexpr size_t WS_WIN = 4 * MiB;
constexpr size_t WS_WBRA = 14 * MiB, WS_WBRB = 15 * MiB;
constexpr size_t WS_WOUT = 16 * MiB;
constexpr size_t WS_WGU = 18 * MiB;
constexpr size_t WS_WD = 82 * MiB;
constexpr size_t WS_XN = 114 * MiB;
constexpr size_t WS_QA = 178 * MiB, WS_KA = 210 * MiB, WS_VA = 242 * MiB, WS_QB = 274 * MiB, WS_KB = 306 * MiB, WS_VB = 338 * MiB;
constexpr size_t WS_GA = 370 * MiB, WS_GB = 434 * MiB;
constexpr size_t WS_H = 178 * MiB;
constexpr size_t WS_TOKL = 306 * MiB, WS_WL = 314 * MiB;
constexpr size_t WS_END = 498 * MiB;
static_assert(WS_H + (size_t)HROWS * DEXP * 2 <= WS_QB && WS_TOKL + (size_t)2 * NEXP * LCAP * 4 <= WS_WL && WS_WL + (size_t)2 * NEXP * LCAP * 4 <= WS_VB, "d_ws map");
constexpr int CW_TMO = 0, CW_CODE = 1;
constexpr int CW_BAR = 4096;
constexpr int CW_CNT = 16384;
constexpr int CW_KMEAN = 65536;
static_assert((CW_KMEAN + 65536) * 4 <= (int)CTL_ZERO_BYTES && CW_CNT + 64 * 64 <= CW_KMEAN && CW_BAR + 3456 <= CW_CNT, "CTL map");

constexpr int RING_OFF = 0, RING_BYTES = 131072;
constexpr int LDSCTL_OFF = RING_BYTES, MISC_OFF = LDSCTL_OFF + 320;
constexpr int TAB_OFF = RING_BYTES + 1024;
constexpr int LDS_BYTES = 147456;
static_assert(MISC_OFF + 128 <= TAB_OFF && TAB_OFF + 2048 <= LDS_BYTES, "LDS map");

#define GAS __attribute__((address_space(1)))
#define LAS __attribute__((address_space(3)))
typedef unsigned short bf16;
typedef unsigned v4u __attribute__((ext_vector_type(4)));
typedef unsigned v2u __attribute__((ext_vector_type(2)));
typedef float f32x4 __attribute__((ext_vector_type(4)));
typedef short bf16x8 __attribute__((ext_vector_type(8)));
typedef GAS unsigned gu32;
#define RLX_AGENT __ATOMIC_RELAXED, __HIP_MEMORY_SCOPE_AGENT
#define LDS_WAIT() asm volatile("s_waitcnt lgkmcnt(0)" ::: "memory")
#define VM_WAIT() asm volatile("s_waitcnt vmcnt(0)" ::: "memory")
__device__ __forceinline__ unsigned f2bf(float f) { unsigned u = __builtin_bit_cast(unsigned, f); return (u + 0x7fffu + ((u >> 16) & 1u)) >> 16; }
__device__ __forceinline__ unsigned pk2(float lo, float hi) { return f2bf(lo) | (f2bf(hi) << 16); }
__device__ __forceinline__ float bflo(unsigned u) { return __uint_as_float(u << 16); }
__device__ __forceinline__ float bfhi(unsigned u) { return __uint_as_float(u & 0xffff0000u); }
__device__ __forceinline__ float fsigmoid(float v) { return __builtin_amdgcn_rcpf(1.0f + __builtin_amdgcn_exp2f(-v * LOG2E)); }
#define XB_TMO      128
#define XB_XCNT(j)  (256  + 64 * (j))
#define XB_XSUB(j)  (1280 + 64 * (j))
#define XB_XGEN(j)  (2304 + 64 * (j))
#define XB_TOP      3328
#define XB_TOPGEN   3392
#define XCD_BAR_WORDS 3456
#define XB_SPIN_CAP (1u << 22)

__device__ __forceinline__ unsigned xb_ld(unsigned* p)              { return __hip_atomic_load(p, __ATOMIC_RELAXED, __HIP_MEMORY_SCOPE_AGENT); }
__device__ __forceinline__ unsigned xb_add(unsigned* p, unsigned v) { return __hip_atomic_fetch_add(p, v, __ATOMIC_RELAXED, __HIP_MEMORY_SCOPE_AGENT); }
__device__ __forceinline__ unsigned xb_xcc_id() { return (unsigned)__builtin_amdgcn_s_getreg((3 << 11) | 20) & 0xFu; }
#define XB_SPIN(cond, bar) do { unsigned _sp = 0; while (cond) { __builtin_amdgcn_s_sleep(1); \
    if ((++_sp & 255u) == 0u) { if (xb_ld(&(bar)[XB_TMO])) break; if (_sp > XB_SPIN_CAP) { atomicAdd(&(bar)[XB_TMO], 1u); break; } } } } while (0)

struct XcdBarrier {
    unsigned* bar; unsigned x;
    volatile LAS unsigned* st;
};

__device__ __forceinline__ XcdBarrier xcd_barrier_post(unsigned* bar, volatile LAS unsigned* st) {
    XcdBarrier b; b.bar = bar; b.x = xb_xcc_id(); b.st = st;
    if (threadIdx.x == 0) (void)xb_add(&bar[XB_XCNT(b.x)], 1u);
    return b;
}
__device__ __forceinline__ void xcd_barrier_complete(unsigned* bar, unsigned x, unsigned& nloc, unsigned& nx) {
    const unsigned G = gridDim.x * gridDim.y * gridDim.z;
    unsigned sum, cnt, mine, sp = 0u;
    for (;;) {
        sum = 0u; cnt = 0u; mine = 0u;
#pragma unroll
        for (unsigned j = 0; j < 16; ++j) { const unsigned c = xb_ld(&bar[XB_XCNT(j)]); sum += c; cnt += (c > 0u) ? 1u : 0u; mine = (j == x) ? c : mine; }
        if (sum == G) break;
        __builtin_amdgcn_s_sleep(1);
        if ((++sp & 255u) == 0u) { if (xb_ld(&bar[XB_TMO])) break; if (sp > XB_SPIN_CAP) { atomicAdd(&bar[XB_TMO], 1u); break; } }
    }
    nloc = mine > 0u ? mine : 1u; nx = cnt > 0u ? cnt : 1u;
}

__device__ __forceinline__ void xcd_barrier(const XcdBarrier& b) {
    asm volatile("s_waitcnt vmcnt(0)" ::: "memory");
    __syncthreads();
    if (threadIdx.x == 0) {
        unsigned* bar = b.bar;
        __builtin_amdgcn_s_waitcnt(0);
        unsigned nloc = b.st[0], nx = b.st[1];
        if (nloc == 0u) { xcd_barrier_complete(bar, b.x, nloc, nx); b.st[0] = nloc; b.st[1] = nx; }
        const unsigned old = xb_add(&bar[XB_XSUB(b.x)], 1u);
        const unsigned gen = old / nloc;
        if (old + 1u == (gen + 1u) * nloc) {
            __builtin_amdgcn_fence(__ATOMIC_RELEASE, "agent");
            asm volatile("s_waitcnt vmcnt(0)" ::: "memory");
            const unsigned og = xb_add(&bar[XB_TOP], 1u);
            const unsigned tg = og / nx;
            if (og + 1u == (tg + 1u) * nx) xb_add(&bar[XB_TOPGEN], 1u);
            else XB_SPIN(xb_ld(&bar[XB_TOPGEN]) == tg, bar);
            __builtin_amdgcn_fence(__ATOMIC_ACQUIRE, "agent");
            xb_add(&bar[XB_XGEN(b.x)], 1u);
            asm volatile("s_waitcnt vmcnt(0)" ::: "memory");
        } else {
            XB_SPIN(xb_ld(&bar[XB_XGEN(b.x)]) == gen, bar);
            __builtin_amdgcn_fence(__ATOMIC_ACQUIRE, "agent");
            asm volatile("s_waitcnt vmcnt(0)" ::: "memory");
        }
    }
    __syncthreads();
}
namespace pg8 {
struct EpiProj {
    static constexpr bool PERM = true;
    bf16_t* qkv;
    bf16_t* ga; bf16_t* gb;
    const float* gq; const float* gk;
    float* kmean;
    __device__ __forceinline__ void operator()(const f32x4 (&acc)[2][2][4][2], const Unit& u, int wr, int wc, int fr, int fq) const {
        const int pn = u.pn; const int row0 = u.pm * BM + wr * 64 + fr;
        if (pn < 4) {
            const bool isq = pn < 2; const float* gv = isq ? gq : gk; const float post = isq ? C2 : 1.0f;
            bf16_t* base = qkv + (size_t)(pn >> 1) * ((size_t)NTOK * WATT) + (pn & 1) * 256 + wc * 64 + 8 * fq;
            float g[2][2][4];
#pragma unroll
            for (int bj = 0; bj < 2; ++bj)
#pragma unroll
                for (int n = 0; n < 2; ++n) { const f32x4 t = *(const f32x4*)(gv + 32 * bj + 8 * fq + 4 * n); g[bj][n][0] = t[0] * post; g[bj][n][1] = t[1] * post; g[bj][n][2] = t[2] * post; g[bj][n][3] = t[3] * post; }
            float cs[2][2][4];
#pragma unroll
            for (int bj = 0; bj < 2; ++bj)
#pragma unroll
                for (int n = 0; n < 2; ++n)
#pragma unroll
                    for (int e = 0; e < 4; ++e) cs[bj][n][e] = 0.f;
#pragma unroll
            for (int ai = 0; ai < 2; ++ai)
#pragma unroll
                for (int m = 0; m < 4; ++m) {
                    float ss = 0.f;
#pragma unroll
                    for (int bj = 0; bj < 2; ++bj)
#pragma unroll
                        for (int n = 0; n < 2; ++n) { const f32x4 x = acc[ai][bj][m][n]; ss += (x[0] * x[0] + x[1] * x[1]) + (x[2] * x[2] + x[3] * x[3]); }
                    ss += __shfl_xor(ss, 16); ss += __shfl_xor(ss, 32);
                    const float rstd = __builtin_amdgcn_rsqf(ss * (1.0f / 64.0f) + RMS_EPS);
                    bf16_t* rowp = base + (size_t)(row0 + ai * HALF + m * 16) * WATT;
#pragma unroll
                    for (int bj = 0; bj < 2; ++bj) { float o[2][4];
#pragma unroll
                        for (int n = 0; n < 2; ++n)
#pragma unroll
                            for (int e = 0; e < 4; ++e) { o[n][e] = acc[ai][bj][m][n][e] * rstd * g[bj][n][e]; cs[bj][n][e] += o[n][e]; }
                        u32x4 w; w.x = cvt_pk_bf16(o[0][0], o[0][1]); w.y = cvt_pk_bf16(o[0][2], o[0][3]); w.z = cvt_pk_bf16(o[1][0], o[1][1]); w.w = cvt_pk_bf16(o[1][2], o[1][3]);
                        *(u32x4*)(rowp + 32 * bj) = w; }
                }
            if (!isq) {
#pragma unroll
                for (int bj = 0; bj < 2; ++bj)
#pragma unroll
                    for (int n = 0; n < 2; ++n)
#pragma unroll
                        for (int e = 0; e < 4; ++e) { float v = cs[bj][n][e]; v += __shfl_xor(v, 1); v += __shfl_xor(v, 2); v += __shfl_xor(v, 4); v += __shfl_xor(v, 8); cs[bj][n][e] = v; }
                if (fr == 0) { float* kp = kmean + ((size_t)u.pm * NH + (pn & 1) * 4 + wc) * HD + 8 * fq;
#pragma unroll
                    for (int bj = 0; bj < 2; ++bj)
#pragma unroll
                        for (int n = 0; n < 2; ++n)
#pragma unroll
                            for (int e = 0; e < 4; ++e) atomicAdd(kp + 32 * bj + 4 * n + e, cs[bj][n][e]); }
            }
        } else {
            const bool isg = pn >= 12; const float sc = (pn == 6 || pn == 7) ? C2 : 1.0f;
            bf16_t* base; int ldc;
            if (isg) { base = (pn < 16 ? ga : gb) + (pn & 3) * 256 + wc * 64 + 8 * fq; ldc = D; }
            else { base = qkv + (size_t)(pn >> 1) * ((size_t)NTOK * WATT) + (pn & 1) * 256 + wc * 64 + 8 * fq; ldc = WATT; }
#pragma unroll
            for (int ai = 0; ai < 2; ++ai)
#pragma unroll
                for (int m = 0; m < 4; ++m) { bf16_t* rowp = base + (size_t)(row0 + ai * HALF + m * 16) * ldc;
#pragma unroll
                    for (int bj = 0; bj < 2; ++bj) { f32x4 v0 = acc[ai][bj][m][0], v1 = acc[ai][bj][m][1];
                        if (isg) {
#pragma unroll
                            for (int e = 0; e < 4; ++e) { v0[e] = __builtin_amdgcn_rcpf(1.0f + __builtin_amdgcn_exp2f(-v0[e] * LOG2E)); v1[e] = __builtin_amdgcn_rcpf(1.0f + __builtin_amdgcn_exp2f(-v1[e] * LOG2E)); } }
                        else { v0 = v0 * sc; v1 = v1 * sc; }
                        u32x4 w; w.x = cvt_pk_bf16(v0[0], v0[1]); w.y = cvt_pk_bf16(v0[2], v0[3]); w.z = cvt_pk_bf16(v1[0], v1[1]); w.w = cvt_pk_bf16(v1[2], v1[3]);
                        *(u32x4*)(rowp + 32 * bj) = w; } }
        }
    }
};

template <int MODE> struct EpiBranch {
    static constexpr bool PERM = true;
    bf16_t* sg; const bf16_t* tin;
    __device__ __forceinline__ void operator()(const f32x4 (&acc)[2][2][4][2], const Unit& u, int wr, int wc, int fr, int fq) const {
        const int row0 = u.pm * BM + wr * 64 + fr, col0 = u.pn * BM + wc * 32 + 8 * fq;
#pragma unroll
        for (int ai = 0; ai < 2; ++ai)
#pragma unroll
            for (int m = 0; m < 4; ++m) { const size_t off = (size_t)(row0 + ai * HALF + m * 16) * D + col0;
#pragma unroll
                for (int bj = 0; bj < 2; ++bj) { const u32x4 gw = *(const u32x4*)(sg + off + bj * HALF); u32x4 tw = (u32x4){0u, 0u, 0u, 0u}; if (MODE == 1) tw = *(const u32x4*)(tin + off + bj * HALF);
                    const f32x4 v0 = acc[ai][bj][m][0], v1 = acc[ai][bj][m][1]; float o[8];
                    o[0] = bflo(gw.x) * v0[0]; o[1] = bfhi(gw.x) * v0[1]; o[2] = bflo(gw.y) * v0[2]; o[3] = bfhi(gw.y) * v0[3];
                    o[4] = bflo(gw.z) * v1[0]; o[5] = bfhi(gw.z) * v1[1]; o[6] = bflo(gw.w) * v1[2]; o[7] = bfhi(gw.w) * v1[3];
                    if (MODE == 1) { o[0] += bflo(tw.x); o[1] += bfhi(tw.x); o[2] += bflo(tw.y); o[3] += bfhi(tw.y); o[4] += bflo(tw.z); o[5] += bfhi(tw.z); o[6] += bflo(tw.w); o[7] += bfhi(tw.w); }
                    u32x4 w; w.x = cvt_pk_bf16(o[0], o[1]); w.y = cvt_pk_bf16(o[2], o[3]); w.z = cvt_pk_bf16(o[4], o[5]); w.w = cvt_pk_bf16(o[6], o[7]);
                    *(u32x4*)(sg + off + bj * HALF) = w; } }
    }
};

struct EpiResid {
    static constexpr bool PERM = false;
    const float* x; float* out; const float* gt;
    float* stats;
    __device__ __forceinline__ void operator()(const f32x4 (&acc)[2][2][4][2], const Unit& u, int wr, int wc, int fr, int fq) const {
        const int row0 = u.pm * BM + wr * 64 + fr, col0 = u.pn * BM + wc * 32 + 4 * fq; const int b = (u.pm * BM) / SEQ;
        f32x4 gv[2][2];
#pragma unroll
        for (int bj = 0; bj < 2; ++bj)
#pragma unroll
            for (int n = 0; n < 2; ++n) gv[bj][n] = *(const f32x4*)(gt + (size_t)b * (NMOD * D) + col0 + bj * HALF + n * 16);
#pragma unroll
        for (int ai = 0; ai < 2; ++ai)
#pragma unroll
            for (int m = 0; m < 4; ++m) { const int row = row0 + ai * HALF + m * 16; const size_t off = (size_t)row * D + col0; float ss = 0.f;
#pragma unroll
                for (int bj = 0; bj < 2; ++bj)
#pragma unroll
                    for (int n = 0; n < 2; ++n) { const f32x4 xv = *(const f32x4*)(x + off + bj * HALF + n * 16); const f32x4 o = xv + gv[bj][n] * acc[ai][bj][m][n];
                        *(f32x4*)(out + off + bj * HALF + n * 16) = o; ss += (o[0] * o[0] + o[1] * o[1]) + (o[2] * o[2] + o[3] * o[3]); }
                ss += __shfl_xor(ss, 16); ss += __shfl_xor(ss, 32);
                if (fq == 0) stats[(size_t)row * 16 + u.pn * 4 + wc] = ss; }
    }
};

struct EpiGateUp {
    static constexpr bool PERM = true;
    bf16_t* H;
    __device__ __forceinline__ void operator()(const f32x4 (&acc)[2][2][4][2], const Unit& u, int wr, int wc, int fr, int fq) const {
        bf16_t* base = H + (size_t)(u.arow + wr * 64 + fr) * DEXP + u.pn * 128 + wc * 32 + 8 * fq;
#pragma unroll
        for (int ai = 0; ai < 2; ++ai)
#pragma unroll
            for (int m = 0; m < 4; ++m) { float o[8];
#pragma unroll
                for (int n = 0; n < 2; ++n)
#pragma unroll
                    for (int e = 0; e < 4; ++e) { const float gg = acc[ai][0][m][n][e], uu = acc[ai][1][m][n][e]; o[4 * n + e] = gg * __builtin_amdgcn_rcpf(1.0f + __builtin_amdgcn_exp2f(-gg * LOG2E)) * uu; }
                u32x4 w; w.x = cvt_pk_bf16(o[0], o[1]); w.y = cvt_pk_bf16(o[2], o[3]); w.z = cvt_pk_bf16(o[4], o[5]); w.w = cvt_pk_bf16(o[6], o[7]);
                *(u32x4*)(base + (size_t)(ai * HALF + m * 16) * DEXP) = w; }
    }
};

struct EpiDown {
    static constexpr bool PERM = false;
    float* out; const float* gt;
    const int* tl; const float* wl;
    __device__ __forceinline__ void operator()(const f32x4 (&acc)[2][2][4][2], const Unit& u, int wr, int wc, int fr, int fq) const {
        const int col0 = u.pn * BM + wc * 32 + 4 * fq;
#pragma unroll
        for (int ai = 0; ai < 2; ++ai)
#pragma unroll
            for (int m = 0; m < 4; ++m) { const int r = ai * HALF + wr * 64 + m * 16 + fr;
                if (r < u.x1) { const int tok = tl[u.x0 + r]; const float w = wl[u.x0 + r]; const int b = tok / SEQ; const size_t off = (size_t)tok * D + col0;
#pragma unroll
                    for (int bj = 0; bj < 2; ++bj)
#pragma unroll
                        for (int n = 0; n < 2; ++n) { const f32x4 gv = *(const f32x4*)(gt + (size_t)b * (NMOD * D) + col0 + bj * HALF + n * 16); float* p = out + off + bj * HALF + n * 16;
                            const f32x4 ov = *(const f32x4*)p; *(f32x4*)p = ov + gv * (acc[ai][bj][m][n] * w); } } }
    }
};

struct GateUpOrder {
    const PG8_LAS int* T; const int* tokl; int G, c;
    __device__ bool next(int i, Unit& u) const {
        const int L = i * G + c; const int total = T[64 + 32] * 4; if (L >= total) return false;
        const int rt = L >> 2; int e = 0; while (T[64 + e + 1] <= rt) ++e;
        const int lt = rt - T[64 + e];
        u.pm = lt; u.pn = L & 3; u.x0 = e; u.x1 = 0; u.arow = T[128 + e] + lt * 256; u.brow = e * 1024 + (L & 3) * 256; return true;
    }
    __device__ __forceinline__ int arow_of(const Unit& u, int r) const {
        const int idx = u.pm * 256 + r, c0 = T[u.x0], c1 = T[32 + u.x0];
        int tok = 0;
        if (idx < c0) tok = tokl[(size_t)u.x0 * LCAP + idx]; else if (idx < c0 + c1) tok = tokl[(size_t)(NEXP + u.x0) * LCAP + idx - c0];
        return tok;
    }
};
template <int SLOT> struct DownOrder {
    const PG8_LAS int* T; int G, c;
    __device__ bool next(int i, Unit& u) const {
        const int PO = SLOT ? 256 : 192; const int L = i * G + c; const int total = T[PO + 32] * 4; if (L >= total) return false;
        const int rt = L >> 2; int e = 0; while (T[PO + e + 1] <= rt) ++e;
        const int lt = rt - T[PO + e]; const int cs = T[SLOT * 32 + e]; const int rem = cs - lt * 256;
        u.pm = lt; u.pn = L & 3; u.x0 = (SLOT * NEXP + e) * LCAP + lt * 256; u.x1 = rem < 256 ? rem : 256;
        u.arow = T[128 + e] + (SLOT ? T[e] : 0) + lt * 256; u.brow = e * 1024 + (L & 3) * 256; return true;
    }
    __device__ __forceinline__ int arow_of(const Unit&, int) const { return 0; }
};
}
struct Frame {
    LAS unsigned char* lds;
    volatile LAS unsigned* MISC;
    gu32* ctl;
    int tid, lane, wave;
    int vcu, G;
    const float *x, *c, *w_ada, *b_ada, *g_mix, *w_in, *g_q, *g_k, *rel_bias, *w_br_moba, *w_br_sb, *w_out, *g_ffn, *w_rg, *b_rg, *w_re, *b_re, *w_gate, *w_up, *w_down;
    float* out;
    float *mod, *biasT, *stats, *kmean;
    bf16 *Win_t, *Wbra_t, *Wbrb_t, *Wout_t, *Wgu_t, *Wd_t;
    bf16 *XN, *QA, *KA, *VA, *QB, *KB, *VB, *GA, *GB, *H;
    int* tokl; float* wl; unsigned* cnt;
};
__device__ __forceinline__ float wave_sum(float v) {
#pragma unroll
    for (int o = 1; o < 64; o <<= 1) v += __shfl_xor(v, o);
    return v;
}
__device__ __forceinline__ int lane_zero() { int z; asm volatile("v_mov_b32 %0, 0" : "=v"(z)); return z; }

__device__ __forceinline__ void p0_transpose_item(const float* W, int K, int N, bf16* WT, int k0, int n0, int drow0, LAS float* scr, int lane) {
#pragma unroll 8
    for (int i = 0; i < 32; ++i) { const int kk = 2 * i + (lane >> 5); scr[kk * 33 + (lane & 31)] = W[(size_t)(k0 + kk) * N + n0 + (lane & 31)]; }
    LDS_WAIT(); asm volatile("" ::: "memory");
    const int c = lane & 7;
#pragma unroll
    for (int j = 0; j < 4; ++j) { const int n = (lane >> 3) + 8 * j; const LAS float* s = scr + (8 * c) * 33 + n;
        v4u o; o.x = pk2(s[0 * 33], s[1 * 33]); o.y = pk2(s[2 * 33], s[3 * 33]); o.z = pk2(s[4 * 33], s[5 * 33]); o.w = pk2(s[6 * 33], s[7 * 33]);
        *(GAS v4u*)(WT + (size_t)(drow0 + n) * K + k0 + 8 * c) = o; }
    LDS_WAIT(); asm volatile("" ::: "memory");
}

__device__ __forceinline__ void p0_prologue(Frame& F) {
    {
        LAS float* sc = (LAS float*)(F.lds + RING_OFF);
        LAS float* part = (LAS float*)(F.lds + RING_OFF + 32768);
        for (int i = F.tid; i < BATCH * D; i += NWAVES * 64) { const float v = F.c[i]; sc[i] = v * fsigmoid(v); }
        __syncthreads();
        for (int chunk = F.vcu; chunk < 256; chunk += F.G) {
            const int kp = F.tid / 24, cI = F.tid % 24;
            if (kp < 21) {
                float a[8];
#pragma unroll
                for (int b = 0; b < 8; ++b) a[b] = 0.f;
                const int k0 = kp * 49, k1 = (k0 + 49 < D) ? k0 + 49 : D;
                for (int k = k0; k < k1; ++k) { const float w = F.w_ada[(size_t)k * (NMOD * D) + chunk * 24 + cI];
#pragma unroll
                    for (int b = 0; b < 8; ++b) a[b] += sc[b * D + k] * w; }
#pragma unroll
                for (int b = 0; b < 8; ++b) part[(kp * 24 + cI) * 8 + b] = a[b];
            }
            __syncthreads();
            if (F.tid < 192) { const int cI2 = F.tid % 24, b = F.tid / 24; float s = 0.f;
                for (int kp2 = 0; kp2 < 21; ++kp2) s += part[(kp2 * 24 + cI2) * 8 + b];
                const int col = chunk * 24 + cI2; F.mod[(size_t)b * (NMOD * D) + col] = s + F.b_ada[col]; }
            __syncthreads();
        }
    }
    const int gw = F.vcu * NWAVES + F.wave, NGW = F.G * NWAVES;
    for (int i = gw * 64 + F.lane; i < NH * SEQ; i += NGW * 64) { const int h = i / SEQ, n = i % SEQ; int bk;
        if (n < 16) bk = n; else { const float nf = (float)n; int lg = 16 + (int)(logf(nf / 16.0f) / 4.1588830833596715f * 16.0f); bk = lg < 31 ? lg : 31; }
        F.biasT[i] = F.rel_bias[h * 32 + bk] * LOG2E; }
    LAS float* scr = (LAS float*)(F.lds + RING_OFF + F.wave * 16384);
    constexpr int I_IN = (D / 64) * (INCOLS / 32), I_BR = (WATT / 64) * (D / 32), I_OUT = (D / 64) * (D / 32), I_G = NEXP * (D / 64) * (DEXP / 32), I_D = NEXP * (DEXP / 64) * (D / 32);
    constexpr int NITEMS = I_IN + 2 * I_BR + I_OUT + 2 * I_G + I_D;
    for (int it = gw; it < NITEMS; it += NGW) {
        int r = it;
        if (r < I_IN) { const int nblk = INCOLS / 32, kb = r / nblk, nb = r % nblk, n0 = 32 * nb, t = n0 & 255;
            const int p0 = 128 * ((t >> 5) & 1) + 32 * (t >> 6);
            p0_transpose_item(F.w_in, D, INCOLS, F.Win_t, 64 * kb, n0, (n0 - t) + p0, scr, F.lane); continue; } r -= I_IN;
        if (r < I_BR) { const int nblk = D / 32, kb = r / nblk, nb = r % nblk; p0_transpose_item(F.w_br_moba, WATT, D, F.Wbra_t, 64 * kb, 32 * nb, 32 * nb, scr, F.lane); continue; } r -= I_BR;
        if (r < I_BR) { const int nblk = D / 32, kb = r / nblk, nb = r % nblk; p0_transpose_item(F.w_br_sb, WATT, D, F.Wbrb_t, 64 * kb, 32 * nb, 32 * nb, scr, F.lane); continue; } r -= I_BR;
        if (r < I_OUT) { const int nblk = D / 32, kb = r / nblk, nb = r % nblk; p0_transpose_item(F.w_out, D, D, F.Wout_t, 64 * kb, 32 * nb, 32 * nb, scr, F.lane); continue; } r -= I_OUT;
        if (r < 2 * I_G) { const int up = r >= I_G; if (up) r -= I_G; constexpr int per = (D / 64) * (DEXP / 32); const int e = r / per, q = r % per, nblk = DEXP / 32, kb = q / nblk, nb = q % nblk, n0 = 32 * nb;
            p0_transpose_item((up ? F.w_up : F.w_gate) + (size_t)e * D * DEXP, D, DEXP, F.Wgu_t, 64 * kb, n0, e * 1024 + 256 * (n0 >> 7) + (up ? 128 : 0) + (n0 & 127), scr, F.lane); continue; } r -= 2 * I_G;
        { constexpr int per = (DEXP / 64) * (D / 32); const int e = r / per, q = r % per, nblk = D / 32, kb = q / nblk, nb = q % nblk;
            p0_transpose_item(F.w_down + (size_t)e * DEXP * D, DEXP, D, F.Wd_t, 64 * kb, 32 * nb, e * 1024 + 32 * nb, scr, F.lane); }
    }
}

__device__ __forceinline__ void p1_norm(Frame& F) {
    const int gw = F.vcu * NWAVES + F.wave, NGW = F.G * NWAVES;
    for (int m = gw; m < NTOK; m += NGW) {
        const int b = m / SEQ;
        const GAS f32x4* xr = (const GAS f32x4*)(F.x + (size_t)m * D) + F.lane;
        const GAS f32x4* gr = (const GAS f32x4*)F.g_mix + F.lane;
        const GAS f32x4* shr = (const GAS f32x4*)(F.mod + (size_t)b * (NMOD * D)) + F.lane;
        const GAS f32x4* scr = (const GAS f32x4*)(F.mod + (size_t)b * (NMOD * D) + D) + F.lane;
        f32x4 v[4]; float s = 0.f;
#pragma unroll
        for (int j = 0; j < 4; ++j) { v[j] = xr[64 * j]; s += (v[j].x * v[j].x + v[j].y * v[j].y) + (v[j].z * v[j].z + v[j].w * v[j].w); }
        const float rstd = __builtin_amdgcn_rsqf(wave_sum(s) * (1.f / D) + RMS_EPS);
        GAS unsigned long long* o8 = (GAS unsigned long long*)(F.XN + (size_t)m * D) + F.lane;
#pragma unroll
        for (int j = 0; j < 4; ++j) { const f32x4 g = gr[64 * j], sh = shr[64 * j], sc = scr[64 * j]; const f32x4 y = (v[j] * rstd * g) * (sc + 1.0f) + sh;
            o8[64 * j] = (unsigned long long)pk2(y.x, y.y) | ((unsigned long long)pk2(y.z, y.w) << 32); }
    }
}

__device__ __forceinline__ float dot64(const unsigned (&q)[32], const v4u (&k)[8]) {
    float a0 = 0.f, a1 = 0.f;
#pragma unroll
    for (int i = 0; i < 8; ++i) {
        a0 += bflo(q[4 * i]) * bflo(k[i].x) + bflo(q[4 * i + 1]) * bflo(k[i].y) + bflo(q[4 * i + 2]) * bflo(k[i].z) + bflo(q[4 * i + 3]) * bflo(k[i].w);
        a1 += bfhi(q[4 * i]) * bfhi(k[i].x) + bfhi(q[4 * i + 1]) * bfhi(k[i].y) + bfhi(q[4 * i + 2]) * bfhi(k[i].z) + bfhi(q[4 * i + 3]) * bfhi(k[i].w); }
    return a0 + a1;
}
#define LOADROW(dst, p) do { _Pragma("unroll") for (int i_ = 0; i_ < 8; ++i_) dst[i_] = ((const GAS v4u*)(p))[i_]; } while (0)
#define AXPY64(o, p, v) do { _Pragma("unroll") for (int i_ = 0; i_ < 8; ++i_) { \
    o[8 * i_ + 0] += p * bflo(v[i_].x); o[8 * i_ + 1] += p * bfhi(v[i_].x); o[8 * i_ + 2] += p * bflo(v[i_].y); o[8 * i_ + 3] += p * bfhi(v[i_].y); \
    o[8 * i_ + 4] += p * bflo(v[i_].z); o[8 * i_ + 5] += p * bfhi(v[i_].z); o[8 * i_ + 6] += p * bflo(v[i_].w); o[8 * i_ + 7] += p * bfhi(v[i_].w); } } while (0)
#define STOREO(ptr, o, sc) do { _Pragma("unroll") for (int i_ = 0; i_ < 8; ++i_) { v4u w_; w_.x = pk2(o[8 * i_] * sc, o[8 * i_ + 1] * sc); w_.y = pk2(o[8 * i_ + 2] * sc, o[8 * i_ + 3] * sc); \
    w_.z = pk2(o[8 * i_ + 4] * sc, o[8 * i_ + 5] * sc); w_.w = pk2(o[8 * i_ + 6] * sc, o[8 * i_ + 7] * sc); ((GAS v4u*)(ptr))[i_] = w_; } } while (0)

__device__ __forceinline__ void moba_naive_item(Frame& F, int item) {
    const int bh = item >> 6, ch = item & 63, b = bh >> 3, h = bh & 7, lz = lane_zero();
    const int t = ch * 64 + F.lane, own = ch >> 2, tl = t & 255;
    const size_t rowb = (size_t)b * SEQ;
    unsigned q[32]; { v4u t4[8]; LOADROW(t4, F.QA + (rowb + t) * WATT + h * HD);
#pragma unroll
        for (int i = 0; i < 8; ++i) { q[4 * i] = t4[i].x; q[4 * i + 1] = t4[i].y; q[4 * i + 2] = t4[i].z; q[4 * i + 3] = t4[i].w; } }
    float v0 = -INFINITY, v1 = -INFINITY, v2 = -INFINITY; int i0 = 0, i1 = 0, i2 = 0;
    for (int j = 0; j < own; ++j) {
        const GAS f32x4* km = (const GAS f32x4*)(F.kmean + ((size_t)(b * NBLK + j) * NH + h) * HD + lz);
        float g = 0.f;
#pragma unroll
        for (int i = 0; i < 16; ++i) { const f32x4 kv = km[i]; g += bflo(q[2 * i]) * kv.x + bfhi(q[2 * i]) * kv.y + bflo(q[2 * i + 1]) * kv.z + bfhi(q[2 * i + 1]) * kv.w; }
        if (g > v0) { v2 = v1; i2 = i1; v1 = v0; i1 = i0; v0 = g; i0 = j; } else if (g > v1) { v2 = v1; i2 = i1; v1 = g; i1 = j; } else if (g > v2) { v2 = g; i2 = j; }
    }
    float m = -INFINITY, l = 0.f; float o[64];
#pragma unroll
    for (int i = 0; i < 64; ++i) o[i] = 0.f;
    const float* bt = F.biasT + h * SEQ;
    const int nsel = own < 3 ? own : 3;
    for (int sl = 0; sl < nsel; ++sl) {
        const int blk = sl == 0 ? i0 : (sl == 1 ? i1 : i2);
        const bf16* kp = F.KA + (rowb + blk * MBLK) * WATT + h * HD; const bf16* vp = F.VA + (rowb + blk * MBLK) * WATT + h * HD;
        const int dist0 = t - blk * MBLK;
        for (int s = 0; s < MBLK; ++s) {
            v4u kk[8]; LOADROW(kk, kp + (size_t)s * WATT); const float sc = dot64(q, kk) + bt[dist0 - s];
            const float mn = fmaxf(m, sc), al = __builtin_amdgcn_exp2f(m - mn), p = __builtin_amdgcn_exp2f(sc - mn);
            l = l * al + p; m = mn;
#pragma unroll
            for (int i = 0; i < 64; ++i) o[i] *= al;
            v4u vv[8]; LOADROW(vv, vp + (size_t)s * WATT); AXPY64(o, p, vv);
        }
    }
    {
        const bf16* kp = F.KA + (rowb + own * MBLK) * WATT + h * HD + lz; const bf16* vp = F.VA + (rowb + own * MBLK) * WATT + h * HD + lz;
        const int smax = (ch & 3) * 64 + 63;
        for (int s = 0; s <= smax; ++s) {
            v4u kk[8]; LOADROW(kk, kp + (size_t)s * WATT); const int dist = tl - s; const float sc = dot64(q, kk) + bt[dist > 0 ? dist : 0];
            if (dist >= 0) {
                const float mn = fmaxf(m, sc), al = __builtin_amdgcn_exp2f(m - mn), p = __builtin_amdgcn_exp2f(sc - mn);
                l = l * al + p; m = mn;
#pragma unroll
                for (int i = 0; i < 64; ++i) o[i] *= al;
                v4u vv[8]; LOADROW(vv, vp + (size_t)s * WATT); AXPY64(o, p, vv);
            }
        }
    }
    const float rl = 1.0f / l;
    STOREO(F.QA + (rowb + t) * WATT + h * HD, o, rl);
}
__device__ __forceinline__ void sb_naive_item(Frame& F, int item) {
    const int bh = item >> 6, ch = item & 63, b = bh >> 3, h = bh & 7, lz = lane_zero();
    const int t = ch * 64 + F.lane;
    const size_t rowb = (size_t)b * SEQ;
    unsigned q[32]; { v4u t4[8]; LOADROW(t4, F.QB + (rowb + t) * WATT + h * HD);
#pragma unroll
        for (int i = 0; i < 8; ++i) { q[4 * i] = t4[i].x; q[4 * i + 1] = t4[i].y; q[4 * i + 2] = t4[i].z; q[4 * i + 3] = t4[i].w; } }
    float c = 1.0f; float o[64];
#pragma unroll
    for (int i = 0; i < 64; ++i) o[i] = 0.f;
    const bf16* kp = F.KB + rowb * WATT + h * HD + lz; const bf16* vp = F.VB + rowb * WATT + h * HD + lz;
    for (int s = ch * 64 + 62; s >= 0; --s) {
        v4u kk[8]; LOADROW(kk, kp + (size_t)s * WATT); const float e = __builtin_amdgcn_exp2f(dot64(q, kk)); const float r = 1.0f / (1.0f + e);
        if (s < t) { const float a = e * r * c; c *= r; v4u vv[8]; LOADROW(vv, vp + (size_t)s * WATT); AXPY64(o, a, vv); }
    }
    STOREO(F.QB + (rowb + t) * WATT + h * HD, o, 1.0f);
}
__device__ __forceinline__ void p3_attn_naive(Frame& F) {
    const int gw = F.vcu * NWAVES + F.wave, NGW = F.G * NWAVES;
    for (int p = gw; p < 2048; p += NGW) { const int bh = p >> 5, j = p & 31;
        sb_naive_item(F, bh * 64 + j); sb_naive_item(F, bh * 64 + 63 - j); }
    for (int p = gw; p < 2048; p += NGW) { const int bh = p >> 5, j = p & 31;
        moba_naive_item(F, bh * 64 + j); moba_naive_item(F, bh * 64 + 63 - j); }
}

__device__ __forceinline__ void p6_route(Frame& F) {
    const int gw = F.vcu * NWAVES + F.wave, NGW = F.G * NWAVES;
    for (int m = gw; m < NTOK; m += NGW) {
        const int b = m / SEQ;
        const GAS f32x4* xr = (const GAS f32x4*)(F.out + (size_t)m * D) + F.lane;
        const GAS f32x4* gr = (const GAS f32x4*)F.g_ffn + F.lane;
        const GAS f32x4* shr = (const GAS f32x4*)(F.mod + (size_t)b * (NMOD * D) + 3 * D) + F.lane;
        const GAS f32x4* scr = (const GAS f32x4*)(F.mod + (size_t)b * (NMOD * D) + 4 * D) + F.lane;
        float ss = 0.f; { const GAS f32x4* sp = (const GAS f32x4*)(F.stats + (size_t)m * 16);
#pragma unroll
            for (int j = 0; j < 4; ++j) { const f32x4 s4 = sp[j]; ss += (s4.x + s4.y) + (s4.z + s4.w); } }
        const float rstd = __builtin_amdgcn_rsqf(ss * (1.f / D) + RMS_EPS);
        f32x4 y[4];
        GAS unsigned long long* o8 = (GAS unsigned long long*)(F.XN + (size_t)m * D) + F.lane;
#pragma unroll
        for (int j = 0; j < 4; ++j) { const f32x4 v = xr[64 * j], g = gr[64 * j], sh = shr[64 * j], sc = scr[64 * j]; y[j] = (v * rstd * g) * (sc + 1.0f) + sh;
            o8[64 * j] = (unsigned long long)pk2(y[j].x, y[j].y) | ((unsigned long long)pk2(y[j].z, y[j].w) << 32); }
        float gl[4] = {0.f, 0.f, 0.f, 0.f};
#pragma unroll
        for (int j = 0; j < 4; ++j) { const GAS f32x4* wp = (const GAS f32x4*)(F.w_rg + (size_t)(4 * F.lane + 256 * j) * NGRP);
#pragma unroll
            for (int e = 0; e < 4; ++e) { const f32x4 w = wp[e]; const float yv = y[j][e]; gl[0] += yv * w.x; gl[1] += yv * w.y; gl[2] += yv * w.z; gl[3] += yv * w.w; } }
#pragma unroll
        for (int g = 0; g < 4; ++g) gl[g] = wave_sum(gl[g]) + F.b_rg[g];
        int gi = 0; float gm = gl[0];
#pragma unroll
        for (int g = 1; g < 4; ++g) if (gl[g] > gm) { gm = gl[g]; gi = g; }
        float den = 0.f;
#pragma unroll
        for (int g = 0; g < 4; ++g) den += __expf(gl[g] - gm);
        const float gwt = 1.0f / den;
        float el[8] = {0.f, 0.f, 0.f, 0.f, 0.f, 0.f, 0.f, 0.f};
#pragma unroll
        for (int j = 0; j < 4; ++j)
#pragma unroll
            for (int e = 0; e < 4; ++e) { const GAS f32x4* wp = (const GAS f32x4*)(F.w_re + (size_t)(4 * F.lane + 256 * j + e) * NEXP + gi * EPG); const f32x4 w0 = wp[0], w1 = wp[1]; const float yv = y[j][e];
                el[0] += yv * w0.x; el[1] += yv * w0.y; el[2] += yv * w0.z; el[3] += yv * w0.w; el[4] += yv * w1.x; el[5] += yv * w1.y; el[6] += yv * w1.z; el[7] += yv * w1.w; }
#pragma unroll
        for (int k = 0; k < 8; ++k) el[k] = wave_sum(el[k]) + F.b_re[gi * EPG + k];
        int k1 = 0; float t1 = el[0];
#pragma unroll
        for (int k = 1; k < 8; ++k) if (el[k] > t1) { t1 = el[k]; k1 = k; }
        int k2 = -1; float t2 = -INFINITY;
#pragma unroll
        for (int k = 0; k < 8; ++k) if (k != k1 && el[k] > t2) { t2 = el[k]; k2 = k; }
        const float ex = __expf(t2 - t1); const float w1v = gwt / (1.0f + ex), w2v = gwt * ex / (1.0f + ex);
        if (F.lane < 2) { const int e = gi * EPG + (F.lane == 0 ? k1 : k2); const float w = F.lane == 0 ? w1v : w2v;
            const unsigned pos = __hip_atomic_fetch_add(F.cnt + (F.lane * NEXP + e) * 64, 1u, __ATOMIC_RELAXED, __HIP_MEMORY_SCOPE_AGENT);
            F.tokl[(size_t)(F.lane * NEXP + e) * LCAP + pos] = m; F.wl[(size_t)(F.lane * NEXP + e) * LCAP + pos] = w; }
    }
}
__device__ __forceinline__ void moe_tables(Frame& F) {
    LAS int* T = (LAS int*)(F.lds + TAB_OFF);
    if (F.tid < 64) T[F.tid] = (int)__hip_atomic_load(F.cnt + F.tid * 64, RLX_AGENT);
    __syncthreads();
    if (F.tid == 0) { int pa = 0, hs = 0, p0 = 0, p1 = 0;
        for (int e = 0; e < NEXP; ++e) { const int c0 = T[e], c1 = T[32 + e], ta = (c0 + c1 + 255) >> 8;
            T[64 + e] = pa; T[128 + e] = hs; T[192 + e] = p0; T[256 + e] = p1; pa += ta; hs += ta * 256; p0 += (c0 + 255) >> 8; p1 += (c1 + 255) >> 8; }
        T[64 + 32] = pa; T[128 + 32] = hs; T[192 + 32] = p0; T[256 + 32] = p1; }
    __syncthreads();
}
#ifndef MK_N_LAUNCHES
#define MK_N_LAUNCHES 10
#endif
constexpr int N_PHASES = 10;
constexpr int N_LAUNCHES = MK_N_LAUNCHES;
static_assert(N_LAUNCHES == 1 || N_LAUNCHES == N_PHASES, "MK_N_LAUNCHES is 1 or N_PHASES");
struct Args { const float* in[20]; float* out; unsigned char* ws; int ph_lo, ph_hi; };
__global__ void __launch_bounds__(NWAVES * 64, 2) fwd(Args args) {
    extern __shared__ __attribute__((aligned(16))) unsigned char lds[];
    Frame F;
    F.lds = (LAS unsigned char*)lds;
    F.MISC = (volatile LAS unsigned*)(F.lds + MISC_OFF);
    F.tid = threadIdx.x; F.lane = F.tid & 63; F.wave = __builtin_amdgcn_readfirstlane(F.tid >> 6);
    F.G = gridDim.x; { const int bx = blockIdx.x; F.vcu = (F.G % 8 == 0) ? (bx % 8) * (F.G / 8) + bx / 8 : bx; }
    unsigned char* ws = args.ws;
    F.ctl = (gu32*)(ws + WS_CTL);
    F.x = args.in[0]; F.c = args.in[1]; F.w_ada = args.in[2]; F.b_ada = args.in[3]; F.g_mix = args.in[4]; F.w_in = args.in[5]; F.g_q = args.in[6]; F.g_k = args.in[7]; F.rel_bias = args.in[8];
    F.w_br_moba = args.in[9]; F.w_br_sb = args.in[10]; F.w_out = args.in[11]; F.g_ffn = args.in[12]; F.w_rg = args.in[13]; F.b_rg = args.in[14]; F.w_re = args.in[15]; F.b_re = args.in[16];
    F.w_gate = args.in[17]; F.w_up = args.in[18]; F.w_down = args.in[19]; F.out = args.out;
    F.mod = (float*)(ws + WS_MOD); F.biasT = (float*)(ws + WS_BIAS); F.stats = (float*)(ws + WS_STATS); F.kmean = (float*)(ws + WS_CTL) + CW_KMEAN;
    F.Win_t = (bf16*)(ws + WS_WIN); F.Wbra_t = (bf16*)(ws + WS_WBRA); F.Wbrb_t = (bf16*)(ws + WS_WBRB); F.Wout_t = (bf16*)(ws + WS_WOUT); F.Wgu_t = (bf16*)(ws + WS_WGU); F.Wd_t = (bf16*)(ws + WS_WD);
    F.XN = (bf16*)(ws + WS_XN); F.QA = (bf16*)(ws + WS_QA); F.KA = (bf16*)(ws + WS_KA); F.VA = (bf16*)(ws + WS_VA); F.QB = (bf16*)(ws + WS_QB); F.KB = (bf16*)(ws + WS_KB); F.VB = (bf16*)(ws + WS_VB);
    F.GA = (bf16*)(ws + WS_GA); F.GB = (bf16*)(ws + WS_GB); F.H = (bf16*)(ws + WS_H);
    F.tokl = (int*)(ws + WS_TOKL); F.wl = (float*)(ws + WS_WL); F.cnt = (unsigned*)(ws + WS_CTL) + CW_CNT;
    for (int u = F.tid; u < (LDS_BYTES - LDSCTL_OFF) / 4; u += NWAVES * 64) ((LAS unsigned*)(F.lds + LDSCTL_OFF))[u] = 0u;
    __syncthreads();
    XcdBarrier bar; bar.bar = (unsigned*)(F.ctl + CW_BAR); bar.x = 0; bar.st = nullptr;
    if (N_LAUNCHES == 1) bar = xcd_barrier_post((unsigned*)(F.ctl + CW_BAR), F.MISC + 8);
#define GRID_BAR() do { if (N_LAUNCHES == 1) { xcd_barrier(bar); } } while (0)
    const int lo = args.ph_lo, hi = args.ph_hi;
#define IN(k) (lo <= (k) && (k) < hi)
#define BOTH(k) (IN(k) && IN((k) + 1))

    if (IN(0)) { p0_prologue(F); if (BOTH(0)) GRID_BAR(); }
    if (IN(1)) { p1_norm(F); if (BOTH(1)) GRID_BAR(); }
    if (IN(2)) {
        __syncthreads();
        pg8::Gemm g{F.XN, F.Win_t, D}; pg8::DenseOrder S; S.init(NTOK, INCOLS, F.G, (int)blockIdx.x);
        pg8::EpiProj E{F.QA, F.GA, F.GB, F.g_q, F.g_k, F.kmean};
        pg8::gemm_phase<pg8::EpiProj, pg8::DenseOrder, false>(F.lds + RING_OFF, g, S, E);
        if (BOTH(2)) GRID_BAR();
    }
    if (IN(3)) { p3_attn_naive(F); if (BOTH(3)) GRID_BAR(); }
    if (IN(4)) {
        __syncthreads();
        { pg8::Gemm g{F.QA, F.Wbra_t, WATT}; pg8::DenseOrder S; S.init(NTOK, D, F.G, (int)blockIdx.x);
          pg8::EpiBranch<0> E{F.GA, nullptr};
          pg8::gemm_phase<pg8::EpiBranch<0>, pg8::DenseOrder, false>(F.lds + RING_OFF, g, S, E); }
        { pg8::Gemm g{F.QB, F.Wbrb_t, WATT}; pg8::DenseOrder S; S.init(NTOK, D, F.G, (int)blockIdx.x);
          pg8::EpiBranch<1> E{F.GB, F.GA};
          pg8::gemm_phase<pg8::EpiBranch<1>, pg8::DenseOrder, false>(F.lds + RING_OFF, g, S, E); }
        if (BOTH(4)) GRID_BAR();
    }
    if (IN(5)) {
        __syncthreads();
        pg8::Gemm g{F.GB, F.Wout_t, D}; pg8::DenseOrder S; S.init(NTOK, D, F.G, (int)blockIdx.x);
        pg8::EpiResid E{F.x, F.out, F.mod + 2 * D, F.stats};
        pg8::gemm_phase<pg8::EpiResid, pg8::DenseOrder, false>(F.lds + RING_OFF, g, S, E);
        if (BOTH(5)) GRID_BAR();
    }
    if (IN(6)) { p6_route(F); if (BOTH(6)) GRID_BAR(); }
    if (IN(7)) {
        moe_tables(F);
        pg8::Gemm g{F.XN, F.Wgu_t, D}; pg8::GateUpOrder S{(const LAS int*)(F.lds + TAB_OFF), F.tokl, F.G, (int)blockIdx.x};
        pg8::EpiGateUp E{F.H};
        pg8::gemm_phase<pg8::EpiGateUp, pg8::GateUpOrder, true>(F.lds + RING_OFF, g, S, E);
        if (BOTH(7)) GRID_BAR();
    }
    if (IN(8)) {
        moe_tables(F);
        pg8::Gemm g{F.H, F.Wd_t, DEXP}; pg8::DownOrder<0> S{(const LAS int*)(F.lds + TAB_OFF), F.G, (int)blockIdx.x};
        pg8::EpiDown E{F.out, F.mod + 5 * D, F.tokl, F.wl};
        pg8::gemm_phase<pg8::EpiDown, pg8::DownOrder<0>, false>(F.lds + RING_OFF, g, S, E);
        if (BOTH(8)) GRID_BAR();
    }
    if (IN(9)) {
        moe_tables(F);
        pg8::Gemm g{F.H, F.Wd_t, DEXP}; pg8::DownOrder<1> S{(const LAS int*)(F.lds + TAB_OFF), F.G, (int)blockIdx.x};
        pg8::EpiDown E{F.out, F.mod + 5 * D, F.tokl, F.wl};
        pg8::gemm_phase<pg8::EpiDown, pg8::DownOrder<1>, false>(F.lds + RING_OFF, g, S, E);
    }
#undef IN
#undef BOTH
}

extern "C" void kernel_launch(void* const* d_in, const int* in_sizes, int n_in, void* d_out, int out_size, void* d_ws, size_t ws_size, hipStream_t stream) {
    static int grid = 0;
    if (grid == 0) {
        if (n_in != 20 || in_sizes[0] != NTOK * D || out_size != NTOK * D || ws_size < WS_END) { fprintf(stderr, "kernel_launch: built for 20 inputs, x/out of %d floats, >= %zu bytes of workspace; got n_in %d, in0 %d, out %d, ws %zu; nothing launched\n", NTOK * D, (size_t)WS_END, n_in, n_in > 0 ? in_sizes[0] : -1, out_size, ws_size); grid = -1; return; }
        int dev = 0, cus = 0, per_cu = 0;
        if (hipGetDevice(&dev) != hipSuccess || hipDeviceGetAttribute(&cus, hipDeviceAttributeMultiprocessorCount, dev) != hipSuccess) { fprintf(stderr, "kernel_launch: hipGetDevice / hipDeviceGetAttribute failed\n"); grid = -1; return; }
        if (hipFuncSetAttribute((const void*)fwd, hipFuncAttributeMaxDynamicSharedMemorySize, LDS_BYTES) != hipSuccess) { fprintf(stderr, "kernel_launch: hipFuncSetAttribute failed\n"); grid = -1; return; }
        if (hipOccupancyMaxActiveBlocksPerMultiprocessor(&per_cu, (const void*)fwd, NWAVES * 64, LDS_BYTES) != hipSuccess || per_cu < 1)
            fprintf(stderr, "kernel_launch: note: the occupancy query reports %d workgroups per CU\n", per_cu);
        (void)hipGetLastError();
        grid = cus;
    }
    if (grid < 0) return;
    if (hipMemsetAsync((char*)d_ws + WS_CTL, 0, CTL_ZERO_BYTES, stream) != hipSuccess) { fprintf(stderr, "kernel_launch: hipMemsetAsync failed\n"); return; }
    Args a{};
    for (int i = 0; i < 20; ++i) a.in[i] = (const float*)d_in[i];
    a.out = (float*)d_out; a.ws = (unsigned char*)d_ws;
    for (int li = 0; li < N_LAUNCHES; ++li) {
        a.ph_lo = (N_LAUNCHES == 1) ? 0 : li; a.ph_hi = (N_LAUNCHES == 1) ? N_PHASES : li + 1;
        hipLaunchKernelGGL(fwd, dim3(grid), dim3(NWAVES * 64), LDS_BYTES, stream, a);
        const hipError_t le = hipPeekAtLastError();
        if (le != hipSuccess) { fprintf(stderr, "kernel_launch: launch %d failed: %s\n", li, hipGetErrorName(le)); break; }
    }
}
```

```cpp
#include <hip/hip_runtime.h>
#include <cstdio>
#include <cstdint>
#include <cmath>
namespace pg8 {
#define PG8_LAS __attribute__((address_space(3)))
typedef unsigned short bf16_t;
typedef short bf16x8 __attribute__((ext_vector_type(8)));
typedef float f32x4 __attribute__((ext_vector_type(4)));
typedef unsigned u32x4 __attribute__((ext_vector_type(4)));
constexpr int BM = 256, BK = 64, HALF = 128, HTB = HALF * BK * 2  , STAGE_BYTES = 8 * HTB, NXCD = 8, WGM = 8;

__host__ __device__ __forceinline__ int lds_byte(int r, int c) { const int st = (r >> 4) * 2 + (c >> 5), rr = r & 15, cc = c & 31, ob = rr * 64 + cc * 2; return st * 1024 + (ob ^ (((ob >> 9) & 1) << 5)); }
__host__ __device__ __forceinline__ void stage_rc(int b, int& R, int& C) { const int st = b / 1024, sb = b % 1024, swz = sb ^ (((sb >> 9) & 1) << 5); R = (st >> 1) * 16 + swz / 64; C = (st & 1) * 32 + (swz % 64) / 2; }
__host__ __device__ __forceinline__ int perm32(int rho) { const int n = rho >> 4, i = rho & 15; return 8 * (i >> 2) + 4 * n + (i & 3); }

struct Unit { int arow, brow, pm, pn, x0, x1; };
struct Gemm { const bf16_t* A; const bf16_t* Bt; int K; };

struct DenseOrder {
    int nM, nN, nwg, G, c;
    __device__ void init(int M, int N, int G_, int c_) { nM = M / BM; nN = N / BM; nwg = nM * nN; G = G_; c = c_; }
    __device__ bool next(int i, Unit& u) const {
        const long L = (long)i * G + c; if (L >= nwg) return false;
        int wgid = (int)L; { const int q = nwg / NXCD, r = nwg % NXCD, xcd = wgid % NXCD, off = wgid / NXCD; wgid = (xcd < r ? xcd * (q + 1) : r * (q + 1) + (xcd - r) * q) + off; }
        const int nig = WGM * nN, gid = wgid / nig, fm = gid * WGM, gsz = (nM - fm) < WGM ? (nM - fm) : WGM;
        u.pm = fm + ((wgid % nig) % gsz); u.pn = (wgid % nig) / gsz; u.arow = u.pm * BM; u.brow = u.pn * BM; u.x0 = 0; u.x1 = 0; return true;
    }
    __device__ __forceinline__ int arow_of(const Unit&, int) const { return 0; }
};

__device__ __forceinline__ unsigned cvt_pk_bf16(float lo, float hi) { unsigned r; asm volatile("v_cvt_pk_bf16_f32 %0, %1, %2" : "=v"(r) : "v"(lo), "v"(hi)); return r; }

template <class Epi, class Sched, bool GATHER, bool ALIGN_EPI = true, bool SP2 = true>
__device__ __forceinline__ void gemm_phase(PG8_LAS unsigned char* lds, const Gemm g, const Sched& S, const Epi& E) {
    const int tid = threadIdx.x, wid = __builtin_amdgcn_readfirstlane(tid >> 6), lane = tid & 63, wr = wid >> 2, wc = wid & 3, fr = lane & 15, fq = lane >> 4;
    const int K = g.K, nt = K / BK;
    unsigned voffA[2], voffB[2]; int stR[2], stC[2];
#pragma unroll
    for (int i = 0; i < 2; ++i) { int R, C; stage_rc(tid * 16 + i * 8192, R, C); const int Rb = Epi::PERM ? ((R & ~31) + perm32(R & 31)) : R;
        stR[i] = R; stC[i] = C; voffA[i] = (unsigned)(R * K + C) * 2u; voffB[i] = (unsigned)(Rb * K + C) * 2u; }
    const size_t kstep = (size_t)(BK * 2);
    const size_t hstep = (size_t)HALF * K * 2;
    const size_t rstep = (size_t)K * 2;
    const unsigned ldsw = (unsigned)wid * 1024u;
    const int aoff = lds_byte(wr * 64 + fr, fq * 8), boff = lds_byte(wc * 32 + fr, fq * 8);
#define PG8_SA(b, h) (((b) * 2 + (h)) * HTB)
#define PG8_SB(b, h) ((4 + (b) * 2 + (h)) * HTB)
#define PG8_STAGE(bufoff, gbase, voff) do { _Pragma("unroll") for (int _i = 0; _i < 2; ++_i) \
        __builtin_amdgcn_global_load_lds((const unsigned*)((const char*)(gbase) + (voff)[_i]), (PG8_LAS unsigned*)(lds + (bufoff) + ldsw + _i * 8192), 16, 0, 0); } while (0)
#define PG8_STAGE_A(bufoff, ub, h, VS) do { if constexpr (GATHER) { PG8_STAGE(bufoff, ub, VS[h]); } else { PG8_STAGE(bufoff, (ub) + (h) * hstep, voffA); } } while (0)
#define PG8_VOFFS(dst, U) do { _Pragma("unroll") for (int h_ = 0; h_ < 2; ++h_) _Pragma("unroll") for (int i_ = 0; i_ < 2; ++i_) \
        dst[h_][i_] = (unsigned)(S.arow_of(U, h_ * HALF + stR[i_]) * K + stC[i_]) * 2u; } while (0)
#define PG8_LDA(dst, b, h) do { _Pragma("unroll") for (int m = 0; m < 4; ++m) _Pragma("unroll") for (int k = 0; k < 2; ++k) dst[m][k] = *(const PG8_LAS bf16x8*)(lds + PG8_SA(b, h) + aoff + m * 2048 + k * 1024); } while (0)
#define PG8_LDB(dst, b, h) do { _Pragma("unroll") for (int n = 0; n < 2; ++n) _Pragma("unroll") for (int k = 0; k < 2; ++k) dst[n][k] = *(const PG8_LAS bf16x8*)(lds + PG8_SB(b, h) + boff + n * 2048 + k * 1024); } while (0)
#define PG8_MMA(ai, bj, At, Bt) do { __builtin_amdgcn_s_setprio(1); _Pragma("unroll") for (int m = 0; m < 4; ++m) _Pragma("unroll") for (int n = 0; n < 2; ++n) _Pragma("unroll") for (int k = 0; k < 2; ++k) \
        acc[ai][bj][m][n] = __builtin_amdgcn_mfma_f32_16x16x32_bf16(Bt[n][k], At[m][k], acc[ai][bj][m][n], 0, 0, 0); __builtin_amdgcn_s_setprio(0); } while (0)
#define PG8_WAIT_V(n) asm volatile("s_waitcnt vmcnt(" #n ")" ::: "memory")
#define PG8_WAIT_L(n) asm volatile("s_waitcnt lgkmcnt(" #n ")" ::: "memory")
#define PG8_BAR __builtin_amdgcn_s_barrier()
#define PG8_SCHED __builtin_amdgcn_sched_barrier(0)
    Unit cur, nxt; int ui = 0;
    if (!S.next(0, cur)) return;
    bool has_next = S.next(1, nxt);
    unsigned vAc[2][2], vAn[2][2];
    if constexpr (GATHER) { PG8_VOFFS(vAc, cur); if (has_next) { PG8_VOFFS(vAn, nxt); } else {
#pragma unroll
        for (int h_ = 0; h_ < 2; ++h_) { vAn[h_][0] = vAc[h_][0]; vAn[h_][1] = vAc[h_][1]; } } }
    else {
#pragma unroll
        for (int h_ = 0; h_ < 2; ++h_) { vAc[h_][0] = 0u; vAc[h_][1] = 0u; vAn[h_][0] = 0u; vAn[h_][1] = 0u; } }
    f32x4 acc[2][2][4][2];
#pragma unroll
    for (int a = 0; a < 2; ++a)
#pragma unroll
        for (int b = 0; b < 2; ++b)
#pragma unroll
            for (int m = 0; m < 4; ++m)
#pragma unroll
                for (int n = 0; n < 2; ++n) acc[a][b][m][n] = (f32x4){0.f, 0.f, 0.f, 0.f};
    bf16x8 At[4][2], B0[2][2], B1[2][2];
    const char* const A0 = (const char*)g.A;
    const char* cA = GATHER ? A0 : A0 + (size_t)cur.arow * rstep; const char* cB = (const char*)g.Bt + (size_t)cur.brow * rstep;
    if constexpr (SP2) {
        PG8_STAGE(PG8_SB(0, 0), cB, voffB); PG8_STAGE(PG8_SB(0, 1), cB + hstep, voffB); PG8_STAGE_A(PG8_SA(0, 0), cA, 0, vAc); PG8_STAGE_A(PG8_SA(0, 1), cA, 1, vAc);
        if (wr == 1) PG8_BAR;
        PG8_WAIT_V(2); PG8_BAR;
        PG8_STAGE(PG8_SB(1, 0), cB + kstep, voffB); PG8_STAGE_A(PG8_SA(1, 0), cA + kstep, 0, vAc); PG8_STAGE(PG8_SB(1, 1), cB + hstep + kstep, voffB);
        PG8_WAIT_V(6); PG8_BAR;
    } else {
        PG8_STAGE(PG8_SB(0, 0), cB, voffB); PG8_STAGE_A(PG8_SA(0, 0), cA, 0, vAc); PG8_STAGE(PG8_SB(0, 1), cB + hstep, voffB); PG8_STAGE_A(PG8_SA(0, 1), cA, 1, vAc);
        if (wr == 1) PG8_BAR;
        PG8_WAIT_V(4); PG8_BAR;
        PG8_STAGE(PG8_SB(1, 0), cB + kstep, voffB); PG8_STAGE_A(PG8_SA(1, 0), cA + kstep, 0, vAc); PG8_STAGE(PG8_SB(1, 1), cB + hstep + kstep, voffB);
        PG8_WAIT_V(6); PG8_BAR;
    }
    for (;;) {
        const char* nA = GATHER ? A0 : (has_next ? A0 + (size_t)nxt.arow * rstep : cA); const char* nB = has_next ? (const char*)g.Bt + (size_t)nxt.brow * rstep : cB;
        for (int t = 0; t < nt; t += 2) {
            const bool last = (t == nt - 2);
            const char* a1 = cA + (size_t)(t + 1) * kstep;
            const char* a2 = last ? nA : cA + (size_t)(t + 2) * kstep; const char* b2 = last ? nB : cB + (size_t)(t + 2) * kstep;
            const char* a3 = a2 + kstep; const char* b3 = b2 + kstep;
            unsigned vS[2][2];
#pragma unroll
            for (int h_ = 0; h_ < 2; ++h_) { vS[h_][0] = last ? vAn[h_][0] : vAc[h_][0]; vS[h_][1] = last ? vAn[h_][1] : vAc[h_][1]; }
            if constexpr (SP2) {
            PG8_LDB(B0, 0, 0); PG8_LDB(B1, 0, 1); PG8_SCHED; PG8_LDA(At, 0, 0); PG8_STAGE_A(PG8_SA(1, 1), a1, 1, vAc);
            PG8_WAIT_V(8); PG8_WAIT_L(0); PG8_BAR; PG8_MMA(0, 0, At, B0); PG8_MMA(0, 1, At, B1); PG8_BAR; PG8_SCHED;
            PG8_LDA(At, 0, 1); PG8_STAGE(PG8_SB(0, 0), b2, voffB); PG8_STAGE(PG8_SB(0, 1), b2 + hstep, voffB); PG8_STAGE_A(PG8_SA(0, 0), a2, 0, vS);
            PG8_WAIT_V(8); PG8_WAIT_L(0); PG8_BAR; PG8_MMA(1, 0, At, B0); PG8_MMA(1, 1, At, B1); PG8_BAR; PG8_SCHED;
            PG8_LDB(B0, 1, 0); PG8_LDB(B1, 1, 1); PG8_SCHED; PG8_LDA(At, 1, 0); PG8_STAGE_A(PG8_SA(0, 1), a2, 1, vS);
            PG8_WAIT_V(8); PG8_WAIT_L(0); PG8_BAR; PG8_MMA(0, 0, At, B0); PG8_MMA(0, 1, At, B1); PG8_BAR; PG8_SCHED;
            PG8_LDA(At, 1, 1); PG8_STAGE(PG8_SB(1, 0), b3, voffB); PG8_STAGE(PG8_SB(1, 1), b3 + hstep, voffB); PG8_STAGE_A(PG8_SA(1, 0), a3, 0, vS);
            PG8_WAIT_V(8); PG8_WAIT_L(0); PG8_BAR; PG8_MMA(1, 0, At, B0); PG8_MMA(1, 1, At, B1); PG8_BAR; PG8_SCHED;
            } else {
            PG8_LDB(B0, 0, 0); PG8_SCHED; PG8_LDA(At, 0, 0); PG8_STAGE_A(PG8_SA(1, 1), a1, 1, vAc);
            PG8_WAIT_L(8); PG8_BAR; PG8_WAIT_L(0); PG8_MMA(0, 0, At, B0); PG8_BAR; PG8_SCHED;
            PG8_LDB(B1, 0, 1); PG8_STAGE(PG8_SB(0, 0), b2, voffB);
            PG8_BAR; PG8_WAIT_L(0); PG8_MMA(0, 1, At, B1); PG8_BAR;
            PG8_LDA(At, 0, 1); PG8_STAGE_A(PG8_SA(0, 0), a2, 0, vS);
            PG8_BAR; PG8_WAIT_L(0); PG8_MMA(1, 0, At, B0); PG8_BAR; PG8_SCHED;
            PG8_STAGE(PG8_SB(0, 1), b2 + hstep, voffB);
            PG8_WAIT_V(6); PG8_BAR; PG8_MMA(1, 1, At, B1); PG8_BAR;
            PG8_LDB(B0, 1, 0); PG8_SCHED; PG8_LDA(At, 1, 0); PG8_STAGE_A(PG8_SA(0, 1), a2, 1, vS);
            PG8_WAIT_L(8); PG8_BAR; PG8_WAIT_L(0); PG8_MMA(0, 0, At, B0); PG8_BAR; PG8_SCHED;
            PG8_LDB(B1, 1, 1); PG8_STAGE(PG8_SB(1, 0), b3, voffB);
            PG8_BAR; PG8_WAIT_L(0); PG8_MMA(0, 1, At, B1); PG8_BAR;
            PG8_LDA(At, 1, 1); PG8_STAGE_A(PG8_SA(1, 0), a3, 0, vS);
            PG8_BAR; PG8_WAIT_L(0); PG8_MMA(1, 0, At, B0); PG8_BAR; PG8_SCHED;
            PG8_STAGE(PG8_SB(1, 1), b3 + hstep, voffB);
            PG8_WAIT_V(6); PG8_BAR; PG8_MMA(1, 1, At, B1); PG8_BAR;
            }
        }
        if constexpr (ALIGN_EPI) { if (wr == 0) PG8_BAR; }
        E(acc, cur, wr, wc, fr, fq);
        if (!has_next) break;
#pragma unroll
        for (int a = 0; a < 2; ++a)
#pragma unroll
            for (int b = 0; b < 2; ++b)
#pragma unroll
                for (int m = 0; m < 4; ++m)
#pragma unroll
                    for (int n = 0; n < 2; ++n) acc[a][b][m][n] = (f32x4){0.f, 0.f, 0.f, 0.f};
        cur = nxt; cA = nA; cB = nB; ++ui;
        has_next = S.next(ui + 1, nxt);
        if constexpr (GATHER) {
#pragma unroll
            for (int h_ = 0; h_ < 2; ++h_) { vAc[h_][0] = vAn[h_][0]; vAc[h_][1] = vAn[h_][1]; }
            if (has_next) { PG8_VOFFS(vAn, nxt); }
        }
        if constexpr (ALIGN_EPI) { if (wr == 1) PG8_BAR; }
    }
    PG8_WAIT_V(0);
    if constexpr (!ALIGN_EPI) { if (wr == 0) PG8_BAR; }
    PG8_BAR;
#undef PG8_SA
#undef PG8_SB
#undef PG8_STAGE
#undef PG8_STAGE_A
#undef PG8_VOFFS
#undef PG8_LDA
#undef PG8_LDB
#undef PG8_MMA
#undef PG8_WAIT_V
#undef PG8_WAIT_L
#undef PG8_BAR
#undef PG8_SCHED
}
}
constexpr int NWAVES = 8;
constexpr int BATCH = 8, SEQ = 4096, D = 1024, NTOK = BATCH * SEQ;
constexpr int HD = 64, NH = 8, WATT = NH * HD;
constexpr int INCOLS = 5120, NMOD = 6;
constexpr int MBLK = 256, NBLK = SEQ / MBLK;
constexpr int NEXP = 32, EPG = 8, NGRP = 4, DEXP = 512;
constexpr float RMS_EPS = 1e-6f;
constexpr float LOG2E = 1.4426950408889634f;
constexpr float C2 = 0.125f * 1.4426950408889634f;
constexpr int LCAP = NTOK;
constexpr int HROWS = 2 * NTOK + NEXP * 256 + 256;

constexpr size_t MiB = 1u << 20;
constexpr size_t WS_CTL = 0, CTL_ZERO_BYTES = 1 * MiB;
constexpr size_t WS_MOD = 1 * MiB;
constexpr size_t WS_BIAS = 1 * MiB + 256 * 1024;
constexpr size_t WS_STATS = 2 * MiB;
constexpr size_t WS_WIN = 4 * MiB;
constexpr size_t WS_WBRA = 14 * MiB, WS_WBRB = 15 * MiB;
constexpr size_t WS_WOUT = 16 * MiB;
constexpr size_t WS_WGU = 18 * MiB;
constexpr size_t WS_WD = 82 * MiB;
constexpr size_t WS_XN = 114 * MiB;
constexpr size_t WS_QA = 178 * MiB, WS_KA = 210 * MiB, WS_VA = 242 * MiB, WS_QB = 274 * MiB, WS_KB = 306 * MiB, WS_VB = 338 * MiB;
constexpr size_t WS_GA = 370 * MiB, WS_GB = 434 * MiB;
constexpr size_t WS_H = 178 * MiB;
constexpr size_t WS_TOKL = 306 * MiB, WS_WL = 314 * MiB;
constexpr size_t WS_END = 498 * MiB;
static_assert(WS_H + (size_t)HROWS * DEXP * 2 <= WS_QB && WS_TOKL + (size_t)2 * NEXP * LCAP * 4 <= WS_WL && WS_WL + (size_t)2 * NEXP * LCAP * 4 <= WS_VB, "d_ws map");
constexpr int CW_TMO = 0, CW_CODE = 1;
constexpr int CW_BAR = 4096;
constexpr int CW_CNT = 16384;
constexpr int CW_KMEAN = 65536;
static_assert((CW_KMEAN + 65536) * 4 <= (int)CTL_ZERO_BYTES && CW_CNT + 64 * 64 <= CW_KMEAN && CW_BAR + 3456 <= CW_CNT, "CTL map");

constexpr int RING_OFF = 0, RING_BYTES = 131072;
constexpr int LDSCTL_OFF = RING_BYTES, MISC_OFF = LDSCTL_OFF + 320;
constexpr int TAB_OFF = RING_BYTES + 1024;
constexpr int LDS_BYTES = 147456;
static_assert(MISC_OFF + 128 <= TAB_OFF && TAB_OFF + 2048 <= LDS_BYTES, "LDS map");

#define GAS __attribute__((address_space(1)))
#define LAS __attribute__((address_space(3)))
typedef unsigned short bf16;
typedef unsigned v4u __attribute__((ext_vector_type(4)));
typedef unsigned v2u __attribute__((ext_vector_type(2)));
typedef float f32x4 __attribute__((ext_vector_type(4)));
typedef short bf16x8 __attribute__((ext_vector_type(8)));
typedef GAS unsigned gu32;
#define RLX_AGENT __ATOMIC_RELAXED, __HIP_MEMORY_SCOPE_AGENT
#define LDS_WAIT() asm volatile("s_waitcnt lgkmcnt(0)" ::: "memory")
#define VM_WAIT() asm volatile("s_waitcnt vmcnt(0)" ::: "memory")
__device__ __forceinline__ unsigned f2bf(float f) { unsigned u = __builtin_bit_cast(unsigned, f); return (u + 0x7fffu + ((u >> 16) & 1u)) >> 16; }
__device__ __forceinline__ unsigned pk2(float lo, float hi) { return f2bf(lo) | (f2bf(hi) << 16); }
__device__ __forceinline__ float bflo(unsigned u) { return __uint_as_float(u << 16); }
__device__ __forceinline__ float bfhi(unsigned u) { return __uint_as_float(u & 0xffff0000u); }
__device__ __forceinline__ float fsigmoid(float v) { return __builtin_amdgcn_rcpf(1.0f + __builtin_amdgcn_exp2f(-v * LOG2E)); }
#define XB_TMO      128
#define XB_XCNT(j)  (256  + 64 * (j))
#define XB_XSUB(j)  (1280 + 64 * (j))
#define XB_XGEN(j)  (2304 + 64 * (j))
#define XB_TOP      3328
#define XB_TOPGEN   3392
#define XCD_BAR_WORDS 3456
#define XB_SPIN_CAP (1u << 22)

__device__ __forceinline__ unsigned xb_ld(unsigned* p)              { return __hip_atomic_load(p, __ATOMIC_RELAXED, __HIP_MEMORY_SCOPE_AGENT); }
__device__ __forceinline__ unsigned xb_add(unsigned* p, unsigned v) { return __hip_atomic_fetch_add(p, v, __ATOMIC_RELAXED, __HIP_MEMORY_SCOPE_AGENT); }
__device__ __forceinline__ unsigned xb_xcc_id() { return (unsigned)__builtin_amdgcn_s_getreg((3 << 11) | 20) & 0xFu; }
#define XB_SPIN(cond, bar) do { unsigned _sp = 0; while (cond) { __builtin_amdgcn_s_sleep(1); \
    if ((++_sp & 255u) == 0u) { if (xb_ld(&(bar)[XB_TMO])) break; if (_sp > XB_SPIN_CAP) { atomicAdd(&(bar)[XB_TMO], 1u); break; } } } } while (0)

struct XcdBarrier {
    unsigned* bar; unsigned x;
    volatile LAS unsigned* st;
};

__device__ __forceinline__ XcdBarrier xcd_barrier_post(unsigned* bar, volatile LAS unsigned* st) {
    XcdBarrier b; b.bar = bar; b.x = xb_xcc_id(); b.st = st;
    if (threadIdx.x == 0) (void)xb_add(&bar[XB_XCNT(b.x)], 1u);
    return b;
}
__device__ __forceinline__ void xcd_barrier_complete(unsigned* bar, unsigned x, unsigned& nloc, unsigned& nx) {
    const unsigned G = gridDim.x * gridDim.y * gridDim.z;
    unsigned sum, cnt, mine, sp = 0u;
    for (;;) {
        sum = 0u; cnt = 0u; mine = 0u;
#pragma unroll
        for (unsigned j = 0; j < 16; ++j) { const unsigned c = xb_ld(&bar[XB_XCNT(j)]); sum += c; cnt += (c > 0u) ? 1u : 0u; mine = (j == x) ? c : mine; }
        if (sum == G) break;
        __builtin_amdgcn_s_sleep(1);
        if ((++sp & 255u) == 0u) { if (xb_ld(&bar[XB_TMO])) break; if (sp > XB_SPIN_CAP) { atomicAdd(&bar[XB_TMO], 1u); break; } }
    }
    nloc = mine > 0u ? mine : 1u; nx = cnt > 0u ? cnt : 1u;
}

__device__ __forceinline__ void xcd_barrier(const XcdBarrier& b) {
    asm volatile("s_waitcnt vmcnt(0)" ::: "memory");
    __syncthreads();
    if (threadIdx.x == 0) {
        unsigned* bar = b.bar;
        __builtin_amdgcn_s_waitcnt(0);
        unsigned nloc = b.st[0], nx = b.st[1];
        if (nloc == 0u) { xcd_barrier_complete(bar, b.x, nloc, nx); b.st[0] = nloc; b.st[1] = nx; }
        const unsigned old = xb_add(&bar[XB_XSUB(b.x)], 1u);
        const unsigned gen = old / nloc;
        if (old + 1u == (gen + 1u) * nloc) {
            __builtin_amdgcn_fence(__ATOMIC_RELEASE, "agent");
            asm volatile("s_waitcnt vmcnt(0)" ::: "memory");
            const unsigned og = xb_add(&bar[XB_TOP], 1u);
            const unsigned tg = og / nx;
            if (og + 1u == (tg + 1u) * nx) xb_add(&bar[XB_TOPGEN], 1u);
            else XB_SPIN(xb_ld(&bar[XB_TOPGEN]) == tg, bar);
            __builtin_amdgcn_fence(__ATOMIC_ACQUIRE, "agent");
            xb_add(&bar[XB_XGEN(b.x)], 1u);
            asm volatile("s_waitcnt vmcnt(0)" ::: "memory");
        } else {
            XB_SPIN(xb_ld(&bar[XB_XGEN(b.x)]) == gen, bar);
            __builtin_amdgcn_fence(__ATOMIC_ACQUIRE, "agent");
            asm volatile("s_waitcnt vmcnt(0)" ::: "memory");
        }
    }
    __syncthreads();
}
namespace pg8 {
struct EpiProj {
    static constexpr bool PERM = true;
    bf16_t* qkv;
    bf16_t* ga; bf16_t* gb;
    const float* gq; const float* gk;
    float* kmean;
    __device__ __forceinline__ void operator()(const f32x4 (&acc)[2][2][4][2], const Unit& u, int wr, int wc, int fr, int fq) const {
        const int pn = u.pn; const int row0 = u.pm * BM + wr * 64 + fr;
        if (pn < 4) {
            const bool isq = pn < 2; const float* gv = isq ? gq : gk; const float post = isq ? C2 : 1.0f;
            bf16_t* base = qkv + (size_t)(pn >> 1) * ((size_t)NTOK * WATT) + (pn & 1) * 256 + wc * 64 + 8 * fq;
            float g[2][2][4];
#pragma unroll
            for (int bj = 0; bj < 2; ++bj)
#pragma unroll
                for (int n = 0; n < 2; ++n) { const f32x4 t = *(const f32x4*)(gv + 32 * bj + 8 * fq + 4 * n); g[bj][n][0] = t[0] * post; g[bj][n][1] = t[1] * post; g[bj][n][2] = t[2] * post; g[bj][n][3] = t[3] * post; }
            float cs[2][2][4];
#pragma unroll
            for (int bj = 0; bj < 2; ++bj)
#pragma unroll
                for (int n = 0; n < 2; ++n)
#pragma unroll
                    for (int e = 0; e < 4; ++e) cs[bj][n][e] = 0.f;
#pragma unroll
            for (int ai = 0; ai < 2; ++ai)
#pragma unroll
                for (int m = 0; m < 4; ++m) {
                    float ss = 0.f;
#pragma unroll
                    for (int bj = 0; bj < 2; ++bj)
#pragma unroll
                        for (int n = 0; n < 2; ++n) { const f32x4 x = acc[ai][bj][m][n]; ss += (x[0] * x[0] + x[1] * x[1]) + (x[2] * x[2] + x[3] * x[3]); }
                    ss += __shfl_xor(ss, 16); ss += __shfl_xor(ss, 32);
                    const float rstd = __builtin_amdgcn_rsqf(ss * (1.0f / 64.0f) + RMS_EPS);
                    bf16_t* rowp = base + (size_t)(row0 + ai * HALF + m * 16) * WATT;
#pragma unroll
                    for (int bj = 0; bj < 2; ++bj) { float o[2][4];
#pragma unroll
                        for (int n = 0; n < 2; ++n)
#pragma unroll
                            for (int e = 0; e < 4; ++e) { o[n][e] = acc[ai][bj][m][n][e] * rstd * g[bj][n][e]; cs[bj][n][e] += o[n][e]; }
                        u32x4 w; w.x = cvt_pk_bf16(o[0][0], o[0][1]); w.y = cvt_pk_bf16(o[0][2], o[0][3]); w.z = cvt_pk_bf16(o[1][0], o[1][1]); w.w = cvt_pk_bf16(o[1][2], o[1][3]);
                        *(u32x4*)(rowp + 32 * bj) = w; }
                }
            if (!isq) {
#pragma unroll
                for (int bj = 0; bj < 2; ++bj)
#pragma unroll
                    for (int n = 0; n < 2; ++n)
#pragma unroll
                        for (int e = 0; e < 4; ++e) { float v = cs[bj][n][e]; v += __shfl_xor(v, 1); v += __shfl_xor(v, 2); v += __shfl_xor(v, 4); v += __shfl_xor(v, 8); cs[bj][n][e] = v; }
                if (fr == 0) { float* kp = kmean + ((size_t)u.pm * NH + (pn & 1) * 4 + wc) * HD + 8 * fq;
#pragma unroll
                    for (int bj = 0; bj < 2; ++bj)
#pragma unroll
                        for (int n = 0; n < 2; ++n)
#pragma unroll
                            for (int e = 0; e < 4; ++e) atomicAdd(kp + 32 * bj + 4 * n + e, cs[bj][n][e]); }
            }
        } else {
            const bool isg = pn >= 12; const float sc = (pn == 6 || pn == 7) ? C2 : 1.0f;
            bf16_t* base; int ldc;
            if (isg) { base = (pn < 16 ? ga : gb) + (pn & 3) * 256 + wc * 64 + 8 * fq; ldc = D; }
            else { base = qkv + (size_t)(pn >> 1) * ((size_t)NTOK * WATT) + (pn & 1) * 256 + wc * 64 + 8 * fq; ldc = WATT; }
#pragma unroll
            for (int ai = 0; ai < 2; ++ai)
#pragma unroll
                for (int m = 0; m < 4; ++m) { bf16_t* rowp = base + (size_t)(row0 + ai * HALF + m * 16) * ldc;
#pragma unroll
                    for (int bj = 0; bj < 2; ++bj) { f32x4 v0 = acc[ai][bj][m][0], v1 = acc[ai][bj][m][1];
                        if (isg) {
#pragma unroll
                            for (int e = 0; e < 4; ++e) { v0[e] = __builtin_amdgcn_rcpf(1.0f + __builtin_amdgcn_exp2f(-v0[e] * LOG2E)); v1[e] = __builtin_amdgcn_rcpf(1.0f + __builtin_amdgcn_exp2f(-v1[e] * LOG2E)); } }
                        else { v0 = v0 * sc; v1 = v1 * sc; }
                        u32x4 w; w.x = cvt_pk_bf16(v0[0], v0[1]); w.y = cvt_pk_bf16(v0[2], v0[3]); w.z = cvt_pk_bf16(v1[0], v1[1]); w.w = cvt_pk_bf16(v1[2], v1[3]);
                        *(u32x4*)(rowp + 32 * bj) = w; } }
        }
    }
};

template <int MODE> struct EpiBranch {
    static constexpr bool PERM = true;
    bf16_t* sg; const bf16_t* tin;
    __device__ __forceinline__ void operator()(const f32x4 (&acc)[2][2][4][2], const Unit& u, int wr, int wc, int fr, int fq) const {
        const int row0 = u.pm * BM + wr * 64 + fr, col0 = u.pn * BM + wc * 32 + 8 * fq;
#pragma unroll
        for (int ai = 0; ai < 2; ++ai)
#pragma unroll
            for (int m = 0; m < 4; ++m) { const size_t off = (size_t)(row0 + ai * HALF + m * 16) * D + col0;
#pragma unroll
                for (int bj = 0; bj < 2; ++bj) { const u32x4 gw = *(const u32x4*)(sg + off + bj * HALF); u32x4 tw = (u32x4){0u, 0u, 0u, 0u}; if (MODE == 1) tw = *(const u32x4*)(tin + off + bj * HALF);
                    const f32x4 v0 = acc[ai][bj][m][0], v1 = acc[ai][bj][m][1]; float o[8];
                    o[0] = bflo(gw.x) * v0[0]; o[1] = bfhi(gw.x) * v0[1]; o[2] = bflo(gw.y) * v0[2]; o[3] = bfhi(gw.y) * v0[3];
                    o[4] = bflo(gw.z) * v1[0]; o[5] = bfhi(gw.z) * v1[1]; o[6] = bflo(gw.w) * v1[2]; o[7] = bfhi(gw.w) * v1[3];
                    if (MODE == 1) { o[0] += bflo(tw.x); o[1] += bfhi(tw.x); o[2] += bflo(tw.y); o[3] += bfhi(tw.y); o[4] += bflo(tw.z); o[5] += bfhi(tw.z); o[6] += bflo(tw.w); o[7] += bfhi(tw.w); }
                    u32x4 w; w.x = cvt_pk_bf16(o[0], o[1]); w.y = cvt_pk_bf16(o[2], o[3]); w.z = cvt_pk_bf16(o[4], o[5]); w.w = cvt_pk_bf16(o[6], o[7]);
                    *(u32x4*)(sg + off + bj * HALF) = w; } }
    }
};

struct EpiResid {
    static constexpr bool PERM = false;
    const float* x; float* out; const float* gt;
    float* stats;
    __device__ __forceinline__ void operator()(const f32x4 (&acc)[2][2][4][2], const Unit& u, int wr, int wc, int fr, int fq) const {
        const int row0 = u.pm * BM + wr * 64 + fr, col0 = u.pn * BM + wc * 32 + 4 * fq; const int b = (u.pm * BM) / SEQ;
        f32x4 gv[2][2];
#pragma unroll
        for (int bj = 0; bj < 2; ++bj)
#pragma unroll
            for (int n = 0; n < 2; ++n) gv[bj][n] = *(const f32x4*)(gt + (size_t)b * (NMOD * D) + col0 + bj * HALF + n * 16);
#pragma unroll
        for (int ai = 0; ai < 2; ++ai)
#pragma unroll
            for (int m = 0; m < 4; ++m) { const int row = row0 + ai * HALF + m * 16; const size_t off = (size_t)row * D + col0; float ss = 0.f;
#pragma unroll
                for (int bj = 0; bj < 2; ++bj)
#pragma unroll
                    for (int n = 0; n < 2; ++n) { const f32x4 xv = *(const f32x4*)(x + off + bj * HALF + n * 16); const f32x4 o = xv + gv[bj][n] * acc[ai][bj][m][n];
                        *(f32x4*)(out + off + bj * HALF + n * 16) = o; ss += (o[0] * o[0] + o[1] * o[1]) + (o[2] * o[2] + o[3] * o[3]); }
                ss += __shfl_xor(ss, 16); ss += __shfl_xor(ss, 32);
                if (fq == 0) stats[(size_t)row * 16 + u.pn * 4 + wc] = ss; }
    }
};

struct EpiGateUp {
    static constexpr bool PERM = true;
    bf16_t* H;
    __device__ __forceinline__ void operator()(const f32x4 (&acc)[2][2][4][2], const Unit& u, int wr, int wc, int fr, int fq) const {
        bf16_t* base = H + (size_t)(u.arow + wr * 64 + fr) * DEXP + u.pn * 128 + wc * 32 + 8 * fq;
#pragma unroll
        for (int ai = 0; ai < 2; ++ai)
#pragma unroll
            for (int m = 0; m < 4; ++m) { float o[8];
#pragma unroll
                for (int n = 0; n < 2; ++n)
#pragma unroll
                    for (int e = 0; e < 4; ++e) { const float gg = acc[ai][0][m][n][e], uu = acc[ai][1][m][n][e]; o[4 * n + e] = gg * __builtin_amdgcn_rcpf(1.0f + __builtin_amdgcn_exp2f(-gg * LOG2E)) * uu; }
                u32x4 w; w.x = cvt_pk_bf16(o[0], o[1]); w.y = cvt_pk_bf16(o[2], o[3]); w.z = cvt_pk_bf16(o[4], o[5]); w.w = cvt_pk_bf16(o[6], o[7]);
                *(u32x4*)(base + (size_t)(ai * HALF + m * 16) * DEXP) = w; }
    }
};

struct EpiDown {
    static constexpr bool PERM = false;
    float* out; const float* gt;
    const int* tl; const float* wl;
    __device__ __forceinline__ void operator()(const f32x4 (&acc)[2][2][4][2], const Unit& u, int wr, int wc, int fr, int fq) const {
        const int col0 = u.pn * BM + wc * 32 + 4 * fq;
#pragma unroll
        for (int ai = 0; ai < 2; ++ai)
#pragma unroll
            for (int m = 0; m < 4; ++m) { const int r = ai * HALF + wr * 64 + m * 16 + fr;
                if (r < u.x1) { const int tok = tl[u.x0 + r]; const float w = wl[u.x0 + r]; const int b = tok / SEQ; const size_t off = (size_t)tok * D + col0;
#pragma unroll
                    for (int bj = 0; bj < 2; ++bj)
#pragma unroll
                        for (int n = 0; n < 2; ++n) { const f32x4 gv = *(const f32x4*)(gt + (size_t)b * (NMOD * D) + col0 + bj * HALF + n * 16); float* p = out + off + bj * HALF + n * 16;
                            const f32x4 ov = *(const f32x4*)p; *(f32x4*)p = ov + gv * (acc[ai][bj][m][n] * w); } } }
    }
};

struct GateUpOrder {
    const PG8_LAS int* T; const int* tokl; int G, c;
    __device__ bool next(int i, Unit& u) const {
        const int L = i * G + c; const int total = T[64 + 32] * 4; if (L >= total) return false;
        const int rt = L >> 2; int e = 0; while (T[64 + e + 1] <= rt) ++e;
        const int lt = rt - T[64 + e];
        u.pm = lt; u.pn = L & 3; u.x0 = e; u.x1 = 0; u.arow = T[128 + e] + lt * 256; u.brow = e * 1024 + (L & 3) * 256; return true;
    }
    __device__ __forceinline__ int arow_of(const Unit& u, int r) const {
        const int idx = u.pm * 256 + r, c0 = T[u.x0], c1 = T[32 + u.x0];
        int tok = 0;
        if (idx < c0) tok = tokl[(size_t)u.x0 * LCAP + idx]; else if (idx < c0 + c1) tok = tokl[(size_t)(NEXP + u.x0) * LCAP + idx - c0];
        return tok;
    }
};
template <int SLOT> struct DownOrder {
    const PG8_LAS int* T; int G, c;
    __device__ bool next(int i, Unit& u) const {
        const int PO = SLOT ? 256 : 192; const int L = i * G + c; const int total = T[PO + 32] * 4; if (L >= total) return false;
        const int rt = L >> 2; int e = 0; while (T[PO + e + 1] <= rt) ++e;
        const int lt = rt - T[PO + e]; const int cs = T[SLOT * 32 + e]; const int rem = cs - lt * 256;
        u.pm = lt; u.pn = L & 3; u.x0 = (SLOT * NEXP + e) * LCAP + lt * 256; u.x1 = rem < 256 ? rem : 256;
        u.arow = T[128 + e] + (SLOT ? T[e] : 0) + lt * 256; u.brow = e * 1024 + (L & 3) * 256; return true;
    }
    __device__ __forceinline__ int arow_of(const Unit&, int) const { return 0; }
};
}
struct Frame {
    LAS unsigned char* lds;
    volatile LAS unsigned* MISC;
    gu32* ctl;
    int tid, lane, wave;
    int vcu, G;
    const float *x, *c, *w_ada, *b_ada, *g_mix, *w_in, *g_q, *g_k, *rel_bias, *w_br_moba, *w_br_sb, *w_out, *g_ffn, *w_rg, *b_rg, *w_re, *b_re, *w_gate, *w_up, *w_down;
    float* out;
    float *mod, *biasT, *stats, *kmean;
    bf16 *Win_t, *Wbra_t, *Wbrb_t, *Wout_t, *Wgu_t, *Wd_t;
    bf16 *XN, *QA, *KA, *VA, *QB, *KB, *VB, *GA, *GB, *H;
    int* tokl; float* wl; unsigned* cnt;
};
__device__ __forceinline__ float wave_sum(float v) {
#pragma unroll
    for (int o = 1; o < 64; o <<= 1) v += __shfl_xor(v, o);
    return v;
}
__device__ __forceinline__ int lane_zero() { int z; asm volatile("v_mov_b32 %0, 0" : "=v"(z)); return z; }

__device__ __forceinline__ void p0_transpose_item(const float* W, int K, int N, bf16* WT, int k0, int n0, int drow0, LAS float* scr, int lane) {
#pragma unroll 8
    for (int i = 0; i < 32; ++i) { const int kk = 2 * i + (lane >> 5); scr[kk * 33 + (lane & 31)] = W[(size_t)(k0 + kk) * N + n0 + (lane & 31)]; }
    LDS_WAIT(); asm volatile("" ::: "memory");
    const int c = lane & 7;
#pragma unroll
    for (int j = 0; j < 4; ++j) { const int n = (lane >> 3) + 8 * j; const LAS float* s = scr + (8 * c) * 33 + n;
        v4u o; o.x = pk2(s[0 * 33], s[1 * 33]); o.y = pk2(s[2 * 33], s[3 * 33]); o.z = pk2(s[4 * 33], s[5 * 33]); o.w = pk2(s[6 * 33], s[7 * 33]);
        *(GAS v4u*)(WT + (size_t)(drow0 + n) * K + k0 + 8 * c) = o; }
    LDS_WAIT(); asm volatile("" ::: "memory");
}

__device__ __forceinline__ void p0_prologue(Frame& F) {
    {
        LAS float* sc = (LAS float*)(F.lds + RING_OFF);
        LAS float* part = (LAS float*)(F.lds + RING_OFF + 32768);
        for (int i = F.tid; i < BATCH * D; i += NWAVES * 64) { const float v = F.c[i]; sc[i] = v * fsigmoid(v); }
        __syncthreads();
        for (int chunk = F.vcu; chunk < 256; chunk += F.G) {
            const int kp = F.tid / 24, cI = F.tid % 24;
            if (kp < 21) {
                float a[8];
#pragma unroll
                for (int b = 0; b < 8; ++b) a[b] = 0.f;
                const int k0 = kp * 49, k1 = (k0 + 49 < D) ? k0 + 49 : D;
                for (int k = k0; k < k1; ++k) { const float w = F.w_ada[(size_t)k * (NMOD * D) + chunk * 24 + cI];
#pragma unroll
                    for (int b = 0; b < 8; ++b) a[b] += sc[b * D + k] * w; }
#pragma unroll
                for (int b = 0; b < 8; ++b) part[(kp * 24 + cI) * 8 + b] = a[b];
            }
            __syncthreads();
            if (F.tid < 192) { const int cI2 = F.tid % 24, b = F.tid / 24; float s = 0.f;
                for (int kp2 = 0; kp2 < 21; ++kp2) s += part[(kp2 * 24 + cI2) * 8 + b];
                const int col = chunk * 24 + cI2; F.mod[(size_t)b * (NMOD * D) + col] = s + F.b_ada[col]; }
            __syncthreads();
        }
    }
    const int gw = F.vcu * NWAVES + F.wave, NGW = F.G * NWAVES;
    for (int i = gw * 64 + F.lane; i < NH * SEQ; i += NGW * 64) { const int h = i / SEQ, n = i % SEQ; int bk;
        if (n < 16) bk = n; else { const float nf = (float)n; int lg = 16 + (int)(logf(nf / 16.0f) / 4.1588830833596715f * 16.0f); bk = lg < 31 ? lg : 31; }
        F.biasT[i] = F.rel_bias[h * 32 + bk] * LOG2E; }
    LAS float* scr = (LAS float*)(F.lds + RING_OFF + F.wave * 16384);
    constexpr int I_IN = (D / 64) * (INCOLS / 32), I_BR = (WATT / 64) * (D / 32), I_OUT = (D / 64) * (D / 32), I_G = NEXP * (D / 64) * (DEXP / 32), I_D = NEXP * (DEXP / 64) * (D / 32);
    constexpr int NITEMS = I_IN + 2 * I_BR + I_OUT + 2 * I_G + I_D;
    for (int it = gw; it < NITEMS; it += NGW) {
        int r = it;
        if (r < I_IN) { const int nblk = INCOLS / 32, kb = r / nblk, nb = r % nblk, n0 = 32 * nb, t = n0 & 255;
            const int p0 = 128 * ((t >> 5) & 1) + 32 * (t >> 6);
            p0_transpose_item(F.w_in, D, INCOLS, F.Win_t, 64 * kb, n0, (n0 - t) + p0, scr, F.lane); continue; } r -= I_IN;
        if (r < I_BR) { const int nblk = D / 32, kb = r / nblk, nb = r % nblk; p0_transpose_item(F.w_br_moba, WATT, D, F.Wbra_t, 64 * kb, 32 * nb, 32 * nb, scr, F.lane); continue; } r -= I_BR;
        if (r < I_BR) { const int nblk = D / 32, kb = r / nblk, nb = r % nblk; p0_transpose_item(F.w_br_sb, WATT, D, F.Wbrb_t, 64 * kb, 32 * nb, 32 * nb, scr, F.lane); continue; } r -= I_BR;
        if (r < I_OUT) { const int nblk = D / 32, kb = r / nblk, nb = r % nblk; p0_transpose_item(F.w_out, D, D, F.Wout_t, 64 * kb, 32 * nb, 32 * nb, scr, F.lane); continue; } r -= I_OUT;
        if (r < 2 * I_G) { const int up = r >= I_G; if (up) r -= I_G; constexpr int per = (D / 64) * (DEXP / 32); const int e = r / per, q = r % per, nblk = DEXP / 32, kb = q / nblk, nb = q % nblk, n0 = 32 * nb;
            p0_transpose_item((up ? F.w_up : F.w_gate) + (size_t)e * D * DEXP, D, DEXP, F.Wgu_t, 64 * kb, n0, e * 1024 + 256 * (n0 >> 7) + (up ? 128 : 0) + (n0 & 127), scr, F.lane); continue; } r -= 2 * I_G;
        { constexpr int per = (DEXP / 64) * (D / 32); const int e = r / per, q = r % per, nblk = D / 32, kb = q / nblk, nb = q % nblk;
            p0_transpose_item(F.w_down + (size_t)e * DEXP * D, DEXP, D, F.Wd_t, 64 * kb, 32 * nb, e * 1024 + 32 * nb, scr, F.lane); }
    }
}

__device__ __forceinline__ void p1_norm(Frame& F) {
    const int gw = F.vcu * NWAVES + F.wave, NGW = F.G * NWAVES;
    for (int m = gw; m < NTOK; m += NGW) {
        const int b = m / SEQ;
        const GAS f32x4* xr = (const GAS f32x4*)(F.x + (size_t)m * D) + F.lane;
        const GAS f32x4* gr = (const GAS f32x4*)F.g_mix + F.lane;
        const GAS f32x4* shr = (const GAS f32x4*)(F.mod + (size_t)b * (NMOD * D)) + F.lane;
        const GAS f32x4* scr = (const GAS f32x4*)(F.mod + (size_t)b * (NMOD * D) + D) + F.lane;
        f32x4 v[4]; float s = 0.f;
#pragma unroll
        for (int j = 0; j < 4; ++j) { v[j] = xr[64 * j]; s += (v[j].x * v[j].x + v[j].y * v[j].y) + (v[j].z * v[j].z + v[j].w * v[j].w); }
        const float rstd = __builtin_amdgcn_rsqf(wave_sum(s) * (1.f / D) + RMS_EPS);
        GAS unsigned long long* o8 = (GAS unsigned long long*)(F.XN + (size_t)m * D) + F.lane;
#pragma unroll
        for (int j = 0; j < 4; ++j) { const f32x4 g = gr[64 * j], sh = shr[64 * j], sc = scr[64 * j]; const f32x4 y = (v[j] * rstd * g) * (sc + 1.0f) + sh;
            o8[64 * j] = (unsigned long long)pk2(y.x, y.y) | ((unsigned long long)pk2(y.z, y.w) << 32); }
    }
}

__device__ __forceinline__ float dot64(const unsigned (&q)[32], const v4u (&k)[8]) {
    float a0 = 0.f, a1 = 0.f;
#pragma unroll
    for (int i = 0; i < 8; ++i) {
        a0 += bflo(q[4 * i]) * bflo(k[i].x) + bflo(q[4 * i + 1]) * bflo(k[i].y) + bflo(q[4 * i + 2]) * bflo(k[i].z) + bflo(q[4 * i + 3]) * bflo(k[i].w);
        a1 += bfhi(q[4 * i]) * bfhi(k[i].x) + bfhi(q[4 * i + 1]) * bfhi(k[i].y) + bfhi(q[4 * i + 2]) * bfhi(k[i].z) + bfhi(q[4 * i + 3]) * bfhi(k[i].w); }
    return a0 + a1;
}
#define LOADROW(dst, p) do { _Pragma("unroll") for (int i_ = 0; i_ < 8; ++i_) dst[i_] = ((const GAS v4u*)(p))[i_]; } while (0)
#define AXPY64(o, p, v) do { _Pragma("unroll") for (int i_ = 0; i_ < 8; ++i_) { \
    o[8 * i_ + 0] += p * bflo(v[i_].x); o[8 * i_ + 1] += p * bfhi(v[i_].x); o[8 * i_ + 2] += p * bflo(v[i_].y); o[8 * i_ + 3] += p * bfhi(v[i_].y); \
    o[8 * i_ + 4] += p * bflo(v[i_].z); o[8 * i_ + 5] += p * bfhi(v[i_].z); o[8 * i_ + 6] += p * bflo(v[i_].w); o[8 * i_ + 7] += p * bfhi(v[i_].w); } } while (0)
#define STOREO(ptr, o, sc) do { _Pragma("unroll") for (int i_ = 0; i_ < 8; ++i_) { v4u w_; w_.x = pk2(o[8 * i_] * sc, o[8 * i_ + 1] * sc); w_.y = pk2(o[8 * i_ + 2] * sc, o[8 * i_ + 3] * sc); \
    w_.z = pk2(o[8 * i_ + 4] * sc, o[8 * i_ + 5] * sc); w_.w = pk2(o[8 * i_ + 6] * sc, o[8 * i_ + 7] * sc); ((GAS v4u*)(ptr))[i_] = w_; } } while (0)

__device__ __forceinline__ void moba_naive_item(Frame& F, int item) {
    const int bh = item >> 6, ch = item & 63, b = bh >> 3, h = bh & 7, lz = lane_zero();
    const int t = ch * 64 + F.lane, own = ch >> 2, tl = t & 255;
    const size_t rowb = (size_t)b * SEQ;
    unsigned q[32]; { v4u t4[8]; LOADROW(t4, F.QA + (rowb + t) * WATT + h * HD);
#pragma unroll
        for (int i = 0; i < 8; ++i) { q[4 * i] = t4[i].x; q[4 * i + 1] = t4[i].y; q[4 * i + 2] = t4[i].z; q[4 * i + 3] = t4[i].w; } }
    float v0 = -INFINITY, v1 = -INFINITY, v2 = -INFINITY; int i0 = 0, i1 = 0, i2 = 0;
    for (int j = 0; j < own; ++j) {
        const GAS f32x4* km = (const GAS f32x4*)(F.kmean + ((size_t)(b * NBLK + j) * NH + h) * HD + lz);
        float g = 0.f;
#pragma unroll
        for (int i = 0; i < 16; ++i) { const f32x4 kv = km[i]; g += bflo(q[2 * i]) * kv.x + bfhi(q[2 * i]) * kv.y + bflo(q[2 * i + 1]) * kv.z + bfhi(q[2 * i + 1]) * kv.w; }
        if (g > v0) { v2 = v1; i2 = i1; v1 = v0; i1 = i0; v0 = g; i0 = j; } else if (g > v1) { v2 = v1; i2 = i1; v1 = g; i1 = j; } else if (g > v2) { v2 = g; i2 = j; }
    }
    float m = -INFINITY, l = 0.f; float o[64];
#pragma unroll
    for (int i = 0; i < 64; ++i) o[i] = 0.f;
    const float* bt = F.biasT + h * SEQ;
    const int nsel = own < 3 ? own : 3;
    for (int sl = 0; sl < nsel; ++sl) {
        const int blk = sl == 0 ? i0 : (sl == 1 ? i1 : i2);
        const bf16* kp = F.KA + (rowb + blk * MBLK) * WATT + h * HD; const bf16* vp = F.VA + (rowb + blk * MBLK) * WATT + h * HD;
        const int dist0 = t - blk * MBLK;
        for (int s = 0; s < MBLK; ++s) {
            v4u kk[8]; LOADROW(kk, kp + (size_t)s * WATT); const float sc = dot64(q, kk) + bt[dist0 - s];
            const float mn = fmaxf(m, sc), al = __builtin_amdgcn_exp2f(m - mn), p = __builtin_amdgcn_exp2f(sc - mn);
            l = l * al + p; m = mn;
#pragma unroll
            for (int i = 0; i < 64; ++i) o[i] *= al;
            v4u vv[8]; LOADROW(vv, vp + (size_t)s * WATT); AXPY64(o, p, vv);
        }
    }
    {
        const bf16* kp = F.KA + (rowb + own * MBLK) * WATT + h * HD + lz; const bf16* vp = F.VA + (rowb + own * MBLK) * WATT + h * HD + lz;
        const int smax = (ch & 3) * 64 + 63;
        for (int s = 0; s <= smax; ++s) {
            v4u kk[8]; LOADROW(kk, kp + (size_t)s * WATT); const int dist = tl - s; const float sc = dot64(q, kk) + bt[dist > 0 ? dist : 0];
            if (dist >= 0) {
                const float mn = fmaxf(m, sc), al = __builtin_amdgcn_exp2f(m - mn), p = __builtin_amdgcn_exp2f(sc - mn);
                l = l * al + p; m = mn;
#pragma unroll
                for (int i = 0; i < 64; ++i) o[i] *= al;
                v4u vv[8]; LOADROW(vv, vp + (size_t)s * WATT); AXPY64(o, p, vv);
            }
        }
    }
    const float rl = 1.0f / l;
    STOREO(F.QA + (rowb + t) * WATT + h * HD, o, rl);
}
__device__ __forceinline__ void sb_naive_item(Frame& F, int item) {
    const int bh = item >> 6, ch = item & 63, b = bh >> 3, h = bh & 7, lz = lane_zero();
    const int t = ch * 64 + F.lane;
    const size_t rowb = (size_t)b * SEQ;
    unsigned q[32]; { v4u t4[8]; LOADROW(t4, F.QB + (rowb + t) * WATT + h * HD);
#pragma unroll
        for (int i = 0; i < 8; ++i) { q[4 * i] = t4[i].x; q[4 * i + 1] = t4[i].y; q[4 * i + 2] = t4[i].z; q[4 * i + 3] = t4[i].w; } }
    float c = 1.0f; float o[64];
#pragma unroll
    for (int i = 0; i < 64; ++i) o[i] = 0.f;
    const bf16* kp = F.KB + rowb * WATT + h * HD + lz; const bf16* vp = F.VB + rowb * WATT + h * HD + lz;
    for (int s = ch * 64 + 62; s >= 0; --s) {
        v4u kk[8]; LOADROW(kk, kp + (size_t)s * WATT); const float e = __builtin_amdgcn_exp2f(dot64(q, kk)); const float r = 1.0f / (1.0f + e);
        if (s < t) { const float a = e * r * c; c *= r; v4u vv[8]; LOADROW(vv, vp + (size_t)s * WATT); AXPY64(o, a, vv); }
    }
    STOREO(F.QB + (rowb + t) * WATT + h * HD, o, 1.0f);
}
__device__ __forceinline__ void p3_attn_naive(Frame& F) {
    const int gw = F.vcu * NWAVES + F.wave, NGW = F.G * NWAVES;
    for (int p = gw; p < 2048; p += NGW) { const int bh = p >> 5, j = p & 31;
        sb_naive_item(F, bh * 64 + j); sb_naive_item(F, bh * 64 + 63 - j); }
    for (int p = gw; p < 2048; p += NGW) { const int bh = p >> 5, j = p & 31;
        moba_naive_item(F, bh * 64 + j); moba_naive_item(F, bh * 64 + 63 - j); }
}

__device__ __forceinline__ void p6_route(Frame& F) {
    const int gw = F.vcu * NWAVES + F.wave, NGW = F.G * NWAVES;
    for (int m = gw; m < NTOK; m += NGW) {
        const int b = m / SEQ;
        const GAS f32x4* xr = (const GAS f32x4*)(F.out + (size_t)m * D) + F.lane;
        const GAS f32x4* gr = (const GAS f32x4*)F.g_ffn + F.lane;
        const GAS f32x4* shr = (const GAS f32x4*)(F.mod + (size_t)b * (NMOD * D) + 3 * D) + F.lane;
        const GAS f32x4* scr = (const GAS f32x4*)(F.mod + (size_t)b * (NMOD * D) + 4 * D) + F.lane;
        float ss = 0.f; { const GAS f32x4* sp = (const GAS f32x4*)(F.stats + (size_t)m * 16);
#pragma unroll
            for (int j = 0; j < 4; ++j) { const f32x4 s4 = sp[j]; ss += (s4.x + s4.y) + (s4.z + s4.w); } }
        const float rstd = __builtin_amdgcn_rsqf(ss * (1.f / D) + RMS_EPS);
        f32x4 y[4];
        GAS unsigned long long* o8 = (GAS unsigned long long*)(F.XN + (size_t)m * D) + F.lane;
#pragma unroll
        for (int j = 0; j < 4; ++j) { const f32x4 v = xr[64 * j], g = gr[64 * j], sh = shr[64 * j], sc = scr[64 * j]; y[j] = (v * rstd * g) * (sc + 1.0f) + sh;
            o8[64 * j] = (unsigned long long)pk2(y[j].x, y[j].y) | ((unsigned long long)pk2(y[j].z, y[j].w) << 32); }
        float gl[4] = {0.f, 0.f, 0.f, 0.f};
#pragma unroll
        for (int j = 0; j < 4; ++j) { const GAS f32x4* wp = (const GAS f32x4*)(F.w_rg + (size_t)(4 * F.lane + 256 * j) * NGRP);
#pragma unroll
            for (int e = 0; e < 4; ++e) { const f32x4 w = wp[e]; const float yv = y[j][e]; gl[0] += yv * w.x; gl[1] += yv * w.y; gl[2] += yv * w.z; gl[3] += yv * w.w; } }
#pragma unroll
        for (int g = 0; g < 4; ++g) gl[g] = wave_sum(gl[g]) + F.b_rg[g];
        int gi = 0; float gm = gl[0];
#pragma unroll
        for (int g = 1; g < 4; ++g) if (gl[g] > gm) { gm = gl[g]; gi = g; }
        float den = 0.f;
#pragma unroll
        for (int g = 0; g < 4; ++g) den += __expf(gl[g] - gm);
        const float gwt = 1.0f / den;
        float el[8] = {0.f, 0.f, 0.f, 0.f, 0.f, 0.f, 0.f, 0.f};
#pragma unroll
        for (int j = 0; j < 4; ++j)
#pragma unroll
            for (int e = 0; e < 4; ++e) { const GAS f32x4* wp = (const GAS f32x4*)(F.w_re + (size_t)(4 * F.lane + 256 * j + e) * NEXP + gi * EPG); const f32x4 w0 = wp[0], w1 = wp[1]; const float yv = y[j][e];
                el[0] += yv * w0.x; el[1] += yv * w0.y; el[2] += yv * w0.z; el[3] += yv * w0.w; el[4] += yv * w1.x; el[5] += yv * w1.y; el[6] += yv * w1.z; el[7] += yv * w1.w; }
#pragma unroll
        for (int k = 0; k < 8; ++k) el[k] = wave_sum(el[k]) + F.b_re[gi * EPG + k];
        int k1 = 0; float t1 = el[0];
#pragma unroll
        for (int k = 1; k < 8; ++k) if (el[k] > t1) { t1 = el[k]; k1 = k; }
        int k2 = -1; float t2 = -INFINITY;
#pragma unroll
        for (int k = 0; k < 8; ++k) if (k != k1 && el[k] > t2) { t2 = el[k]; k2 = k; }
        const float ex = __expf(t2 - t1); const float w1v = gwt / (1.0f + ex), w2v = gwt * ex / (1.0f + ex);
        if (F.lane < 2) { const int e = gi * EPG + (F.lane == 0 ? k1 : k2); const float w = F.lane == 0 ? w1v : w2v;
            const unsigned pos = __hip_atomic_fetch_add(F.cnt + (F.lane * NEXP + e) * 64, 1u, __ATOMIC_RELAXED, __HIP_MEMORY_SCOPE_AGENT);
            F.tokl[(size_t)(F.lane * NEXP + e) * LCAP + pos] = m; F.wl[(size_t)(F.lane * NEXP + e) * LCAP + pos] = w; }
    }
}
__device__ __forceinline__ void moe_tables(Frame& F) {
    LAS int* T = (LAS int*)(F.lds + TAB_OFF);
    if (F.tid < 64) T[F.tid] = (int)__hip_atomic_load(F.cnt + F.tid * 64, RLX_AGENT);
    __syncthreads();
    if (F.tid == 0) { int pa = 0, hs = 0, p0 = 0, p1 = 0;
        for (int e = 0; e < NEXP; ++e) { const int c0 = T[e], c1 = T[32 + e], ta = (c0 + c1 + 255) >> 8;
            T[64 + e] = pa; T[128 + e] = hs; T[192 + e] = p0; T[256 + e] = p1; pa += ta; hs += ta * 256; p0 += (c0 + 255) >> 8; p1 += (c1 + 255) >> 8; }
        T[64 + 32] = pa; T[128 + 32] = hs; T[192 + 32] = p0; T[256 + 32] = p1; }
    __syncthreads();
}
#ifndef MK_N_LAUNCHES
#define MK_N_LAUNCHES 1
#endif
constexpr int N_PHASES = 10;
constexpr int N_LAUNCHES = MK_N_LAUNCHES;
static_assert(N_LAUNCHES == 1 || N_LAUNCHES == N_PHASES, "MK_N_LAUNCHES is 1 or N_PHASES");
struct Args { const float* in[20]; float* out; unsigned char* ws; int ph_lo, ph_hi; };
__global__ void __launch_bounds__(NWAVES * 64, 2) fwd(Args args) {
    extern __shared__ __attribute__((aligned(16))) unsigned char lds[];
    Frame F;
    F.lds = (LAS unsigned char*)lds;
    F.MISC = (volatile LAS unsigned*)(F.lds + MISC_OFF);
    F.tid = threadIdx.x; F.lane = F.tid & 63; F.wave = __builtin_amdgcn_readfirstlane(F.tid >> 6);
    F.G = gridDim.x; { const int bx = blockIdx.x; F.vcu = (F.G % 8 == 0) ? (bx % 8) * (F.G / 8) + bx / 8 : bx; }
    unsigned char* ws = args.ws;
    F.ctl = (gu32*)(ws + WS_CTL);
    F.x = args.in[0]; F.c = args.in[1]; F.w_ada = args.in[2]; F.b_ada = args.in[3]; F.g_mix = args.in[4]; F.w_in = args.in[5]; F.g_q = args.in[6]; F.g_k = args.in[7]; F.rel_bias = args.in[8];
    F.w_br_moba = args.in[9]; F.w_br_sb = args.in[10]; F.w_out = args.in[11]; F.g_ffn = args.in[12]; F.w_rg = args.in[13]; F.b_rg = args.in[14]; F.w_re = args.in[15]; F.b_re = args.in[16];
    F.w_gate = args.in[17]; F.w_up = args.in[18]; F.w_down = args.in[19]; F.out = args.out;
    F.mod = (float*)(ws + WS_MOD); F.biasT = (float*)(ws + WS_BIAS); F.stats = (float*)(ws + WS_STATS); F.kmean = (float*)(ws + WS_CTL) + CW_KMEAN;
    F.Win_t = (bf16*)(ws + WS_WIN); F.Wbra_t = (bf16*)(ws + WS_WBRA); F.Wbrb_t = (bf16*)(ws + WS_WBRB); F.Wout_t = (bf16*)(ws + WS_WOUT); F.Wgu_t = (bf16*)(ws + WS_WGU); F.Wd_t = (bf16*)(ws + WS_WD);
    F.XN = (bf16*)(ws + WS_XN); F.QA = (bf16*)(ws + WS_QA); F.KA = (bf16*)(ws + WS_KA); F.VA = (bf16*)(ws + WS_VA); F.QB = (bf16*)(ws + WS_QB); F.KB = (bf16*)(ws + WS_KB); F.VB = (bf16*)(ws + WS_VB);
    F.GA = (bf16*)(ws + WS_GA); F.GB = (bf16*)(ws + WS_GB); F.H = (bf16*)(ws + WS_H);
    F.tokl = (int*)(ws + WS_TOKL); F.wl = (float*)(ws + WS_WL); F.cnt = (unsigned*)(ws + WS_CTL) + CW_CNT;
    for (int u = F.tid; u < (LDS_BYTES - LDSCTL_OFF) / 4; u += NWAVES * 64) ((LAS unsigned*)(F.lds + LDSCTL_OFF))[u] = 0u;
    __syncthreads();
    XcdBarrier bar; bar.bar = (unsigned*)(F.ctl + CW_BAR); bar.x = 0; bar.st = nullptr;
    if (N_LAUNCHES == 1) bar = xcd_barrier_post((unsigned*)(F.ctl + CW_BAR), F.MISC + 8);
#define GRID_BAR() do { if (N_LAUNCHES == 1) { xcd_barrier(bar); } } while (0)
    const int lo = args.ph_lo, hi = args.ph_hi;
#define IN(k) (lo <= (k) && (k) < hi)
#define BOTH(k) (IN(k) && IN((k) + 1))

    if (IN(0)) { p0_prologue(F); if (BOTH(0)) GRID_BAR(); }
    if (IN(1)) { p1_norm(F); if (BOTH(1)) GRID_BAR(); }
    if (IN(2)) {
        __syncthreads();
        pg8::Gemm g{F.XN, F.Win_t, D}; pg8::DenseOrder S; S.init(NTOK, INCOLS, F.G, (int)blockIdx.x);
        pg8::EpiProj E{F.QA, F.GA, F.GB, F.g_q, F.g_k, F.kmean};
        pg8::gemm_phase<pg8::EpiProj, pg8::DenseOrder, false>(F.lds + RING_OFF, g, S, E);
        if (BOTH(2)) GRID_BAR();
    }
    if (IN(3)) { p3_attn_naive(F); if (BOTH(3)) GRID_BAR(); }
    if (IN(4)) {
        __syncthreads();
        { pg8::Gemm g{F.QA, F.Wbra_t, WATT}; pg8::DenseOrder S; S.init(NTOK, D, F.G, (int)blockIdx.x);
          pg8::EpiBranch<0> E{F.GA, nullptr};
          pg8::gemm_phase<pg8::EpiBranch<0>, pg8::DenseOrder, false>(F.lds + RING_OFF, g, S, E); }
        { pg8::Gemm g{F.QB, F.Wbrb_t, WATT}; pg8::DenseOrder S; S.init(NTOK, D, F.G, (int)blockIdx.x);
          pg8::EpiBranch<1> E{F.GB, F.GA};
          pg8::gemm_phase<pg8::EpiBranch<1>, pg8::DenseOrder, false>(F.lds + RING_OFF, g, S, E); }
        if (BOTH(4)) GRID_BAR();
    }
    if (IN(5)) {
        __syncthreads();
        pg8::Gemm g{F.GB, F.Wout_t, D}; pg8::DenseOrder S; S.init(NTOK, D, F.G, (int)blockIdx.x);
        pg8::EpiResid E{F.x, F.out, F.mod + 2 * D, F.stats};
        pg8::gemm_phase<pg8::EpiResid, pg8::DenseOrder, false>(F.lds + RING_OFF, g, S, E);
        if (BOTH(5)) GRID_BAR();
    }
    if (IN(6)) { p6_route(F); if (BOTH(6)) GRID_BAR(); }
    if (IN(7)) {
        moe_tables(F);
        pg8::Gemm g{F.XN, F.Wgu_t, D}; pg8::GateUpOrder S{(const LAS int*)(F.lds + TAB_OFF), F.tokl, F.G, (int)blockIdx.x};
        pg8::EpiGateUp E{F.H};
        pg8::gemm_phase<pg8::EpiGateUp, pg8::GateUpOrder, true>(F.lds + RING_OFF, g, S, E);
        if (BOTH(7)) GRID_BAR();
    }
    if (IN(8)) {
        moe_tables(F);
        pg8::Gemm g{F.H, F.Wd_t, DEXP}; pg8::DownOrder<0> S{(const LAS int*)(F.lds + TAB_OFF), F.G, (int)blockIdx.x};
        pg8::EpiDown E{F.out, F.mod + 5 * D, F.tokl, F.wl};
        pg8::gemm_phase<pg8::EpiDown, pg8::DownOrder<0>, false>(F.lds + RING_OFF, g, S, E);
        if (BOTH(8)) GRID_BAR();
    }
    if (IN(9)) {
        moe_tables(F);
        pg8::Gemm g{F.H, F.Wd_t, DEXP}; pg8::DownOrder<1> S{(const LAS int*)(F.lds + TAB_OFF), F.G, (int)blockIdx.x};
        pg8::EpiDown E{F.out, F.mod + 5 * D, F.tokl, F.wl};
        pg8::gemm_phase<pg8::EpiDown, pg8::DownOrder<1>, false>(F.lds + RING_OFF, g, S, E);
    }
#undef IN
#undef BOTH
}

extern "C" void kernel_launch(void* const* d_in, const int* in_sizes, int n_in, void* d_out, int out_size, void* d_ws, size_t ws_size, hipStream_t stream) {
    static int grid = 0;
    if (grid == 0) {
        if (n_in != 20 || in_sizes[0] != NTOK * D || out_size != NTOK * D || ws_size < WS_END) { fprintf(stderr, "kernel_launch: built for 20 inputs, x/out of %d floats, >= %zu bytes of workspace; got n_in %d, in0 %d, out %d, ws %zu; nothing launched\n", NTOK * D, (size_t)WS_END, n_in, n_in > 0 ? in_sizes[0] : -1, out_size, ws_size); grid = -1; return; }
        int dev = 0, cus = 0, per_cu = 0;
        if (hipGetDevice(&dev) != hipSuccess || hipDeviceGetAttribute(&cus, hipDeviceAttributeMultiprocessorCount, dev) != hipSuccess) { fprintf(stderr, "kernel_launch: hipGetDevice / hipDeviceGetAttribute failed\n"); grid = -1; return; }
        if (hipFuncSetAttribute((const void*)fwd, hipFuncAttributeMaxDynamicSharedMemorySize, LDS_BYTES) != hipSuccess) { fprintf(stderr, "kernel_launch: hipFuncSetAttribute failed\n"); grid = -1; return; }
        if (hipOccupancyMaxActiveBlocksPerMultiprocessor(&per_cu, (const void*)fwd, NWAVES * 64, LDS_BYTES) != hipSuccess || per_cu < 1)
            fprintf(stderr, "kernel_launch: note: the occupancy query reports %d workgroups per CU\n", per_cu);
        (void)hipGetLastError();
        grid = cus;
    }
    if (grid < 0) return;
    if (hipMemsetAsync((char*)d_ws + WS_CTL, 0, CTL_ZERO_BYTES, stream) != hipSuccess) { fprintf(stderr, "kernel_launch: hipMemsetAsync failed\n"); return; }
    Args a{};
    for (int i = 0; i < 20; ++i) a.in[i] = (const float*)d_in[i];
    a.out = (float*)d_out; a.ws = (unsigned char*)d_ws;
    for (int li = 0; li < N_LAUNCHES; ++li) {
        a.ph_lo = (N_LAUNCHES == 1) ? 0 : li; a.ph_hi = (N_LAUNCHES == 1) ? N_PHASES : li + 1;
        hipLaunchKernelGGL(fwd, dim3(grid), dim3(NWAVES * 64), LDS_BYTES, stream, a);
        const hipError_t le = hipPeekAtLastError();
        if (le != hipSuccess) { fprintf(stderr, "kernel_launch: launch %d failed: %s\n", li, hipGetErrorName(le)); break; }
    }
}
```

```cpp
#include <hip/hip_runtime.h>
#include <cstdio>
#include <cstdint>
#include <cmath>
namespace pg8 {
#define PG8_LAS __attribute__((address_space(3)))
typedef unsigned short bf16_t;
typedef short bf16x8 __attribute__((ext_vector_type(8)));
typedef float f32x4 __attribute__((ext_vector_type(4)));
typedef unsigned u32x4 __attribute__((ext_vector_type(4)));
constexpr int BM = 256, BK = 64, HALF = 128, HTB = HALF * BK * 2  , STAGE_BYTES = 8 * HTB, NXCD = 8, WGM = 8;

__host__ __device__ __forceinline__ int lds_byte(int r, int c) { const int st = (r >> 4) * 2 + (c >> 5), rr = r & 15, cc = c & 31, ob = rr * 64 + cc * 2; return st * 1024 + (ob ^ (((ob >> 9) & 1) << 5)); }
__host__ __device__ __forceinline__ void stage_rc(int b, int& R, int& C) { const int st = b / 1024, sb = b % 1024, swz = sb ^ (((sb >> 9) & 1) << 5); R = (st >> 1) * 16 + swz / 64; C = (st & 1) * 32 + (swz % 64) / 2; }
__host__ __device__ __forceinline__ int perm32(int rho) { const int n = rho >> 4, i = rho & 15; return 8 * (i >> 2) + 4 * n + (i & 3); }

struct Unit { int arow, brow, pm, pn, x0, x1; };
struct Gemm { const bf16_t* A; const bf16_t* Bt; int K; };

struct DenseOrder {
    int nM, nN, nwg, G, c;
    __device__ void init(int M, int N, int G_, int c_) { nM = M / BM; nN = N / BM; nwg = nM * nN; G = G_; c = c_; }
    __device__ bool next(int i, Unit& u) const {
        const long L = (long)i * G + c; if (L >= nwg) return false;
        int wgid = (int)L; { const int q = nwg / NXCD, r = nwg % NXCD, xcd = wgid % NXCD, off = wgid / NXCD; wgid = (xcd < r ? xcd * (q + 1) : r * (q + 1) + (xcd - r) * q) + off; }
        const int nig = WGM * nN, gid = wgid / nig, fm = gid * WGM, gsz = (nM - fm) < WGM ? (nM - fm) : WGM;
        u.pm = fm + ((wgid % nig) % gsz); u.pn = (wgid % nig) / gsz; u.arow = u.pm * BM; u.brow = u.pn * BM; u.x0 = 0; u.x1 = 0; return true;
    }
    __device__ __forceinline__ int arow_of(const Unit&, int) const { return 0; }
};

__device__ __forceinline__ unsigned cvt_pk_bf16(float lo, float hi) { unsigned r; asm volatile("v_cvt_pk_bf16_f32 %0, %1, %2" : "=v"(r) : "v"(lo), "v"(hi)); return r; }

template <class Epi, class Sched, bool GATHER, bool ALIGN_EPI = true, bool SP2 = true>
__device__ __forceinline__ void gemm_phase(PG8_LAS unsigned char* lds, const Gemm g, const Sched& S, const Epi& E) {
    const int tid = threadIdx.x, wid = __builtin_amdgcn_readfirstlane(tid >> 6), lane = tid & 63, wr = wid >> 2, wc = wid & 3, fr = lane & 15, fq = lane >> 4;
    const int K = g.K, nt = K / BK;
    unsigned voffA[2], voffB[2]; int stR[2], stC[2];
#pragma unroll
    for (int i = 0; i < 2; ++i) { int R, C; stage_rc(tid * 16 + i * 8192, R, C); const int Rb = Epi::PERM ? ((R & ~31) + perm32(R & 31)) : R;
        stR[i] = R; stC[i] = C; voffA[i] = (unsigned)(R * K + C) * 2u; voffB[i] = (unsigned)(Rb * K + C) * 2u; }
    const size_t kstep = (size_t)(BK * 2);
    const size_t hstep = (size_t)HALF * K * 2;
    const size_t rstep = (size_t)K * 2;
    const unsigned ldsw = (unsigned)wid * 1024u;
    const int aoff = lds_byte(wr * 64 + fr, fq * 8), boff = lds_byte(wc * 32 + fr, fq * 8);
#define PG8_SA(b, h) (((b) * 2 + (h)) * HTB)
#define PG8_SB(b, h) ((4 + (b) * 2 + (h)) * HTB)
#define PG8_STAGE(bufoff, gbase, voff) do { _Pragma("unroll") for (int _i = 0; _i < 2; ++_i) \
        __builtin_amdgcn_global_load_lds((const unsigned*)((const char*)(gbase) + (voff)[_i]), (PG8_LAS unsigned*)(lds + (bufoff) + ldsw + _i * 8192), 16, 0, 0); } while (0)
#define PG8_STAGE_A(bufoff, ub, h, VS) do { if constexpr (GATHER) { PG8_STAGE(bufoff, ub, VS[h]); } else { PG8_STAGE(bufoff, (ub) + (h) * hstep, voffA); } } while (0)
#define PG8_VOFFS(dst, U) do { _Pragma("unroll") for (int h_ = 0; h_ < 2; ++h_) _Pragma("unroll") for (int i_ = 0; i_ < 2; ++i_) \
        dst[h_][i_] = (unsigned)(S.arow_of(U, h_ * HALF + stR[i_]) * K + stC[i_]) * 2u; } while (0)
#define PG8_LDA(dst, b, h) do { _Pragma("unroll") for (int m = 0; m < 4; ++m) _Pragma("unroll") for (int k = 0; k < 2; ++k) dst[m][k] = *(const PG8_LAS bf16x8*)(lds + PG8_SA(b, h) + aoff + m * 2048 + k * 1024); } while (0)
#define PG8_LDB(dst, b, h) do { _Pragma("unroll") for (int n = 0; n < 2; ++n) _Pragma("unroll") for (int k = 0; k < 2; ++k) dst[n][k] = *(const PG8_LAS bf16x8*)(lds + PG8_SB(b, h) + boff + n * 2048 + k * 1024); } while (0)
#define PG8_MMA(ai, bj, At, Bt) do { __builtin_amdgcn_s_setprio(1); _Pragma("unroll") for (int m = 0; m < 4; ++m) _Pragma("unroll") for (int n = 0; n < 2; ++n) _Pragma("unroll") for (int k = 0; k < 2; ++k) \
        acc[ai][bj][m][n] = __builtin_amdgcn_mfma_f32_16x16x32_bf16(Bt[n][k], At[m][k], acc[ai][bj][m][n], 0, 0, 0); __builtin_amdgcn_s_setprio(0); } while (0)
#define PG8_WAIT_V(n) asm volatile("s_waitcnt vmcnt(" #n ")" ::: "memory")
#define PG8_WAIT_L(n) asm volatile("s_waitcnt lgkmcnt(" #n ")" ::: "memory")
#define PG8_BAR __builtin_amdgcn_s_barrier()
#define PG8_SCHED __builtin_amdgcn_sched_barrier(0)
    Unit cur, nxt; int ui = 0;
    if (!S.next(0, cur)) return;
    bool has_next = S.next(1, nxt);
    unsigned vAc[2][2], vAn[2][2];
    if constexpr (GATHER) { PG8_VOFFS(vAc, cur); if (has_next) { PG8_VOFFS(vAn, nxt); } else {
#pragma unroll
        for (int h_ = 0; h_ < 2; ++h_) { vAn[h_][0] = vAc[h_][0]; vAn[h_][1] = vAc[h_][1]; } } }
    else {
#pragma unroll
        for (int h_ = 0; h_ < 2; ++h_) { vAc[h_][0] = 0u; vAc[h_][1] = 0u; vAn[h_][0] = 0u; vAn[h_][1] = 0u; } }
    f32x4 acc[2][2][4][2];
#pragma unroll
    for (int a = 0; a < 2; ++a)
#pragma unroll
        for (int b = 0; b < 2; ++b)
#pragma unroll
            for (int m = 0; m < 4; ++m)
#pragma unroll
                for (int n = 0; n < 2; ++n) acc[a][b][m][n] = (f32x4){0.f, 0.f, 0.f, 0.f};
    bf16x8 At[4][2], B0[2][2], B1[2][2];
    const char* const A0 = (const char*)g.A;
    const char* cA = GATHER ? A0 : A0 + (size_t)cur.arow * rstep; const char* cB = (const char*)g.Bt + (size_t)cur.brow * rstep;
    if constexpr (SP2) {
        PG8_STAGE(PG8_SB(0, 0), cB, voffB); PG8_STAGE(PG8_SB(0, 1), cB + hstep, voffB); PG8_STAGE_A(PG8_SA(0, 0), cA, 0, vAc); PG8_STAGE_A(PG8_SA(0, 1), cA, 1, vAc);
        if (wr == 1) PG8_BAR;
        PG8_WAIT_V(2); PG8_BAR;
        PG8_STAGE(PG8_SB(1, 0), cB + kstep, voffB); PG8_STAGE_A(PG8_SA(1, 0), cA + kstep, 0, vAc); PG8_STAGE(PG8_SB(1, 1), cB + hstep + kstep, voffB);
        PG8_WAIT_V(6); PG8_BAR;
    } else {
        PG8_STAGE(PG8_SB(0, 0), cB, voffB); PG8_STAGE_A(PG8_SA(0, 0), cA, 0, vAc); PG8_STAGE(PG8_SB(0, 1), cB + hstep, voffB); PG8_STAGE_A(PG8_SA(0, 1), cA, 1, vAc);
        if (wr == 1) PG8_BAR;
        PG8_WAIT_V(4); PG8_BAR;
        PG8_STAGE(PG8_SB(1, 0), cB + kstep, voffB); PG8_STAGE_A(PG8_SA(1, 0), cA + kstep, 0, vAc); PG8_STAGE(PG8_SB(1, 1), cB + hstep + kstep, voffB);
        PG8_WAIT_V(6); PG8_BAR;
    }
    for (;;) {
        const char* nA = GATHER ? A0 : (has_next ? A0 + (size_t)nxt.arow * rstep : cA); const char* nB = has_next ? (const char*)g.Bt + (size_t)nxt.brow * rstep : cB;
        for (int t = 0; t < nt; t += 2) {
            const bool last = (t == nt - 2);
            const char* a1 = cA + (size_t)(t + 1) * kstep;
            const char* a2 = last ? nA : cA + (size_t)(t + 2) * kstep; const char* b2 = last ? nB : cB + (size_t)(t + 2) * kstep;
            const char* a3 = a2 + kstep; const char* b3 = b2 + kstep;
            unsigned vS[2][2];
#pragma unroll
            for (int h_ = 0; h_ < 2; ++h_) { vS[h_][0] = last ? vAn[h_][0] : vAc[h_][0]; vS[h_][1] = last ? vAn[h_][1] : vAc[h_][1]; }
            if constexpr (SP2) {
            PG8_LDB(B0, 0, 0); PG8_LDB(B1, 0, 1); PG8_SCHED; PG8_LDA(At, 0, 0); PG8_STAGE_A(PG8_SA(1, 1), a1, 1, vAc);
            PG8_WAIT_V(8); PG8_WAIT_L(0); PG8_BAR; PG8_MMA(0, 0, At, B0); PG8_MMA(0, 1, At, B1); PG8_BAR; PG8_SCHED;
            PG8_LDA(At, 0, 1); PG8_STAGE(PG8_SB(0, 0), b2, voffB); PG8_STAGE(PG8_SB(0, 1), b2 + hstep, voffB); PG8_STAGE_A(PG8_SA(0, 0), a2, 0, vS);
            PG8_WAIT_V(8); PG8_WAIT_L(0); PG8_BAR; PG8_MMA(1, 0, At, B0); PG8_MMA(1, 1, At, B1); PG8_BAR; PG8_SCHED;
            PG8_LDB(B0, 1, 0); PG8_LDB(B1, 1, 1); PG8_SCHED; PG8_LDA(At, 1, 0); PG8_STAGE_A(PG8_SA(0, 1), a2, 1, vS);
            PG8_WAIT_V(8); PG8_WAIT_L(0); PG8_BAR; PG8_MMA(0, 0, At, B0); PG8_MMA(0, 1, At, B1); PG8_BAR; PG8_SCHED;
            PG8_LDA(At, 1, 1); PG8_STAGE(PG8_SB(1, 0), b3, voffB); PG8_STAGE(PG8_SB(1, 1), b3 + hstep, voffB); PG8_STAGE_A(PG8_SA(1, 0), a3, 0, vS);
            PG8_WAIT_V(8); PG8_WAIT_L(0); PG8_BAR; PG8_MMA(1, 0, At, B0); PG8_MMA(1, 1, At, B1); PG8_BAR; PG8_SCHED;
            } else {
            PG8_LDB(B0, 0, 0); PG8_SCHED; PG8_LDA(At, 0, 0); PG8_STAGE_A(PG8_SA(1, 1), a1, 1, vAc);
            PG8_WAIT_L(8); PG8_BAR; PG8_WAIT_L(0); PG8_MMA(0, 0, At, B0); PG8_BAR; PG8_SCHED;
            PG8_LDB(B1, 0, 1); PG8_STAGE(PG8_SB(0, 0), b2, voffB);
            PG8_BAR; PG8_WAIT_L(0); PG8_MMA(0, 1, At, B1); PG8_BAR;
            PG8_LDA(At, 0, 1); PG8_STAGE_A(PG8_SA(0, 0), a2, 0, vS);
            PG8_BAR; PG8_WAIT_L(0); PG8_MMA(1, 0, At, B0); PG8_BAR; PG8_SCHED;
            PG8_STAGE(PG8_SB(0, 1), b2 + hstep, voffB);
            PG8_WAIT_V(6); PG8_BAR; PG8_MMA(1, 1, At, B1); PG8_BAR;
            PG8_LDB(B0, 1, 0); PG8_SCHED; PG8_LDA(At, 1, 0); PG8_STAGE_A(PG8_SA(0, 1), a2, 1, vS);
            PG8_WAIT_L(8); PG8_BAR; PG8_WAIT_L(0); PG8_MMA(0, 0, At, B0); PG8_BAR; PG8_SCHED;
            PG8_LDB(B1, 1, 1); PG8_STAGE(PG8_SB(1, 0), b3, voffB);
            PG8_BAR; PG8_WAIT_L(0); PG8_MMA(0, 1, At, B1); PG8_BAR;
            PG8_LDA(At, 1, 1); PG8_STAGE_A(PG8_SA(1, 0), a3, 0, vS);
            PG8_BAR; PG8_WAIT_L(0); PG8_MMA(1, 0, At, B0); PG8_BAR; PG8_SCHED;
            PG8_STAGE(PG8_SB(1, 1), b3 + hstep, voffB);
            PG8_WAIT_V(6); PG8_BAR; PG8_MMA(1, 1, At, B1); PG8_BAR;
            }
        }
        if constexpr (ALIGN_EPI) { if (wr == 0) PG8_BAR; }
        E(acc, cur, wr, wc, fr, fq);
        if (!has_next) break;
#pragma unroll
        for (int a = 0; a < 2; ++a)
#pragma unroll
            for (int b = 0; b < 2; ++b)
#pragma unroll
                for (int m = 0; m < 4; ++m)
#pragma unroll
                    for (int n = 0; n < 2; ++n) acc[a][b][m][n] = (f32x4){0.f, 0.f, 0.f, 0.f};
        cur = nxt; cA = nA; cB = nB; ++ui;
        has_next = S.next(ui + 1, nxt);
        if constexpr (GATHER) {
#pragma unroll
            for (int h_ = 0; h_ < 2; ++h_) { vAc[h_][0] = vAn[h_][0]; vAc[h_][1] = vAn[h_][1]; }
            if (has_next) { PG8_VOFFS(vAn, nxt); }
        }
        if constexpr (ALIGN_EPI) { if (wr == 1) PG8_BAR; }
    }
    PG8_WAIT_V(0);
    if constexpr (!ALIGN_EPI) { if (wr == 0) PG8_BAR; }
    PG8_BAR;
#undef PG8_SA
#undef PG8_SB
#undef PG8_STAGE
#undef PG8_STAGE_A
#undef PG8_VOFFS
#undef PG8_LDA
#undef PG8_LDB
#undef PG8_MMA
#undef PG8_WAIT_V
#undef PG8_WAIT_L
#undef PG8_BAR
#undef PG8_SCHED
}
}
constexpr int NWAVES = 8;
constexpr int BATCH = 8, SEQ = 4096, D = 1024, NTOK = BATCH * SEQ;
constexpr int HD = 64, NH = 8, WATT = NH * HD;
constexpr int INCOLS = 5120, NMOD = 6;
constexpr int MBLK = 256, NBLK = SEQ / MBLK;
constexpr int NEXP = 32, EPG = 8, NGRP = 4, DEXP = 512;
constexpr float RMS_EPS = 1e-6f;
constexpr float LOG2E = 1.4426950408889634f;
constexpr float C2 = 0.125f * 1.4426950408889634f;
constexpr int LCAP = NTOK;
constexpr int HROWS = 2 * NTOK + NEXP * 256 + 256;

constexpr size_t MiB = 1u << 20;
constexpr size_t WS_CTL = 0, CTL_ZERO_BYTES = 1 * MiB;
constexpr size_t WS_MOD = 1 * MiB;
constexpr size_t WS_BIAS = 1 * MiB + 256 * 1024;
constexpr size_t WS_STATS = 2 * MiB;
constexpr size_t WS_WIN = 4 * MiB;
constexpr size_t WS_WBRA = 14 * MiB, WS_WBRB = 15 * MiB;
constexpr size_t WS_WOUT = 16 * MiB;
constexpr size_t WS_WGU = 18 * MiB;
constexpr size_t WS_WD = 82 * MiB;
constexpr size_t WS_XN = 114 * MiB;
constexpr size_t WS_QA = 178 * MiB, WS_KA = 210 * MiB, WS_VA = 242 * MiB, WS_QB = 274 * MiB, WS_KB = 306 * MiB, WS_VB = 338 * MiB;
constexpr size_t WS_GA = 370 * MiB, WS_GB = 434 * MiB;
constexpr size_t WS_H = 178 * MiB;
constexpr size_t WS_TOKL = 306 * MiB, WS_WL = 314 * MiB;
constexpr size_t WS_END = 498 * MiB;
static_assert(WS_H + (size_t)HROWS * DEXP * 2 <= WS_QB && WS_TOKL + (size_t)2 * NEXP * LCAP * 4 <= WS_WL && WS_WL + (size_t)2 * NEXP * LCAP * 4 <= WS_VB, "d_ws map");
constexpr int CW_TMO = 0, CW_CODE = 1;
constexpr int CW_BAR = 4096;
constexpr int CW_CNT = 16384;
constexpr int CW_KMEAN = 65536;
static_assert((CW_KMEAN + 65536) * 4 <= (int)CTL_ZERO_BYTES && CW_CNT + 64 * 64 <= CW_KMEAN && CW_BAR + 3456 <= CW_CNT, "CTL map");

constexpr int RING_OFF = 0, RING_BYTES = 131072;
constexpr int LDSCTL_OFF = RING_BYTES, MISC_OFF = LDSCTL_OFF + 320;
constexpr int TAB_OFF = RING_BYTES + 1024;
constexpr int LDS_BYTES = 147456;
static_assert(MISC_OFF + 128 <= TAB_OFF && TAB_OFF + 2048 <= LDS_BYTES, "LDS map");

#define GAS __attribute__((address_space(1)))
#define LAS __attribute__((address_space(3)))
typedef unsigned short bf16;
typedef unsigned v4u __attribute__((ext_vector_type(4)));
typedef unsigned v2u __attribute__((ext_vector_type(2)));
typedef float f32x4 __attribute__((ext_vector_type(4)));
typedef short bf16x8 __attribute__((ext_vector_type(8)));
typedef GAS unsigned gu32;
#define RLX_AGENT __ATOMIC_RELAXED, __HIP_MEMORY_SCOPE_AGENT
#define LDS_WAIT() asm volatile("s_waitcnt lgkmcnt(0)" ::: "memory")
#define VM_WAIT() asm volatile("s_waitcnt vmcnt(0)" ::: "memory")
__device__ __forceinline__ unsigned f2bf(float f) { unsigned u = __builtin_bit_cast(unsigned, f); return (u + 0x7fffu + ((u >> 16) & 1u)) >> 16; }
__device__ __forceinline__ unsigned pk2(float lo, float hi) { return f2bf(lo) | (f2bf(hi) << 16); }
__device__ __forceinline__ float bflo(unsigned u) { return __uint_as_float(u << 16); }
__device__ __forceinline__ float bfhi(unsigned u) { return __uint_as_float(u & 0xffff0000u); }
__device__ __forceinline__ float fsigmoid(float v) { return __builtin_amdgcn_rcpf(1.0f + __builtin_amdgcn_exp2f(-v * LOG2E)); }
#define XB_TMO      128
#define XB_XCNT(j)  (256  + 64 * (j))
#define XB_XSUB(j)  (1280 + 64 * (j))
#define XB_XGEN(j)  (2304 + 64 * (j))
#define XB_TOP      3328
#define XB_TOPGEN   3392
#define XCD_BAR_WORDS 3456
#define XB_SPIN_CAP (1u << 22)

__device__ __forceinline__ unsigned xb_ld(unsigned* p)              { return __hip_atomic_load(p, __ATOMIC_RELAXED, __HIP_MEMORY_SCOPE_AGENT); }
__device__ __forceinline__ unsigned xb_add(unsigned* p, unsigned v) { return __hip_atomic_fetch_add(p, v, __ATOMIC_RELAXED, __HIP_MEMORY_SCOPE_AGENT); }
__device__ __forceinline__ unsigned xb_xcc_id() { return (unsigned)__builtin_amdgcn_s_getreg((3 << 11) | 20) & 0xFu; }
#define XB_SPIN(cond, bar) do { unsigned _sp = 0; while (cond) { __builtin_amdgcn_s_sleep(1); \
    if ((++_sp & 255u) == 0u) { if (xb_ld(&(bar)[XB_TMO])) break; if (_sp > XB_SPIN_CAP) { atomicAdd(&(bar)[XB_TMO], 1u); break; } } } } while (0)

struct XcdBarrier {
    unsigned* bar; unsigned x;
    volatile LAS unsigned* st;
};

__device__ __forceinline__ XcdBarrier xcd_barrier_post(unsigned* bar, volatile LAS unsigned* st) {
    XcdBarrier b; b.bar = bar; b.x = xb_xcc_id(); b.st = st;
    if (threadIdx.x == 0) (void)xb_add(&bar[XB_XCNT(b.x)], 1u);
    return b;
}
__device__ __forceinline__ void xcd_barrier_complete(unsigned* bar, unsigned x, unsigned& nloc, unsigned& nx) {
    const unsigned G = gridDim.x * gridDim.y * gridDim.z;
    unsigned sum, cnt, mine, sp = 0u;
    for (;;) {
        sum = 0u; cnt = 0u; mine = 0u;
#pragma unroll
        for (unsigned j = 0; j < 16; ++j) { const unsigned c = xb_ld(&bar[XB_XCNT(j)]); sum += c; cnt += (c > 0u) ? 1u : 0u; mine = (j == x) ? c : mine; }
        if (sum == G) break;
        __builtin_amdgcn_s_sleep(1);
        if ((++sp & 255u) == 0u) { if (xb_ld(&bar[XB_TMO])) break; if (sp > XB_SPIN_CAP) { atomicAdd(&bar[XB_TMO], 1u); break; } }
    }
    nloc = mine > 0u ? mine : 1u; nx = cnt > 0u ? cnt : 1u;
}

__device__ __forceinline__ void xcd_barrier(const XcdBarrier& b) {
    asm volatile("s_waitcnt vmcnt(0)" ::: "memory");
    __syncthreads();
    if (threadIdx.x == 0) {
        unsigned* bar = b.bar;
        __builtin_amdgcn_s_waitcnt(0);
        unsigned nloc = b.st[0], nx = b.st[1];
        if (nloc == 0u) { xcd_barrier_complete(bar, b.x, nloc, nx); b.st[0] = nloc; b.st[1] = nx; }
        const unsigned old = xb_add(&bar[XB_XSUB(b.x)], 1u);
        const unsigned gen = old / nloc;
        if (old + 1u == (gen + 1u) * nloc) {
            __builtin_amdgcn_fence(__ATOMIC_RELEASE, "agent");
            asm volatile("s_waitcnt vmcnt(0)" ::: "memory");
            const unsigned og = xb_add(&bar[XB_TOP], 1u);
            const unsigned tg = og / nx;
            if (og + 1u == (tg + 1u) * nx) xb_add(&bar[XB_TOPGEN], 1u);
            else XB_SPIN(xb_ld(&bar[XB_TOPGEN]) == tg, bar);
            __builtin_amdgcn_fence(__ATOMIC_ACQUIRE, "agent");
            xb_add(&bar[XB_XGEN(b.x)], 1u);
            asm volatile("s_waitcnt vmcnt(0)" ::: "memory");
        } else {
            XB_SPIN(xb_ld(&bar[XB_XGEN(b.x)]) == gen, bar);
            __builtin_amdgcn_fence(__ATOMIC_ACQUIRE, "agent");
            asm volatile("s_waitcnt vmcnt(0)" ::: "memory");
        }
    }
    __syncthreads();
}
namespace pg8 {
struct EpiProj {
    static constexpr bool PERM = true;
    bf16_t* qkv;
    bf16_t* ga; bf16_t* gb;
    const float* gq; const float* gk;
    float* kmean;
    __device__ __forceinline__ void operator()(const f32x4 (&acc)[2][2][4][2], const Unit& u, int wr, int wc, int fr, int fq) const {
        const int pn = u.pn; const int row0 = u.pm * BM + wr * 64 + fr;
        if (pn < 4) {
            const bool isq = pn < 2; const float* gv = isq ? gq : gk; const float post = isq ? C2 : 1.0f;
            bf16_t* base = qkv + (size_t)(pn >> 1) * ((size_t)NTOK * WATT) + (pn & 1) * 256 + wc * 64 + 8 * fq;
            float g[2][2][4];
#pragma unroll
            for (int bj = 0; bj < 2; ++bj)
#pragma unroll
                for (int n = 0; n < 2; ++n) { const f32x4 t = *(const f32x4*)(gv + 32 * bj + 8 * fq + 4 * n); g[bj][n][0] = t[0] * post; g[bj][n][1] = t[1] * post; g[bj][n][2] = t[2] * post; g[bj][n][3] = t[3] * post; }
            float cs[2][2][4];
#pragma unroll
            for (int bj = 0; bj < 2; ++bj)
#pragma unroll
                for (int n = 0; n < 2; ++n)
#pragma unroll
                    for (int e = 0; e < 4; ++e) cs[bj][n][e] = 0.f;
#pragma unroll
            for (int ai = 0; ai < 2; ++ai)
#pragma unroll
                for (int m = 0; m < 4; ++m) {
                    float ss = 0.f;
#pragma unroll
                    for (int bj = 0; bj < 2; ++bj)
#pragma unroll
                        for (int n = 0; n < 2; ++n) { const f32x4 x = acc[ai][bj][m][n]; ss += (x[0] * x[0] + x[1] * x[1]) + (x[2] * x[2] + x[3] * x[3]); }
                    ss += __shfl_xor(ss, 16); ss += __shfl_xor(ss, 32);
                    const float rstd = __builtin_amdgcn_rsqf(ss * (1.0f / 64.0f) + RMS_EPS);
                    bf16_t* rowp = base + (size_t)(row0 + ai * HALF + m * 16) * WATT;
#pragma unroll
                    for (int bj = 0; bj < 2; ++bj) { float o[2][4];
#pragma unroll
                        for (int n = 0; n < 2; ++n)
#pragma unroll
                            for (int e = 0; e < 4; ++e) { o[n][e] = acc[ai][bj][m][n][e] * rstd * g[bj][n][e]; cs[bj][n][e] += o[n][e]; }
                        u32x4 w; w.x = cvt_pk_bf16(o[0][0], o[0][1]); w.y = cvt_pk_bf16(o[0][2], o[0][3]); w.z = cvt_pk_bf16(o[1][0], o[1][1]); w.w = cvt_pk_bf16(o[1][2], o[1][3]);
                        *(u32x4*)(rowp + 32 * bj) = w; }
                }
            if (!isq) {
#pragma unroll
                for (int bj = 0; bj < 2; ++bj)
#pragma unroll
                    for (int n = 0; n < 2; ++n)
#pragma unroll
                        for (int e = 0; e < 4; ++e) { float v = cs[bj][n][e]; v += __shfl_xor(v, 1); v += __shfl_xor(v, 2); v += __shfl_xor(v, 4); v += __shfl_xor(v, 8); cs[bj][n][e] = v; }
                if (fr == 0) { float* kp = kmean + ((size_t)u.pm * NH + (pn & 1) * 4 + wc) * HD + 8 * fq;
#pragma unroll
                    for (int bj = 0; bj < 2; ++bj)
#pragma unroll
                        for (int n = 0; n < 2; ++n)
#pragma unroll
                            for (int e = 0; e < 4; ++e) atomicAdd(kp + 32 * bj + 4 * n + e, cs[bj][n][e]); }
            }
        } else {
            const bool isg = pn >= 12; const float sc = (pn == 6 || pn == 7) ? C2 : 1.0f;
            bf16_t* base; int ldc;
            if (isg) { base = (pn < 16 ? ga : gb) + (pn & 3) * 256 + wc * 64 + 8 * fq; ldc = D; }
            else { base = qkv + (size_t)(pn >> 1) * ((size_t)NTOK * WATT) + (pn & 1) * 256 + wc * 64 + 8 * fq; ldc = WATT; }
#pragma unroll
            for (int ai = 0; ai < 2; ++ai)
#pragma unroll
                for (int m = 0; m < 4; ++m) { bf16_t* rowp = base + (size_t)(row0 + ai * HALF + m * 16) * ldc;
#pragma unroll
                    for (int bj = 0; bj < 2; ++bj) { f32x4 v0 = acc[ai][bj][m][0], v1 = acc[ai][bj][m][1];
                        if (isg) {
#pragma unroll
                            for (int e = 0; e < 4; ++e) { v0[e] = __builtin_amdgcn_rcpf(1.0f + __builtin_amdgcn_exp2f(-v0[e] * LOG2E)); v1[e] = __builtin_amdgcn_rcpf(1.0f + __builtin_amdgcn_exp2f(-v1[e] * LOG2E)); } }
                        else { v0 = v0 * sc; v1 = v1 * sc; }
                        u32x4 w; w.x = cvt_pk_bf16(v0[0], v0[1]); w.y = cvt_pk_bf16(v0[2], v0[3]); w.z = cvt_pk_bf16(v1[0], v1[1]); w.w = cvt_pk_bf16(v1[2], v1[3]);
                        *(u32x4*)(rowp + 32 * bj) = w; } }
        }
    }
};

template <int MODE> struct EpiBranch {
    static constexpr bool PERM = true;
    bf16_t* sg; const bf16_t* tin;
    __device__ __forceinline__ void operator()(const f32x4 (&acc)[2][2][4][2], const Unit& u, int wr, int wc, int fr, int fq) const {
        const int row0 = u.pm * BM + wr * 64 + fr, col0 = u.pn * BM + wc * 32 + 8 * fq;
#pragma unroll
        for (int ai = 0; ai < 2; ++ai)
#pragma unroll
            for (int m = 0; m < 4; ++m) { const size_t off = (size_t)(row0 + ai * HALF + m * 16) * D + col0;
#pragma unroll
                for (int bj = 0; bj < 2; ++bj) { const u32x4 gw = *(const u32x4*)(sg + off + bj * HALF); u32x4 tw = (u32x4){0u, 0u, 0u, 0u}; if (MODE == 1) tw = *(const u32x4*)(tin + off + bj * HALF);
                    const f32x4 v0 = acc[ai][bj][m][0], v1 = acc[ai][bj][m][1]; float o[8];
                    o[0] = bflo(gw.x) * v0[0]; o[1] = bfhi(gw.x) * v0[1]; o[2] = bflo(gw.y) * v0[2]; o[3] = bfhi(gw.y) * v0[3];
                    o[4] = bflo(gw.z) * v1[0]; o[5] = bfhi(gw.z) * v1[1]; o[6] = bflo(gw.w) * v1[2]; o[7] = bfhi(gw.w) * v1[3];
                    if (MODE == 1) { o[0] += bflo(tw.x); o[1] += bfhi(tw.x); o[2] += bflo(tw.y); o[3] += bfhi(tw.y); o[4] += bflo(tw.z); o[5] += bfhi(tw.z); o[6] += bflo(tw.w); o[7] += bfhi(tw.w); }
                    u32x4 w; w.x = cvt_pk_bf16(o[0], o[1]); w.y = cvt_pk_bf16(o[2], o[3]); w.z = cvt_pk_bf16(o[4], o[5]); w.w = cvt_pk_bf16(o[6], o[7]);
                    *(u32x4*)(sg + off + bj * HALF) = w; } }
    }
};

struct EpiResid {
    static constexpr bool PERM = false;
    const float* x; float* out; const float* gt;
    float* stats;
    __device__ __forceinline__ void operator()(const f32x4 (&acc)[2][2][4][2], const Unit& u, int wr, int wc, int fr, int fq) const {
        const int row0 = u.pm * BM + wr * 64 + fr, col0 = u.pn * BM + wc * 32 + 4 * fq; const int b = (u.pm * BM) / SEQ;
        f32x4 gv[2][2];
#pragma unroll
        for (int bj = 0; bj < 2; ++bj)
#pragma unroll
            for (int n = 0; n < 2; ++n) gv[bj][n] = *(const f32x4*)(gt + (size_t)b * (NMOD * D) + col0 + bj * HALF + n * 16);
#pragma unroll
        for (int ai = 0; ai < 2; ++ai)
#pragma unroll
            for (int m = 0; m < 4; ++m) { const int row = row0 + ai * HALF + m * 16; const size_t off = (size_t)row * D + col0; float ss = 0.f;
#pragma unroll
                for (int bj = 0; bj < 2; ++bj)
#pragma unroll
                    for (int n = 0; n < 2; ++n) { const f32x4 xv = *(const f32x4*)(x + off + bj * HALF + n * 16); const f32x4 o = xv + gv[bj][n] * acc[ai][bj][m][n];
                        *(f32x4*)(out + off + bj * HALF + n * 16) = o; ss += (o[0] * o[0] + o[1] * o[1]) + (o[2] * o[2] + o[3] * o[3]); }
                ss += __shfl_xor(ss, 16); ss += __shfl_xor(ss, 32);
                if (fq == 0) stats[(size_t)row * 16 + u.pn * 4 + wc] = ss; }
    }
};

struct EpiGateUp {
    static constexpr bool PERM = true;
    bf16_t* H;
    __device__ __forceinline__ void operator()(const f32x4 (&acc)[2][2][4][2], const Unit& u, int wr, int wc, int fr, int fq) const {
        bf16_t* base = H + (size_t)(u.arow + wr * 64 + fr) * DEXP + u.pn * 128 + wc * 32 + 8 * fq;
#pragma unroll
        for (int ai = 0; ai < 2; ++ai)
#pragma unroll
            for (int m = 0; m < 4; ++m) { float o[8];
#pragma unroll
                for (int n = 0; n < 2; ++n)
#pragma unroll
                    for (int e = 0; e < 4; ++e) { const float gg = acc[ai][0][m][n][e], uu = acc[ai][1][m][n][e]; o[4 * n + e] = gg * __builtin_amdgcn_rcpf(1.0f + __builtin_amdgcn_exp2f(-gg * LOG2E)) * uu; }
                u32x4 w; w.x = cvt_pk_bf16(o[0], o[1]); w.y = cvt_pk_bf16(o[2], o[3]); w.z = cvt_pk_bf16(o[4], o[5]); w.w = cvt_pk_bf16(o[6], o[7]);
                *(u32x4*)(base + (size_t)(ai * HALF + m * 16) * DEXP) = w; }
    }
};

struct EpiDown {
    static constexpr bool PERM = false;
    float* out; const float* gt;
    const int* tl; const float* wl;
    __device__ __forceinline__ void operator()(const f32x4 (&acc)[2][2][4][2], const Unit& u, int wr, int wc, int fr, int fq) const {
        const int col0 = u.pn * BM + wc * 32 + 4 * fq;
#pragma unroll
        for (int ai = 0; ai < 2; ++ai)
#pragma unroll
            for (int m = 0; m < 4; ++m) { const int r = ai * HALF + wr * 64 + m * 16 + fr;
                if (r < u.x1) { const int tok = tl[u.x0 + r]; const float w = wl[u.x0 + r]; const int b = tok / SEQ; const size_t off = (size_t)tok * D + col0;
#pragma unroll
                    for (int bj = 0; bj < 2; ++bj)
#pragma unroll
                        for (int n = 0; n < 2; ++n) { const f32x4 gv = *(const f32x4*)(gt + (size_t)b * (NMOD * D) + col0 + bj * HALF + n * 16); float* p = out + off + bj * HALF + n * 16;
                            const f32x4 ov = *(const f32x4*)p; *(f32x4*)p = ov + gv * (acc[ai][bj][m][n] * w); } } }
    }
};

struct GateUpOrder {
    const PG8_LAS int* T; const int* tokl; int G, c;
    __device__ bool next(int i, Unit& u) const {
        const int L = i * G + c; const int total = T[64 + 32] * 4; if (L >= total) return false;
        const int rt = L >> 2; int e = 0; while (T[64 + e + 1] <= rt) ++e;
        const int lt = rt - T[64 + e];
        u.pm = lt; u.pn = L & 3; u.x0 = e; u.x1 = 0; u.arow = T[128 + e] + lt * 256; u.brow = e * 1024 + (L & 3) * 256; return true;
    }
    __device__ __forceinline__ int arow_of(const Unit& u, int r) const {
        const int idx = u.pm * 256 + r, c0 = T[u.x0], c1 = T[32 + u.x0];
        int tok = 0;
        if (idx < c0) tok = tokl[(size_t)u.x0 * LCAP + idx]; else if (idx < c0 + c1) tok = tokl[(size_t)(NEXP + u.x0) * LCAP + idx - c0];
        return tok;
    }
};
template <int SLOT> struct DownOrder {
    const PG8_LAS int* T; int G, c;
    __device__ bool next(int i, Unit& u) const {
        const int PO = SLOT ? 256 : 192; const int L = i * G + c; const int total = T[PO + 32] * 4; if (L >= total) return false;
        const int rt = L >> 2; int e = 0; while (T[PO + e + 1] <= rt) ++e;
        const int lt = rt - T[PO + e]; const int cs = T[SLOT * 32 + e]; const int rem = cs - lt * 256;
        u.pm = lt; u.pn = L & 3; u.x0 = (SLOT * NEXP + e) * LCAP + lt * 256; u.x1 = rem < 256 ? rem : 256;
        u.arow = T[128 + e] + (SLOT ? T[e] : 0) + lt * 256; u.brow = e * 1024 + (L & 3) * 256; return true;
    }
    __device__ __forceinline__ int arow_of(const Unit&, int) const { return 0; }
};
}
namespace attn {
using bf16x8 = __attribute__((ext_vector_type(8))) short;
using s16x4 = __attribute__((ext_vector_type(4))) short;
using f32x16 = __attribute__((ext_vector_type(16))) float;
using f32x4v = __attribute__((ext_vector_type(4))) float;
using u32x4 = __attribute__((ext_vector_type(4))) unsigned;
typedef unsigned short bf16;
constexpr int DM = 512, QBLK = 32, NW = 8, QB = 256, KVBLK = 64;
constexpr int NSLOT = 3, SLOTB = 8192;
constexpr int LDS_K = 0, LDS_V = NSLOT * SLOTB, LDS_WS = 2 * NSLOT * SLOTB, LDS_OST = LDS_WS + NW * 64 * 4, LDS_BT = LDS_OST + NW * 4096;
constexpr int REV = 896, BT_LEN = 1168, COPYB = BT_LEN * 4, NEG_OFF = 4 * COPYB, BT_BYTES = NEG_OFF + 256;
constexpr int LDS_BYTES = LDS_BT + BT_BYTES;
static_assert(BT_LEN >= REV + 256 + 8 + 3 && COPYB % 16 == 0 && LDS_BT % 16 == 0, "bias image");
#define SBAR() __builtin_amdgcn_sched_barrier(0)
#define WAIT_BAR(N) asm volatile("s_waitcnt vmcnt(" #N ") lgkmcnt(0)\n\ts_barrier":::"memory")
typedef __attribute__((address_space(3))) const char* lds_cptr;
typedef short v4i16_t __attribute__((ext_vector_type(4)));
typedef float f32x2_t __attribute__((ext_vector_type(2))); typedef __bf16 bf16x2_t __attribute__((ext_vector_type(2)));
__device__ __forceinline__ int crow(int r, int hi) { return (r & 3) + 8 * (r >> 2) + 4 * hi; }
__device__ __forceinline__ void glds16(const void* gsrc, unsigned lds_dst) { unsigned keep;
  asm volatile("s_mov_b32 %0, m0\n\ts_mov_b32 m0, %2\n\ts_nop 0\n\tglobal_load_lds_dwordx4 %1, off\n\ts_mov_b32 m0, %0" : "=&s"(keep) : "v"(gsrc), "s"(lds_dst) : "memory"); }
__device__ __forceinline__ unsigned cvtpk_s(float lo, float hi) { f32x2_t v = {lo, hi}; bf16x2_t b = __builtin_convertvector(v, bf16x2_t); return __builtin_bit_cast(unsigned, b); }
__device__ __forceinline__ void kload8(bf16x8* kf, lds_cptr kp) {
  kf[0] = *(const __attribute__((address_space(3))) bf16x8*)(kp);        kf[1] = *(const __attribute__((address_space(3))) bf16x8*)(kp + 512);
  kf[2] = *(const __attribute__((address_space(3))) bf16x8*)(kp + 2048); kf[3] = *(const __attribute__((address_space(3))) bf16x8*)(kp + 2560);
  kf[4] = *(const __attribute__((address_space(3))) bf16x8*)(kp + 4096); kf[5] = *(const __attribute__((address_space(3))) bf16x8*)(kp + 4608);
  kf[6] = *(const __attribute__((address_space(3))) bf16x8*)(kp + 6144); kf[7] = *(const __attribute__((address_space(3))) bf16x8*)(kp + 6656);
}
__device__ __forceinline__ void kload2(bf16x8* kf, lds_cptr kp, int j) { kf[2 * j] = *(const __attribute__((address_space(3))) bf16x8*)(kp + j * 2048); kf[2 * j + 1] = *(const __attribute__((address_space(3))) bf16x8*)(kp + j * 2048 + 512); }
__device__ __forceinline__ s16x4 vtr(lds_cptr p) { return __builtin_bit_cast(s16x4, __builtin_amdgcn_ds_read_tr16_b64_v4i16((__attribute__((address_space(3))) v4i16_t*)p)); }
__device__ __forceinline__ f32x4v ldsf4(lds_cptr p) { return *(const __attribute__((address_space(3))) f32x4v*)p; }
#define MFMA32(a, b, c) __builtin_amdgcn_mfma_f32_32x32x16_bf16(a, b, c, 0, 0, 0)
__device__ __forceinline__ void pv(f32x16* o, int vb, bf16x8 pa0, bf16x8 pa1, bf16x8 pa2, bf16x8 pa3) {
  #pragma unroll
  for (int d0 = 0; d0 < 2; ++d0) { s16x4 lo[4], hi[4];
    #pragma unroll
    for (int ks = 0; ks < 4; ++ks) {
      asm volatile("ds_read_b64_tr_b16 %0,%1 offset:%c2" : "=&v"(lo[ks]) : "v"(vb), "i"(d0 * 4096 + ks * 1024) : "memory");
      asm volatile("ds_read_b64_tr_b16 %0,%1 offset:%c2" : "=&v"(hi[ks]) : "v"(vb), "i"(d0 * 4096 + ks * 1024 + 512) : "memory"); }
    asm volatile("s_waitcnt lgkmcnt(0)" ::: "memory"); SBAR();
    #define PK(k) (bf16x8){lo[k][0], lo[k][1], lo[k][2], lo[k][3], hi[k][0], hi[k][1], hi[k][2], hi[k][3]}
    o[d0] = MFMA32(pa0, PK(0), o[d0]); o[d0] = MFMA32(pa1, PK(1), o[d0]); o[d0] = MFMA32(pa2, PK(2), o[d0]); o[d0] = MFMA32(pa3, PK(3), o[d0]);
    #undef PK
  }
}
#define ATTN_STORE16(p, v) (*(u32x4*)(p) = (v))

__device__ __forceinline__ void moba_unit(int b, int h, int qb, const bf16* Q, const bf16* __restrict__ K, const bf16* __restrict__ V, bf16* O, const float* __restrict__ ksum, char* shm) {
  const int tid = threadIdx.x, lane = tid & 63, r32 = lane & 31, hi = lane >> 5; const int wid = __builtin_amdgcn_readfirstlane(tid >> 6);
  const long rowbase = (long)b * 4096; const int q0 = qb * QB;
  const bf16* Qw = Q + (rowbase + q0 + wid * QBLK) * DM + h * 64;
  const bf16* Kh = K + rowbase * DM + h * 64, *Vh = V + rowbase * DM + h * 64;
  const unsigned lds0 = (unsigned)(uintptr_t)shm;
  float* wsf = (float*)(shm + LDS_WS) + wid * 64;
  const lds_cptr shm3 = (lds_cptr)shm;
  if (tid < 128) { const int j = tid >> 3, c = tid & 7; f32x4v a = {0.f, 0.f, 0.f, 0.f}, bq = {0.f, 0.f, 0.f, 0.f};
    if (j < qb) { const f32x4v* kp = (const f32x4v*)(ksum + ((size_t)(b * 16 + j) * 8 + h) * 64 + c * 8); a = kp[0]; bq = kp[1]; }
    const float v[8] = {a[0], a[1], a[2], a[3], bq[0], bq[1], bq[2], bq[3]}; unsigned hw[4], lw[4];
    #pragma unroll
    for (int i = 0; i < 4; ++i) { const unsigned hp = cvtpk_s(v[2 * i], v[2 * i + 1]); const float r0 = v[2 * i] - __uint_as_float(hp << 16), r1 = v[2 * i + 1] - __uint_as_float(hp & 0xffff0000u); hw[i] = hp; lw[i] = cvtpk_s(r0, r1); }
    *(__attribute__((address_space(3))) u32x4*)(shm3 + LDS_OST + c * 1024 + j * 16) = (u32x4){hw[0], hw[1], hw[2], hw[3]};
    *(__attribute__((address_space(3))) u32x4*)(shm3 + LDS_OST + 8192 + c * 1024 + j * 16) = (u32x4){lw[0], lw[1], lw[2], lw[3]}; }
  asm volatile("s_waitcnt vmcnt(0)" ::: "memory");
  const bf16* ksrc = Kh + (long)lane * DM + wid * 8;
  const bf16* vsrc = Vh + (long)(16 * (wid & 3) + (lane >> 2)) * DM + (wid >> 2) * 32 + (lane & 3) * 8;
  const unsigned kdst = lds0 + LDS_K + wid * 1024, vdst = lds0 + LDS_V + wid * 1024;
  #define DMA_K(t, slot) glds16(ksrc + (long)(t) * KVBLK * DM, (unsigned)__builtin_amdgcn_readfirstlane(kdst + (slot)))
  #define DMA_V(t, slot) glds16(vsrc + (long)(t) * KVBLK * DM, (unsigned)__builtin_amdgcn_readfirstlane(vdst + (slot)))
  const int vb0 = (int)(lds0 + LDS_V) + ((lane >> 4) & 1) * 32 + (lane & 3) * 8 + (4 * hi + ((lane & 15) >> 2)) * 64;
  bf16x8 kf[8];
  const lds_cptr kp0 = shm3 + LDS_K + hi * 1024 + r32 * 16; const lds_cptr vp0 = shm3 + LDS_V + ((lane >> 4) & 1) * 32 + (lane & 3) * 8 + (4 * hi + ((lane & 15) >> 2)) * 64;
  const int NT = (q0 + QB) / KVBLK;
  DMA_K(0, 0); DMA_V(0, 0); DMA_K(1, SLOTB);
  bf16x8 qr[4];
  #pragma unroll
  for (int d0 = 0; d0 < 4; ++d0) qr[d0] = *reinterpret_cast<const bf16x8*>(&Qw[(long)r32 * DM + d0 * 16 + hi * 8]);
  float l_reg = 0.f; f32x16 o[2]; o[0] = f32x16{}; o[1] = f32x16{};
  const int tq = q0 + wid * QBLK + r32, acp = (REV - tq) & 3;
  const int cbase = LDS_BT + acp * COPYB; int baddr = cbase + 4 * (REV - tq + 4 * hi - acp);
  DMA_K(2, 2 * SLOTB);
  WAIT_BAR(3);
  unsigned selmask;
  { f32x16 ga = f32x16{};
    #pragma unroll
    for (int d0 = 0; d0 < 4; ++d0) { const bf16x8 ah = *(const __attribute__((address_space(3))) bf16x8*)(shm3 + LDS_OST + hi * 1024 + r32 * 16 + d0 * 2048);
      const bf16x8 al = *(const __attribute__((address_space(3))) bf16x8*)(shm3 + LDS_OST + 8192 + hi * 1024 + r32 * 16 + d0 * 2048);
      ga = MFMA32(ah, qr[d0], ga); ga = MFMA32(al, qr[d0], ga); }
    float G[16];
    #pragma unroll
    for (int r = 0; r < 8; ++r) { auto rr = __builtin_amdgcn_permlane32_swap(__float_as_uint(ga[r]), __float_as_uint(ga[r]), false, false);
      G[(r & 3) + 8 * (r >> 2)] = __uint_as_float(rr[0]); G[(r & 3) + 8 * (r >> 2) + 4] = __uint_as_float(rr[1]); }
    #pragma unroll
    for (int j = 0; j < 16; ++j) if (j >= qb) G[j] = -INFINITY;
    selmask = 1u << qb;
    #pragma unroll
    for (int pass = 0; pass < 3; ++pass) { float best = -INFINITY; int bi = 16;
      #pragma unroll
      for (int j = 0; j < 16; ++j) if (G[j] > best) { best = G[j]; bi = j; }
      if (bi < 16) selmask |= 1u << bi;
      #pragma unroll
      for (int j = 0; j < 16; ++j) if (j == bi) G[j] = -INFINITY; }
  }
  f32x16 pA0, pA1, pB0, pB1;
  #define BEFF(T) (((selmask >> ((T) >> 2)) & 1u) ? (baddr + 256 * (T) > cbase ? baddr + 256 * (T) : cbase) : (LDS_BT + NEG_OFF))
  #define BRD1(X0, X1, eff, i) do { const f32x4v bv_ = ldsf4(shm3 + (eff) + ((i) < 4 ? 32 * (i) : 128 + 32 * ((i) - 4))); \
      if ((i) < 4) { X0[4 * (i)] = bv_[0]; X0[4 * (i) + 1] = bv_[1]; X0[4 * (i) + 2] = bv_[2]; X0[4 * (i) + 3] = bv_[3]; } \
      else { X1[4 * ((i) - 4)] = bv_[0]; X1[4 * ((i) - 4) + 1] = bv_[1]; X1[4 * ((i) - 4) + 2] = bv_[2]; X1[4 * ((i) - 4) + 3] = bv_[3]; } } while (0)
  { const int e0 = BEFF(0);
    #pragma unroll
    for (int i = 0; i < 8; ++i) BRD1(pA0, pA1, e0, i); }
  int sl_prev = 0, sl_cur = 0, sl_next = SLOTB;
  #define ROT() do { sl_prev = sl_cur; sl_cur = sl_next; sl_next = (sl_next == (NSLOT - 1) * SLOTB) ? 0 : sl_next + SLOTB; } while (0)
  { const char* kb = shm + LDS_K + hi * 1024 + r32 * 16;
    #pragma unroll
    for (int d0 = 0; d0 < 4; ++d0) { const bf16x8 b0 = *reinterpret_cast<const bf16x8*>(kb + d0 * 2048); const bf16x8 b1 = *reinterpret_cast<const bf16x8*>(kb + d0 * 2048 + 512);
      pA0 = MFMA32(b0, qr[d0], pA0); pA1 = MFMA32(b1, qr[d0], pA1); } }
  #pragma unroll
  for (int r = 0; r < 16; ++r) { pA0[r] = __builtin_amdgcn_exp2f(pA0[r]); pA1[r] = __builtin_amdgcn_exp2f(pA1[r]); }
  { const int e1 = BEFF(1);
    #pragma unroll
    for (int i = 0; i < 8; ++i) BRD1(pB0, pB1, e1, i); }
  WAIT_BAR(0);
  DMA_K(3, 0); DMA_V(1, SLOTB);
  ROT();
  kload8(kf, kp0 + sl_cur);
  WAIT_BAR(2);
  s16x4 vlo[8], vhi[8]; u32x4 pw0, pw1, pw2, pw3;
  #define PKW(P, B) cvtpk_s(P[B], P[B + 1])
  #define PAF(k) __builtin_bit_cast(bf16x8, pw##k)
  #define VFR(i) (bf16x8){vlo[i][0], vlo[i][1], vlo[i][2], vlo[i][3], vhi[i][0], vhi[i][1], vhi[i][2], vhi[i][3]}
  #define PIN(x) asm volatile("" : "+v"(x))
  #define GAPA(MF, A0, A1, A2, A3, W0, W1, PW) do { MF; sacc += A0; sacc += A1; sacc += A2; sacc += A3; PIN(sacc); W0; W1; PIN(PW); SBAR(); } while (0)
  #define EX(v) __builtin_amdgcn_exp2f(v)
  #define GAPB(MF, X, B) do { MF; X[B] = EX(X[B]); X[B + 1] = EX(X[B + 1]); X[B + 2] = EX(X[B + 2]); X[B + 3] = EX(X[B + 3]); PIN(X); SBAR(); } while (0)
  #define VRD(i) do { vlo[i] = vtr(vp_ + (((i) >> 2) * 4096 + ((i) & 3) * 1024)); vhi[i] = vtr(vp_ + (((i) >> 2) * 4096 + ((i) & 3) * 1024 + 512)); } while (0)
  #define KRD(G, j) do { if (G) { kload2(kf, kp0 + sl_next, j); SBAR(); } } while (0)
  #define BRD(G, i, X0, X1) do { if (G) { BRD1(X0, X1, eff_, i); } } while (0)
  #define STEP(C0, C1, P0, P1, t, GK, GV, GL) do { SBAR(); \
    const lds_cptr vp_ = vp0 + sl_prev; \
    VRD(0); SBAR(); float sacc = (P0[0] + P0[1]); \
    GAPA(C0 = MFMA32(kf[0], qr[0], C0), P0[2], P0[3], P0[4], P0[5],     pw0[0] = PKW(P0, 0), pw0[1] = PKW(P0, 2), pw0); \
    VRD(4); SBAR(); GAPA(C1 = MFMA32(kf[1], qr[0], C1), P0[6], P0[7], P0[8], P0[9],     pw0[2] = PKW(P0, 4), pw0[3] = PKW(P0, 6), pw0); \
    VRD(1); SBAR(); GAPA(C0 = MFMA32(kf[2], qr[1], C0),   P0[10], P0[11], P0[12], P0[13], pw1[0] = PKW(P0, 8), pw1[1] = PKW(P0, 10), pw1); \
    VRD(5); SBAR(); GAPA(C1 = MFMA32(kf[3], qr[1], C1),   P0[14], P0[15], P1[0], P1[1],   pw1[2] = PKW(P0, 12), pw1[3] = PKW(P0, 14), pw1); \
    VRD(2); SBAR(); GAPA(C0 = MFMA32(kf[4], qr[2], C0),   P1[2], P1[3], P1[4], P1[5],     pw2[0] = PKW(P1, 0), pw2[1] = PKW(P1, 2), pw2); \
    VRD(6); SBAR(); GAPA(C1 = MFMA32(kf[5], qr[2], C1),   P1[6], P1[7], P1[8], P1[9],     pw2[2] = PKW(P1, 4), pw2[3] = PKW(P1, 6), pw2); \
    VRD(3); SBAR(); GAPA(C0 = MFMA32(kf[6], qr[3], C0),   P1[10], P1[11], P1[12], P1[13], pw3[0] = PKW(P1, 8), pw3[1] = PKW(P1, 10), pw3); \
    VRD(7); SBAR(); GAPA(C1 = MFMA32(kf[7], qr[3], C1),   P1[14], P1[15], 0.f, 0.f,       pw3[2] = PKW(P1, 12), pw3[3] = PKW(P1, 14), pw3); \
    l_reg += sacc; \
    if (GK) { DMA_K((t) + 3, sl_cur); } if (GV) { DMA_V((t) + 1, sl_next); } \
    const int eff_ = BEFF((t) + 1); \
    SBAR(); \
    BRD(GL, 0, P0, P1); GAPB(o[0] = MFMA32(PAF(0), VFR(0), o[0]), C0, 0); \
    BRD(GL, 1, P0, P1); GAPB(o[1] = MFMA32(PAF(0), VFR(4), o[1]), C0, 4); \
    BRD(GL, 2, P0, P1); KRD(GL, 0); GAPB(o[0] = MFMA32(PAF(1), VFR(1), o[0]), C0, 8); \
    BRD(GL, 3, P0, P1); KRD(GL, 1); GAPB(o[1] = MFMA32(PAF(1), VFR(5), o[1]), C0, 12); \
    BRD(GL, 4, P0, P1); KRD(GL, 2); GAPB(o[0] = MFMA32(PAF(2), VFR(2), o[0]), C1, 0); \
    BRD(GL, 5, P0, P1); KRD(GL, 3); GAPB(o[1] = MFMA32(PAF(2), VFR(6), o[1]), C1, 4); \
    BRD(GL, 6, P0, P1); GAPB(o[0] = MFMA32(PAF(3), VFR(3), o[0]), C1, 8); \
    BRD(GL, 7, P0, P1); GAPB(o[1] = MFMA32(PAF(3), VFR(7), o[1]), C1, 12); \
    } while (0)
  int t = 1;
  for (; t + 5 < NT; t += 2) {
    STEP(pB0, pB1, pA0, pA1, t, true, true, true);     WAIT_BAR(2); ROT();
    STEP(pA0, pA1, pB0, pB1, t + 1, true, true, true); WAIT_BAR(2); ROT();
  }
  #define ENDW(tt) do { if ((tt) + 3 < NT) { WAIT_BAR(2); } else if ((tt) + 2 < NT) { WAIT_BAR(1); } else { WAIT_BAR(0); } } while (0)
  for (; t + 1 < NT; t += 2) {
    STEP(pB0, pB1, pA0, pA1, t, (t + 3 < NT), (t + 1 < NT), (t + 1 < NT));       ENDW(t);     ROT();
    STEP(pA0, pA1, pB0, pB1, t + 1, (t + 4 < NT), (t + 2 < NT), (t + 2 < NT));   ENDW(t + 1); ROT();
  }
  STEP(pB0, pB1, pA0, pA1, NT - 1, false, false, false);
  { float sacc = pB0[0] + pB0[1];
    #pragma unroll
    for (int r = 2; r < 16; ++r) sacc += pB0[r];
    #pragma unroll
    for (int r = 0; r < 16; ++r) sacc += pB1[r];
    l_reg += sacc;
    pw0 = (u32x4){PKW(pB0, 0), PKW(pB0, 2), PKW(pB0, 4), PKW(pB0, 6)}; pw1 = (u32x4){PKW(pB0, 8), PKW(pB0, 10), PKW(pB0, 12), PKW(pB0, 14)};
    pw2 = (u32x4){PKW(pB1, 0), PKW(pB1, 2), PKW(pB1, 4), PKW(pB1, 6)}; pw3 = (u32x4){PKW(pB1, 8), PKW(pB1, 10), PKW(pB1, 12), PKW(pB1, 14)};
    SBAR(); pv(o, vb0 + sl_cur, PAF(0), PAF(1), PAF(2), PAF(3)); }
  #undef STEP
  #undef BRD
  #undef KRD
  #undef VRD
  #undef GAPB
  #undef GAPA
  { auto rr = __builtin_amdgcn_permlane32_swap(__float_as_uint(l_reg), __float_as_uint(l_reg), false, false); l_reg = __uint_as_float(rr[0]) + __uint_as_float(rr[1]); }
  if (hi == 0) wsf[32 + r32] = l_reg; asm volatile("s_waitcnt lgkmcnt(0)" ::: "memory");
  float rli[16];
  #pragma unroll
  for (int r = 0; r < 16; ++r) rli[r] = __builtin_amdgcn_rcpf(wsf[32 + crow(r, hi)]);
  bf16* Ow = O + (rowbase + q0 + wid * QBLK) * DM + h * 64;
  { bf16* stg = (bf16*)(shm + LDS_OST) + wid * 2048;
    #pragma unroll
    for (int r = 0; r < 16; ++r) { const int orow = crow(r, hi);
      #pragma unroll
      for (int d0 = 0; d0 < 2; ++d0) stg[orow * 64 + d0 * 32 + r32] = (bf16)(cvtpk_s(o[d0][r] * rli[r], 0.f) & 0xffffu); }
    asm volatile("s_waitcnt lgkmcnt(0)" ::: "memory");
    #pragma unroll
    for (int i = 0; i < 4; ++i) { const int row = i * 8 + (lane >> 3), ch = lane & 7; const u32x4 v = *(const u32x4*)(stg + row * 64 + ch * 8); ATTN_STORE16(Ow + (long)row * DM + ch * 8, v); } }
  asm volatile("s_waitcnt lgkmcnt(0)\n\ts_barrier" ::: "memory");
  #undef DMA_K
  #undef DMA_V
  #undef ROT
  #undef BEFF
  #undef BRD1
  #undef ENDW
  #undef PKW
  #undef PAF
  #undef VFR
  #undef PIN
  #undef EX
}
}
struct Frame {
    LAS unsigned char* lds;
    volatile LAS unsigned* MISC;
    gu32* ctl;
    int tid, lane, wave;
    int vcu, G;
    const float *x, *c, *w_ada, *b_ada, *g_mix, *w_in, *g_q, *g_k, *rel_bias, *w_br_moba, *w_br_sb, *w_out, *g_ffn, *w_rg, *b_rg, *w_re, *b_re, *w_gate, *w_up, *w_down;
    float* out;
    float *mod, *biasT, *btg, *stats, *kmean;
    bf16 *Win_t, *Wbra_t, *Wbrb_t, *Wout_t, *Wgu_t, *Wd_t;
    bf16 *XN, *QA, *KA, *VA, *QB, *KB, *VB, *GA, *GB, *H;
    int* tokl; float* wl; unsigned* cnt;
};
__device__ __forceinline__ float wave_sum(float v) {
#pragma unroll
    for (int o = 1; o < 64; o <<= 1) v += __shfl_xor(v, o);
    return v;
}
__device__ __forceinline__ int lane_zero() { int z; asm volatile("v_mov_b32 %0, 0" : "=v"(z)); return z; }

__device__ __forceinline__ void p0_transpose_item(const float* W, int K, int N, bf16* WT, int k0, int n0, int drow0, LAS float* scr, int lane) {
#pragma unroll 8
    for (int i = 0; i < 32; ++i) { const int kk = 2 * i + (lane >> 5); scr[kk * 33 + (lane & 31)] = W[(size_t)(k0 + kk) * N + n0 + (lane & 31)]; }
    LDS_WAIT(); asm volatile("" ::: "memory");
    const int c = lane & 7;
#pragma unroll
    for (int j = 0; j < 4; ++j) { const int n = (lane >> 3) + 8 * j; const LAS float* s = scr + (8 * c) * 33 + n;
        v4u o; o.x = pk2(s[0 * 33], s[1 * 33]); o.y = pk2(s[2 * 33], s[3 * 33]); o.z = pk2(s[4 * 33], s[5 * 33]); o.w = pk2(s[6 * 33], s[7 * 33]);
        *(GAS v4u*)(WT + (size_t)(drow0 + n) * K + k0 + 8 * c) = o; }
    LDS_WAIT(); asm volatile("" ::: "memory");
}

__device__ __forceinline__ void p0_prologue(Frame& F) {
    {
        LAS float* sc = (LAS float*)(F.lds + RING_OFF);
        LAS float* part = (LAS float*)(F.lds + RING_OFF + 32768);
        for (int i = F.tid; i < BATCH * D; i += NWAVES * 64) { const float v = F.c[i]; sc[i] = v * fsigmoid(v); }
        __syncthreads();
        for (int chunk = F.vcu; chunk < 256; chunk += F.G) {
            const int kp = F.tid / 24, cI = F.tid % 24;
            if (kp < 21) {
                float a[8];
#pragma unroll
                for (int b = 0; b < 8; ++b) a[b] = 0.f;
                const int k0 = kp * 49, k1 = (k0 + 49 < D) ? k0 + 49 : D;
                for (int k = k0; k < k1; ++k) { const float w = F.w_ada[(size_t)k * (NMOD * D) + chunk * 24 + cI];
#pragma unroll
                    for (int b = 0; b < 8; ++b) a[b] += sc[b * D + k] * w; }
#pragma unroll
                for (int b = 0; b < 8; ++b) part[(kp * 24 + cI) * 8 + b] = a[b];
            }
            __syncthreads();
            if (F.tid < 192) { const int cI2 = F.tid % 24, b = F.tid / 24; float s = 0.f;
                for (int kp2 = 0; kp2 < 21; ++kp2) s += part[(kp2 * 24 + cI2) * 8 + b];
                const int col = chunk * 24 + cI2; F.mod[(size_t)b * (NMOD * D) + col] = s + F.b_ada[col]; }
            __syncthreads();
        }
    }
    const int gw = F.vcu * NWAVES + F.wave, NGW = F.G * NWAVES;
    for (int i = gw * 64 + F.lane; i < NH * SEQ; i += NGW * 64) { const int h = i / SEQ, n = i % SEQ; int bk;
        if (n < 16) bk = n; else { const float nf = (float)n; int lg = 16 + (int)(logf(nf / 16.0f) / 4.1588830833596715f * 16.0f); bk = lg < 31 ? lg : 31; }
        F.biasT[i] = F.rel_bias[h * 32 + bk] * LOG2E; }
    for (int i = gw * 64 + F.lane; i < NH * (attn::BT_BYTES / 4); i += NGW * 64) { const int h = i / (attn::BT_BYTES / 4), w = i % (attn::BT_BYTES / 4); float val = -INFINITY;
        if (w < 4 * attn::BT_LEN) { const int a = w / attn::BT_LEN, xx = w % attn::BT_LEN, ri = xx + a;
            if (ri <= attn::REV) { const int n = attn::REV - ri; int bk; if (n < 16) bk = n; else { const float nf = (float)n; int lg = 16 + (int)(logf(nf / 16.0f) / 4.1588830833596715f * 16.0f); bk = lg < 31 ? lg : 31; }
                val = F.rel_bias[h * 32 + bk] * LOG2E; } }
        F.btg[i] = val; }
    LAS float* scr = (LAS float*)(F.lds + RING_OFF + F.wave * 16384);
    constexpr int I_IN = (D / 64) * (INCOLS / 32), I_BR = (WATT / 64) * (D / 32), I_OUT = (D / 64) * (D / 32), I_G = NEXP * (D / 64) * (DEXP / 32), I_D = NEXP * (DEXP / 64) * (D / 32);
    constexpr int NITEMS = I_IN + 2 * I_BR + I_OUT + 2 * I_G + I_D;
    for (int it = gw; it < NITEMS; it += NGW) {
        int r = it;
        if (r < I_IN) { const int nblk = INCOLS / 32, kb = r / nblk, nb = r % nblk, n0 = 32 * nb, t = n0 & 255;
            const int p0 = 128 * ((t >> 5) & 1) + 32 * (t >> 6);
            p0_transpose_item(F.w_in, D, INCOLS, F.Win_t, 64 * kb, n0, (n0 - t) + p0, scr, F.lane); continue; } r -= I_IN;
        if (r < I_BR) { const int nblk = D / 32, kb = r / nblk, nb = r % nblk; p0_transpose_item(F.w_br_moba, WATT, D, F.Wbra_t, 64 * kb, 32 * nb, 32 * nb, scr, F.lane); continue; } r -= I_BR;
        if (r < I_BR) { const int nblk = D / 32, kb = r / nblk, nb = r % nblk; p0_transpose_item(F.w_br_sb, WATT, D, F.Wbrb_t, 64 * kb, 32 * nb, 32 * nb, scr, F.lane); continue; } r -= I_BR;
        if (r < I_OUT) { const int nblk = D / 32, kb = r / nblk, nb = r % nblk; p0_transpose_item(F.w_out, D, D, F.Wout_t, 64 * kb, 32 * nb, 32 * nb, scr, F.lane); continue; } r -= I_OUT;
        if (r < 2 * I_G) { const int up = r >= I_G; if (up) r -= I_G; constexpr int per = (D / 64) * (DEXP / 32); const int e = r / per, q = r % per, nblk = DEXP / 32, kb = q / nblk, nb = q % nblk, n0 = 32 * nb;
            p0_transpose_item((up ? F.w_up : F.w_gate) + (size_t)e * D * DEXP, D, DEXP, F.Wgu_t, 64 * kb, n0, e * 1024 + 256 * (n0 >> 7) + (up ? 128 : 0) + (n0 & 127), scr, F.lane); continue; } r -= 2 * I_G;
        { constexpr int per = (DEXP / 64) * (D / 32); const int e = r / per, q = r % per, nblk = D / 32, kb = q / nblk, nb = q % nblk;
            p0_transpose_item(F.w_down + (size_t)e * DEXP * D, DEXP, D, F.Wd_t, 64 * kb, 32 * nb, e * 1024 + 32 * nb, scr, F.lane); }
    }
}

__device__ __forceinline__ void p1_norm(Frame& F) {
    const int gw = F.vcu * NWAVES + F.wave, NGW = F.G * NWAVES;
    for (int m = gw; m < NTOK; m += NGW) {
        const int b = m / SEQ;
        const GAS f32x4* xr = (const GAS f32x4*)(F.x + (size_t)m * D) + F.lane;
        const GAS f32x4* gr = (const GAS f32x4*)F.g_mix + F.lane;
        const GAS f32x4* shr = (const GAS f32x4*)(F.mod + (size_t)b * (NMOD * D)) + F.lane;
        const GAS f32x4* scr = (const GAS f32x4*)(F.mod + (size_t)b * (NMOD * D) + D) + F.lane;
        f32x4 v[4]; float s = 0.f;
#pragma unroll
        for (int j = 0; j < 4; ++j) { v[j] = xr[64 * j]; s += (v[j].x * v[j].x + v[j].y * v[j].y) + (v[j].z * v[j].z + v[j].w * v[j].w); }
        const float rstd = __builtin_amdgcn_rsqf(wave_sum(s) * (1.f / D) + RMS_EPS);
        GAS unsigned long long* o8 = (GAS unsigned long long*)(F.XN + (size_t)m * D) + F.lane;
#pragma unroll
        for (int j = 0; j < 4; ++j) { const f32x4 g = gr[64 * j], sh = shr[64 * j], sc = scr[64 * j]; const f32x4 y = (v[j] * rstd * g) * (sc + 1.0f) + sh;
            o8[64 * j] = (unsigned long long)pk2(y.x, y.y) | ((unsigned long long)pk2(y.z, y.w) << 32); }
    }
}

__device__ __forceinline__ float dot64(const unsigned (&q)[32], const v4u (&k)[8]) {
    float a0 = 0.f, a1 = 0.f;
#pragma unroll
    for (int i = 0; i < 8; ++i) {
        a0 += bflo(q[4 * i]) * bflo(k[i].x) + bflo(q[4 * i + 1]) * bflo(k[i].y) + bflo(q[4 * i + 2]) * bflo(k[i].z) + bflo(q[4 * i + 3]) * bflo(k[i].w);
        a1 += bfhi(q[4 * i]) * bfhi(k[i].x) + bfhi(q[4 * i + 1]) * bfhi(k[i].y) + bfhi(q[4 * i + 2]) * bfhi(k[i].z) + bfhi(q[4 * i + 3]) * bfhi(k[i].w); }
    return a0 + a1;
}
#define LOADROW(dst, p) do { _Pragma("unroll") for (int i_ = 0; i_ < 8; ++i_) dst[i_] = ((const GAS v4u*)(p))[i_]; } while (0)
#define AXPY64(o, p, v) do { _Pragma("unroll") for (int i_ = 0; i_ < 8; ++i_) { \
    o[8 * i_ + 0] += p * bflo(v[i_].x); o[8 * i_ + 1] += p * bfhi(v[i_].x); o[8 * i_ + 2] += p * bflo(v[i_].y); o[8 * i_ + 3] += p * bfhi(v[i_].y); \
    o[8 * i_ + 4] += p * bflo(v[i_].z); o[8 * i_ + 5] += p * bfhi(v[i_].z); o[8 * i_ + 6] += p * bflo(v[i_].w); o[8 * i_ + 7] += p * bfhi(v[i_].w); } } while (0)
#define STOREO(ptr, o, sc) do { _Pragma("unroll") for (int i_ = 0; i_ < 8; ++i_) { v4u w_; w_.x = pk2(o[8 * i_] * sc, o[8 * i_ + 1] * sc); w_.y = pk2(o[8 * i_ + 2] * sc, o[8 * i_ + 3] * sc); \
    w_.z = pk2(o[8 * i_ + 4] * sc, o[8 * i_ + 5] * sc); w_.w = pk2(o[8 * i_ + 6] * sc, o[8 * i_ + 7] * sc); ((GAS v4u*)(ptr))[i_] = w_; } } while (0)

__device__ __forceinline__ void moba_naive_item(Frame& F, int item) {
    const int bh = item >> 6, ch = item & 63, b = bh >> 3, h = bh & 7, lz = lane_zero();
    const int t = ch * 64 + F.lane, own = ch >> 2, tl = t & 255;
    const size_t rowb = (size_t)b * SEQ;
    unsigned q[32]; { v4u t4[8]; LOADROW(t4, F.QA + (rowb + t) * WATT + h * HD);
#pragma unroll
        for (int i = 0; i < 8; ++i) { q[4 * i] = t4[i].x; q[4 * i + 1] = t4[i].y; q[4 * i + 2] = t4[i].z; q[4 * i + 3] = t4[i].w; } }
    float v0 = -INFINITY, v1 = -INFINITY, v2 = -INFINITY; int i0 = 0, i1 = 0, i2 = 0;
    for (int j = 0; j < own; ++j) {
        const GAS f32x4* km = (const GAS f32x4*)(F.kmean + ((size_t)(b * NBLK + j) * NH + h) * HD + lz);
        float g = 0.f;
#pragma unroll
        for (int i = 0; i < 16; ++i) { const f32x4 kv = km[i]; g += bflo(q[2 * i]) * kv.x + bfhi(q[2 * i]) * kv.y + bflo(q[2 * i + 1]) * kv.z + bfhi(q[2 * i + 1]) * kv.w; }
        if (g > v0) { v2 = v1; i2 = i1; v1 = v0; i1 = i0; v0 = g; i0 = j; } else if (g > v1) { v2 = v1; i2 = i1; v1 = g; i1 = j; } else if (g > v2) { v2 = g; i2 = j; }
    }
    float m = -INFINITY, l = 0.f; float o[64];
#pragma unroll
    for (int i = 0; i < 64; ++i) o[i] = 0.f;
    const float* bt = F.biasT + h * SEQ;
    const int nsel = own < 3 ? own : 3;
    for (int sl = 0; sl < nsel; ++sl) {
        const int blk = sl == 0 ? i0 : (sl == 1 ? i1 : i2);
        const bf16* kp = F.KA + (rowb + blk * MBLK) * WATT + h * HD; const bf16* vp = F.VA + (rowb + blk * MBLK) * WATT + h * HD;
        const int dist0 = t - blk * MBLK;
        for (int s = 0; s < MBLK; ++s) {
            v4u kk[8]; LOADROW(kk, kp + (size_t)s * WATT); const float sc = dot64(q, kk) + bt[dist0 - s];
            const float mn = fmaxf(m, sc), al = __builtin_amdgcn_exp2f(m - mn), p = __builtin_amdgcn_exp2f(sc - mn);
            l = l * al + p; m = mn;
#pragma unroll
            for (int i = 0; i < 64; ++i) o[i] *= al;
            v4u vv[8]; LOADROW(vv, vp + (size_t)s * WATT); AXPY64(o, p, vv);
        }
    }
    {
        const bf16* kp = F.KA + (rowb + own * MBLK) * WATT + h * HD + lz; const bf16* vp = F.VA + (rowb + own * MBLK) * WATT + h * HD + lz;
        const int smax = (ch & 3) * 64 + 63;
        for (int s = 0; s <= smax; ++s) {
            v4u kk[8]; LOADROW(kk, kp + (size_t)s * WATT); const int dist = tl - s; const float sc = dot64(q, kk) + bt[dist > 0 ? dist : 0];
            if (dist >= 0) {
                const float mn = fmaxf(m, sc), al = __builtin_amdgcn_exp2f(m - mn), p = __builtin_amdgcn_exp2f(sc - mn);
                l = l * al + p; m = mn;
#pragma unroll
                for (int i = 0; i < 64; ++i) o[i] *= al;
                v4u vv[8]; LOADROW(vv, vp + (size_t)s * WATT); AXPY64(o, p, vv);
            }
        }
    }
    const float rl = 1.0f / l;
    STOREO(F.QA + (rowb + t) * WATT + h * HD, o, rl);
}
__device__ __forceinline__ void sb_naive_item(Frame& F, int item) {
    const int bh = item >> 6, ch = item & 63, b = bh >> 3, h = bh & 7, lz = lane_zero();
    const int t = ch * 64 + F.lane;
    const size_t rowb = (size_t)b * SEQ;
    unsigned q[32]; { v4u t4[8]; LOADROW(t4, F.QB + (rowb + t) * WATT + h * HD);
#pragma unroll
        for (int i = 0; i < 8; ++i) { q[4 * i] = t4[i].x; q[4 * i + 1] = t4[i].y; q[4 * i + 2] = t4[i].z; q[4 * i + 3] = t4[i].w; } }
    float c = 1.0f; float o[64];
#pragma unroll
    for (int i = 0; i < 64; ++i) o[i] = 0.f;
    const bf16* kp = F.KB + rowb * WATT + h * HD + lz; const bf16* vp = F.VB + rowb * WATT + h * HD + lz;
    for (int s = ch * 64 + 62; s >= 0; --s) {
        v4u kk[8]; LOADROW(kk, kp + (size_t)s * WATT); const float e = __builtin_amdgcn_exp2f(dot64(q, kk)); const float r = 1.0f / (1.0f + e);
        if (s < t) { const float a = e * r * c; c *= r; v4u vv[8]; LOADROW(vv, vp + (size_t)s * WATT); AXPY64(o, a, vv); }
    }
    STOREO(F.QB + (rowb + t) * WATT + h * HD, o, 1.0f);
}
__device__ __forceinline__ void p3_sb_naive(Frame& F) {
    const int gw = F.vcu * NWAVES + F.wave, NGW = F.G * NWAVES;
    for (int p = gw; p < 2048; p += NGW) { const int bh = p >> 5, j = p & 31;
        sb_naive_item(F, bh * 64 + j); sb_naive_item(F, bh * 64 + 63 - j); }
}
__device__ __forceinline__ void p3_moba_naive(Frame& F) {
    const int gw = F.vcu * NWAVES + F.wave, NGW = F.G * NWAVES;
    for (int p = gw; p < 2048; p += NGW) { const int bh = p >> 5, j = p & 31;
        moba_naive_item(F, bh * 64 + j); moba_naive_item(F, bh * 64 + 63 - j); }
}
__device__ __forceinline__ bool attn_deal(const Frame& F, int i, int& bh, int& qb) {
    if (F.G == 256) { if (i >= 4) return false; const int s = F.vcu & 3; bh = F.vcu >> 2; qb = (i == 0) ? s : (i == 1) ? 7 - s : (i == 2) ? 8 + s : 15 - s; return true; }
    const int u = F.vcu + i * F.G; if (u >= 1024) return false; bh = u >> 4; qb = u & 15; return true;
}
__device__ __forceinline__ void p3_moba(Frame& F) {
    int bh, qb, curh = -1;
    for (int i = 0; attn_deal(F, i, bh, qb); ++i) { const int b = bh >> 3, h = bh & 7;
        if (h != curh) { __syncthreads();
            for (int k = F.tid; k < attn::BT_BYTES / 16; k += NWAVES * 64) *(LAS v4u*)(F.lds + RING_OFF + attn::LDS_BT + 16 * k) = *(const GAS v4u*)(F.btg + (size_t)h * (attn::BT_BYTES / 4) + 4 * k);
            __syncthreads(); curh = h; }
        attn::moba_unit(b, h, qb, F.QA, F.KA, F.VA, F.QA, F.kmean, (char*)F.lds + RING_OFF); }
}
__device__ __forceinline__ void p6_route(Frame& F) {
    const int gw = F.vcu * NWAVES + F.wave, NGW = F.G * NWAVES;
    for (int m = gw; m < NTOK; m += NGW) {
        const int b = m / SEQ;
        const GAS f32x4* xr = (const GAS f32x4*)(F.out + (size_t)m * D) + F.lane;
        const GAS f32x4* gr = (const GAS f32x4*)F.g_ffn + F.lane;
        const GAS f32x4* shr = (const GAS f32x4*)(F.mod + (size_t)b * (NMOD * D) + 3 * D) + F.lane;
        const GAS f32x4* scr = (const GAS f32x4*)(F.mod + (size_t)b * (NMOD * D) + 4 * D) + F.lane;
        float ss = 0.f; { const GAS f32x4* sp = (const GAS f32x4*)(F.stats + (size_t)m * 16);
#pragma unroll
            for (int j = 0; j < 4; ++j) { const f32x4 s4 = sp[j]; ss += (s4.x + s4.y) + (s4.z + s4.w); } }
        const float rstd = __builtin_amdgcn_rsqf(ss * (1.f / D) + RMS_EPS);
        f32x4 y[4];
        GAS unsigned long long* o8 = (GAS unsigned long long*)(F.XN + (size_t)m * D) + F.lane;
#pragma unroll
        for (int j = 0; j < 4; ++j) { const f32x4 v = xr[64 * j], g = gr[64 * j], sh = shr[64 * j], sc = scr[64 * j]; y[j] = (v * rstd * g) * (sc + 1.0f) + sh;
            o8[64 * j] = (unsigned long long)pk2(y[j].x, y[j].y) | ((unsigned long long)pk2(y[j].z, y[j].w) << 32); }
        float gl[4] = {0.f, 0.f, 0.f, 0.f};
#pragma unroll
        for (int j = 0; j < 4; ++j) { const GAS f32x4* wp = (const GAS f32x4*)(F.w_rg + (size_t)(4 * F.lane + 256 * j) * NGRP);
#pragma unroll
            for (int e = 0; e < 4; ++e) { const f32x4 w = wp[e]; const float yv = y[j][e]; gl[0] += yv * w.x; gl[1] += yv * w.y; gl[2] += yv * w.z; gl[3] += yv * w.w; } }
#pragma unroll
        for (int g = 0; g < 4; ++g) gl[g] = wave_sum(gl[g]) + F.b_rg[g];
        int gi = 0; float gm = gl[0];
#pragma unroll
        for (int g = 1; g < 4; ++g) if (gl[g] > gm) { gm = gl[g]; gi = g; }
        float den = 0.f;
#pragma unroll
        for (int g = 0; g < 4; ++g) den += __expf(gl[g] - gm);
        const float gwt = 1.0f / den;
        float el[8] = {0.f, 0.f, 0.f, 0.f, 0.f, 0.f, 0.f, 0.f};
#pragma unroll
        for (int j = 0; j < 4; ++j)
#pragma unroll
            for (int e = 0; e < 4; ++e) { const GAS f32x4* wp = (const GAS f32x4*)(F.w_re + (size_t)(4 * F.lane + 256 * j + e) * NEXP + gi * EPG); const f32x4 w0 = wp[0], w1 = wp[1]; const float yv = y[j][e];
                el[0] += yv * w0.x; el[1] += yv * w0.y; el[2] += yv * w0.z; el[3] += yv * w0.w; el[4] += yv * w1.x; el[5] += yv * w1.y; el[6] += yv * w1.z; el[7] += yv * w1.w; }
#pragma unroll
        for (int k = 0; k < 8; ++k) el[k] = wave_sum(el[k]) + F.b_re[gi * EPG + k];
        int k1 = 0; float t1 = el[0];
#pragma unroll
        for (int k = 1; k < 8; ++k) if (el[k] > t1) { t1 = el[k]; k1 = k; }
        int k2 = -1; float t2 = -INFINITY;
#pragma unroll
        for (int k = 0; k < 8; ++k) if (k != k1 && el[k] > t2) { t2 = el[k]; k2 = k; }
        const float ex = __expf(t2 - t1); const float w1v = gwt / (1.0f + ex), w2v = gwt * ex / (1.0f + ex);
        if (F.lane < 2) { const int e = gi * EPG + (F.lane == 0 ? k1 : k2); const float w = F.lane == 0 ? w1v : w2v;
            const unsigned pos = __hip_atomic_fetch_add(F.cnt + (F.lane * NEXP + e) * 64, 1u, __ATOMIC_RELAXED, __HIP_MEMORY_SCOPE_AGENT);
            F.tokl[(size_t)(F.lane * NEXP + e) * LCAP + pos] = m; F.wl[(size_t)(F.lane * NEXP + e) * LCAP + pos] = w; }
    }
}
__device__ __forceinline__ void moe_tables(Frame& F) {
    LAS int* T = (LAS int*)(F.lds + TAB_OFF);
    if (F.tid < 64) T[F.tid] = (int)__hip_atomic_load(F.cnt + F.tid * 64, RLX_AGENT);
    __syncthreads();
    if (F.tid == 0) { int pa = 0, hs = 0, p0 = 0, p1 = 0;
        for (int e = 0; e < NEXP; ++e) { const int c0 = T[e], c1 = T[32 + e], ta = (c0 + c1 + 255) >> 8;
            T[64 + e] = pa; T[128 + e] = hs; T[192 + e] = p0; T[256 + e] = p1; pa += ta; hs += ta * 256; p0 += (c0 + 255) >> 8; p1 += (c1 + 255) >> 8; }
        T[64 + 32] = pa; T[128 + 32] = hs; T[192 + 32] = p0; T[256 + 32] = p1; }
    __syncthreads();
}
#ifndef MK_N_LAUNCHES
#define MK_N_LAUNCHES 1
#endif
constexpr int N_PHASES = 10;
constexpr int N_LAUNCHES = MK_N_LAUNCHES;
static_assert(N_LAUNCHES == 1 || N_LAUNCHES == N_PHASES, "MK_N_LAUNCHES is 1 or N_PHASES");
struct Args { const float* in[20]; float* out; unsigned char* ws; int ph_lo, ph_hi; };
__global__ void __launch_bounds__(NWAVES * 64, 2) fwd(Args args) {
    extern __shared__ __attribute__((aligned(16))) unsigned char lds[];
    Frame F;
    F.lds = (LAS unsigned char*)lds;
    F.MISC = (volatile LAS unsigned*)(F.lds + MISC_OFF);
    F.tid = threadIdx.x; F.lane = F.tid & 63; F.wave = __builtin_amdgcn_readfirstlane(F.tid >> 6);
    F.G = gridDim.x; { const int bx = blockIdx.x; F.vcu = (F.G % 8 == 0) ? (bx % 8) * (F.G / 8) + bx / 8 : bx; }
    unsigned char* ws = args.ws;
    F.ctl = (gu32*)(ws + WS_CTL);
    F.x = args.in[0]; F.c = args.in[1]; F.w_ada = args.in[2]; F.b_ada = args.in[3]; F.g_mix = args.in[4]; F.w_in = args.in[5]; F.g_q = args.in[6]; F.g_k = args.in[7]; F.rel_bias = args.in[8];
    F.w_br_moba = args.in[9]; F.w_br_sb = args.in[10]; F.w_out = args.in[11]; F.g_ffn = args.in[12]; F.w_rg = args.in[13]; F.b_rg = args.in[14]; F.w_re = args.in[15]; F.b_re = args.in[16];
    F.w_gate = args.in[17]; F.w_up = args.in[18]; F.w_down = args.in[19]; F.out = args.out;
    F.mod = (float*)(ws + WS_MOD); F.biasT = (float*)(ws + WS_BIAS); F.btg = (float*)(ws + WS_BIAS + 128 * 1024); F.stats = (float*)(ws + WS_STATS); F.kmean = (float*)(ws + WS_CTL) + CW_KMEAN;
    F.Win_t = (bf16*)(ws + WS_WIN); F.Wbra_t = (bf16*)(ws + WS_WBRA); F.Wbrb_t = (bf16*)(ws + WS_WBRB); F.Wout_t = (bf16*)(ws + WS_WOUT); F.Wgu_t = (bf16*)(ws + WS_WGU); F.Wd_t = (bf16*)(ws + WS_WD);
    F.XN = (bf16*)(ws + WS_XN); F.QA = (bf16*)(ws + WS_QA); F.KA = (bf16*)(ws + WS_KA); F.VA = (bf16*)(ws + WS_VA); F.QB = (bf16*)(ws + WS_QB); F.KB = (bf16*)(ws + WS_KB); F.VB = (bf16*)(ws + WS_VB);
    F.GA = (bf16*)(ws + WS_GA); F.GB = (bf16*)(ws + WS_GB); F.H = (bf16*)(ws + WS_H);
    F.tokl = (int*)(ws + WS_TOKL); F.wl = (float*)(ws + WS_WL); F.cnt = (unsigned*)(ws + WS_CTL) + CW_CNT;
    for (int u = F.tid; u < (LDS_BYTES - LDSCTL_OFF) / 4; u += NWAVES * 64) ((LAS unsigned*)(F.lds + LDSCTL_OFF))[u] = 0u;
    __syncthreads();
    XcdBarrier bar; bar.bar = (unsigned*)(F.ctl + CW_BAR); bar.x = 0; bar.st = nullptr;
    if (N_LAUNCHES == 1) bar = xcd_barrier_post((unsigned*)(F.ctl + CW_BAR), F.MISC + 8);
#define GRID_BAR() do { if (N_LAUNCHES == 1) { xcd_barrier(bar); } } while (0)
    const int lo = args.ph_lo, hi = args.ph_hi;
#define IN(k) (lo <= (k) && (k) < hi)
#define BOTH(k) (IN(k) && IN((k) + 1))

    if (IN(0)) { p0_prologue(F); if (BOTH(0)) GRID_BAR(); }
    if (IN(1)) { p1_norm(F); if (BOTH(1)) GRID_BAR(); }
    if (IN(2)) {
        __syncthreads();
        pg8::Gemm g{F.XN, F.Win_t, D}; pg8::DenseOrder S; S.init(NTOK, INCOLS, F.G, (int)blockIdx.x);
        pg8::EpiProj E{F.QA, F.GA, F.GB, F.g_q, F.g_k, F.kmean};
        pg8::gemm_phase<pg8::EpiProj, pg8::DenseOrder, false>(F.lds + RING_OFF, g, S, E);
        if (BOTH(2)) GRID_BAR();
    }
    if (IN(3)) {
#if defined(MOBA_NAIVE)
        p3_moba_naive(F);
#else
        __syncthreads(); p3_moba(F);
#endif
        p3_sb_naive(F);
        if (BOTH(3)) GRID_BAR(); }
    if (IN(4)) {
        __syncthreads();
        { pg8::Gemm g{F.QA, F.Wbra_t, WATT}; pg8::DenseOrder S; S.init(NTOK, D, F.G, (int)blockIdx.x);
          pg8::EpiBranch<0> E{F.GA, nullptr};
          pg8::gemm_phase<pg8::EpiBranch<0>, pg8::DenseOrder, false>(F.lds + RING_OFF, g, S, E); }
        { pg8::Gemm g{F.QB, F.Wbrb_t, WATT}; pg8::DenseOrder S; S.init(NTOK, D, F.G, (int)blockIdx.x);
          pg8::EpiBranch<1> E{F.GB, F.GA};
          pg8::gemm_phase<pg8::EpiBranch<1>, pg8::DenseOrder, false>(F.lds + RING_OFF, g, S, E); }
        if (BOTH(4)) GRID_BAR();
    }
    if (IN(5)) {
        __syncthreads();
        pg8::Gemm g{F.GB, F.Wout_t, D}; pg8::DenseOrder S; S.init(NTOK, D, F.G, (int)blockIdx.x);
        pg8::EpiResid E{F.x, F.out, F.mod + 2 * D, F.stats};
        pg8::gemm_phase<pg8::EpiResid, pg8::DenseOrder, false>(F.lds + RING_OFF, g, S, E);
        if (BOTH(5)) GRID_BAR();
    }
    if (IN(6)) { p6_route(F); if (BOTH(6)) GRID_BAR(); }
    if (IN(7)) {
        moe_tables(F);
        pg8::Gemm g{F.XN, F.Wgu_t, D}; pg8::GateUpOrder S{(const LAS int*)(F.lds + TAB_OFF), F.tokl, F.G, (int)blockIdx.x};
        pg8::EpiGateUp E{F.H};
        pg8::gemm_phase<pg8::EpiGateUp, pg8::GateUpOrder, true>(F.lds + RING_OFF, g, S, E);
        if (BOTH(7)) GRID_BAR();
    }
    if (IN(8)) {
        moe_tables(F);
        pg8::Gemm g{F.H, F.Wd_t, DEXP}; pg8::DownOrder<0> S{(const LAS int*)(F.lds + TAB_OFF), F.G, (int)blockIdx.x};
        pg8::EpiDown E{F.out, F.mod + 5 * D, F.tokl, F.wl};
        pg8::gemm_phase<pg8::EpiDown, pg8::DownOrder<0>, false>(F.lds + RING_OFF, g, S, E);
        if (BOTH(8)) GRID_BAR();
    }
    if (IN(9)) {
        moe_tables(F);
        pg8::Gemm g{F.H, F.Wd_t, DEXP}; pg8::DownOrder<1> S{(const LAS int*)(F.lds + TAB_OFF), F.G, (int)blockIdx.x};
        pg8::EpiDown E{F.out, F.mod + 5 * D, F.tokl, F.wl};
        pg8::gemm_phase<pg8::EpiDown, pg8::DownOrder<1>, false>(F.lds + RING_OFF, g, S, E);
    }
#undef IN
#undef BOTH
}

extern "C" void kernel_launch(void* const* d_in, const int* in_sizes, int n_in, void* d_out, int out_size, void* d_ws, size_t ws_size, hipStream_t stream) {
    static int grid = 0;
    if (grid == 0) {
        if (n_in != 20 || in_sizes[0] != NTOK * D || out_size != NTOK * D || ws_size < WS_END) { fprintf(stderr, "kernel_launch: built for 20 inputs, x/out of %d floats, >= %zu bytes of workspace; got n_in %d, in0 %d, out %d, ws %zu; nothing launched\n", NTOK * D, (size_t)WS_END, n_in, n_in > 0 ? in_sizes[0] : -1, out_size, ws_size); grid = -1; return; }
        int dev = 0, cus = 0, per_cu = 0;
        if (hipGetDevice(&dev) != hipSuccess || hipDeviceGetAttribute(&cus, hipDeviceAttributeMultiprocessorCount, dev) != hipSuccess) { fprintf(stderr, "kernel_launch: hipGetDevice / hipDeviceGetAttribute failed\n"); grid = -1; return; }
        if (hipFuncSetAttribute((const void*)fwd, hipFuncAttributeMaxDynamicSharedMemorySize, LDS_BYTES) != hipSuccess) { fprintf(stderr, "kernel_launch: hipFuncSetAttribute failed\n"); grid = -1; return; }
        if (hipOccupancyMaxActiveBlocksPerMultiprocessor(&per_cu, (const void*)fwd, NWAVES * 64, LDS_BYTES) != hipSuccess || per_cu < 1)
            fprintf(stderr, "kernel_launch: note: the occupancy query reports %d workgroups per CU\n", per_cu);
        (void)hipGetLastError();
        grid = cus;
    }
    if (grid < 0) return;
    if (hipMemsetAsync((char*)d_ws + WS_CTL, 0, CTL_ZERO_BYTES, stream) != hipSuccess) { fprintf(stderr, "kernel_launch: hipMemsetAsync failed\n"); return; }
    Args a{};
    for (int i = 0; i < 20; ++i) a.in[i] = (const float*)d_in[i];
    a.out = (float*)d_out; a.ws = (unsigned char*)d_ws;
    for (int li = 0; li < N_LAUNCHES; ++li) {
        a.ph_lo = (N_LAUNCHES == 1) ? 0 : li; a.ph_hi = (N_LAUNCHES == 1) ? N_PHASES : li + 1;
        hipLaunchKernelGGL(fwd, dim3(grid), dim3(NWAVES * 64), LDS_BYTES, stream, a);
        const hipError_t le = hipPeekAtLastError();
        if (le != hipSuccess) { fprintf(stderr, "kernel_launch: launch %d failed: %s\n", li, hipGetErrorName(le)); break; }
    }
}
```

```cpp
#include <hip/hip_runtime.h>
#include <cstdio>
#include <cstdint>
#include <cmath>
namespace pg8 {
#define PG8_LAS __attribute__((address_space(3)))
typedef unsigned short bf16_t;
typedef short bf16x8 __attribute__((ext_vector_type(8)));
typedef float f32x4 __attribute__((ext_vector_type(4)));
typedef unsigned u32x4 __attribute__((ext_vector_type(4)));
constexpr int BM = 256, BK = 64, HALF = 128, HTB = HALF * BK * 2  , STAGE_BYTES = 8 * HTB, NXCD = 8, WGM = 8;

__host__ __device__ __forceinline__ int lds_byte(int r, int c) { const int st = (r >> 4) * 2 + (c >> 5), rr = r & 15, cc = c & 31, ob = rr * 64 + cc * 2; return st * 1024 + (ob ^ (((ob >> 9) & 1) << 5)); }
__host__ __device__ __forceinline__ void stage_rc(int b, int& R, int& C) { const int st = b / 1024, sb = b % 1024, swz = sb ^ (((sb >> 9) & 1) << 5); R = (st >> 1) * 16 + swz / 64; C = (st & 1) * 32 + (swz % 64) / 2; }
__host__ __device__ __forceinline__ int perm32(int rho) { const int n = rho >> 4, i = rho & 15; return 8 * (i >> 2) + 4 * n + (i & 3); }

struct Unit { int arow, brow, pm, pn, x0, x1; };
struct Gemm { const bf16_t* A; const bf16_t* Bt; int K; };

struct DenseOrder {
    int nM, nN, nwg, G, c;
    __device__ void init(int M, int N, int G_, int c_) { nM = M / BM; nN = N / BM; nwg = nM * nN; G = G_; c = c_; }
    __device__ bool next(int i, Unit& u) const {
        const long L = (long)i * G + c; if (L >= nwg) return false;
        int wgid = (int)L; { const int q = nwg / NXCD, r = nwg % NXCD, xcd = wgid % NXCD, off = wgid / NXCD; wgid = (xcd < r ? xcd * (q + 1) : r * (q + 1) + (xcd - r) * q) + off; }
        const int nig = WGM * nN, gid = wgid / nig, fm = gid * WGM, gsz = (nM - fm) < WGM ? (nM - fm) : WGM;
        u.pm = fm + ((wgid % nig) % gsz); u.pn = (wgid % nig) / gsz; u.arow = u.pm * BM; u.brow = u.pn * BM; u.x0 = 0; u.x1 = 0; return true;
    }
    __device__ __forceinline__ int arow_of(const Unit&, int) const { return 0; }
};

__device__ __forceinline__ unsigned cvt_pk_bf16(float lo, float hi) { unsigned r; asm volatile("v_cvt_pk_bf16_f32 %0, %1, %2" : "=v"(r) : "v"(lo), "v"(hi)); return r; }

template <class Epi, class Sched, bool GATHER, bool ALIGN_EPI = true, bool SP2 = true>
__device__ __forceinline__ void gemm_phase(PG8_LAS unsigned char* lds, const Gemm g, const Sched& S, const Epi& E) {
    const int tid = threadIdx.x, wid = __builtin_amdgcn_readfirstlane(tid >> 6), lane = tid & 63, wr = wid >> 2, wc = wid & 3, fr = lane & 15, fq = lane >> 4;
    const int K = g.K, nt = K / BK;
    unsigned voffA[2], voffB[2]; int stR[2], stC[2];
#pragma unroll
    for (int i = 0; i < 2; ++i) { int R, C; stage_rc(tid * 16 + i * 8192, R, C); const int Rb = Epi::PERM ? ((R & ~31) + perm32(R & 31)) : R;
        stR[i] = R; stC[i] = C; voffA[i] = (unsigned)(R * K + C) * 2u; voffB[i] = (unsigned)(Rb * K + C) * 2u; }
    const size_t kstep = (size_t)(BK * 2);
    const size_t hstep = (size_t)HALF * K * 2;
    const size_t rstep = (size_t)K * 2;
    const unsigned ldsw = (unsigned)wid * 1024u;
    const int aoff = lds_byte(wr * 64 + fr, fq * 8), boff = lds_byte(wc * 32 + fr, fq * 8);
#define PG8_SA(b, h) (((b) * 2 + (h)) * HTB)
#define PG8_SB(b, h) ((4 + (b) * 2 + (h)) * HTB)
#define PG8_STAGE(bufoff, gbase, voff) do { _Pragma("unroll") for (int _i = 0; _i < 2; ++_i) \
        __builtin_amdgcn_global_load_lds((const unsigned*)((const char*)(gbase) + (voff)[_i]), (PG8_LAS unsigned*)(lds + (bufoff) + ldsw + _i * 8192), 16, 0, 0); } while (0)
#define PG8_STAGE_A(bufoff, ub, h, VS) do { if constexpr (GATHER) { PG8_STAGE(bufoff, ub, VS[h]); } else { PG8_STAGE(bufoff, (ub) + (h) * hstep, voffA); } } while (0)
#define PG8_VOFFS(dst, U) do { _Pragma("unroll") for (int h_ = 0; h_ < 2; ++h_) _Pragma("unroll") for (int i_ = 0; i_ < 2; ++i_) \
        dst[h_][i_] = (unsigned)(S.arow_of(U, h_ * HALF + stR[i_]) * K + stC[i_]) * 2u; } while (0)
#define PG8_LDA(dst, b, h) do { _Pragma("unroll") for (int m = 0; m < 4; ++m) _Pragma("unroll") for (int k = 0; k < 2; ++k) dst[m][k] = *(const PG8_LAS bf16x8*)(lds + PG8_SA(b, h) + aoff + m * 2048 + k * 1024); } while (0)
#define PG8_LDB(dst, b, h) do { _Pragma("unroll") for (int n = 0; n < 2; ++n) _Pragma("unroll") for (int k = 0; k < 2; ++k) dst[n][k] = *(const PG8_LAS bf16x8*)(lds + PG8_SB(b, h) + boff + n * 2048 + k * 1024); } while (0)
#define PG8_MMA(ai, bj, At, Bt) do { __builtin_amdgcn_s_setprio(1); _Pragma("unroll") for (int m = 0; m < 4; ++m) _Pragma("unroll") for (int n = 0; n < 2; ++n) _Pragma("unroll") for (int k = 0; k < 2; ++k) \
        acc[ai][bj][m][n] = __builtin_amdgcn_mfma_f32_16x16x32_bf16(Bt[n][k], At[m][k], acc[ai][bj][m][n], 0, 0, 0); __builtin_amdgcn_s_setprio(0); } while (0)
#define PG8_WAIT_V(n) asm volatile("s_waitcnt vmcnt(" #n ")" ::: "memory")
#define PG8_WAIT_L(n) asm volatile("s_waitcnt lgkmcnt(" #n ")" ::: "memory")
#define PG8_BAR __builtin_amdgcn_s_barrier()
#define PG8_SCHED __builtin_amdgcn_sched_barrier(0)
    Unit cur, nxt; int ui = 0;
    if (!S.next(0, cur)) return;
    bool has_next = S.next(1, nxt);
    unsigned vAc[2][2], vAn[2][2];
    if constexpr (GATHER) { PG8_VOFFS(vAc, cur); if (has_next) { PG8_VOFFS(vAn, nxt); } else {
#pragma unroll
        for (int h_ = 0; h_ < 2; ++h_) { vAn[h_][0] = vAc[h_][0]; vAn[h_][1] = vAc[h_][1]; } } }
    else {
#pragma unroll
        for (int h_ = 0; h_ < 2; ++h_) { vAc[h_][0] = 0u; vAc[h_][1] = 0u; vAn[h_][0] = 0u; vAn[h_][1] = 0u; } }
    f32x4 acc[2][2][4][2];
#pragma unroll
    for (int a = 0; a < 2; ++a)
#pragma unroll
        for (int b = 0; b < 2; ++b)
#pragma unroll
            for (int m = 0; m < 4; ++m)
#pragma unroll
                for (int n = 0; n < 2; ++n) acc[a][b][m][n] = (f32x4){0.f, 0.f, 0.f, 0.f};
    bf16x8 At[4][2], B0[2][2], B1[2][2];
    const char* const A0 = (const char*)g.A;
    const char* cA = GATHER ? A0 : A0 + (size_t)cur.arow * rstep; const char* cB = (const char*)g.Bt + (size_t)cur.brow * rstep;
    if constexpr (SP2) {
        PG8_STAGE(PG8_SB(0, 0), cB, voffB); PG8_STAGE(PG8_SB(0, 1), cB + hstep, voffB); PG8_STAGE_A(PG8_SA(0, 0), cA, 0, vAc); PG8_STAGE_A(PG8_SA(0, 1), cA, 1, vAc);
        if (wr == 1) PG8_BAR;
        PG8_WAIT_V(2); PG8_BAR;
        PG8_STAGE(PG8_SB(1, 0), cB + kstep, voffB); PG8_STAGE_A(PG8_SA(1, 0), cA + kstep, 0, vAc); PG8_STAGE(PG8_SB(1, 1), cB + hstep + kstep, voffB);
        PG8_WAIT_V(6); PG8_BAR;
    } else {
        PG8_STAGE(PG8_SB(0, 0), cB, voffB); PG8_STAGE_A(PG8_SA(0, 0), cA, 0, vAc); PG8_STAGE(PG8_SB(0, 1), cB + hstep, voffB); PG8_STAGE_A(PG8_SA(0, 1), cA, 1, vAc);
        if (wr == 1) PG8_BAR;
        PG8_WAIT_V(4); PG8_BAR;
        PG8_STAGE(PG8_SB(1, 0), cB + kstep, voffB); PG8_STAGE_A(PG8_SA(1, 0), cA + kstep, 0, vAc); PG8_STAGE(PG8_SB(1, 1), cB + hstep + kstep, voffB);
        PG8_WAIT_V(6); PG8_BAR;
    }
    for (;;) {
        const char* nA = GATHER ? A0 : (has_next ? A0 + (size_t)nxt.arow * rstep : cA); const char* nB = has_next ? (const char*)g.Bt + (size_t)nxt.brow * rstep : cB;
        for (int t = 0; t < nt; t += 2) {
            const bool last = (t == nt - 2);
            const char* a1 = cA + (size_t)(t + 1) * kstep;
            const char* a2 = last ? nA : cA + (size_t)(t + 2) * kstep; const char* b2 = last ? nB : cB + (size_t)(t + 2) * kstep;
            const char* a3 = a2 + kstep; const char* b3 = b2 + kstep;
            unsigned vS[2][2];
#pragma unroll
            for (int h_ = 0; h_ < 2; ++h_) { vS[h_][0] = last ? vAn[h_][0] : vAc[h_][0]; vS[h_][1] = last ? vAn[h_][1] : vAc[h_][1]; }
            if constexpr (SP2) {
            PG8_LDB(B0, 0, 0); PG8_LDB(B1, 0, 1); PG8_SCHED; PG8_LDA(At, 0, 0); PG8_STAGE_A(PG8_SA(1, 1), a1, 1, vAc);
            PG8_WAIT_V(8); PG8_WAIT_L(0); PG8_BAR; PG8_MMA(0, 0, At, B0); PG8_MMA(0, 1, At, B1); PG8_BAR; PG8_SCHED;
            PG8_LDA(At, 0, 1); PG8_STAGE(PG8_SB(0, 0), b2, voffB); PG8_STAGE(PG8_SB(0, 1), b2 + hstep, voffB); PG8_STAGE_A(PG8_SA(0, 0), a2, 0, vS);
            PG8_WAIT_V(8); PG8_WAIT_L(0); PG8_BAR; PG8_MMA(1, 0, At, B0); PG8_MMA(1, 1, At, B1); PG8_BAR; PG8_SCHED;
            PG8_LDB(B0, 1, 0); PG8_LDB(B1, 1, 1); PG8_SCHED; PG8_LDA(At, 1, 0); PG8_STAGE_A(PG8_SA(0, 1), a2, 1, vS);
            PG8_WAIT_V(8); PG8_WAIT_L(0); PG8_BAR; PG8_MMA(0, 0, At, B0); PG8_MMA(0, 1, At, B1); PG8_BAR; PG8_SCHED;
            PG8_LDA(At, 1, 1); PG8_STAGE(PG8_SB(1, 0), b3, voffB); PG8_STAGE(PG8_SB(1, 1), b3 + hstep, voffB); PG8_STAGE_A(PG8_SA(1, 0), a3, 0, vS);
            PG8_WAIT_V(8); PG8_WAIT_L(0); PG8_BAR; PG8_MMA(1, 0, At, B0); PG8_MMA(1, 1, At, B1); PG8_BAR; PG8_SCHED;
            } else {
            PG8_LDB(B0, 0, 0); PG8_SCHED; PG8_LDA(At, 0, 0); PG8_STAGE_A(PG8_SA(1, 1), a1, 1, vAc);
            PG8_WAIT_L(8); PG8_BAR; PG8_WAIT_L(0); PG8_MMA(0, 0, At, B0); PG8_BAR; PG8_SCHED;
            PG8_LDB(B1, 0, 1); PG8_STAGE(PG8_SB(0, 0), b2, voffB);
            PG8_BAR; PG8_WAIT_L(0); PG8_MMA(0, 1, At, B1); PG8_BAR;
            PG8_LDA(At, 0, 1); PG8_STAGE_A(PG8_SA(0, 0), a2, 0, vS);
            PG8_BAR; PG8_WAIT_L(0); PG8_MMA(1, 0, At, B0); PG8_BAR; PG8_SCHED;
            PG8_STAGE(PG8_SB(0, 1), b2 + hstep, voffB);
            PG8_WAIT_V(6); PG8_BAR; PG8_MMA(1, 1, At, B1); PG8_BAR;
            PG8_LDB(B0, 1, 0); PG8_SCHED; PG8_LDA(At, 1, 0); PG8_STAGE_A(PG8_SA(0, 1), a2, 1, vS);
            PG8_WAIT_L(8); PG8_BAR; PG8_WAIT_L(0); PG8_MMA(0, 0, At, B0); PG8_BAR; PG8_SCHED;
            PG8_LDB(B1, 1, 1); PG8_STAGE(PG8_SB(1, 0), b3, voffB);
            PG8_BAR; PG8_WAIT_L(0); PG8_MMA(0, 1, At, B1); PG8_BAR;
            PG8_LDA(At, 1, 1); PG8_STAGE_A(PG8_SA(1, 0), a3, 0, vS);
            PG8_BAR; PG8_WAIT_L(0); PG8_MMA(1, 0, At, B0); PG8_BAR; PG8_SCHED;
            PG8_STAGE(PG8_SB(1, 1), b3 + hstep, voffB);
            PG8_WAIT_V(6); PG8_BAR; PG8_MMA(1, 1, At, B1); PG8_BAR;
            }
        }
        if constexpr (ALIGN_EPI) { if (wr == 0) PG8_BAR; }
        E(acc, cur, wr, wc, fr, fq);
        if (!has_next) break;
#pragma unroll
        for (int a = 0; a < 2; ++a)
#pragma unroll
            for (int b = 0; b < 2; ++b)
#pragma unroll
                for (int m = 0; m < 4; ++m)
#pragma unroll
                    for (int n = 0; n < 2; ++n) acc[a][b][m][n] = (f32x4){0.f, 0.f, 0.f, 0.f};
        cur = nxt; cA = nA; cB = nB; ++ui;
        has_next = S.next(ui + 1, nxt);
        if constexpr (GATHER) {
#pragma unroll
            for (int h_ = 0; h_ < 2; ++h_) { vAc[h_][0] = vAn[h_][0]; vAc[h_][1] = vAn[h_][1]; }
            if (has_next) { PG8_VOFFS(vAn, nxt); }
        }
        if constexpr (ALIGN_EPI) { if (wr == 1) PG8_BAR; }
    }
    PG8_WAIT_V(0);
    if constexpr (!ALIGN_EPI) { if (wr == 0) PG8_BAR; }
    PG8_BAR;
#undef PG8_SA
#undef PG8_SB
#undef PG8_STAGE
#undef PG8_STAGE_A
#undef PG8_VOFFS
#undef PG8_LDA
#undef PG8_LDB
#undef PG8_MMA
#undef PG8_WAIT_V
#undef PG8_WAIT_L
#undef PG8_BAR
#undef PG8_SCHED
}
}
constexpr int NWAVES = 8;
constexpr int BATCH = 8, SEQ = 4096, D = 1024, NTOK = BATCH * SEQ;
constexpr int HD = 64, NH = 8, WATT = NH * HD;
constexpr int INCOLS = 5120, NMOD = 6;
constexpr int MBLK = 256, NBLK = SEQ / MBLK;
constexpr int NEXP = 32, EPG = 8, NGRP = 4, DEXP = 512;
constexpr float RMS_EPS = 1e-6f;
constexpr float LOG2E = 1.4426950408889634f;
constexpr float C2 = 0.125f * 1.4426950408889634f;
constexpr int LCAP = NTOK;
constexpr int HROWS = 2 * NTOK + NEXP * 256 + 256;

constexpr size_t MiB = 1u << 20;
constexpr size_t WS_CTL = 0, CTL_ZERO_BYTES = 1 * MiB;
constexpr size_t WS_MOD = 1 * MiB;
constexpr size_t WS_BIAS = 1 * MiB + 256 * 1024;
constexpr size_t WS_STATS = 2 * MiB;
constexpr size_t WS_WIN = 4 * MiB;
constexpr size_t WS_WBRA = 14 * MiB, WS_WBRB = 15 * MiB;
constexpr size_t WS_WOUT = 16 * MiB;
constexpr size_t WS_WGU = 18 * MiB;
constexpr size_t WS_WD = 82 * MiB;
constexpr size_t WS_XN = 114 * MiB;
constexpr size_t WS_QA = 178 * MiB, WS_KA = 210 * MiB, WS_VA = 242 * MiB, WS_QB = 274 * MiB, WS_KB = 306 * MiB, WS_VB = 338 * MiB;
constexpr size_t WS_GA = 370 * MiB, WS_GB = 434 * MiB;
constexpr size_t WS_H = 178 * MiB;
constexpr size_t WS_TOKL = 306 * MiB, WS_WL = 314 * MiB;
constexpr size_t WS_END = 498 * MiB;
static_assert(WS_H + (size_t)HROWS * DEXP * 2 <= WS_QB && WS_TOKL + (size_t)2 * NEXP * LCAP * 4 <= WS_WL && WS_WL + (size_t)2 * NEXP * LCAP * 4 <= WS_VB, "d_ws map");
constexpr int CW_TMO = 0, CW_CODE = 1;
constexpr int CW_BAR = 4096;
constexpr int CW_CNT = 16384;
constexpr int CW_KMEAN = 65536;
static_assert((CW_KMEAN + 65536) * 4 <= (int)CTL_ZERO_BYTES && CW_CNT + 64 * 64 <= CW_KMEAN && CW_BAR + 3456 <= CW_CNT, "CTL map");

constexpr int RING_OFF = 0, RING_BYTES = 131072;
constexpr int LDSCTL_OFF = RING_BYTES, MISC_OFF = LDSCTL_OFF + 320;
constexpr int TAB_OFF = RING_BYTES + 1024;
constexpr int LDS_BYTES = 147456;
static_assert(MISC_OFF + 128 <= TAB_OFF && TAB_OFF + 2048 <= LDS_BYTES, "LDS map");

#define GAS __attribute__((address_space(1)))
#define LAS __attribute__((address_space(3)))
typedef unsigned short bf16;
typedef unsigned v4u __attribute__((ext_vector_type(4)));
typedef unsigned v2u __attribute__((ext_vector_type(2)));
typedef float f32x4 __attribute__((ext_vector_type(4)));
typedef short bf16x8 __attribute__((ext_vector_type(8)));
typedef GAS unsigned gu32;
#define RLX_AGENT __ATOMIC_RELAXED, __HIP_MEMORY_SCOPE_AGENT
#define LDS_WAIT() asm volatile("s_waitcnt lgkmcnt(0)" ::: "memory")
#define VM_WAIT() asm volatile("s_waitcnt vmcnt(0)" ::: "memory")
__device__ __forceinline__ unsigned f2bf(float f) { unsigned u = __builtin_bit_cast(unsigned, f); return (u + 0x7fffu + ((u >> 16) & 1u)) >> 16; }
__device__ __forceinline__ unsigned pk2(float lo, float hi) { return f2bf(lo) | (f2bf(hi) << 16); }
__device__ __forceinline__ float bflo(unsigned u) { return __uint_as_float(u << 16); }
__device__ __forceinline__ float bfhi(unsigned u) { return __uint_as_float(u & 0xffff0000u); }
__device__ __forceinline__ float fsigmoid(float v) { return __builtin_amdgcn_rcpf(1.0f + __builtin_amdgcn_exp2f(-v * LOG2E)); }
#define XB_TMO      128
#define XB_XCNT(j)  (256  + 64 * (j))
#define XB_XSUB(j)  (1280 + 64 * (j))
#define XB_XGEN(j)  (2304 + 64 * (j))
#define XB_TOP      3328
#define XB_TOPGEN   3392
#define XCD_BAR_WORDS 3456
#define XB_SPIN_CAP (1u << 22)

__device__ __forceinline__ unsigned xb_ld(unsigned* p)              { return __hip_atomic_load(p, __ATOMIC_RELAXED, __HIP_MEMORY_SCOPE_AGENT); }
__device__ __forceinline__ unsigned xb_add(unsigned* p, unsigned v) { return __hip_atomic_fetch_add(p, v, __ATOMIC_RELAXED, __HIP_MEMORY_SCOPE_AGENT); }
__device__ __forceinline__ unsigned xb_xcc_id() { return (unsigned)__builtin_amdgcn_s_getreg((3 << 11) | 20) & 0xFu; }
#define XB_SPIN(cond, bar) do { unsigned _sp = 0; while (cond) { __builtin_amdgcn_s_sleep(1); \
    if ((++_sp & 255u) == 0u) { if (xb_ld(&(bar)[XB_TMO])) break; if (_sp > XB_SPIN_CAP) { atomicAdd(&(bar)[XB_TMO], 1u); break; } } } } while (0)

struct XcdBarrier {
    unsigned* bar; unsigned x;
    volatile LAS unsigned* st;
};

__device__ __forceinline__ XcdBarrier xcd_barrier_post(unsigned* bar, volatile LAS unsigned* st) {
    XcdBarrier b; b.bar = bar; b.x = xb_xcc_id(); b.st = st;
    if (threadIdx.x == 0) (void)xb_add(&bar[XB_XCNT(b.x)], 1u);
    return b;
}
__device__ __forceinline__ void xcd_barrier_complete(unsigned* bar, unsigned x, unsigned& nloc, unsigned& nx) {
    const unsigned G = gridDim.x * gridDim.y * gridDim.z;
    unsigned sum, cnt, mine, sp = 0u;
    for (;;) {
        sum = 0u; cnt = 0u; mine = 0u;
#pragma unroll
        for (unsigned j = 0; j < 16; ++j) { const unsigned c = xb_ld(&bar[XB_XCNT(j)]); sum += c; cnt += (c > 0u) ? 1u : 0u; mine = (j == x) ? c : mine; }
        if (sum == G) break;
        __builtin_amdgcn_s_sleep(1);
        if ((++sp & 255u) == 0u) { if (xb_ld(&bar[XB_TMO])) break; if (sp > XB_SPIN_CAP) { atomicAdd(&bar[XB_TMO], 1u); break; } }
    }
    nloc = mine > 0u ? mine : 1u; nx = cnt > 0u ? cnt : 1u;
}

__device__ __forceinline__ void xcd_barrier(const XcdBarrier& b) {
    asm volatile("s_waitcnt vmcnt(0)" ::: "memory");
    __syncthreads();
    if (threadIdx.x == 0) {
        unsigned* bar = b.bar;
        __builtin_amdgcn_s_waitcnt(0);
        unsigned nloc = b.st[0], nx = b.st[1];
        if (nloc == 0u) { xcd_barrier_complete(bar, b.x, nloc, nx); b.st[0] = nloc; b.st[1] = nx; }
        const unsigned old = xb_add(&bar[XB_XSUB(b.x)], 1u);
        const unsigned gen = old / nloc;
        if (old + 1u == (gen + 1u) * nloc) {
            __builtin_amdgcn_fence(__ATOMIC_RELEASE, "agent");
            asm volatile("s_waitcnt vmcnt(0)" ::: "memory");
            const unsigned og = xb_add(&bar[XB_TOP], 1u);
            const unsigned tg = og / nx;
            if (og + 1u == (tg + 1u) * nx) xb_add(&bar[XB_TOPGEN], 1u);
            else XB_SPIN(xb_ld(&bar[XB_TOPGEN]) == tg, bar);
            __builtin_amdgcn_fence(__ATOMIC_ACQUIRE, "agent");
            xb_add(&bar[XB_XGEN(b.x)], 1u);
            asm volatile("s_waitcnt vmcnt(0)" ::: "memory");
        } else {
            XB_SPIN(xb_ld(&bar[XB_XGEN(b.x)]) == gen, bar);
            __builtin_amdgcn_fence(__ATOMIC_ACQUIRE, "agent");
            asm volatile("s_waitcnt vmcnt(0)" ::: "memory");
        }
    }
    __syncthreads();
}
namespace pg8 {
struct EpiProj {
    static constexpr bool PERM = true;
    bf16_t* qkv;
    bf16_t* ga; bf16_t* gb;
    const float* gq; const float* gk;
    float* kmean;
    __device__ __forceinline__ void operator()(const f32x4 (&acc)[2][2][4][2], const Unit& u, int wr, int wc, int fr, int fq) const {
        const int pn = u.pn; const int row0 = u.pm * BM + wr * 64 + fr;
        if (pn < 4) {
            const bool isq = pn < 2; const float* gv = isq ? gq : gk; const float post = isq ? C2 : 1.0f;
            bf16_t* base = qkv + (size_t)(pn >> 1) * ((size_t)NTOK * WATT) + (pn & 1) * 256 + wc * 64 + 8 * fq;
            float g[2][2][4];
#pragma unroll
            for (int bj = 0; bj < 2; ++bj)
#pragma unroll
                for (int n = 0; n < 2; ++n) { const f32x4 t = *(const f32x4*)(gv + 32 * bj + 8 * fq + 4 * n); g[bj][n][0] = t[0] * post; g[bj][n][1] = t[1] * post; g[bj][n][2] = t[2] * post; g[bj][n][3] = t[3] * post; }
            float cs[2][2][4];
#pragma unroll
            for (int bj = 0; bj < 2; ++bj)
#pragma unroll
                for (int n = 0; n < 2; ++n)
#pragma unroll
                    for (int e = 0; e < 4; ++e) cs[bj][n][e] = 0.f;
#pragma unroll
            for (int ai = 0; ai < 2; ++ai)
#pragma unroll
                for (int m = 0; m < 4; ++m) {
                    float ss = 0.f;
#pragma unroll
                    for (int bj = 0; bj < 2; ++bj)
#pragma unroll
                        for (int n = 0; n < 2; ++n) { const f32x4 x = acc[ai][bj][m][n]; ss += (x[0] * x[0] + x[1] * x[1]) + (x[2] * x[2] + x[3] * x[3]); }
                    ss += __shfl_xor(ss, 16); ss += __shfl_xor(ss, 32);
                    const float rstd = __builtin_amdgcn_rsqf(ss * (1.0f / 64.0f) + RMS_EPS);
                    bf16_t* rowp = base + (size_t)(row0 + ai * HALF + m * 16) * WATT;
#pragma unroll
                    for (int bj = 0; bj < 2; ++bj) { float o[2][4];
#pragma unroll
                        for (int n = 0; n < 2; ++n)
#pragma unroll
                            for (int e = 0; e < 4; ++e) { o[n][e] = acc[ai][bj][m][n][e] * rstd * g[bj][n][e]; cs[bj][n][e] += o[n][e]; }
                        u32x4 w; w.x = cvt_pk_bf16(o[0][0], o[0][1]); w.y = cvt_pk_bf16(o[0][2], o[0][3]); w.z = cvt_pk_bf16(o[1][0], o[1][1]); w.w = cvt_pk_bf16(o[1][2], o[1][3]);
                        *(u32x4*)(rowp + 32 * bj) = w; }
                }
            if (!isq) {
#pragma unroll
                for (int bj = 0; bj < 2; ++bj)
#pragma unroll
                    for (int n = 0; n < 2; ++n)
#pragma unroll
                        for (int e = 0; e < 4; ++e) { float v = cs[bj][n][e]; v += __shfl_xor(v, 1); v += __shfl_xor(v, 2); v += __shfl_xor(v, 4); v += __shfl_xor(v, 8); cs[bj][n][e] = v; }
                if (fr == 0) { float* kp = kmean + ((size_t)u.pm * NH + (pn & 1) * 4 + wc) * HD + 8 * fq;
#pragma unroll
                    for (int bj = 0; bj < 2; ++bj)
#pragma unroll
                        for (int n = 0; n < 2; ++n)
#pragma unroll
                            for (int e = 0; e < 4; ++e) atomicAdd(kp + 32 * bj + 4 * n + e, cs[bj][n][e]); }
            }
        } else {
            const bool isg = pn >= 12; const float sc = (pn == 6 || pn == 7) ? C2 : 1.0f;
            bf16_t* base; int ldc;
            if (isg) { base = (pn < 16 ? ga : gb) + (pn & 3) * 256 + wc * 64 + 8 * fq; ldc = D; }
            else { base = qkv + (size_t)(pn >> 1) * ((size_t)NTOK * WATT) + (pn & 1) * 256 + wc * 64 + 8 * fq; ldc = WATT; }
#pragma unroll
            for (int ai = 0; ai < 2; ++ai)
#pragma unroll
                for (int m = 0; m < 4; ++m) { bf16_t* rowp = base + (size_t)(row0 + ai * HALF + m * 16) * ldc;
#pragma unroll
                    for (int bj = 0; bj < 2; ++bj) { f32x4 v0 = acc[ai][bj][m][0], v1 = acc[ai][bj][m][1];
                        if (isg) {
#pragma unroll
                            for (int e = 0; e < 4; ++e) { v0[e] = __builtin_amdgcn_rcpf(1.0f + __builtin_amdgcn_exp2f(-v0[e] * LOG2E)); v1[e] = __builtin_amdgcn_rcpf(1.0f + __builtin_amdgcn_exp2f(-v1[e] * LOG2E)); } }
                        else { v0 = v0 * sc; v1 = v1 * sc; }
                        u32x4 w; w.x = cvt_pk_bf16(v0[0], v0[1]); w.y = cvt_pk_bf16(v0[2], v0[3]); w.z = cvt_pk_bf16(v1[0], v1[1]); w.w = cvt_pk_bf16(v1[2], v1[3]);
                        *(u32x4*)(rowp + 32 * bj) = w; } }
        }
    }
};

template <int MODE> struct EpiBranch {
    static constexpr bool PERM = true;
    bf16_t* sg; const bf16_t* tin;
    __device__ __forceinline__ void operator()(const f32x4 (&acc)[2][2][4][2], const Unit& u, int wr, int wc, int fr, int fq) const {
        const int row0 = u.pm * BM + wr * 64 + fr, col0 = u.pn * BM + wc * 32 + 8 * fq;
#pragma unroll
        for (int ai = 0; ai < 2; ++ai)
#pragma unroll
            for (int m = 0; m < 4; ++m) { const size_t off = (size_t)(row0 + ai * HALF + m * 16) * D + col0;
#pragma unroll
                for (int bj = 0; bj < 2; ++bj) { const u32x4 gw = *(const u32x4*)(sg + off + bj * HALF); u32x4 tw = (u32x4){0u, 0u, 0u, 0u}; if (MODE == 1) tw = *(const u32x4*)(tin + off + bj * HALF);
                    const f32x4 v0 = acc[ai][bj][m][0], v1 = acc[ai][bj][m][1]; float o[8];
                    o[0] = bflo(gw.x) * v0[0]; o[1] = bfhi(gw.x) * v0[1]; o[2] = bflo(gw.y) * v0[2]; o[3] = bfhi(gw.y) * v0[3];
                    o[4] = bflo(gw.z) * v1[0]; o[5] = bfhi(gw.z) * v1[1]; o[6] = bflo(gw.w) * v1[2]; o[7] = bfhi(gw.w) * v1[3];
                    if (MODE == 1) { o[0] += bflo(tw.x); o[1] += bfhi(tw.x); o[2] += bflo(tw.y); o[3] += bfhi(tw.y); o[4] += bflo(tw.z); o[5] += bfhi(tw.z); o[6] += bflo(tw.w); o[7] += bfhi(tw.w); }
                    u32x4 w; w.x = cvt_pk_bf16(o[0], o[1]); w.y = cvt_pk_bf16(o[2], o[3]); w.z = cvt_pk_bf16(o[4], o[5]); w.w = cvt_pk_bf16(o[6], o[7]);
                    *(u32x4*)(sg + off + bj * HALF) = w; } }
    }
};

struct EpiResid {
    static constexpr bool PERM = false;
    const float* x; float* out; const float* gt;
    float* stats;
    __device__ __forceinline__ void operator()(const f32x4 (&acc)[2][2][4][2], const Unit& u, int wr, int wc, int fr, int fq) const {
        const int row0 = u.pm * BM + wr * 64 + fr, col0 = u.pn * BM + wc * 32 + 4 * fq; const int b = (u.pm * BM) / SEQ;
        f32x4 gv[2][2];
#pragma unroll
        for (int bj = 0; bj < 2; ++bj)
#pragma unroll
            for (int n = 0; n < 2; ++n) gv[bj][n] = *(const f32x4*)(gt + (size_t)b * (NMOD * D) + col0 + bj * HALF + n * 16);
#pragma unroll
        for (int ai = 0; ai < 2; ++ai)
#pragma unroll
            for (int m = 0; m < 4; ++m) { const int row = row0 + ai * HALF + m * 16; const size_t off = (size_t)row * D + col0; float ss = 0.f;
#pragma unroll
                for (int bj = 0; bj < 2; ++bj)
#pragma unroll
                    for (int n = 0; n < 2; ++n) { const f32x4 xv = *(const f32x4*)(x + off + bj * HALF + n * 16); const f32x4 o = xv + gv[bj][n] * acc[ai][bj][m][n];
                        *(f32x4*)(out + off + bj * HALF + n * 16) = o; ss += (o[0] * o[0] + o[1] * o[1]) + (o[2] * o[2] + o[3] * o[3]); }
                ss += __shfl_xor(ss, 16); ss += __shfl_xor(ss, 32);
                if (fq == 0) stats[(size_t)row * 16 + u.pn * 4 + wc] = ss; }
    }
};

struct EpiGateUp {
    static constexpr bool PERM = true;
    bf16_t* H;
    __device__ __forceinline__ void operator()(const f32x4 (&acc)[2][2][4][2], const Unit& u, int wr, int wc, int fr, int fq) const {
        bf16_t* base = H + (size_t)(u.arow + wr * 64 + fr) * DEXP + u.pn * 128 + wc * 32 + 8 * fq;
#pragma unroll
        for (int ai = 0; ai < 2; ++ai)
#pragma unroll
            for (int m = 0; m < 4; ++m) { float o[8];
#pragma unroll
                for (int n = 0; n < 2; ++n)
#pragma unroll
                    for (int e = 0; e < 4; ++e) { const float gg = acc[ai][0][m][n][e], uu = acc[ai][1][m][n][e]; o[4 * n + e] = gg * __builtin_amdgcn_rcpf(1.0f + __builtin_amdgcn_exp2f(-gg * LOG2E)) * uu; }
                u32x4 w; w.x = cvt_pk_bf16(o[0], o[1]); w.y = cvt_pk_bf16(o[2], o[3]); w.z = cvt_pk_bf16(o[4], o[5]); w.w = cvt_pk_bf16(o[6], o[7]);
                *(u32x4*)(base + (size_t)(ai * HALF + m * 16) * DEXP) = w; }
    }
};

struct EpiDown {
    static constexpr bool PERM = false;
    float* out; const float* gt;
    const int* tl; const float* wl;
    __device__ __forceinline__ void operator()(const f32x4 (&acc)[2][2][4][2], const Unit& u, int wr, int wc, int fr, int fq) const {
        const int col0 = u.pn * BM + wc * 32 + 4 * fq;
#pragma unroll
        for (int ai = 0; ai < 2; ++ai)
#pragma unroll
            for (int m = 0; m < 4; ++m) { const int r = ai * HALF + wr * 64 + m * 16 + fr;
                if (r < u.x1) { const int tok = tl[u.x0 + r]; const float w = wl[u.x0 + r]; const int b = tok / SEQ; const size_t off = (size_t)tok * D + col0;
#pragma unroll
                    for (int bj = 0; bj < 2; ++bj)
#pragma unroll
                        for (int n = 0; n < 2; ++n) { const f32x4 gv = *(const f32x4*)(gt + (size_t)b * (NMOD * D) + col0 + bj * HALF + n * 16); float* p = out + off + bj * HALF + n * 16;
                            const f32x4 ov = *(const f32x4*)p; *(f32x4*)p = ov + gv * (acc[ai][bj][m][n] * w); } } }
    }
};

struct GateUpOrder {
    const PG8_LAS int* T; const int* tokl; int G, c;
    __device__ bool next(int i, Unit& u) const {
        const int L = i * G + c; const int total = T[64 + 32] * 4; if (L >= total) return false;
        const int rt = L >> 2; int e = 0; while (T[64 + e + 1] <= rt) ++e;
        const int lt = rt - T[64 + e];
        u.pm = lt; u.pn = L & 3; u.x0 = e; u.x1 = 0; u.arow = T[128 + e] + lt * 256; u.brow = e * 1024 + (L & 3) * 256; return true;
    }
    __device__ __forceinline__ int arow_of(const Unit& u, int r) const {
        const int idx = u.pm * 256 + r, c0 = T[u.x0], c1 = T[32 + u.x0];
        int tok = 0;
        if (idx < c0) tok = tokl[(size_t)u.x0 * LCAP + idx]; else if (idx < c0 + c1) tok = tokl[(size_t)(NEXP + u.x0) * LCAP + idx - c0];
        return tok;
    }
};
template <int SLOT> struct DownOrder {
    const PG8_LAS int* T; int G, c;
    __device__ bool next(int i, Unit& u) const {
        const int PO = SLOT ? 256 : 192; const int L = i * G + c; const int total = T[PO + 32] * 4; if (L >= total) return false;
        const int rt = L >> 2; int e = 0; while (T[PO + e + 1] <= rt) ++e;
        const int lt = rt - T[PO + e]; const int cs = T[SLOT * 32 + e]; const int rem = cs - lt * 256;
        u.pm = lt; u.pn = L & 3; u.x0 = (SLOT * NEXP + e) * LCAP + lt * 256; u.x1 = rem < 256 ? rem : 256;
        u.arow = T[128 + e] + (SLOT ? T[e] : 0) + lt * 256; u.brow = e * 1024 + (L & 3) * 256; return true;
    }
    __device__ __forceinline__ int arow_of(const Unit&, int) const { return 0; }
};
}
namespace attn {
using bf16x8 = __attribute__((ext_vector_type(8))) short;
using s16x4 = __attribute__((ext_vector_type(4))) short;
using f32x16 = __attribute__((ext_vector_type(16))) float;
using f32x4v = __attribute__((ext_vector_type(4))) float;
using u32x4 = __attribute__((ext_vector_type(4))) unsigned;
typedef unsigned short bf16;
constexpr int DM = 512, QBLK = 32, NW = 8, QB = 256, KVBLK = 64;
constexpr int NSLOT = 3, SLOTB = 8192;
constexpr int LDS_K = 0, LDS_V = NSLOT * SLOTB, LDS_WS = 2 * NSLOT * SLOTB, LDS_OST = LDS_WS + NW * 64 * 4, LDS_BT = LDS_OST + NW * 4096;
constexpr int REV = 896, BT_LEN = 1168, COPYB = BT_LEN * 4, NEG_OFF = 4 * COPYB, BT_BYTES = NEG_OFF + 256;
constexpr int LDS_BYTES = LDS_BT + BT_BYTES;
static_assert(BT_LEN >= REV + 256 + 8 + 3 && COPYB % 16 == 0 && LDS_BT % 16 == 0, "bias image");
#define SBAR() __builtin_amdgcn_sched_barrier(0)
#define WAIT_BAR(N) asm volatile("s_waitcnt vmcnt(" #N ") lgkmcnt(0)\n\ts_barrier":::"memory")
typedef __attribute__((address_space(3))) const char* lds_cptr;
typedef short v4i16_t __attribute__((ext_vector_type(4)));
typedef float f32x2_t __attribute__((ext_vector_type(2))); typedef __bf16 bf16x2_t __attribute__((ext_vector_type(2)));
__device__ __forceinline__ int crow(int r, int hi) { return (r & 3) + 8 * (r >> 2) + 4 * hi; }
__device__ __forceinline__ void glds16(const void* gsrc, unsigned lds_dst) { unsigned keep;
  asm volatile("s_mov_b32 %0, m0\n\ts_mov_b32 m0, %2\n\ts_nop 0\n\tglobal_load_lds_dwordx4 %1, off\n\ts_mov_b32 m0, %0" : "=&s"(keep) : "v"(gsrc), "s"(lds_dst) : "memory"); }
__device__ __forceinline__ unsigned cvtpk_s(float lo, float hi) { f32x2_t v = {lo, hi}; bf16x2_t b = __builtin_convertvector(v, bf16x2_t); return __builtin_bit_cast(unsigned, b); }
__device__ __forceinline__ void kload8(bf16x8* kf, lds_cptr kp) {
  kf[0] = *(const __attribute__((address_space(3))) bf16x8*)(kp);        kf[1] = *(const __attribute__((address_space(3))) bf16x8*)(kp + 512);
  kf[2] = *(const __attribute__((address_space(3))) bf16x8*)(kp + 2048); kf[3] = *(const __attribute__((address_space(3))) bf16x8*)(kp + 2560);
  kf[4] = *(const __attribute__((address_space(3))) bf16x8*)(kp + 4096); kf[5] = *(const __attribute__((address_space(3))) bf16x8*)(kp + 4608);
  kf[6] = *(const __attribute__((address_space(3))) bf16x8*)(kp + 6144); kf[7] = *(const __attribute__((address_space(3))) bf16x8*)(kp + 6656);
}
__device__ __forceinline__ void kload2(bf16x8* kf, lds_cptr kp, int j) { kf[2 * j] = *(const __attribute__((address_space(3))) bf16x8*)(kp + j * 2048); kf[2 * j + 1] = *(const __attribute__((address_space(3))) bf16x8*)(kp + j * 2048 + 512); }
__device__ __forceinline__ s16x4 vtr(lds_cptr p) { return __builtin_bit_cast(s16x4, __builtin_amdgcn_ds_read_tr16_b64_v4i16((__attribute__((address_space(3))) v4i16_t*)p)); }
__device__ __forceinline__ f32x4v ldsf4(lds_cptr p) { return *(const __attribute__((address_space(3))) f32x4v*)p; }
#define MFMA32(a, b, c) __builtin_amdgcn_mfma_f32_32x32x16_bf16(a, b, c, 0, 0, 0)
__device__ __forceinline__ void pv(f32x16* o, int vb, bf16x8 pa0, bf16x8 pa1, bf16x8 pa2, bf16x8 pa3) {
  #pragma unroll
  for (int d0 = 0; d0 < 2; ++d0) { s16x4 lo[4], hi[4];
    #pragma unroll
    for (int ks = 0; ks < 4; ++ks) {
      asm volatile("ds_read_b64_tr_b16 %0,%1 offset:%c2" : "=&v"(lo[ks]) : "v"(vb), "i"(d0 * 4096 + ks * 1024) : "memory");
      asm volatile("ds_read_b64_tr_b16 %0,%1 offset:%c2" : "=&v"(hi[ks]) : "v"(vb), "i"(d0 * 4096 + ks * 1024 + 512) : "memory"); }
    asm volatile("s_waitcnt lgkmcnt(0)" ::: "memory"); SBAR();
    #define PK(k) (bf16x8){lo[k][0], lo[k][1], lo[k][2], lo[k][3], hi[k][0], hi[k][1], hi[k][2], hi[k][3]}
    o[d0] = MFMA32(pa0, PK(0), o[d0]); o[d0] = MFMA32(pa1, PK(1), o[d0]); o[d0] = MFMA32(pa2, PK(2), o[d0]); o[d0] = MFMA32(pa3, PK(3), o[d0]);
    #undef PK
  }
}
#define ATTN_STORE16(p, v) (*(u32x4*)(p) = (v))

__device__ __forceinline__ void moba_unit(int b, int h, int qb, const bf16* Q, const bf16* __restrict__ K, const bf16* __restrict__ V, bf16* O, const float* __restrict__ ksum, char* shm) {
  const int tid = threadIdx.x, lane = tid & 63, r32 = lane & 31, hi = lane >> 5; const int wid = __builtin_amdgcn_readfirstlane(tid >> 6);
  const long rowbase = (long)b * 4096; const int q0 = qb * QB;
  const bf16* Qw = Q + (rowbase + q0 + wid * QBLK) * DM + h * 64;
  const bf16* Kh = K + rowbase * DM + h * 64, *Vh = V + rowbase * DM + h * 64;
  const unsigned lds0 = (unsigned)(uintptr_t)shm;
  float* wsf = (float*)(shm + LDS_WS) + wid * 64;
  const lds_cptr shm3 = (lds_cptr)shm;
  if (tid < 128) { const int j = tid >> 3, c = tid & 7; f32x4v a = {0.f, 0.f, 0.f, 0.f}, bq = {0.f, 0.f, 0.f, 0.f};
    if (j < qb) { const f32x4v* kp = (const f32x4v*)(ksum + ((size_t)(b * 16 + j) * 8 + h) * 64 + c * 8); a = kp[0]; bq = kp[1]; }
    const float v[8] = {a[0], a[1], a[2], a[3], bq[0], bq[1], bq[2], bq[3]}; unsigned hw[4], lw[4];
    #pragma unroll
    for (int i = 0; i < 4; ++i) { const unsigned hp = cvtpk_s(v[2 * i], v[2 * i + 1]); const float r0 = v[2 * i] - __uint_as_float(hp << 16), r1 = v[2 * i + 1] - __uint_as_float(hp & 0xffff0000u); hw[i] = hp; lw[i] = cvtpk_s(r0, r1); }
    *(__attribute__((address_space(3))) u32x4*)(shm3 + LDS_OST + c * 1024 + j * 16) = (u32x4){hw[0], hw[1], hw[2], hw[3]};
    *(__attribute__((address_space(3))) u32x4*)(shm3 + LDS_OST + 8192 + c * 1024 + j * 16) = (u32x4){lw[0], lw[1], lw[2], lw[3]}; }
  asm volatile("s_waitcnt vmcnt(0)" ::: "memory");
  const bf16* ksrc = Kh + (long)lane * DM + wid * 8;
  const bf16* vsrc = Vh + (long)(16 * (wid & 3) + (lane >> 2)) * DM + (wid >> 2) * 32 + (lane & 3) * 8;
  const unsigned kdst = lds0 + LDS_K + wid * 1024, vdst = lds0 + LDS_V + wid * 1024;
  #define DMA_K(t, slot) glds16(ksrc + (long)(t) * KVBLK * DM, (unsigned)__builtin_amdgcn_readfirstlane(kdst + (slot)))
  #define DMA_V(t, slot) glds16(vsrc + (long)(t) * KVBLK * DM, (unsigned)__builtin_amdgcn_readfirstlane(vdst + (slot)))
  const int vb0 = (int)(lds0 + LDS_V) + ((lane >> 4) & 1) * 32 + (lane & 3) * 8 + (4 * hi + ((lane & 15) >> 2)) * 64;
  bf16x8 kf[8];
  const lds_cptr kp0 = shm3 + LDS_K + hi * 1024 + r32 * 16; const lds_cptr vp0 = shm3 + LDS_V + ((lane >> 4) & 1) * 32 + (lane & 3) * 8 + (4 * hi + ((lane & 15) >> 2)) * 64;
  const int NT = (q0 + QB) / KVBLK;
  DMA_K(0, 0); DMA_V(0, 0); DMA_K(1, SLOTB);
  bf16x8 qr[4];
  #pragma unroll
  for (int d0 = 0; d0 < 4; ++d0) qr[d0] = *reinterpret_cast<const bf16x8*>(&Qw[(long)r32 * DM + d0 * 16 + hi * 8]);
  float l_reg = 0.f; f32x16 o[2]; o[0] = f32x16{}; o[1] = f32x16{};
  const int tq = q0 + wid * QBLK + r32, acp = (REV - tq) & 3;
  const int cbase = LDS_BT + acp * COPYB; int baddr = cbase + 4 * (REV - tq + 4 * hi - acp);
  DMA_K(2, 2 * SLOTB);
  WAIT_BAR(3);
  unsigned selmask;
  { f32x16 ga = f32x16{};
    #pragma unroll
    for (int d0 = 0; d0 < 4; ++d0) { const bf16x8 ah = *(const __attribute__((address_space(3))) bf16x8*)(shm3 + LDS_OST + hi * 1024 + r32 * 16 + d0 * 2048);
      const bf16x8 al = *(const __attribute__((address_space(3))) bf16x8*)(shm3 + LDS_OST + 8192 + hi * 1024 + r32 * 16 + d0 * 2048);
      ga = MFMA32(ah, qr[d0], ga); ga = MFMA32(al, qr[d0], ga); }
    float G[16];
    #pragma unroll
    for (int r = 0; r < 8; ++r) { auto rr = __builtin_amdgcn_permlane32_swap(__float_as_uint(ga[r]), __float_as_uint(ga[r]), false, false);
      G[(r & 3) + 8 * (r >> 2)] = __uint_as_float(rr[0]); G[(r & 3) + 8 * (r >> 2) + 4] = __uint_as_float(rr[1]); }
    #pragma unroll
    for (int j = 0; j < 16; ++j) if (j >= qb) G[j] = -INFINITY;
    selmask = 1u << qb;
    #pragma unroll
    for (int pass = 0; pass < 3; ++pass) { float best = -INFINITY; int bi = 16;
      #pragma unroll
      for (int j = 0; j < 16; ++j) if (G[j] > best) { best = G[j]; bi = j; }
      if (bi < 16) selmask |= 1u << bi;
      #pragma unroll
      for (int j = 0; j < 16; ++j) if (j == bi) G[j] = -INFINITY; }
  }
  f32x16 pA0, pA1, pB0, pB1;
  #define BEFF(T) (((selmask >> ((T) >> 2)) & 1u) ? (baddr + 256 * (T) > cbase ? baddr + 256 * (T) : cbase) : (LDS_BT + NEG_OFF))
  #define BRD1(X0, X1, eff, i) do { const f32x4v bv_ = ldsf4(shm3 + (eff) + ((i) < 4 ? 32 * (i) : 128 + 32 * ((i) - 4))); \
      if ((i) < 4) { X0[4 * (i)] = bv_[0]; X0[4 * (i) + 1] = bv_[1]; X0[4 * (i) + 2] = bv_[2]; X0[4 * (i) + 3] = bv_[3]; } \
      else { X1[4 * ((i) - 4)] = bv_[0]; X1[4 * ((i) - 4) + 1] = bv_[1]; X1[4 * ((i) - 4) + 2] = bv_[2]; X1[4 * ((i) - 4) + 3] = bv_[3]; } } while (0)
  { const int e0 = BEFF(0);
    #pragma unroll
    for (int i = 0; i < 8; ++i) BRD1(pA0, pA1, e0, i); }
  int sl_prev = 0, sl_cur = 0, sl_next = SLOTB;
  #define ROT() do { sl_prev = sl_cur; sl_cur = sl_next; sl_next = (sl_next == (NSLOT - 1) * SLOTB) ? 0 : sl_next + SLOTB; } while (0)
  { const char* kb = shm + LDS_K + hi * 1024 + r32 * 16;
    #pragma unroll
    for (int d0 = 0; d0 < 4; ++d0) { const bf16x8 b0 = *reinterpret_cast<const bf16x8*>(kb + d0 * 2048); const bf16x8 b1 = *reinterpret_cast<const bf16x8*>(kb + d0 * 2048 + 512);
      pA0 = MFMA32(b0, qr[d0], pA0); pA1 = MFMA32(b1, qr[d0], pA1); } }
  #pragma unroll
  for (int r = 0; r < 16; ++r) { pA0[r] = __builtin_amdgcn_exp2f(pA0[r]); pA1[r] = __builtin_amdgcn_exp2f(pA1[r]); }
  { const int e1 = BEFF(1);
    #pragma unroll
    for (int i = 0; i < 8; ++i) BRD1(pB0, pB1, e1, i); }
  WAIT_BAR(0);
  DMA_K(3, 0); DMA_V(1, SLOTB);
  ROT();
  kload8(kf, kp0 + sl_cur);
  WAIT_BAR(2);
  s16x4 vlo[8], vhi[8]; u32x4 pw0, pw1, pw2, pw3;
  #define PKW(P, B) cvtpk_s(P[B], P[B + 1])
  #define PAF(k) __builtin_bit_cast(bf16x8, pw##k)
  #define VFR(i) (bf16x8){vlo[i][0], vlo[i][1], vlo[i][2], vlo[i][3], vhi[i][0], vhi[i][1], vhi[i][2], vhi[i][3]}
  #define PIN(x) asm volatile("" : "+v"(x))
  #define GAPA(MF, A0, A1, A2, A3, W0, W1, PW) do { MF; sacc += A0; sacc += A1; sacc += A2; sacc += A3; PIN(sacc); W0; W1; PIN(PW); SBAR(); } while (0)
  #define EX(v) __builtin_amdgcn_exp2f(v)
  #define GAPB(MF, X, B) do { MF; X[B] = EX(X[B]); X[B + 1] = EX(X[B + 1]); X[B + 2] = EX(X[B + 2]); X[B + 3] = EX(X[B + 3]); PIN(X); SBAR(); } while (0)
  #define VRD(i) do { vlo[i] = vtr(vp_ + (((i) >> 2) * 4096 + ((i) & 3) * 1024)); vhi[i] = vtr(vp_ + (((i) >> 2) * 4096 + ((i) & 3) * 1024 + 512)); } while (0)
  #define KRD(G, j) do { if (G) { kload2(kf, kp0 + sl_next, j); SBAR(); } } while (0)
  #define BRD(G, i, X0, X1) do { if (G) { BRD1(X0, X1, eff_, i); } } while (0)
  #define STEP(C0, C1, P0, P1, t, GK, GV, GL) do { SBAR(); \
    const lds_cptr vp_ = vp0 + sl_prev; \
    VRD(0); SBAR(); float sacc = (P0[0] + P0[1]); \
    GAPA(C0 = MFMA32(kf[0], qr[0], C0), P0[2], P0[3], P0[4], P0[5],     pw0[0] = PKW(P0, 0), pw0[1] = PKW(P0, 2), pw0); \
    VRD(4); SBAR(); GAPA(C1 = MFMA32(kf[1], qr[0], C1), P0[6], P0[7], P0[8], P0[9],     pw0[2] = PKW(P0, 4), pw0[3] = PKW(P0, 6), pw0); \
    VRD(1); SBAR(); GAPA(C0 = MFMA32(kf[2], qr[1], C0),   P0[10], P0[11], P0[12], P0[13], pw1[0] = PKW(P0, 8), pw1[1] = PKW(P0, 10), pw1); \
    VRD(5); SBAR(); GAPA(C1 = MFMA32(kf[3], qr[1], C1),   P0[14], P0[15], P1[0], P1[1],   pw1[2] = PKW(P0, 12), pw1[3] = PKW(P0, 14), pw1); \
    VRD(2); SBAR(); GAPA(C0 = MFMA32(kf[4], qr[2], C0),   P1[2], P1[3], P1[4], P1[5],     pw2[0] = PKW(P1, 0), pw2[1] = PKW(P1, 2), pw2); \
    VRD(6); SBAR(); GAPA(C1 = MFMA32(kf[5], qr[2], C1),   P1[6], P1[7], P1[8], P1[9],     pw2[2] = PKW(P1, 4), pw2[3] = PKW(P1, 6), pw2); \
    VRD(3); SBAR(); GAPA(C0 = MFMA32(kf[6], qr[3], C0),   P1[10], P1[11], P1[12], P1[13], pw3[0] = PKW(P1, 8), pw3[1] = PKW(P1, 10), pw3); \
    VRD(7); SBAR(); GAPA(C1 = MFMA32(kf[7], qr[3], C1),   P1[14], P1[15], 0.f, 0.f,       pw3[2] = PKW(P1, 12), pw3[3] = PKW(P1, 14), pw3); \
    l_reg += sacc; \
    if (GK) { DMA_K((t) + 3, sl_cur); } if (GV) { DMA_V((t) + 1, sl_next); } \
    const int eff_ = BEFF((t) + 1); \
    SBAR(); \
    BRD(GL, 0, P0, P1); GAPB(o[0] = MFMA32(PAF(0), VFR(0), o[0]), C0, 0); \
    BRD(GL, 1, P0, P1); GAPB(o[1] = MFMA32(PAF(0), VFR(4), o[1]), C0, 4); \
    BRD(GL, 2, P0, P1); KRD(GL, 0); GAPB(o[0] = MFMA32(PAF(1), VFR(1), o[0]), C0, 8); \
    BRD(GL, 3, P0, P1); KRD(GL, 1); GAPB(o[1] = MFMA32(PAF(1), VFR(5), o[1]), C0, 12); \
    BRD(GL, 4, P0, P1); KRD(GL, 2); GAPB(o[0] = MFMA32(PAF(2), VFR(2), o[0]), C1, 0); \
    BRD(GL, 5, P0, P1); KRD(GL, 3); GAPB(o[1] = MFMA32(PAF(2), VFR(6), o[1]), C1, 4); \
    BRD(GL, 6, P0, P1); GAPB(o[0] = MFMA32(PAF(3), VFR(3), o[0]), C1, 8); \
    BRD(GL, 7, P0, P1); GAPB(o[1] = MFMA32(PAF(3), VFR(7), o[1]), C1, 12); \
    } while (0)
  int t = 1;
  for (; t + 5 < NT; t += 2) {
    STEP(pB0, pB1, pA0, pA1, t, true, true, true);     WAIT_BAR(2); ROT();
    STEP(pA0, pA1, pB0, pB1, t + 1, true, true, true); WAIT_BAR(2); ROT();
  }
  #define ENDW(tt) do { if ((tt) + 3 < NT) { WAIT_BAR(2); } else if ((tt) + 2 < NT) { WAIT_BAR(1); } else { WAIT_BAR(0); } } while (0)
  for (; t + 1 < NT; t += 2) {
    STEP(pB0, pB1, pA0, pA1, t, (t + 3 < NT), (t + 1 < NT), (t + 1 < NT));       ENDW(t);     ROT();
    STEP(pA0, pA1, pB0, pB1, t + 1, (t + 4 < NT), (t + 2 < NT), (t + 2 < NT));   ENDW(t + 1); ROT();
  }
  STEP(pB0, pB1, pA0, pA1, NT - 1, false, false, false);
  { float sacc = pB0[0] + pB0[1];
    #pragma unroll
    for (int r = 2; r < 16; ++r) sacc += pB0[r];
    #pragma unroll
    for (int r = 0; r < 16; ++r) sacc += pB1[r];
    l_reg += sacc;
    pw0 = (u32x4){PKW(pB0, 0), PKW(pB0, 2), PKW(pB0, 4), PKW(pB0, 6)}; pw1 = (u32x4){PKW(pB0, 8), PKW(pB0, 10), PKW(pB0, 12), PKW(pB0, 14)};
    pw2 = (u32x4){PKW(pB1, 0), PKW(pB1, 2), PKW(pB1, 4), PKW(pB1, 6)}; pw3 = (u32x4){PKW(pB1, 8), PKW(pB1, 10), PKW(pB1, 12), PKW(pB1, 14)};
    SBAR(); pv(o, vb0 + sl_cur, PAF(0), PAF(1), PAF(2), PAF(3)); }
  #undef STEP
  #undef BRD
  #undef KRD
  #undef VRD
  #undef GAPB
  #undef GAPA
  { auto rr = __builtin_amdgcn_permlane32_swap(__float_as_uint(l_reg), __float_as_uint(l_reg), false, false); l_reg = __uint_as_float(rr[0]) + __uint_as_float(rr[1]); }
  if (hi == 0) wsf[32 + r32] = l_reg; asm volatile("s_waitcnt lgkmcnt(0)" ::: "memory");
  float rli[16];
  #pragma unroll
  for (int r = 0; r < 16; ++r) rli[r] = __builtin_amdgcn_rcpf(wsf[32 + crow(r, hi)]);
  bf16* Ow = O + (rowbase + q0 + wid * QBLK) * DM + h * 64;
  { bf16* stg = (bf16*)(shm + LDS_OST) + wid * 2048;
    #pragma unroll
    for (int r = 0; r < 16; ++r) { const int orow = crow(r, hi);
      #pragma unroll
      for (int d0 = 0; d0 < 2; ++d0) stg[orow * 64 + d0 * 32 + r32] = (bf16)(cvtpk_s(o[d0][r] * rli[r], 0.f) & 0xffffu); }
    asm volatile("s_waitcnt lgkmcnt(0)" ::: "memory");
    #pragma unroll
    for (int i = 0; i < 4; ++i) { const int row = i * 8 + (lane >> 3), ch = lane & 7; const u32x4 v = *(const u32x4*)(stg + row * 64 + ch * 8); ATTN_STORE16(Ow + (long)row * DM + ch * 8, v); } }
  asm volatile("s_waitcnt lgkmcnt(0)\n\ts_barrier" ::: "memory");
  #undef DMA_K
  #undef DMA_V
  #undef ROT
  #undef BEFF
  #undef BRD1
  #undef ENDW
  #undef PKW
  #undef PAF
  #undef VFR
  #undef PIN
  #undef EX
}

__device__ __forceinline__ void sb_unit(int b, int h, int qb, const bf16* Q, const bf16* __restrict__ K, const bf16* __restrict__ V, bf16* O, char* shm) {
  const int tid = threadIdx.x, lane = tid & 63, r32 = lane & 31, hi = lane >> 5; const int wid = __builtin_amdgcn_readfirstlane(tid >> 6);
  const long rowbase = (long)b * 4096; const int q0 = qb * QB;
  const bf16* Qw = Q + (rowbase + q0 + wid * QBLK) * DM + h * 64;
  const bf16* Kh = K + rowbase * DM + h * 64, *Vh = V + rowbase * DM + h * 64;
  const unsigned lds0 = (unsigned)(uintptr_t)shm;
  const lds_cptr shm3 = (lds_cptr)shm;
  const bf16* ksrc = Kh + (long)lane * DM + wid * 8;
  const bf16* vsrc = Vh + (long)(16 * (wid & 3) + (lane >> 2)) * DM + (wid >> 2) * 32 + (lane & 3) * 8;
  const unsigned kdst = lds0 + LDS_K + wid * 1024, vdst = lds0 + LDS_V + wid * 1024;
  const int NT = (q0 + QB) / KVBLK;
  #define TT(u) (NT - 1 - (u))
  #define DMA_K(u, slot) glds16(ksrc + (long)TT(u) * KVBLK * DM, (unsigned)__builtin_amdgcn_readfirstlane(kdst + (slot)))
  #define DMA_V(u, slot) glds16(vsrc + (long)TT(u) * KVBLK * DM, (unsigned)__builtin_amdgcn_readfirstlane(vdst + (slot)))
  const int vb0 = (int)(lds0 + LDS_V) + ((lane >> 4) & 1) * 32 + (lane & 3) * 8 + (4 * hi + ((lane & 15) >> 2)) * 64;
  bf16x8 kf[8];
  const lds_cptr kp0 = shm3 + LDS_K + hi * 1024 + r32 * 16; const lds_cptr vp0 = shm3 + LDS_V + ((lane >> 4) & 1) * 32 + (lane & 3) * 8 + (4 * hi + ((lane & 15) >> 2)) * 64;
  DMA_K(0, 0); DMA_V(0, 0); DMA_K(1, SLOTB);
  bf16x8 qr[4];
  #pragma unroll
  for (int d0 = 0; d0 < 4; ++d0) qr[d0] = *reinterpret_cast<const bf16x8*>(&Qw[(long)r32 * DM + d0 * 16 + hi * 8]);
  f32x16 o[2]; o[0] = f32x16{}; o[1] = f32x16{};
  const int tq = q0 + wid * QBLK + r32;
  const f32x16 zero16 = f32x16{};
  DMA_K(2, 2 * SLOTB);
  WAIT_BAR(3);
  f32x16 pA0, pA1, pB0, pB1;
  float cc = 1.0f, pf[8], rD0, rD1, G[8];
  const bool hib = hi != 0;
  #define CMASK(X0, X1, T) do { const int lim_ = tq - 64 * (T) - 4 * hi; \
      _Pragma("unroll") for (int r_ = 0; r_ < 16; ++r_) { const int kq_ = (r_ & 3) + 8 * (r_ >> 2); if (kq_ >= lim_) X0[r_] = -INFINITY; if (kq_ + 32 >= lim_) X1[r_] = -INFINITY; } } while (0)
  #define EX(v) __builtin_amdgcn_exp2f(v)
  #define PIN(x) asm volatile("" : "+v"(x))
  #define EXPG(X, B, k) do { X[B] = EX(X[B]); X[B + 1] = EX(X[B + 1]); X[B + 2] = EX(X[B + 2]); X[B + 3] = EX(X[B + 3]); \
      float g_ = 1.0f + X[B]; g_ = __builtin_fmaf(g_, X[B + 1], g_); g_ = __builtin_fmaf(g_, X[B + 2], g_); g_ = __builtin_fmaf(g_, X[B + 3], g_); G[k] = g_; } while (0)
  #define TAIL() do { float Gp_[8], W_[8]; \
      _Pragma("unroll") for (int k_ = 0; k_ < 8; ++k_) { auto rr_ = __builtin_amdgcn_permlane32_swap(__float_as_uint(G[k_]), __float_as_uint(G[k_]), false, false); \
          const float lo_ = __uint_as_float(rr_[0]), hi_ = __uint_as_float(rr_[1]); W_[k_] = lo_ * hi_; Gp_[k_] = hib ? lo_ : 1.0f; } \
      { const float p1_ = W_[0], p2_ = p1_ * W_[1], p3_ = p2_ * W_[2]; rD0 = __builtin_amdgcn_rcpf(p3_ * W_[3]); pf[0] = Gp_[0]; pf[1] = p1_ * Gp_[1]; pf[2] = p2_ * Gp_[2]; pf[3] = p3_ * Gp_[3]; } \
      { const float p1_ = W_[4], p2_ = p1_ * W_[5], p3_ = p2_ * W_[6]; rD1 = __builtin_amdgcn_rcpf(p3_ * W_[7]); pf[4] = Gp_[4]; pf[5] = p1_ * Gp_[5]; pf[6] = p2_ * Gp_[6]; pf[7] = p3_ * Gp_[7]; } } while (0)
  #define SCAN(X, B, k, cx) do { float u_ = (cx) * pf[k]; const float a0_ = u_ * X[B]; u_ += a0_; const float a1_ = u_ * X[B + 1]; u_ += a1_; const float a2_ = u_ * X[B + 2]; u_ += a2_; const float a3_ = u_ * X[B + 3]; \
      X[B] = a0_; X[B + 1] = a1_; X[B + 2] = a2_; X[B + 3] = a3_; } while (0)
  pA0 = zero16; pA1 = zero16;
  int sl_prev = 0, sl_cur = 0, sl_next = SLOTB;
  #define ROT() do { sl_prev = sl_cur; sl_cur = sl_next; sl_next = (sl_next == (NSLOT - 1) * SLOTB) ? 0 : sl_next + SLOTB; } while (0)
  { const char* kb = shm + LDS_K + hi * 1024 + r32 * 16;
    #pragma unroll
    for (int d0 = 0; d0 < 4; ++d0) { const bf16x8 b0 = *reinterpret_cast<const bf16x8*>(kb + d0 * 2048); const bf16x8 b1 = *reinterpret_cast<const bf16x8*>(kb + d0 * 2048 + 512);
      pA0 = MFMA32(b0, qr[d0], pA0); pA1 = MFMA32(b1, qr[d0], pA1); } }
  CMASK(pA0, pA1, TT(0));
  EXPG(pA0, 0, 0); EXPG(pA0, 4, 1); EXPG(pA0, 8, 2); EXPG(pA0, 12, 3); EXPG(pA1, 0, 4); EXPG(pA1, 4, 5); EXPG(pA1, 8, 6); EXPG(pA1, 12, 7); TAIL();
  WAIT_BAR(0);
  DMA_K(3, 0); DMA_V(1, SLOTB);
  ROT();
  kload8(kf, kp0 + sl_cur);
  WAIT_BAR(2);
  s16x4 vlo[8], vhi[8]; u32x4 pw0, pw1, pw2, pw3;
  #define PKW(P, B) cvtpk_s(P[B], P[B + 1])
  #define PAF(k) __builtin_bit_cast(bf16x8, pw##k)
  #define VFR(i) (bf16x8){vlo[i][0], vlo[i][1], vlo[i][2], vlo[i][3], vhi[i][0], vhi[i][1], vhi[i][2], vhi[i][3]}
  #define GAPA(MF, SC, W0, W1, PW) do { MF; SC; W0; W1; PIN(PW); SBAR(); } while (0)
  #define GAPB(MF, X, B, k) do { MF; EXPG(X, B, k); PIN(X); PIN(G[k]); SBAR(); } while (0)
  #define VRD(i) do { vlo[i] = vtr(vp_ + (((i) >> 2) * 4096 + ((i) & 3) * 1024)); vhi[i] = vtr(vp_ + (((i) >> 2) * 4096 + ((i) & 3) * 1024 + 512)); } while (0)
  #define KRD(Gd, j) do { if (Gd) { kload2(kf, kp0 + sl_next, j); SBAR(); } } while (0)
  #define STEP(C0, C1, P0, P1, u, GK, GV, GL) do { SBAR(); \
    const lds_cptr vp_ = vp0 + sl_prev; \
    const float cm_ = cc * rD1, co_ = cm_ * rD0; \
    VRD(0); SBAR(); \
    GAPA(C0 = MFMA32(kf[0], qr[0], zero16), SCAN(P0, 0, 0, co_),  pw0[0] = PKW(P0, 0), pw0[1] = PKW(P0, 2), pw0); \
    VRD(4); SBAR(); GAPA(C1 = MFMA32(kf[1], qr[0], zero16), SCAN(P0, 4, 1, co_),  pw0[2] = PKW(P0, 4), pw0[3] = PKW(P0, 6), pw0); \
    VRD(1); SBAR(); GAPA(C0 = MFMA32(kf[2], qr[1], C0), SCAN(P0, 8, 2, co_),  pw1[0] = PKW(P0, 8), pw1[1] = PKW(P0, 10), pw1); \
    VRD(5); SBAR(); GAPA(C1 = MFMA32(kf[3], qr[1], C1), SCAN(P0, 12, 3, co_), pw1[2] = PKW(P0, 12), pw1[3] = PKW(P0, 14), pw1); \
    VRD(2); SBAR(); GAPA(C0 = MFMA32(kf[4], qr[2], C0), SCAN(P1, 0, 4, cm_),  pw2[0] = PKW(P1, 0), pw2[1] = PKW(P1, 2), pw2); \
    VRD(6); SBAR(); GAPA(C1 = MFMA32(kf[5], qr[2], C1), SCAN(P1, 4, 5, cm_),  pw2[2] = PKW(P1, 4), pw2[3] = PKW(P1, 6), pw2); \
    VRD(3); SBAR(); GAPA(C0 = MFMA32(kf[6], qr[3], C0), SCAN(P1, 8, 6, cm_),  pw3[0] = PKW(P1, 8), pw3[1] = PKW(P1, 10), pw3); \
    VRD(7); SBAR(); GAPA(C1 = MFMA32(kf[7], qr[3], C1), SCAN(P1, 12, 7, cm_), pw3[2] = PKW(P1, 12), pw3[3] = PKW(P1, 14), pw3); \
    cc = co_; \
    if (GK) { DMA_K((u) + 3, sl_cur); } if (GV) { DMA_V((u) + 1, sl_next); } \
    if ((u) < 4) { CMASK(C0, C1, TT(u)); } \
    SBAR(); \
    GAPB(o[0] = MFMA32(PAF(0), VFR(0), o[0]), C0, 0, 0); \
    GAPB(o[1] = MFMA32(PAF(0), VFR(4), o[1]), C0, 4, 1); \
    KRD(GL, 0); GAPB(o[0] = MFMA32(PAF(1), VFR(1), o[0]), C0, 8, 2); \
    KRD(GL, 1); GAPB(o[1] = MFMA32(PAF(1), VFR(5), o[1]), C0, 12, 3); \
    KRD(GL, 2); GAPB(o[0] = MFMA32(PAF(2), VFR(2), o[0]), C1, 0, 4); \
    KRD(GL, 3); GAPB(o[1] = MFMA32(PAF(2), VFR(6), o[1]), C1, 4, 5); \
    GAPB(o[0] = MFMA32(PAF(3), VFR(3), o[0]), C1, 8, 6); \
    GAPB(o[1] = MFMA32(PAF(3), VFR(7), o[1]), C1, 12, 7); \
    TAIL(); SBAR(); \
    } while (0)
  int t = 1;
  for (; t + 5 < NT; t += 2) {
    STEP(pB0, pB1, pA0, pA1, t, true, true, true);     WAIT_BAR(2); ROT();
    STEP(pA0, pA1, pB0, pB1, t + 1, true, true, true); WAIT_BAR(2); ROT();
  }
  #define ENDW(tt) do { if ((tt) + 3 < NT) { WAIT_BAR(2); } else if ((tt) + 2 < NT) { WAIT_BAR(1); } else { WAIT_BAR(0); } } while (0)
  for (; t + 1 < NT; t += 2) {
    STEP(pB0, pB1, pA0, pA1, t, (t + 3 < NT), (t + 1 < NT), (t + 1 < NT));       ENDW(t);     ROT();
    STEP(pA0, pA1, pB0, pB1, t + 1, (t + 4 < NT), (t + 2 < NT), (t + 2 < NT));   ENDW(t + 1); ROT();
  }
  STEP(pB0, pB1, pA0, pA1, NT - 1, false, false, false);
  { const float cm_ = cc * rD1, co_ = cm_ * rD0;
    SCAN(pB0, 0, 0, co_); SCAN(pB0, 4, 1, co_); SCAN(pB0, 8, 2, co_); SCAN(pB0, 12, 3, co_); SCAN(pB1, 0, 4, cm_); SCAN(pB1, 4, 5, cm_); SCAN(pB1, 8, 6, cm_); SCAN(pB1, 12, 7, cm_);
    pw0 = (u32x4){PKW(pB0, 0), PKW(pB0, 2), PKW(pB0, 4), PKW(pB0, 6)}; pw1 = (u32x4){PKW(pB0, 8), PKW(pB0, 10), PKW(pB0, 12), PKW(pB0, 14)};
    pw2 = (u32x4){PKW(pB1, 0), PKW(pB1, 2), PKW(pB1, 4), PKW(pB1, 6)}; pw3 = (u32x4){PKW(pB1, 8), PKW(pB1, 10), PKW(pB1, 12), PKW(pB1, 14)};
    SBAR(); pv(o, vb0 + sl_cur, PAF(0), PAF(1), PAF(2), PAF(3)); }
  bf16* Ow = O + (rowbase + q0 + wid * QBLK) * DM + h * 64;
  { bf16* stg = (bf16*)(shm + LDS_OST) + wid * 2048;
    #pragma unroll
    for (int r = 0; r < 16; ++r) { const int orow = crow(r, hi);
      #pragma unroll
      for (int d0 = 0; d0 < 2; ++d0) stg[orow * 64 + d0 * 32 + r32] = (bf16)(cvtpk_s(o[d0][r], 0.f) & 0xffffu); }
    asm volatile("s_waitcnt lgkmcnt(0)" ::: "memory");
    #pragma unroll
    for (int i = 0; i < 4; ++i) { const int row = i * 8 + (lane >> 3), ch = lane & 7; const u32x4 v = *(const u32x4*)(stg + row * 64 + ch * 8); ATTN_STORE16(Ow + (long)row * DM + ch * 8, v); } }
  asm volatile("s_waitcnt lgkmcnt(0)\n\ts_barrier" ::: "memory");
  #undef STEP
  #undef KRD
  #undef VRD
  #undef GAPB
  #undef GAPA
  #undef DMA_K
  #undef DMA_V
  #undef ROT
  #undef CMASK
  #undef ENDW
  #undef PKW
  #undef PAF
  #undef VFR
  #undef PIN
  #undef EX
  #undef EXPG
  #undef TAIL
  #undef SCAN
  #undef TT
}
}
struct Frame {
    LAS unsigned char* lds;
    volatile LAS unsigned* MISC;
    gu32* ctl;
    int tid, lane, wave;
    int vcu, G;
    const float *x, *c, *w_ada, *b_ada, *g_mix, *w_in, *g_q, *g_k, *rel_bias, *w_br_moba, *w_br_sb, *w_out, *g_ffn, *w_rg, *b_rg, *w_re, *b_re, *w_gate, *w_up, *w_down;
    float* out;
    float *mod, *biasT, *btg, *stats, *kmean;
    bf16 *Win_t, *Wbra_t, *Wbrb_t, *Wout_t, *Wgu_t, *Wd_t;
    bf16 *XN, *QA, *KA, *VA, *QB, *KB, *VB, *GA, *GB, *H;
    int* tokl; float* wl; unsigned* cnt;
};
__device__ __forceinline__ float wave_sum(float v) {
#pragma unroll
    for (int o = 1; o < 64; o <<= 1) v += __shfl_xor(v, o);
    return v;
}
__device__ __forceinline__ int lane_zero() { int z; asm volatile("v_mov_b32 %0, 0" : "=v"(z)); return z; }

__device__ __forceinline__ void p0_transpose_item(const float* W, int K, int N, bf16* WT, int k0, int n0, int drow0, LAS float* scr, int lane) {
#pragma unroll 8
    for (int i = 0; i < 32; ++i) { const int kk = 2 * i + (lane >> 5); scr[kk * 33 + (lane & 31)] = W[(size_t)(k0 + kk) * N + n0 + (lane & 31)]; }
    LDS_WAIT(); asm volatile("" ::: "memory");
    const int c = lane & 7;
#pragma unroll
    for (int j = 0; j < 4; ++j) { const int n = (lane >> 3) + 8 * j; const LAS float* s = scr + (8 * c) * 33 + n;
        v4u o; o.x = pk2(s[0 * 33], s[1 * 33]); o.y = pk2(s[2 * 33], s[3 * 33]); o.z = pk2(s[4 * 33], s[5 * 33]); o.w = pk2(s[6 * 33], s[7 * 33]);
        *(GAS v4u*)(WT + (size_t)(drow0 + n) * K + k0 + 8 * c) = o; }
    LDS_WAIT(); asm volatile("" ::: "memory");
}

__device__ __forceinline__ void p0_prologue(Frame& F) {
    {
        LAS float* sc = (LAS float*)(F.lds + RING_OFF);
        LAS float* part = (LAS float*)(F.lds + RING_OFF + 32768);
        for (int i = F.tid; i < BATCH * D; i += NWAVES * 64) { const float v = F.c[i]; sc[i] = v * fsigmoid(v); }
        __syncthreads();
        for (int chunk = F.vcu; chunk < 256; chunk += F.G) {
            const int kp = F.tid / 24, cI = F.tid % 24;
            if (kp < 21) {
                float a[8];
#pragma unroll
                for (int b = 0; b < 8; ++b) a[b] = 0.f;
                const int k0 = kp * 49, k1 = (k0 + 49 < D) ? k0 + 49 : D;
                for (int k = k0; k < k1; ++k) { const float w = F.w_ada[(size_t)k * (NMOD * D) + chunk * 24 + cI];
#pragma unroll
                    for (int b = 0; b < 8; ++b) a[b] += sc[b * D + k] * w; }
#pragma unroll
                for (int b = 0; b < 8; ++b) part[(kp * 24 + cI) * 8 + b] = a[b];
            }
            __syncthreads();
            if (F.tid < 192) { const int cI2 = F.tid % 24, b = F.tid / 24; float s = 0.f;
                for (int kp2 = 0; kp2 < 21; ++kp2) s += part[(kp2 * 24 + cI2) * 8 + b];
                const int col = chunk * 24 + cI2; F.mod[(size_t)b * (NMOD * D) + col] = s + F.b_ada[col]; }
            __syncthreads();
        }
    }
    const int gw = F.vcu * NWAVES + F.wave, NGW = F.G * NWAVES;
    for (int i = gw * 64 + F.lane; i < NH * SEQ; i += NGW * 64) { const int h = i / SEQ, n = i % SEQ; int bk;
        if (n < 16) bk = n; else { const float nf = (float)n; int lg = 16 + (int)(logf(nf / 16.0f) / 4.1588830833596715f * 16.0f); bk = lg < 31 ? lg : 31; }
        F.biasT[i] = F.rel_bias[h * 32 + bk] * LOG2E; }
    for (int i = gw * 64 + F.lane; i < (NH + 1) * (attn::BT_BYTES / 4); i += NGW * 64) { const int h = i / (attn::BT_BYTES / 4), w = i % (attn::BT_BYTES / 4); float val = -INFINITY;
        if (w < 4 * attn::BT_LEN) { const int a = w / attn::BT_LEN, xx = w % attn::BT_LEN, ri = xx + a;
            if (h == NH) { if (ri < attn::REV) val = 0.f; }
            else if (ri <= attn::REV) { const int n = attn::REV - ri; int bk; if (n < 16) bk = n; else { const float nf = (float)n; int lg = 16 + (int)(logf(nf / 16.0f) / 4.1588830833596715f * 16.0f); bk = lg < 31 ? lg : 31; }
                val = F.rel_bias[h * 32 + bk] * LOG2E; } }
        F.btg[i] = val; }
    LAS float* scr = (LAS float*)(F.lds + RING_OFF + F.wave * 16384);
    constexpr int I_IN = (D / 64) * (INCOLS / 32), I_BR = (WATT / 64) * (D / 32), I_OUT = (D / 64) * (D / 32), I_G = NEXP * (D / 64) * (DEXP / 32), I_D = NEXP * (DEXP / 64) * (D / 32);
    constexpr int NITEMS = I_IN + 2 * I_BR + I_OUT + 2 * I_G + I_D;
    for (int it = gw; it < NITEMS; it += NGW) {
        int r = it;
        if (r < I_IN) { const int nblk = INCOLS / 32, kb = r / nblk, nb = r % nblk, n0 = 32 * nb, t = n0 & 255;
            const int p0 = 128 * ((t >> 5) & 1) + 32 * (t >> 6);
            p0_transpose_item(F.w_in, D, INCOLS, F.Win_t, 64 * kb, n0, (n0 - t) + p0, scr, F.lane); continue; } r -= I_IN;
        if (r < I_BR) { const int nblk = D / 32, kb = r / nblk, nb = r % nblk; p0_transpose_item(F.w_br_moba, WATT, D, F.Wbra_t, 64 * kb, 32 * nb, 32 * nb, scr, F.lane); continue; } r -= I_BR;
        if (r < I_BR) { const int nblk = D / 32, kb = r / nblk, nb = r % nblk; p0_transpose_item(F.w_br_sb, WATT, D, F.Wbrb_t, 64 * kb, 32 * nb, 32 * nb, scr, F.lane); continue; } r -= I_BR;
        if (r < I_OUT) { const int nblk = D / 32, kb = r / nblk, nb = r % nblk; p0_transpose_item(F.w_out, D, D, F.Wout_t, 64 * kb, 32 * nb, 32 * nb, scr, F.lane); continue; } r -= I_OUT;
        if (r < 2 * I_G) { const int up = r >= I_G; if (up) r -= I_G; constexpr int per = (D / 64) * (DEXP / 32); const int e = r / per, q = r % per, nblk = DEXP / 32, kb = q / nblk, nb = q % nblk, n0 = 32 * nb;
            p0_transpose_item((up ? F.w_up : F.w_gate) + (size_t)e * D * DEXP, D, DEXP, F.Wgu_t, 64 * kb, n0, e * 1024 + 256 * (n0 >> 7) + (up ? 128 : 0) + (n0 & 127), scr, F.lane); continue; } r -= 2 * I_G;
        { constexpr int per = (DEXP / 64) * (D / 32); const int e = r / per, q = r % per, nblk = D / 32, kb = q / nblk, nb = q % nblk;
            p0_transpose_item(F.w_down + (size_t)e * DEXP * D, DEXP, D, F.Wd_t, 64 * kb, 32 * nb, e * 1024 + 32 * nb, scr, F.lane); }
    }
}

__device__ __forceinline__ void p1_norm(Frame& F) {
    const int gw = F.vcu * NWAVES + F.wave, NGW = F.G * NWAVES;
    for (int m = gw; m < NTOK; m += NGW) {
        const int b = m / SEQ;
        const GAS f32x4* xr = (const GAS f32x4*)(F.x + (size_t)m * D) + F.lane;
        const GAS f32x4* gr = (const GAS f32x4*)F.g_mix + F.lane;
        const GAS f32x4* shr = (const GAS f32x4*)(F.mod + (size_t)b * (NMOD * D)) + F.lane;
        const GAS f32x4* scr = (const GAS f32x4*)(F.mod + (size_t)b * (NMOD * D) + D) + F.lane;
        f32x4 v[4]; float s = 0.f;
#pragma unroll
        for (int j = 0; j < 4; ++j) { v[j] = xr[64 * j]; s += (v[j].x * v[j].x + v[j].y * v[j].y) + (v[j].z * v[j].z + v[j].w * v[j].w); }
        const float rstd = __builtin_amdgcn_rsqf(wave_sum(s) * (1.f / D) + RMS_EPS);
        GAS unsigned long long* o8 = (GAS unsigned long long*)(F.XN + (size_t)m * D) + F.lane;
#pragma unroll
        for (int j = 0; j < 4; ++j) { const f32x4 g = gr[64 * j], sh = shr[64 * j], sc = scr[64 * j]; const f32x4 y = (v[j] * rstd * g) * (sc + 1.0f) + sh;
            o8[64 * j] = (unsigned long long)pk2(y.x, y.y) | ((unsigned long long)pk2(y.z, y.w) << 32); }
    }
}

__device__ __forceinline__ float dot64(const unsigned (&q)[32], const v4u (&k)[8]) {
    float a0 = 0.f, a1 = 0.f;
#pragma unroll
    for (int i = 0; i < 8; ++i) {
        a0 += bflo(q[4 * i]) * bflo(k[i].x) + bflo(q[4 * i + 1]) * bflo(k[i].y) + bflo(q[4 * i + 2]) * bflo(k[i].z) + bflo(q[4 * i + 3]) * bflo(k[i].w);
        a1 += bfhi(q[4 * i]) * bfhi(k[i].x) + bfhi(q[4 * i + 1]) * bfhi(k[i].y) + bfhi(q[4 * i + 2]) * bfhi(k[i].z) + bfhi(q[4 * i + 3]) * bfhi(k[i].w); }
    return a0 + a1;
}
#define LOADROW(dst, p) do { _Pragma("unroll") for (int i_ = 0; i_ < 8; ++i_) dst[i_] = ((const GAS v4u*)(p))[i_]; } while (0)
#define AXPY64(o, p, v) do { _Pragma("unroll") for (int i_ = 0; i_ < 8; ++i_) { \
    o[8 * i_ + 0] += p * bflo(v[i_].x); o[8 * i_ + 1] += p * bfhi(v[i_].x); o[8 * i_ + 2] += p * bflo(v[i_].y); o[8 * i_ + 3] += p * bfhi(v[i_].y); \
    o[8 * i_ + 4] += p * bflo(v[i_].z); o[8 * i_ + 5] += p * bfhi(v[i_].z); o[8 * i_ + 6] += p * bflo(v[i_].w); o[8 * i_ + 7] += p * bfhi(v[i_].w); } } while (0)
#define STOREO(ptr, o, sc) do { _Pragma("unroll") for (int i_ = 0; i_ < 8; ++i_) { v4u w_; w_.x = pk2(o[8 * i_] * sc, o[8 * i_ + 1] * sc); w_.y = pk2(o[8 * i_ + 2] * sc, o[8 * i_ + 3] * sc); \
    w_.z = pk2(o[8 * i_ + 4] * sc, o[8 * i_ + 5] * sc); w_.w = pk2(o[8 * i_ + 6] * sc, o[8 * i_ + 7] * sc); ((GAS v4u*)(ptr))[i_] = w_; } } while (0)

__device__ __forceinline__ void moba_naive_item(Frame& F, int item) {
    const int bh = item >> 6, ch = item & 63, b = bh >> 3, h = bh & 7, lz = lane_zero();
    const int t = ch * 64 + F.lane, own = ch >> 2, tl = t & 255;
    const size_t rowb = (size_t)b * SEQ;
    unsigned q[32]; { v4u t4[8]; LOADROW(t4, F.QA + (rowb + t) * WATT + h * HD);
#pragma unroll
        for (int i = 0; i < 8; ++i) { q[4 * i] = t4[i].x; q[4 * i + 1] = t4[i].y; q[4 * i + 2] = t4[i].z; q[4 * i + 3] = t4[i].w; } }
    float v0 = -INFINITY, v1 = -INFINITY, v2 = -INFINITY; int i0 = 0, i1 = 0, i2 = 0;
    for (int j = 0; j < own; ++j) {
        const GAS f32x4* km = (const GAS f32x4*)(F.kmean + ((size_t)(b * NBLK + j) * NH + h) * HD + lz);
        float g = 0.f;
#pragma unroll
        for (int i = 0; i < 16; ++i) { const f32x4 kv = km[i]; g += bflo(q[2 * i]) * kv.x + bfhi(q[2 * i]) * kv.y + bflo(q[2 * i + 1]) * kv.z + bfhi(q[2 * i + 1]) * kv.w; }
        if (g > v0) { v2 = v1; i2 = i1; v1 = v0; i1 = i0; v0 = g; i0 = j; } else if (g > v1) { v2 = v1; i2 = i1; v1 = g; i1 = j; } else if (g > v2) { v2 = g; i2 = j; }
    }
    float m = -INFINITY, l = 0.f; float o[64];
#pragma unroll
    for (int i = 0; i < 64; ++i) o[i] = 0.f;
    const float* bt = F.biasT + h * SEQ;
    const int nsel = own < 3 ? own : 3;
    for (int sl = 0; sl < nsel; ++sl) {
        const int blk = sl == 0 ? i0 : (sl == 1 ? i1 : i2);
        const bf16* kp = F.KA + (rowb + blk * MBLK) * WATT + h * HD; const bf16* vp = F.VA + (rowb + blk * MBLK) * WATT + h * HD;
        const int dist0 = t - blk * MBLK;
        for (int s = 0; s < MBLK; ++s) {
            v4u kk[8]; LOADROW(kk, kp + (size_t)s * WATT); const float sc = dot64(q, kk) + bt[dist0 - s];
            const float mn = fmaxf(m, sc), al = __builtin_amdgcn_exp2f(m - mn), p = __builtin_amdgcn_exp2f(sc - mn);
            l = l * al + p; m = mn;
#pragma unroll
            for (int i = 0; i < 64; ++i) o[i] *= al;
            v4u vv[8]; LOADROW(vv, vp + (size_t)s * WATT); AXPY64(o, p, vv);
        }
    }
    {
        const bf16* kp = F.KA + (rowb + own * MBLK) * WATT + h * HD + lz; const bf16* vp = F.VA + (rowb + own * MBLK) * WATT + h * HD + lz;
        const int smax = (ch & 3) * 64 + 63;
        for (int s = 0; s <= smax; ++s) {
            v4u kk[8]; LOADROW(kk, kp + (size_t)s * WATT); const int dist = tl - s; const float sc = dot64(q, kk) + bt[dist > 0 ? dist : 0];
            if (dist >= 0) {
                const float mn = fmaxf(m, sc), al = __builtin_amdgcn_exp2f(m - mn), p = __builtin_amdgcn_exp2f(sc - mn);
                l = l * al + p; m = mn;
#pragma unroll
                for (int i = 0; i < 64; ++i) o[i] *= al;
                v4u vv[8]; LOADROW(vv, vp + (size_t)s * WATT); AXPY64(o, p, vv);
            }
        }
    }
    const float rl = 1.0f / l;
    STOREO(F.QA + (rowb + t) * WATT + h * HD, o, rl);
}
__device__ __forceinline__ void sb_naive_item(Frame& F, int item) {
    const int bh = item >> 6, ch = item & 63, b = bh >> 3, h = bh & 7, lz = lane_zero();
    const int t = ch * 64 + F.lane;
    const size_t rowb = (size_t)b * SEQ;
    unsigned q[32]; { v4u t4[8]; LOADROW(t4, F.QB + (rowb + t) * WATT + h * HD);
#pragma unroll
        for (int i = 0; i < 8; ++i) { q[4 * i] = t4[i].x; q[4 * i + 1] = t4[i].y; q[4 * i + 2] = t4[i].z; q[4 * i + 3] = t4[i].w; } }
    float c = 1.0f; float o[64];
#pragma unroll
    for (int i = 0; i < 64; ++i) o[i] = 0.f;
    const bf16* kp = F.KB + rowb * WATT + h * HD + lz; const bf16* vp = F.VB + rowb * WATT + h * HD + lz;
    for (int s = ch * 64 + 62; s >= 0; --s) {
        v4u kk[8]; LOADROW(kk, kp + (size_t)s * WATT); const float e = __builtin_amdgcn_exp2f(dot64(q, kk)); const float r = 1.0f / (1.0f + e);
        if (s < t) { const float a = e * r * c; c *= r; v4u vv[8]; LOADROW(vv, vp + (size_t)s * WATT); AXPY64(o, a, vv); }
    }
    STOREO(F.QB + (rowb + t) * WATT + h * HD, o, 1.0f);
}
__device__ __forceinline__ void p3_sb_naive(Frame& F) {
    const int gw = F.vcu * NWAVES + F.wave, NGW = F.G * NWAVES;
    for (int p = gw; p < 2048; p += NGW) { const int bh = p >> 5, j = p & 31;
        sb_naive_item(F, bh * 64 + j); sb_naive_item(F, bh * 64 + 63 - j); }
}
__device__ __forceinline__ void p3_moba_naive(Frame& F) {
    const int gw = F.vcu * NWAVES + F.wave, NGW = F.G * NWAVES;
    for (int p = gw; p < 2048; p += NGW) { const int bh = p >> 5, j = p & 31;
        moba_naive_item(F, bh * 64 + j); moba_naive_item(F, bh * 64 + 63 - j); }
}
__device__ __forceinline__ bool attn_deal(const Frame& F, int i, int& bh, int& qb) {
    if (F.G == 256) { if (i >= 4) return false; const int s = F.vcu & 3; bh = F.vcu >> 2; qb = (i == 0) ? s : (i == 1) ? 7 - s : (i == 2) ? 8 + s : 15 - s; return true; }
    const int u = F.vcu + i * F.G; if (u >= 1024) return false; bh = u >> 4; qb = u & 15; return true;
}
__device__ __forceinline__ void p3_sb(Frame& F) {
    __syncthreads();
    for (int k = F.tid; k < attn::BT_BYTES / 16; k += NWAVES * 64) *(LAS v4u*)(F.lds + RING_OFF + attn::LDS_BT + 16 * k) = *(const GAS v4u*)(F.btg + (size_t)NH * (attn::BT_BYTES / 4) + 4 * k);
    __syncthreads();
    int bh, qb;
    for (int i = 0; attn_deal(F, i, bh, qb); ++i) attn::sb_unit(bh >> 3, bh & 7, qb, F.QB, F.KB, F.VB, F.QB, (char*)F.lds + RING_OFF);
}
__device__ __forceinline__ void p3_moba(Frame& F) {
    int bh, qb, curh = -1;
    for (int i = 0; attn_deal(F, i, bh, qb); ++i) { const int b = bh >> 3, h = bh & 7;
        if (h != curh) { __syncthreads();
            for (int k = F.tid; k < attn::BT_BYTES / 16; k += NWAVES * 64) *(LAS v4u*)(F.lds + RING_OFF + attn::LDS_BT + 16 * k) = *(const GAS v4u*)(F.btg + (size_t)h * (attn::BT_BYTES / 4) + 4 * k);
            __syncthreads(); curh = h; }
        attn::moba_unit(b, h, qb, F.QA, F.KA, F.VA, F.QA, F.kmean, (char*)F.lds + RING_OFF); }
}
__device__ __forceinline__ void p6_route(Frame& F) {
    const int gw = F.vcu * NWAVES + F.wave, NGW = F.G * NWAVES;
    for (int m = gw; m < NTOK; m += NGW) {
        const int b = m / SEQ;
        const GAS f32x4* xr = (const GAS f32x4*)(F.out + (size_t)m * D) + F.lane;
        const GAS f32x4* gr = (const GAS f32x4*)F.g_ffn + F.lane;
        const GAS f32x4* shr = (const GAS f32x4*)(F.mod + (size_t)b * (NMOD * D) + 3 * D) + F.lane;
        const GAS f32x4* scr = (const GAS f32x4*)(F.mod + (size_t)b * (NMOD * D) + 4 * D) + F.lane;
        float ss = 0.f; { const GAS f32x4* sp = (const GAS f32x4*)(F.stats + (size_t)m * 16);
#pragma unroll
            for (int j = 0; j < 4; ++j) { const f32x4 s4 = sp[j]; ss += (s4.x + s4.y) + (s4.z + s4.w); } }
        const float rstd = __builtin_amdgcn_rsqf(ss * (1.f / D) + RMS_EPS);
        f32x4 y[4];
        GAS unsigned long long* o8 = (GAS unsigned long long*)(F.XN + (size_t)m * D) + F.lane;
#pragma unroll
        for (int j = 0; j < 4; ++j) { const f32x4 v = xr[64 * j], g = gr[64 * j], sh = shr[64 * j], sc = scr[64 * j]; y[j] = (v * rstd * g) * (sc + 1.0f) + sh;
            o8[64 * j] = (unsigned long long)pk2(y[j].x, y[j].y) | ((unsigned long long)pk2(y[j].z, y[j].w) << 32); }
        float gl[4] = {0.f, 0.f, 0.f, 0.f};
#pragma unroll
        for (int j = 0; j < 4; ++j) { const GAS f32x4* wp = (const GAS f32x4*)(F.w_rg + (size_t)(4 * F.lane + 256 * j) * NGRP);
#pragma unroll
            for (int e = 0; e < 4; ++e) { const f32x4 w = wp[e]; const float yv = y[j][e]; gl[0] += yv * w.x; gl[1] += yv * w.y; gl[2] += yv * w.z; gl[3] += yv * w.w; } }
#pragma unroll
        for (int g = 0; g < 4; ++g) gl[g] = wave_sum(gl[g]) + F.b_rg[g];
        int gi = 0; float gm = gl[0];
#pragma unroll
        for (int g = 1; g < 4; ++g) if (gl[g] > gm) { gm = gl[g]; gi = g; }
        float den = 0.f;
#pragma unroll
        for (int g = 0; g < 4; ++g) den += __expf(gl[g] - gm);
        const float gwt = 1.0f / den;
        float el[8] = {0.f, 0.f, 0.f, 0.f, 0.f, 0.f, 0.f, 0.f};
#pragma unroll
        for (int j = 0; j < 4; ++j)
#pragma unroll
            for (int e = 0; e < 4; ++e) { const GAS f32x4* wp = (const GAS f32x4*)(F.w_re + (size_t)(4 * F.lane + 256 * j + e) * NEXP + gi * EPG); const f32x4 w0 = wp[0], w1 = wp[1]; const float yv = y[j][e];
                el[0] += yv * w0.x; el[1] += yv * w0.y; el[2] += yv * w0.z; el[3] += yv * w0.w; el[4] += yv * w1.x; el[5] += yv * w1.y; el[6] += yv * w1.z; el[7] += yv * w1.w; }
#pragma unroll
        for (int k = 0; k < 8; ++k) el[k] = wave_sum(el[k]) + F.b_re[gi * EPG + k];
        int k1 = 0; float t1 = el[0];
#pragma unroll
        for (int k = 1; k < 8; ++k) if (el[k] > t1) { t1 = el[k]; k1 = k; }
        int k2 = -1; float t2 = -INFINITY;
#pragma unroll
        for (int k = 0; k < 8; ++k) if (k != k1 && el[k] > t2) { t2 = el[k]; k2 = k; }
        const float ex = __expf(t2 - t1); const float w1v = gwt / (1.0f + ex), w2v = gwt * ex / (1.0f + ex);
        if (F.lane < 2) { const int e = gi * EPG + (F.lane == 0 ? k1 : k2); const float w = F.lane == 0 ? w1v : w2v;
            const unsigned pos = __hip_atomic_fetch_add(F.cnt + (F.lane * NEXP + e) * 64, 1u, __ATOMIC_RELAXED, __HIP_MEMORY_SCOPE_AGENT);
            F.tokl[(size_t)(F.lane * NEXP + e) * LCAP + pos] = m; F.wl[(size_t)(F.lane * NEXP + e) * LCAP + pos] = w; }
    }
}
__device__ __forceinline__ void moe_tables(Frame& F) {
    LAS int* T = (LAS int*)(F.lds + TAB_OFF);
    if (F.tid < 64) T[F.tid] = (int)__hip_atomic_load(F.cnt + F.tid * 64, RLX_AGENT);
    __syncthreads();
    if (F.tid == 0) { int pa = 0, hs = 0, p0 = 0, p1 = 0;
        for (int e = 0; e < NEXP; ++e) { const int c0 = T[e], c1 = T[32 + e], ta = (c0 + c1 + 255) >> 8;
            T[64 + e] = pa; T[128 + e] = hs; T[192 + e] = p0; T[256 + e] = p1; pa += ta; hs += ta * 256; p0 += (c0 + 255) >> 8; p1 += (c1 + 255) >> 8; }
        T[64 + 32] = pa; T[128 + 32] = hs; T[192 + 32] = p0; T[256 + 32] = p1; }
    __syncthreads();
}
#ifndef MK_N_LAUNCHES
#define MK_N_LAUNCHES 1
#endif
constexpr int N_PHASES = 10;
constexpr int N_LAUNCHES = MK_N_LAUNCHES;
static_assert(N_LAUNCHES == 1 || N_LAUNCHES == N_PHASES, "MK_N_LAUNCHES is 1 or N_PHASES");
struct Args { const float* in[20]; float* out; unsigned char* ws; int ph_lo, ph_hi; };
__global__ void __launch_bounds__(NWAVES * 64, 2) fwd(Args args) {
    extern __shared__ __attribute__((aligned(16))) unsigned char lds[];
    Frame F;
    F.lds = (LAS unsigned char*)lds;
    F.MISC = (volatile LAS unsigned*)(F.lds + MISC_OFF);
    F.tid = threadIdx.x; F.lane = F.tid & 63; F.wave = __builtin_amdgcn_readfirstlane(F.tid >> 6);
    F.G = gridDim.x; { const int bx = blockIdx.x; F.vcu = (F.G % 8 == 0) ? (bx % 8) * (F.G / 8) + bx / 8 : bx; }
    unsigned char* ws = args.ws;
    F.ctl = (gu32*)(ws + WS_CTL);
    F.x = args.in[0]; F.c = args.in[1]; F.w_ada = args.in[2]; F.b_ada = args.in[3]; F.g_mix = args.in[4]; F.w_in = args.in[5]; F.g_q = args.in[6]; F.g_k = args.in[7]; F.rel_bias = args.in[8];
    F.w_br_moba = args.in[9]; F.w_br_sb = args.in[10]; F.w_out = args.in[11]; F.g_ffn = args.in[12]; F.w_rg = args.in[13]; F.b_rg = args.in[14]; F.w_re = args.in[15]; F.b_re = args.in[16];
    F.w_gate = args.in[17]; F.w_up = args.in[18]; F.w_down = args.in[19]; F.out = args.out;
    F.mod = (float*)(ws + WS_MOD); F.biasT = (float*)(ws + WS_BIAS); F.btg = (float*)(ws + WS_BIAS + 128 * 1024); F.stats = (float*)(ws + WS_STATS); F.kmean = (float*)(ws + WS_CTL) + CW_KMEAN;
    F.Win_t = (bf16*)(ws + WS_WIN); F.Wbra_t = (bf16*)(ws + WS_WBRA); F.Wbrb_t = (bf16*)(ws + WS_WBRB); F.Wout_t = (bf16*)(ws + WS_WOUT); F.Wgu_t = (bf16*)(ws + WS_WGU); F.Wd_t = (bf16*)(ws + WS_WD);
    F.XN = (bf16*)(ws + WS_XN); F.QA = (bf16*)(ws + WS_QA); F.KA = (bf16*)(ws + WS_KA); F.VA = (bf16*)(ws + WS_VA); F.QB = (bf16*)(ws + WS_QB); F.KB = (bf16*)(ws + WS_KB); F.VB = (bf16*)(ws + WS_VB);
    F.GA = (bf16*)(ws + WS_GA); F.GB = (bf16*)(ws + WS_GB); F.H = (bf16*)(ws + WS_H);
    F.tokl = (int*)(ws + WS_TOKL); F.wl = (float*)(ws + WS_WL); F.cnt = (unsigned*)(ws + WS_CTL) + CW_CNT;
    for (int u = F.tid; u < (LDS_BYTES - LDSCTL_OFF) / 4; u += NWAVES * 64) ((LAS unsigned*)(F.lds + LDSCTL_OFF))[u] = 0u;
    __syncthreads();
    XcdBarrier bar; bar.bar = (unsigned*)(F.ctl + CW_BAR); bar.x = 0; bar.st = nullptr;
    if (N_LAUNCHES == 1) bar = xcd_barrier_post((unsigned*)(F.ctl + CW_BAR), F.MISC + 8);
#define GRID_BAR() do { if (N_LAUNCHES == 1) { xcd_barrier(bar); } } while (0)
    const int lo = args.ph_lo, hi = args.ph_hi;
#define IN(k) (lo <= (k) && (k) < hi)
#define BOTH(k) (IN(k) && IN((k) + 1))

    if (IN(0)) { p0_prologue(F); if (BOTH(0)) GRID_BAR(); }
    if (IN(1)) { p1_norm(F); if (BOTH(1)) GRID_BAR(); }
    if (IN(2)) {
        __syncthreads();
        pg8::Gemm g{F.XN, F.Win_t, D}; pg8::DenseOrder S; S.init(NTOK, INCOLS, F.G, (int)blockIdx.x);
        pg8::EpiProj E{F.QA, F.GA, F.GB, F.g_q, F.g_k, F.kmean};
        pg8::gemm_phase<pg8::EpiProj, pg8::DenseOrder, false>(F.lds + RING_OFF, g, S, E);
        if (BOTH(2)) GRID_BAR();
    }
    if (IN(3)) {
#if defined(MOBA_NAIVE)
        p3_moba_naive(F);
#else
        __syncthreads(); p3_moba(F);
#endif
#if defined(SB_NAIVE)
        p3_sb_naive(F);
#else
        p3_sb(F);
#endif
        if (BOTH(3)) GRID_BAR(); }
    if (IN(4)) {
        __syncthreads();
        { pg8::Gemm g{F.QA, F.Wbra_t, WATT}; pg8::DenseOrder S; S.init(NTOK, D, F.G, (int)blockIdx.x);
          pg8::EpiBranch<0> E{F.GA, nullptr};
          pg8::gemm_phase<pg8::EpiBranch<0>, pg8::DenseOrder, false>(F.lds + RING_OFF, g, S, E); }
        { pg8::Gemm g{F.QB, F.Wbrb_t, WATT}; pg8::DenseOrder S; S.init(NTOK, D, F.G, (int)blockIdx.x);
          pg8::EpiBranch<1> E{F.GB, F.GA};
          pg8::gemm_phase<pg8::EpiBranch<1>, pg8::DenseOrder, false>(F.lds + RING_OFF, g, S, E); }
        if (BOTH(4)) GRID_BAR();
    }
    if (IN(5)) {
        __syncthreads();
        pg8::Gemm g{F.GB, F.Wout_t, D}; pg8::DenseOrder S; S.init(NTOK, D, F.G, (int)blockIdx.x);
        pg8::EpiResid E{F.x, F.out, F.mod + 2 * D, F.stats};
        pg8::gemm_phase<pg8::EpiResid, pg8::DenseOrder, false>(F.lds + RING_OFF, g, S, E);
        if (BOTH(5)) GRID_BAR();
    }
    if (IN(6)) { p6_route(F); if (BOTH(6)) GRID_BAR(); }
    if (IN(7)) {
        moe_tables(F);
        pg8::Gemm g{F.XN, F.Wgu_t, D}; pg8::GateUpOrder S{(const LAS int*)(F.lds + TAB_OFF), F.tokl, F.G, (int)blockIdx.x};
        pg8::EpiGateUp E{F.H};
        pg8::gemm_phase<pg8::EpiGateUp, pg8::GateUpOrder, true>(F.lds + RING_OFF, g, S, E);
        if (BOTH(7)) GRID_BAR();
    }
    if (IN(8)) {
        moe_tables(F);
        pg8::Gemm g{F.H, F.Wd_t, DEXP}; pg8::DownOrder<0> S{(const LAS int*)(F.lds + TAB_OFF), F.G, (int)blockIdx.x};
        pg8::EpiDown E{F.out, F.mod + 5 * D, F.tokl, F.wl};
        pg8::gemm_phase<pg8::EpiDown, pg8::DownOrder<0>, false>(F.lds + RING_OFF, g, S, E);
        if (BOTH(8)) GRID_BAR();
    }
    if (IN(9)) {
        moe_tables(F);
        pg8::Gemm g{F.H, F.Wd_t, DEXP}; pg8::DownOrder<1> S{(const LAS int*)(F.lds + TAB_OFF), F.G, (int)blockIdx.x};
        pg8::EpiDown E{F.out, F.mod + 5 * D, F.tokl, F.wl};
        pg8::gemm_phase<pg8::EpiDown, pg8::DownOrder<1>, false>(F.lds + RING_OFF, g, S, E);
    }
#undef IN
#undef BOTH
}

extern "C" void kernel_launch(void* const* d_in, const int* in_sizes, int n_in, void* d_out, int out_size, void* d_ws, size_t ws_size, hipStream_t stream) {
    static int grid = 0;
    if (grid == 0) {
        if (n_in != 20 || in_sizes[0] != NTOK * D || out_size != NTOK * D || ws_size < WS_END) { fprintf(stderr, "kernel_launch: built for 20 inputs, x/out of %d floats, >= %zu bytes of workspace; got n_in %d, in0 %d, out %d, ws %zu; nothing launched\n", NTOK * D, (size_t)WS_END, n_in, n_in > 0 ? in_sizes[0] : -1, out_size, ws_size); grid = -1; return; }
        int dev = 0, cus = 0, per_cu = 0;
        if (hipGetDevice(&dev) != hipSuccess || hipDeviceGetAttribute(&cus, hipDeviceAttributeMultiprocessorCount, dev) != hipSuccess) { fprintf(stderr, "kernel_launch: hipGetDevice / hipDeviceGetAttribute failed\n"); grid = -1; return; }
        if (hipFuncSetAttribute((const void*)fwd, hipFuncAttributeMaxDynamicSharedMemorySize, LDS_BYTES) != hipSuccess) { fprintf(stderr, "kernel_launch: hipFuncSetAttribute failed\n"); grid = -1; return; }
        if (hipOccupancyMaxActiveBlocksPerMultiprocessor(&per_cu, (const void*)fwd, NWAVES * 64, LDS_BYTES) != hipSuccess || per_cu < 1)
            fprintf(stderr, "kernel_launch: note: the occupancy query reports %d workgroups per CU\n", per_cu);
        (void)hipGetLastError();
        grid = cus;
    }
    if (grid < 0) return;
    if (hipMemsetAsync((char*)d_ws + WS_CTL, 0, CTL_ZERO_BYTES, stream) != hipSuccess) { fprintf(stderr, "kernel_launch: hipMemsetAsync failed\n"); return; }
    Args a{};
    for (int i = 0; i < 20; ++i) a.in[i] = (const float*)d_in[i];
    a.out = (float*)d_out; a.ws = (unsigned char*)d_ws;
    for (int li = 0; li < N_LAUNCHES; ++li) {
        a.ph_lo = (N_LAUNCHES == 1) ? 0 : li; a.ph_hi = (N_LAUNCHES == 1) ? N_PHASES : li + 1;
        hipLaunchKernelGGL(fwd, dim3(grid), dim3(NWAVES * 64), LDS_BYTES, stream, a);
        const hipError_t le = hipPeekAtLastError();
        if (le != hipSuccess) { fprintf(stderr, "kernel_launch: launch %d failed: %s\n", li, hipGetErrorName(le)); break; }
    }
}
```

```cpp
#include <hip/hip_runtime.h>
#include <cstdio>
#include <cstdint>
#include <cmath>
namespace pg8 {
#define PG8_LAS __attribute__((address_space(3)))
typedef unsigned short bf16_t;
typedef short bf16x8 __attribute__((ext_vector_type(8)));
typedef float f32x4 __attribute__((ext_vector_type(4)));
typedef unsigned u32x4 __attribute__((ext_vector_type(4)));
constexpr int BM = 256, BK = 64, HALF = 128, HTB = HALF * BK * 2  , STAGE_BYTES = 8 * HTB, NXCD = 8, WGM = 8;

__host__ __device__ __forceinline__ int lds_byte(int r, int c) { const int st = (r >> 4) * 2 + (c >> 5), rr = r & 15, cc = c & 31, ob = rr * 64 + cc * 2; return st * 1024 + (ob ^ (((ob >> 9) & 1) << 5)); }
__host__ __device__ __forceinline__ void stage_rc(int b, int& R, int& C) { const int st = b / 1024, sb = b % 1024, swz = sb ^ (((sb >> 9) & 1) << 5); R = (st >> 1) * 16 + swz / 64; C = (st & 1) * 32 + (swz % 64) / 2; }
__host__ __device__ __forceinline__ int perm32(int rho) { const int n = rho >> 4, i = rho & 15; return 8 * (i >> 2) + 4 * n + (i & 3); }

struct Unit { int arow, brow, pm, pn, x0, x1; };
struct Gemm { const bf16_t* A; const bf16_t* Bt; int K; };

struct DenseOrder {
    int nM, nN, nwg, G, c;
    __device__ void init(int M, int N, int G_, int c_) { nM = M / BM; nN = N / BM; nwg = nM * nN; G = G_; c = c_; }
    __device__ bool next(int i, Unit& u) const {
        const long L = (long)i * G + c; if (L >= nwg) return false;
        int wgid = (int)L; { const int q = nwg / NXCD, r = nwg % NXCD, xcd = wgid % NXCD, off = wgid / NXCD; wgid = (xcd < r ? xcd * (q + 1) : r * (q + 1) + (xcd - r) * q) + off; }
        const int nig = WGM * nN, gid = wgid / nig, fm = gid * WGM, gsz = (nM - fm) < WGM ? (nM - fm) : WGM;
        u.pm = fm + ((wgid % nig) % gsz); u.pn = (wgid % nig) / gsz; u.arow = u.pm * BM; u.brow = u.pn * BM; u.x0 = 0; u.x1 = 0; return true;
    }
    __device__ __forceinline__ int arow_of(const Unit&, int) const { return 0; }
};

__device__ __forceinline__ unsigned cvt_pk_bf16(float lo, float hi) { unsigned r; asm volatile("v_cvt_pk_bf16_f32 %0, %1, %2" : "=v"(r) : "v"(lo), "v"(hi)); return r; }

template <class Epi, class Sched, bool GATHER, bool ALIGN_EPI = true, bool SP2 = true>
__device__ __forceinline__ void gemm_phase(PG8_LAS unsigned char* lds, const Gemm g, const Sched& S, const Epi& E) {
    const int tid = threadIdx.x, wid = __builtin_amdgcn_readfirstlane(tid >> 6), lane = tid & 63, wr = wid >> 2, wc = wid & 3, fr = lane & 15, fq = lane >> 4;
    const int K = g.K, nt = K / BK;
    unsigned voffA[2], voffB[2]; int stR[2], stC[2];
#pragma unroll
    for (int i = 0; i < 2; ++i) { int R, C; stage_rc(tid * 16 + i * 8192, R, C); const int Rb = Epi::PERM ? ((R & ~31) + perm32(R & 31)) : R;
        stR[i] = R; stC[i] = C; voffA[i] = (unsigned)(R * K + C) * 2u; voffB[i] = (unsigned)(Rb * K + C) * 2u; }
    const size_t kstep = (size_t)(BK * 2);
    const size_t hstep = (size_t)HALF * K * 2;
    const size_t rstep = (size_t)K * 2;
    const unsigned ldsw = (unsigned)wid * 1024u;
    const int aoff = lds_byte(wr * 64 + fr, fq * 8), boff = lds_byte(wc * 32 + fr, fq * 8);
#define PG8_SA(b, h) (((b) * 2 + (h)) * HTB)
#define PG8_SB(b, h) ((4 + (b) * 2 + (h)) * HTB)
#define PG8_STAGE(bufoff, gbase, voff) do { _Pragma("unroll") for (int _i = 0; _i < 2; ++_i) \
        __builtin_amdgcn_global_load_lds((const unsigned*)((const char*)(gbase) + (voff)[_i]), (PG8_LAS unsigned*)(lds + (bufoff) + ldsw + _i * 8192), 16, 0, 0); } while (0)
#define PG8_STAGE_A(bufoff, ub, h, VS) do { if constexpr (GATHER) { PG8_STAGE(bufoff, ub, VS[h]); } else { PG8_STAGE(bufoff, (ub) + (h) * hstep, voffA); } } while (0)
#define PG8_VOFFS(dst, U) do { _Pragma("unroll") for (int h_ = 0; h_ < 2; ++h_) _Pragma("unroll") for (int i_ = 0; i_ < 2; ++i_) \
        dst[h_][i_] = (unsigned)(S.arow_of(U, h_ * HALF + stR[i_]) * K + stC[i_]) * 2u; } while (0)
#define PG8_LDA(dst, b, h) do { _Pragma("unroll") for (int m = 0; m < 4; ++m) _Pragma("unroll") for (int k = 0; k < 2; ++k) dst[m][k] = *(const PG8_LAS bf16x8*)(lds + PG8_SA(b, h) + aoff + m * 2048 + k * 1024); } while (0)
#define PG8_LDB(dst, b, h) do { _Pragma("unroll") for (int n = 0; n < 2; ++n) _Pragma("unroll") for (int k = 0; k < 2; ++k) dst[n][k] = *(const PG8_LAS bf16x8*)(lds + PG8_SB(b, h) + boff + n * 2048 + k * 1024); } while (0)
#define PG8_MMA(ai, bj, At, Bt) do { __builtin_amdgcn_s_setprio(1); _Pragma("unroll") for (int m = 0; m < 4; ++m) _Pragma("unroll") for (int n = 0; n < 2; ++n) _Pragma("unroll") for (int k = 0; k < 2; ++k) \
        acc[ai][bj][m][n] = __builtin_amdgcn_mfma_f32_16x16x32_bf16(Bt[n][k], At[m][k], acc[ai][bj][m][n], 0, 0, 0); __builtin_amdgcn_s_setprio(0); } while (0)
#define PG8_WAIT_V(n) asm volatile("s_waitcnt vmcnt(" #n ")" ::: "memory")
#define PG8_WAIT_L(n) asm volatile("s_waitcnt lgkmcnt(" #n ")" ::: "memory")
#define PG8_BAR __builtin_amdgcn_s_barrier()
#define PG8_SCHED __builtin_amdgcn_sched_barrier(0)
    Unit cur, nxt; int ui = 0;
    if (!S.next(0, cur)) return;
    bool has_next = S.next(1, nxt);
    unsigned vAc[2][2], vAn[2][2];
    if constexpr (GATHER) { PG8_VOFFS(vAc, cur); if (has_next) { PG8_VOFFS(vAn, nxt); } else {
#pragma unroll
        for (int h_ = 0; h_ < 2; ++h_) { vAn[h_][0] = vAc[h_][0]; vAn[h_][1] = vAc[h_][1]; } } }
    else {
#pragma unroll
        for (int h_ = 0; h_ < 2; ++h_) { vAc[h_][0] = 0u; vAc[h_][1] = 0u; vAn[h_][0] = 0u; vAn[h_][1] = 0u; } }
    f32x4 acc[2][2][4][2];
#pragma unroll
    for (int a = 0; a < 2; ++a)
#pragma unroll
        for (int b = 0; b < 2; ++b)
#pragma unroll
            for (int m = 0; m < 4; ++m)
#pragma unroll
                for (int n = 0; n < 2; ++n) acc[a][b][m][n] = (f32x4){0.f, 0.f, 0.f, 0.f};
    bf16x8 At[4][2], B0[2][2], B1[2][2];
    const char* const A0 = (const char*)g.A;
    const char* cA = GATHER ? A0 : A0 + (size_t)cur.arow * rstep; const char* cB = (const char*)g.Bt + (size_t)cur.brow * rstep;
    if constexpr (SP2) {
        PG8_STAGE(PG8_SB(0, 0), cB, voffB); PG8_STAGE(PG8_SB(0, 1), cB + hstep, voffB); PG8_STAGE_A(PG8_SA(0, 0), cA, 0, vAc); PG8_STAGE_A(PG8_SA(0, 1), cA, 1, vAc);
        if (wr == 1) PG8_BAR;
        PG8_WAIT_V(2); PG8_BAR;
        PG8_STAGE(PG8_SB(1, 0), cB + kstep, voffB); PG8_STAGE_A(PG8_SA(1, 0), cA + kstep, 0, vAc); PG8_STAGE(PG8_SB(1, 1), cB + hstep + kstep, voffB);
        PG8_WAIT_V(6); PG8_BAR;
    } else {
        PG8_STAGE(PG8_SB(0, 0), cB, voffB); PG8_STAGE_A(PG8_SA(0, 0), cA, 0, vAc); PG8_STAGE(PG8_SB(0, 1), cB + hstep, voffB); PG8_STAGE_A(PG8_SA(0, 1), cA, 1, vAc);
        if (wr == 1) PG8_BAR;
        PG8_WAIT_V(4); PG8_BAR;
        PG8_STAGE(PG8_SB(1, 0), cB + kstep, voffB); PG8_STAGE_A(PG8_SA(1, 0), cA + kstep, 0, vAc); PG8_STAGE(PG8_SB(1, 1), cB + hstep + kstep, voffB);
        PG8_WAIT_V(6); PG8_BAR;
    }
    for (;;) {
        const char* nA = GATHER ? A0 : (has_next ? A0 + (size_t)nxt.arow * rstep : cA); const char* nB = has_next ? (const char*)g.Bt + (size_t)nxt.brow * rstep : cB;
        for (int t = 0; t < nt; t += 2) {
            const bool last = (t == nt - 2);
            const char* a1 = cA + (size_t)(t + 1) * kstep;
            const char* a2 = last ? nA : cA + (size_t)(t + 2) * kstep; const char* b2 = last ? nB : cB + (size_t)(t + 2) * kstep;
            const char* a3 = a2 + kstep; const char* b3 = b2 + kstep;
            unsigned vS[2][2];
#pragma unroll
            for (int h_ = 0; h_ < 2; ++h_) { vS[h_][0] = last ? vAn[h_][0] : vAc[h_][0]; vS[h_][1] = last ? vAn[h_][1] : vAc[h_][1]; }
            if constexpr (SP2) {
            PG8_LDB(B0, 0, 0); PG8_LDB(B1, 0, 1); PG8_SCHED; PG8_LDA(At, 0, 0); PG8_STAGE_A(PG8_SA(1, 1), a1, 1, vAc);
            PG8_WAIT_V(8); PG8_WAIT_L(0); PG8_BAR; PG8_MMA(0, 0, At, B0); PG8_MMA(0, 1, At, B1); PG8_BAR; PG8_SCHED;
            PG8_LDA(At, 0, 1); PG8_STAGE(PG8_SB(0, 0), b2, voffB); PG8_STAGE(PG8_SB(0, 1), b2 + hstep, voffB); PG8_STAGE_A(PG8_SA(0, 0), a2, 0, vS);
            PG8_WAIT_V(8); PG8_WAIT_L(0); PG8_BAR; PG8_MMA(1, 0, At, B0); PG8_MMA(1, 1, At, B1); PG8_BAR; PG8_SCHED;
            PG8_LDB(B0, 1, 0); PG8_LDB(B1, 1, 1); PG8_SCHED; PG8_LDA(At, 1, 0); PG8_STAGE_A(PG8_SA(0, 1), a2, 1, vS);
            PG8_WAIT_V(8); PG8_WAIT_L(0); PG8_BAR; PG8_MMA(0, 0, At, B0); PG8_MMA(0, 1, At, B1); PG8_BAR; PG8_SCHED;
            PG8_LDA(At, 1, 1); PG8_STAGE(PG8_SB(1, 0), b3, voffB); PG8_STAGE(PG8_SB(1, 1), b3 + hstep, voffB); PG8_STAGE_A(PG8_SA(1, 0), a3, 0, vS);
            PG8_WAIT_V(8); PG8_WAIT_L(0); PG8_BAR; PG8_MMA(1, 0, At, B0); PG8_MMA(1, 1, At, B1); PG8_BAR; PG8_SCHED;
            } else {
            PG8_LDB(B0, 0, 0); PG8_SCHED; PG8_LDA(At, 0, 0); PG8_STAGE_A(PG8_SA(1, 1), a1, 1, vAc);
            PG8_WAIT_L(8); PG8_BAR; PG8_WAIT_L(0); PG8_MMA(0, 0, At, B0); PG8_BAR; PG8_SCHED;
            PG8_LDB(B1, 0, 1); PG8_STAGE(PG8_SB(0, 0), b2, voffB);
            PG8_BAR; PG8_WAIT_L(0); PG8_MMA(0, 1, At, B1); PG8_BAR;
            PG8_LDA(At, 0, 1); PG8_STAGE_A(PG8_SA(0, 0), a2, 0, vS);
            PG8_BAR; PG8_WAIT_L(0); PG8_MMA(1, 0, At, B0); PG8_BAR; PG8_SCHED;
            PG8_STAGE(PG8_SB(0, 1), b2 + hstep, voffB);
            PG8_WAIT_V(6); PG8_BAR; PG8_MMA(1, 1, At, B1); PG8_BAR;
            PG8_LDB(B0, 1, 0); PG8_SCHED; PG8_LDA(At, 1, 0); PG8_STAGE_A(PG8_SA(0, 1), a2, 1, vS);
            PG8_WAIT_L(8); PG8_BAR; PG8_WAIT_L(0); PG8_MMA(0, 0, At, B0); PG8_BAR; PG8_SCHED;
            PG8_LDB(B1, 1, 1); PG8_STAGE(PG8_SB(1, 0), b3, voffB);
            PG8_BAR; PG8_WAIT_L(0); PG8_MMA(0, 1, At, B1); PG8_BAR;
            PG8_LDA(At, 1, 1); PG8_STAGE_A(PG8_SA(1, 0), a3, 0, vS);
            PG8_BAR; PG8_WAIT_L(0); PG8_MMA(1, 0, At, B0); PG8_BAR; PG8_SCHED;
            PG8_STAGE(PG8_SB(1, 1), b3 + hstep, voffB);
            PG8_WAIT_V(6); PG8_BAR; PG8_MMA(1, 1, At, B1); PG8_BAR;
            }
        }
        if constexpr (ALIGN_EPI) { if (wr == 0) PG8_BAR; }
        E(acc, cur, wr, wc, fr, fq);
        if (!has_next) break;
#pragma unroll
        for (int a = 0; a < 2; ++a)
#pragma unroll
            for (int b = 0; b < 2; ++b)
#pragma unroll
                for (int m = 0; m < 4; ++m)
#pragma unroll
                    for (int n = 0; n < 2; ++n) acc[a][b][m][n] = (f32x4){0.f, 0.f, 0.f, 0.f};
        cur = nxt; cA = nA; cB = nB; ++ui;
        has_next = S.next(ui + 1, nxt);
        if constexpr (GATHER) {
#pragma unroll
            for (int h_ = 0; h_ < 2; ++h_) { vAc[h_][0] = vAn[h_][0]; vAc[h_][1] = vAn[h_][1]; }
            if (has_next) { PG8_VOFFS(vAn, nxt); }
        }
        if constexpr (ALIGN_EPI) { if (wr == 1) PG8_BAR; }
    }
    PG8_WAIT_V(0);
    if constexpr (!ALIGN_EPI) { if (wr == 0) PG8_BAR; }
    PG8_BAR;
#undef PG8_SA
#undef PG8_SB
#undef PG8_STAGE
#undef PG8_STAGE_A
#undef PG8_VOFFS
#undef PG8_LDA
#undef PG8_LDB
#undef PG8_MMA
#undef PG8_WAIT_V
#undef PG8_WAIT_L
#undef PG8_BAR
#undef PG8_SCHED
}
}
constexpr int NWAVES = 8;
constexpr int BATCH = 8, SEQ = 4096, D = 1024, NTOK = BATCH * SEQ;
constexpr int HD = 64, NH = 8, WATT = NH * HD;
constexpr int INCOLS = 5120, NMOD = 6;
constexpr int MBLK = 256, NBLK = SEQ / MBLK;
constexpr int NEXP = 32, EPG = 8, NGRP = 4, DEXP = 512;
constexpr float RMS_EPS = 1e-6f;
constexpr float LOG2E = 1.4426950408889634f;
constexpr float C2 = 0.125f * 1.4426950408889634f;
constexpr int LCAP = NTOK;
constexpr int HROWS = 2 * NTOK + NEXP * 256 + 256;

constexpr size_t MiB = 1u << 20;
constexpr size_t WS_CTL = 0, CTL_ZERO_BYTES = 1 * MiB;
constexpr size_t WS_MOD = 1 * MiB;
constexpr size_t WS_BIAS = 1 * MiB + 256 * 1024;
constexpr size_t WS_STATS = 2 * MiB;
constexpr size_t WS_WIN = 4 * MiB;
constexpr size_t WS_WBRA = 14 * MiB, WS_WBRB = 15 * MiB;
constexpr size_t WS_WOUT = 16 * MiB;
constexpr size_t WS_WGU = 18 * MiB;
constexpr size_t WS_WD = 82 * MiB;
constexpr size_t WS_XN = 114 * MiB;
constexpr size_t WS_QA = 178 * MiB, WS_KA = 210 * MiB, WS_VA = 242 * MiB, WS_QB = 274 * MiB, WS_KB = 306 * MiB, WS_VB = 338 * MiB;
constexpr size_t WS_GA = 370 * MiB, WS_GB = 434 * MiB;
constexpr size_t WS_H = 178 * MiB;
constexpr size_t WS_TOKL = 306 * MiB, WS_WL = 314 * MiB;
constexpr size_t WS_INV = 314 * MiB, WS_WINV = 315 * MiB;
constexpr size_t WS_Y = 322 * MiB;
constexpr size_t WS_END = 498 * MiB;
static_assert(WS_Y + (size_t)HROWS * D * 2 <= WS_END, "Y fits");
static_assert(WS_H + (size_t)HROWS * DEXP * 2 <= WS_QB && WS_TOKL + (size_t)2 * NEXP * LCAP * 4 <= WS_WL && WS_WL + (size_t)2 * NEXP * LCAP * 4 <= WS_VB, "d_ws map");
constexpr int CW_TMO = 0, CW_CODE = 1;
constexpr int CW_BAR = 4096;
constexpr int CW_CNT = 16384;
constexpr int CW_KMEAN = 65536;
static_assert((CW_KMEAN + 65536) * 4 <= (int)CTL_ZERO_BYTES && CW_CNT + 64 * 64 <= CW_KMEAN && CW_BAR + 3456 <= CW_CNT, "CTL map");

constexpr int RING_OFF = 0, RING_BYTES = 131072;
constexpr int LDSCTL_OFF = RING_BYTES, MISC_OFF = LDSCTL_OFF + 320;
constexpr int TAB_OFF = RING_BYTES + 1024;
constexpr int LDS_BYTES = 147456;
static_assert(MISC_OFF + 128 <= TAB_OFF && TAB_OFF + 2048 <= LDS_BYTES, "LDS map");

#define GAS __attribute__((address_space(1)))
#define LAS __attribute__((address_space(3)))
typedef unsigned short bf16;
typedef unsigned v4u __attribute__((ext_vector_type(4)));
typedef unsigned v2u __attribute__((ext_vector_type(2)));
typedef float f32x4 __attribute__((ext_vector_type(4)));
typedef short bf16x8 __attribute__((ext_vector_type(8)));
typedef GAS unsigned gu32;
#define RLX_AGENT __ATOMIC_RELAXED, __HIP_MEMORY_SCOPE_AGENT
#define LDS_WAIT() asm volatile("s_waitcnt lgkmcnt(0)" ::: "memory")
#define VM_WAIT() asm volatile("s_waitcnt vmcnt(0)" ::: "memory")
__device__ __forceinline__ unsigned f2bf(float f) { unsigned u = __builtin_bit_cast(unsigned, f); return (u + 0x7fffu + ((u >> 16) & 1u)) >> 16; }
__device__ __forceinline__ unsigned pk2(float lo, float hi) { return f2bf(lo) | (f2bf(hi) << 16); }
__device__ __forceinline__ float bflo(unsigned u) { return __uint_as_float(u << 16); }
__device__ __forceinline__ float bfhi(unsigned u) { return __uint_as_float(u & 0xffff0000u); }
__device__ __forceinline__ float fsigmoid(float v) { return __builtin_amdgcn_rcpf(1.0f + __builtin_amdgcn_exp2f(-v * LOG2E)); }
#define XB_TMO      128
#define XB_XCNT(j)  (256  + 64 * (j))
#define XB_XSUB(j)  (1280 + 64 * (j))
#define XB_XGEN(j)  (2304 + 64 * (j))
#define XB_TOP      3328
#define XB_TOPGEN   3392
#define XCD_BAR_WORDS 3456
#define XB_SPIN_CAP (1u << 22)

__device__ __forceinline__ unsigned xb_ld(unsigned* p)              { return __hip_atomic_load(p, __ATOMIC_RELAXED, __HIP_MEMORY_SCOPE_AGENT); }
__device__ __forceinline__ unsigned xb_add(unsigned* p, unsigned v) { return __hip_atomic_fetch_add(p, v, __ATOMIC_RELAXED, __HIP_MEMORY_SCOPE_AGENT); }
__device__ __forceinline__ unsigned xb_xcc_id() { return (unsigned)__builtin_amdgcn_s_getreg((3 << 11) | 20) & 0xFu; }
#define XB_SPIN(cond, bar) do { unsigned _sp = 0; while (cond) { __builtin_amdgcn_s_sleep(1); \
    if ((++_sp & 255u) == 0u) { if (xb_ld(&(bar)[XB_TMO])) break; if (_sp > XB_SPIN_CAP) { atomicAdd(&(bar)[XB_TMO], 1u); break; } } } } while (0)

struct XcdBarrier {
    unsigned* bar; unsigned x;
    volatile LAS unsigned* st;
};

__device__ __forceinline__ XcdBarrier xcd_barrier_post(unsigned* bar, volatile LAS unsigned* st) {
    XcdBarrier b; b.bar = bar; b.x = xb_xcc_id(); b.st = st;
    if (threadIdx.x == 0) (void)xb_add(&bar[XB_XCNT(b.x)], 1u);
    return b;
}
__device__ __forceinline__ void xcd_barrier_complete(unsigned* bar, unsigned x, unsigned& nloc, unsigned& nx) {
    const unsigned G = gridDim.x * gridDim.y * gridDim.z;
    unsigned sum, cnt, mine, sp = 0u;
    for (;;) {
        sum = 0u; cnt = 0u; mine = 0u;
#pragma unroll
        for (unsigned j = 0; j < 16; ++j) { const unsigned c = xb_ld(&bar[XB_XCNT(j)]); sum += c; cnt += (c > 0u) ? 1u : 0u; mine = (j == x) ? c : mine; }
        if (sum == G) break;
        __builtin_amdgcn_s_sleep(1);
        if ((++sp & 255u) == 0u) { if (xb_ld(&bar[XB_TMO])) break; if (sp > XB_SPIN_CAP) { atomicAdd(&bar[XB_TMO], 1u); break; } }
    }
    nloc = mine > 0u ? mine : 1u; nx = cnt > 0u ? cnt : 1u;
}

__device__ __forceinline__ void xcd_barrier(const XcdBarrier& b) {
    asm volatile("s_waitcnt vmcnt(0)" ::: "memory");
    __syncthreads();
    if (threadIdx.x == 0) {
        unsigned* bar = b.bar;
        __builtin_amdgcn_s_waitcnt(0);
        unsigned nloc = b.st[0], nx = b.st[1];
        if (nloc == 0u) { xcd_barrier_complete(bar, b.x, nloc, nx); b.st[0] = nloc; b.st[1] = nx; }
        const unsigned old = xb_add(&bar[XB_XSUB(b.x)], 1u);
        const unsigned gen = old / nloc;
        if (old + 1u == (gen + 1u) * nloc) {
            __builtin_amdgcn_fence(__ATOMIC_RELEASE, "agent");
            asm volatile("s_waitcnt vmcnt(0)" ::: "memory");
            const unsigned og = xb_add(&bar[XB_TOP], 1u);
            const unsigned tg = og / nx;
            if (og + 1u == (tg + 1u) * nx) xb_add(&bar[XB_TOPGEN], 1u);
            else XB_SPIN(xb_ld(&bar[XB_TOPGEN]) == tg, bar);
            __builtin_amdgcn_fence(__ATOMIC_ACQUIRE, "agent");
            xb_add(&bar[XB_XGEN(b.x)], 1u);
            asm volatile("s_waitcnt vmcnt(0)" ::: "memory");
        } else {
            XB_SPIN(xb_ld(&bar[XB_XGEN(b.x)]) == gen, bar);
            __builtin_amdgcn_fence(__ATOMIC_ACQUIRE, "agent");
            asm volatile("s_waitcnt vmcnt(0)" ::: "memory");
        }
    }
    __syncthreads();
}
#ifndef BR_MB
#define BR_MB 2
#endif
#ifndef RS_MB
#define RS_MB 2
#endif
#ifndef DN_MB
#define DN_MB 2
#endif
namespace pg8 {
struct EpiProj {
    static constexpr bool PERM = true;
    bf16_t* qkv;
    bf16_t* ga; bf16_t* gb;
    const float* gq; const float* gk;
    float* kmean;
    __device__ __forceinline__ void operator()(const f32x4 (&acc)[2][2][4][2], const Unit& u, int wr, int wc, int fr, int fq) const {
        const int pn = u.pn; const int row0 = u.pm * BM + wr * 64 + fr;
        if (pn < 4) {
            const bool isq = pn < 2; const float* gv = isq ? gq : gk; const float post = isq ? C2 : 1.0f;
            bf16_t* base = qkv + (size_t)(pn >> 1) * ((size_t)NTOK * WATT) + (pn & 1) * 256 + wc * 64 + 8 * fq;
            float g[2][2][4];
#pragma unroll
            for (int bj = 0; bj < 2; ++bj)
#pragma unroll
                for (int n = 0; n < 2; ++n) { const f32x4 t = *(const f32x4*)(gv + 32 * bj + 8 * fq + 4 * n); g[bj][n][0] = t[0] * post; g[bj][n][1] = t[1] * post; g[bj][n][2] = t[2] * post; g[bj][n][3] = t[3] * post; }
            float cs[2][2][4];
#pragma unroll
            for (int bj = 0; bj < 2; ++bj)
#pragma unroll
                for (int n = 0; n < 2; ++n)
#pragma unroll
                    for (int e = 0; e < 4; ++e) cs[bj][n][e] = 0.f;
#pragma unroll
            for (int ai = 0; ai < 2; ++ai)
#pragma unroll
                for (int m = 0; m < 4; ++m) {
                    float ss = 0.f;
#pragma unroll
                    for (int bj = 0; bj < 2; ++bj)
#pragma unroll
                        for (int n = 0; n < 2; ++n) { const f32x4 x = acc[ai][bj][m][n]; ss += (x[0] * x[0] + x[1] * x[1]) + (x[2] * x[2] + x[3] * x[3]); }
                    ss += __shfl_xor(ss, 16); ss += __shfl_xor(ss, 32);
                    const float rstd = __builtin_amdgcn_rsqf(ss * (1.0f / 64.0f) + RMS_EPS);
                    bf16_t* rowp = base + (size_t)(row0 + ai * HALF + m * 16) * WATT;
#pragma unroll
                    for (int bj = 0; bj < 2; ++bj) { float o[2][4];
#pragma unroll
                        for (int n = 0; n < 2; ++n)
#pragma unroll
                            for (int e = 0; e < 4; ++e) { o[n][e] = acc[ai][bj][m][n][e] * rstd * g[bj][n][e]; cs[bj][n][e] += o[n][e]; }
                        u32x4 w; w.x = cvt_pk_bf16(o[0][0], o[0][1]); w.y = cvt_pk_bf16(o[0][2], o[0][3]); w.z = cvt_pk_bf16(o[1][0], o[1][1]); w.w = cvt_pk_bf16(o[1][2], o[1][3]);
                        *(u32x4*)(rowp + 32 * bj) = w; }
                }
            if (!isq) {
#pragma unroll
                for (int bj = 0; bj < 2; ++bj)
#pragma unroll
                    for (int n = 0; n < 2; ++n)
#pragma unroll
                        for (int e = 0; e < 4; ++e) { float v = cs[bj][n][e]; v += __shfl_xor(v, 1); v += __shfl_xor(v, 2); v += __shfl_xor(v, 4); v += __shfl_xor(v, 8); cs[bj][n][e] = v; }
                if (fr == 0) { float* kp = kmean + ((size_t)u.pm * NH + (pn & 1) * 4 + wc) * HD + 8 * fq;
#pragma unroll
                    for (int bj = 0; bj < 2; ++bj)
#pragma unroll
                        for (int n = 0; n < 2; ++n)
#pragma unroll
                            for (int e = 0; e < 4; ++e) atomicAdd(kp + 32 * bj + 4 * n + e, cs[bj][n][e]); }
            }
        } else {
            const bool isg = pn >= 12; const float sc = (pn == 6 || pn == 7) ? C2 : 1.0f;
            bf16_t* base; int ldc;
            if (isg) { base = (pn < 16 ? ga : gb) + (pn & 3) * 256 + wc * 64 + 8 * fq; ldc = D; }
            else { base = qkv + (size_t)(pn >> 1) * ((size_t)NTOK * WATT) + (pn & 1) * 256 + wc * 64 + 8 * fq; ldc = WATT; }
#pragma unroll
            for (int ai = 0; ai < 2; ++ai)
#pragma unroll
                for (int m = 0; m < 4; ++m) { bf16_t* rowp = base + (size_t)(row0 + ai * HALF + m * 16) * ldc;
#pragma unroll
                    for (int bj = 0; bj < 2; ++bj) { f32x4 v0 = acc[ai][bj][m][0], v1 = acc[ai][bj][m][1];
                        if (isg) {
#pragma unroll
                            for (int e = 0; e < 4; ++e) { v0[e] = __builtin_amdgcn_rcpf(1.0f + __builtin_amdgcn_exp2f(-v0[e] * LOG2E)); v1[e] = __builtin_amdgcn_rcpf(1.0f + __builtin_amdgcn_exp2f(-v1[e] * LOG2E)); } }
                        else { v0 = v0 * sc; v1 = v1 * sc; }
                        u32x4 w; w.x = cvt_pk_bf16(v0[0], v0[1]); w.y = cvt_pk_bf16(v0[2], v0[3]); w.z = cvt_pk_bf16(v1[0], v1[1]); w.w = cvt_pk_bf16(v1[2], v1[3]);
                        *(u32x4*)(rowp + 32 * bj) = w; } }
        }
    }
};

template <int MODE> struct EpiBranch {
    static constexpr bool PERM = true;
    bf16_t* sg; const bf16_t* tin;
    __device__ __forceinline__ void operator()(const f32x4 (&acc)[2][2][4][2], const Unit& u, int wr, int wc, int fr, int fq) const {
        const int row0 = u.pm * BM + wr * 64 + fr, col0 = u.pn * BM + wc * 32 + 8 * fq;
#pragma unroll
        for (int ai = 0; ai < 2; ++ai)
#pragma unroll
        for (int mb = 0; mb < 4; mb += BR_MB) { u32x4 gw[4][2], tw[4][2];
#pragma unroll
            for (int m = mb; m < mb + BR_MB; ++m) { const size_t off = (size_t)(row0 + ai * HALF + m * 16) * D + col0;
#pragma unroll
                for (int bj = 0; bj < 2; ++bj) { gw[m][bj] = *(const u32x4*)(sg + off + bj * HALF); if (MODE == 1) tw[m][bj] = *(const u32x4*)(tin + off + bj * HALF); else tw[m][bj] = (u32x4){0u, 0u, 0u, 0u}; } }
#pragma unroll
            for (int m = mb; m < mb + BR_MB; ++m) { const size_t off = (size_t)(row0 + ai * HALF + m * 16) * D + col0;
#pragma unroll
                for (int bj = 0; bj < 2; ++bj) { const u32x4 g = gw[m][bj], t = tw[m][bj];
                    const f32x4 v0 = acc[ai][bj][m][0], v1 = acc[ai][bj][m][1]; float o[8];
                    o[0] = bflo(g.x) * v0[0]; o[1] = bfhi(g.x) * v0[1]; o[2] = bflo(g.y) * v0[2]; o[3] = bfhi(g.y) * v0[3];
                    o[4] = bflo(g.z) * v1[0]; o[5] = bfhi(g.z) * v1[1]; o[6] = bflo(g.w) * v1[2]; o[7] = bfhi(g.w) * v1[3];
                    if (MODE == 1) { o[0] += bflo(t.x); o[1] += bfhi(t.x); o[2] += bflo(t.y); o[3] += bfhi(t.y); o[4] += bflo(t.z); o[5] += bfhi(t.z); o[6] += bflo(t.w); o[7] += bfhi(t.w); }
                    u32x4 w; w.x = cvt_pk_bf16(o[0], o[1]); w.y = cvt_pk_bf16(o[2], o[3]); w.z = cvt_pk_bf16(o[4], o[5]); w.w = cvt_pk_bf16(o[6], o[7]);
                    *(u32x4*)(sg + off + bj * HALF) = w; } } }
    }
};

struct EpiResid {
    static constexpr bool PERM = false;
    const float* x; float* out; const float* gt;
    float* stats;
    __device__ __forceinline__ void operator()(const f32x4 (&acc)[2][2][4][2], const Unit& u, int wr, int wc, int fr, int fq) const {
        const int row0 = u.pm * BM + wr * 64 + fr, col0 = u.pn * BM + wc * 32 + 4 * fq; const int b = (u.pm * BM) / SEQ;
        f32x4 gv[2][2];
#pragma unroll
        for (int bj = 0; bj < 2; ++bj)
#pragma unroll
            for (int n = 0; n < 2; ++n) gv[bj][n] = *(const f32x4*)(gt + (size_t)b * (NMOD * D) + col0 + bj * HALF + n * 16);
#pragma unroll
        for (int ai = 0; ai < 2; ++ai)
#pragma unroll
        for (int mb = 0; mb < 4; mb += RS_MB) { f32x4 xv[4][2][2];
#pragma unroll
            for (int m = mb; m < mb + RS_MB; ++m) { const size_t off = (size_t)(row0 + ai * HALF + m * 16) * D + col0;
#pragma unroll
                for (int bj = 0; bj < 2; ++bj)
#pragma unroll
                    for (int n = 0; n < 2; ++n) xv[m][bj][n] = *(const f32x4*)(x + off + bj * HALF + n * 16); }
#pragma unroll
            for (int m = mb; m < mb + RS_MB; ++m) { const int row = row0 + ai * HALF + m * 16; const size_t off = (size_t)row * D + col0; float ss = 0.f;
#pragma unroll
                for (int bj = 0; bj < 2; ++bj)
#pragma unroll
                    for (int n = 0; n < 2; ++n) { const f32x4 o = xv[m][bj][n] + gv[bj][n] * acc[ai][bj][m][n];
                        *(f32x4*)(out + off + bj * HALF + n * 16) = o; ss += (o[0] * o[0] + o[1] * o[1]) + (o[2] * o[2] + o[3] * o[3]); }
                ss += __shfl_xor(ss, 16); ss += __shfl_xor(ss, 32);
                if (fq == 0) stats[(size_t)row * 16 + u.pn * 4 + wc] = ss; } }
    }
};

struct EpiGateUp {
    static constexpr bool PERM = true;
    bf16_t* H;
    __device__ __forceinline__ void operator()(const f32x4 (&acc)[2][2][4][2], const Unit& u, int wr, int wc, int fr, int fq) const {
        bf16_t* base = H + (size_t)(u.arow + wr * 64 + fr) * DEXP + u.pn * 128 + wc * 32 + 8 * fq;
#pragma unroll
        for (int ai = 0; ai < 2; ++ai)
#pragma unroll
            for (int m = 0; m < 4; ++m) { float o[8];
#pragma unroll
                for (int n = 0; n < 2; ++n)
#pragma unroll
                    for (int e = 0; e < 4; ++e) { const float gg = acc[ai][0][m][n][e], uu = acc[ai][1][m][n][e]; o[4 * n + e] = gg * __builtin_amdgcn_rcpf(1.0f + __builtin_amdgcn_exp2f(-gg * LOG2E)) * uu; }
                u32x4 w; w.x = cvt_pk_bf16(o[0], o[1]); w.y = cvt_pk_bf16(o[2], o[3]); w.z = cvt_pk_bf16(o[4], o[5]); w.w = cvt_pk_bf16(o[6], o[7]);
                *(u32x4*)(base + (size_t)(ai * HALF + m * 16) * DEXP) = w; }
    }
};

struct EpiDown {
    static constexpr bool PERM = false;
    float* out; const float* gt;
    const int* tl; const float* wl;
    __device__ __forceinline__ void operator()(const f32x4 (&acc)[2][2][4][2], const Unit& u, int wr, int wc, int fr, int fq) const {
        const int col0 = u.pn * BM + wc * 32 + 4 * fq;
        int tok[2][4]; float wv[2][4];
#pragma unroll
        for (int ai = 0; ai < 2; ++ai)
#pragma unroll
            for (int m = 0; m < 4; ++m) { const int r = ai * HALF + wr * 64 + m * 16 + fr; const int rr = r < u.x1 ? r : u.x1 - 1; tok[ai][m] = tl[u.x0 + rr]; wv[ai][m] = wl[u.x0 + rr]; }
#pragma unroll
        for (int ai = 0; ai < 2; ++ai)
#pragma unroll
        for (int mb = 0; mb < 4; mb += DN_MB) { f32x4 ov[4][2][2];
#pragma unroll
            for (int m = mb; m < mb + DN_MB; ++m) { const float* op = out + (size_t)tok[ai][m] * D + col0;
#pragma unroll
                for (int bj = 0; bj < 2; ++bj)
#pragma unroll
                    for (int n = 0; n < 2; ++n) ov[m][bj][n] = *(const f32x4*)(op + bj * HALF + n * 16); }
#pragma unroll
            for (int m = mb; m < mb + DN_MB; ++m) { const int r = ai * HALF + wr * 64 + m * 16 + fr; const int tk = tok[ai][m]; const float* gp = gt + (size_t)(tk / SEQ) * (NMOD * D) + col0; f32x4 gv[2][2];
#pragma unroll
                for (int bj = 0; bj < 2; ++bj)
#pragma unroll
                    for (int n = 0; n < 2; ++n) gv[bj][n] = *(const f32x4*)(gp + bj * HALF + n * 16);
                if (r < u.x1) { float* op = out + (size_t)tk * D + col0; const float w = wv[ai][m];
#pragma unroll
                    for (int bj = 0; bj < 2; ++bj)
#pragma unroll
                        for (int n = 0; n < 2; ++n) *(f32x4*)(op + bj * HALF + n * 16) = ov[m][bj][n] + gv[bj][n] * (acc[ai][bj][m][n] * w); } } }
    }
};

struct EpiY {
    static constexpr bool PERM = true;
    bf16_t* Y;
    __device__ __forceinline__ void operator()(const f32x4 (&acc)[2][2][4][2], const Unit& u, int wr, int wc, int fr, int fq) const {
        bf16_t* base = Y + (size_t)(u.arow + wr * 64 + fr) * D + u.pn * BM + wc * 32 + 8 * fq;
#pragma unroll
        for (int ai = 0; ai < 2; ++ai)
#pragma unroll
            for (int m = 0; m < 4; ++m) { bf16_t* rowp = base + (size_t)(ai * HALF + m * 16) * D;
#pragma unroll
                for (int bj = 0; bj < 2; ++bj) { const f32x4 v0 = acc[ai][bj][m][0], v1 = acc[ai][bj][m][1];
                    u32x4 w; w.x = cvt_pk_bf16(v0[0], v0[1]); w.y = cvt_pk_bf16(v0[2], v0[3]); w.z = cvt_pk_bf16(v1[0], v1[1]); w.w = cvt_pk_bf16(v1[2], v1[3]);
                    *(u32x4*)(rowp + bj * HALF) = w; } }
    }
};
struct EpiNull {
    static constexpr bool PERM = false;
    bf16_t* dummy;
    __device__ __forceinline__ void operator()(const f32x4 (&acc)[2][2][4][2], const Unit& u, int wr, int wc, int fr, int fq) const {
        f32x4 s = {0.f, 0.f, 0.f, 0.f};
#pragma unroll
        for (int ai = 0; ai < 2; ++ai)
#pragma unroll
            for (int bj = 0; bj < 2; ++bj)
#pragma unroll
                for (int m = 0; m < 4; ++m)
#pragma unroll
                    for (int n = 0; n < 2; ++n) s += acc[ai][bj][m][n];
        *(f32x4*)((float*)dummy + (size_t)(blockIdx.x * 512 + threadIdx.x) * 4) = s;
    }
};
struct GateUpOrder {
    const PG8_LAS int* T; const int* tokl; int G, c;
    __device__ bool next(int i, Unit& u) const {
        const int L = i * G + c; const int total = T[64 + 32] * 4; if (L >= total) return false;
        const int rt = L >> 2; int e = 0; while (T[64 + e + 1] <= rt) ++e;
        const int lt = rt - T[64 + e];
        u.pm = lt; u.pn = L & 3; u.x0 = e; u.x1 = 0; u.arow = T[128 + e] + lt * 256; u.brow = e * 1024 + (L & 3) * 256; return true;
    }
    __device__ __forceinline__ int arow_of(const Unit& u, int r) const {
        const int idx = u.pm * 256 + r, c0 = T[u.x0], c1 = T[32 + u.x0];
        int tok = 0;
        if (idx < c0) tok = tokl[(size_t)u.x0 * LCAP + idx]; else if (idx < c0 + c1) tok = tokl[(size_t)(NEXP + u.x0) * LCAP + idx - c0];
        return tok;
    }
};
struct DownAllOrder {
    const PG8_LAS int* T; int G, c;
    __device__ bool next(int i, Unit& u) const {
        const int L = i * G + c; const int total = T[64 + 32] * 4; if (L >= total) return false;
        const int rt = L >> 2; int e = 0; while (T[64 + e + 1] <= rt) ++e;
        const int lt = rt - T[64 + e];
        u.pm = lt; u.pn = L & 3; u.x0 = e; u.x1 = 0; u.arow = T[128 + e] + lt * 256; u.brow = e * 1024 + (L & 3) * 256; return true;
    }
    __device__ __forceinline__ int arow_of(const Unit&, int) const { return 0; }
};
template <int SLOT> struct DownOrder {
    const PG8_LAS int* T; int G, c;
    __device__ bool next(int i, Unit& u) const {
        const int PO = SLOT ? 256 : 192; const int L = i * G + c; const int total = T[PO + 32] * 4; if (L >= total) return false;
        const int rt = L >> 2; int e = 0; while (T[PO + e + 1] <= rt) ++e;
        const int lt = rt - T[PO + e]; const int cs = T[SLOT * 32 + e]; const int rem = cs - lt * 256;
        u.pm = lt; u.pn = L & 3; u.x0 = (SLOT * NEXP + e) * LCAP + lt * 256; u.x1 = rem < 256 ? rem : 256;
        u.arow = T[128 + e] + (SLOT ? T[e] : 0) + lt * 256; u.brow = e * 1024 + (L & 3) * 256; return true;
    }
    __device__ __forceinline__ int arow_of(const Unit&, int) const { return 0; }
};
}
namespace attn {
using bf16x8 = __attribute__((ext_vector_type(8))) short;
using s16x4 = __attribute__((ext_vector_type(4))) short;
using f32x16 = __attribute__((ext_vector_type(16))) float;
using f32x4v = __attribute__((ext_vector_type(4))) float;
using u32x4 = __attribute__((ext_vector_type(4))) unsigned;
typedef unsigned short bf16;
constexpr int DM = 512, QBLK = 32, NW = 8, QB = 256, KVBLK = 64;
constexpr int NSLOT = 3, SLOTB = 8192;
constexpr int LDS_K = 0, LDS_V = NSLOT * SLOTB, LDS_WS = 2 * NSLOT * SLOTB, LDS_OST = LDS_WS + NW * 64 * 4, LDS_BT = LDS_OST + NW * 4096;
constexpr int REV = 896, BT_LEN = 1168, COPYB = BT_LEN * 4, NEG_OFF = 4 * COPYB, BT_BYTES = NEG_OFF + 256;
constexpr int LDS_BYTES = LDS_BT + BT_BYTES;
static_assert(BT_LEN >= REV + 256 + 8 + 3 && COPYB % 16 == 0 && LDS_BT % 16 == 0, "bias image");
#define SBAR() __builtin_amdgcn_sched_barrier(0)
#define WAIT_BAR(N) asm volatile("s_waitcnt vmcnt(" #N ") lgkmcnt(0)\n\ts_barrier":::"memory")
typedef __attribute__((address_space(3))) const char* lds_cptr;
typedef short v4i16_t __attribute__((ext_vector_type(4)));
typedef float f32x2_t __attribute__((ext_vector_type(2))); typedef __bf16 bf16x2_t __attribute__((ext_vector_type(2)));
__device__ __forceinline__ int crow(int r, int hi) { return (r & 3) + 8 * (r >> 2) + 4 * hi; }
__device__ __forceinline__ void glds16(const void* gsrc, unsigned lds_dst) { unsigned keep;
  asm volatile("s_mov_b32 %0, m0\n\ts_mov_b32 m0, %2\n\ts_nop 0\n\tglobal_load_lds_dwordx4 %1, off\n\ts_mov_b32 m0, %0" : "=&s"(keep) : "v"(gsrc), "s"(lds_dst) : "memory"); }
__device__ __forceinline__ unsigned cvtpk_s(float lo, float hi) { f32x2_t v = {lo, hi}; bf16x2_t b = __builtin_convertvector(v, bf16x2_t); return __builtin_bit_cast(unsigned, b); }
__device__ __forceinline__ void kload8(bf16x8* kf, lds_cptr kp) {
  kf[0] = *(const __attribute__((address_space(3))) bf16x8*)(kp);        kf[1] = *(const __attribute__((address_space(3))) bf16x8*)(kp + 512);
  kf[2] = *(const __attribute__((address_space(3))) bf16x8*)(kp + 2048); kf[3] = *(const __attribute__((address_space(3))) bf16x8*)(kp + 2560);
  kf[4] = *(const __attribute__((address_space(3))) bf16x8*)(kp + 4096); kf[5] = *(const __attribute__((address_space(3))) bf16x8*)(kp + 4608);
  kf[6] = *(const __attribute__((address_space(3))) bf16x8*)(kp + 6144); kf[7] = *(const __attribute__((address_space(3))) bf16x8*)(kp + 6656);
}
__device__ __forceinline__ void kload2(bf16x8* kf, lds_cptr kp, int j) { kf[2 * j] = *(const __attribute__((address_space(3))) bf16x8*)(kp + j * 2048); kf[2 * j + 1] = *(const __attribute__((address_space(3))) bf16x8*)(kp + j * 2048 + 512); }
__device__ __forceinline__ s16x4 vtr(lds_cptr p) { return __builtin_bit_cast(s16x4, __builtin_amdgcn_ds_read_tr16_b64_v4i16((__attribute__((address_space(3))) v4i16_t*)p)); }
__device__ __forceinline__ f32x4v ldsf4(lds_cptr p) { return *(const __attribute__((address_space(3))) f32x4v*)p; }
#define MFMA32(a, b, c) __builtin_amdgcn_mfma_f32_32x32x16_bf16(a, b, c, 0, 0, 0)
__device__ __forceinline__ void pv(f32x16* o, int vb, bf16x8 pa0, bf16x8 pa1, bf16x8 pa2, bf16x8 pa3) {
  #pragma unroll
  for (int d0 = 0; d0 < 2; ++d0) { s16x4 lo[4], hi[4];
    #pragma unroll
    for (int ks = 0; ks < 4; ++ks) {
      asm volatile("ds_read_b64_tr_b16 %0,%1 offset:%c2" : "=&v"(lo[ks]) : "v"(vb), "i"(d0 * 4096 + ks * 1024) : "memory");
      asm volatile("ds_read_b64_tr_b16 %0,%1 offset:%c2" : "=&v"(hi[ks]) : "v"(vb), "i"(d0 * 4096 + ks * 1024 + 512) : "memory"); }
    asm volatile("s_waitcnt lgkmcnt(0)" ::: "memory"); SBAR();
    #define PK(k) (bf16x8){lo[k][0], lo[k][1], lo[k][2], lo[k][3], hi[k][0], hi[k][1], hi[k][2], hi[k][3]}
    o[d0] = MFMA32(pa0, PK(0), o[d0]); o[d0] = MFMA32(pa1, PK(1), o[d0]); o[d0] = MFMA32(pa2, PK(2), o[d0]); o[d0] = MFMA32(pa3, PK(3), o[d0]);
    #undef PK
  }
}
#define ATTN_STORE16(p, v) (*(u32x4*)(p) = (v))

__device__ __forceinline__ void moba_unit(int b, int h, int qb, const bf16* Q, const bf16* __restrict__ K, const bf16* __restrict__ V, bf16* O, const float* __restrict__ ksum, char* shm) {
  const int tid = threadIdx.x, lane = tid & 63, r32 = lane & 31, hi = lane >> 5; const int wid = __builtin_amdgcn_readfirstlane(tid >> 6);
  const long rowbase = (long)b * 4096; const int q0 = qb * QB;
  const bf16* Qw = Q + (rowbase + q0 + wid * QBLK) * DM + h * 64;
  const bf16* Kh = K + rowbase * DM + h * 64, *Vh = V + rowbase * DM + h * 64;
  const unsigned lds0 = (unsigned)(uintptr_t)shm;
  float* wsf = (float*)(shm + LDS_WS) + wid * 64;
  const lds_cptr shm3 = (lds_cptr)shm;
  if (tid < 128) { const int j = tid >> 3, c = tid & 7; f32x4v a = {0.f, 0.f, 0.f, 0.f}, bq = {0.f, 0.f, 0.f, 0.f};
    if (j < qb) { const f32x4v* kp = (const f32x4v*)(ksum + ((size_t)(b * 16 + j) * 8 + h) * 64 + c * 8); a = kp[0]; bq = kp[1]; }
    const float v[8] = {a[0], a[1], a[2], a[3], bq[0], bq[1], bq[2], bq[3]}; unsigned hw[4], lw[4];
    #pragma unroll
    for (int i = 0; i < 4; ++i) { const unsigned hp = cvtpk_s(v[2 * i], v[2 * i + 1]); const float r0 = v[2 * i] - __uint_as_float(hp << 16), r1 = v[2 * i + 1] - __uint_as_float(hp & 0xffff0000u); hw[i] = hp; lw[i] = cvtpk_s(r0, r1); }
    *(__attribute__((address_space(3))) u32x4*)(shm3 + LDS_OST + c * 1024 + j * 16) = (u32x4){hw[0], hw[1], hw[2], hw[3]};
    *(__attribute__((address_space(3))) u32x4*)(shm3 + LDS_OST + 8192 + c * 1024 + j * 16) = (u32x4){lw[0], lw[1], lw[2], lw[3]}; }
  asm volatile("s_waitcnt vmcnt(0)" ::: "memory");
  const bf16* ksrc = Kh + (long)lane * DM + wid * 8;
  const bf16* vsrc = Vh + (long)(16 * (wid & 3) + (lane >> 2)) * DM + (wid >> 2) * 32 + (lane & 3) * 8;
  const unsigned kdst = lds0 + LDS_K + wid * 1024, vdst = lds0 + LDS_V + wid * 1024;
  #define DMA_K(t, slot) glds16(ksrc + (long)(t) * KVBLK * DM, (unsigned)__builtin_amdgcn_readfirstlane(kdst + (slot)))
  #define DMA_V(t, slot) glds16(vsrc + (long)(t) * KVBLK * DM, (unsigned)__builtin_amdgcn_readfirstlane(vdst + (slot)))
  const int vb0 = (int)(lds0 + LDS_V) + ((lane >> 4) & 1) * 32 + (lane & 3) * 8 + (4 * hi + ((lane & 15) >> 2)) * 64;
  bf16x8 kf[8];
  const lds_cptr kp0 = shm3 + LDS_K + hi * 1024 + r32 * 16; const lds_cptr vp0 = shm3 + LDS_V + ((lane >> 4) & 1) * 32 + (lane & 3) * 8 + (4 * hi + ((lane & 15) >> 2)) * 64;
  const int NT = (q0 + QB) / KVBLK;
  DMA_K(0, 0); DMA_V(0, 0); DMA_K(1, SLOTB);
  bf16x8 qr[4];
  #pragma unroll
  for (int d0 = 0; d0 < 4; ++d0) qr[d0] = *reinterpret_cast<const bf16x8*>(&Qw[(long)r32 * DM + d0 * 16 + hi * 8]);
  float l_reg = 0.f; f32x16 o[2]; o[0] = f32x16{}; o[1] = f32x16{};
  const int tq = q0 + wid * QBLK + r32, acp = (REV - tq) & 3;
  const int cbase = LDS_BT + acp * COPYB; int baddr = cbase + 4 * (REV - tq + 4 * hi - acp);
  DMA_K(2, 2 * SLOTB);
  WAIT_BAR(3);
  unsigned selmask;
  { f32x16 ga = f32x16{};
    #pragma unroll
    for (int d0 = 0; d0 < 4; ++d0) { const bf16x8 ah = *(const __attribute__((address_space(3))) bf16x8*)(shm3 + LDS_OST + hi * 1024 + r32 * 16 + d0 * 2048);
      const bf16x8 al = *(const __attribute__((address_space(3))) bf16x8*)(shm3 + LDS_OST + 8192 + hi * 1024 + r32 * 16 + d0 * 2048);
      ga = MFMA32(ah, qr[d0], ga); ga = MFMA32(al, qr[d0], ga); }
    float G[16];
    #pragma unroll
    for (int r = 0; r < 8; ++r) { auto rr = __builtin_amdgcn_permlane32_swap(__float_as_uint(ga[r]), __float_as_uint(ga[r]), false, false);
      G[(r & 3) + 8 * (r >> 2)] = __uint_as_float(rr[0]); G[(r & 3) + 8 * (r >> 2) + 4] = __uint_as_float(rr[1]); }
    #pragma unroll
    for (int j = 0; j < 16; ++j) if (j >= qb) G[j] = -INFINITY;
    selmask = 1u << qb;
    #pragma unroll
    for (int pass = 0; pass < 3; ++pass) { float best = -INFINITY; int bi = 16;
      #pragma unroll
      for (int j = 0; j < 16; ++j) if (G[j] > best) { best = G[j]; bi = j; }
      if (bi < 16) selmask |= 1u << bi;
      #pragma unroll
      for (int j = 0; j < 16; ++j) if (j == bi) G[j] = -INFINITY; }
  }
  f32x16 pA0, pA1, pB0, pB1;
  #define BEFF(T) (((selmask >> ((T) >> 2)) & 1u) ? (baddr + 256 * (T) > cbase ? baddr + 256 * (T) : cbase) : (LDS_BT + NEG_OFF))
  #define BRD1(X0, X1, eff, i) do { const f32x4v bv_ = ldsf4(shm3 + (eff) + ((i) < 4 ? 32 * (i) : 128 + 32 * ((i) - 4))); \
      if ((i) < 4) { X0[4 * (i)] = bv_[0]; X0[4 * (i) + 1] = bv_[1]; X0[4 * (i) + 2] = bv_[2]; X0[4 * (i) + 3] = bv_[3]; } \
      else { X1[4 * ((i) - 4)] = bv_[0]; X1[4 * ((i) - 4) + 1] = bv_[1]; X1[4 * ((i) - 4) + 2] = bv_[2]; X1[4 * ((i) - 4) + 3] = bv_[3]; } } while (0)
  { const int e0 = BEFF(0);
    #pragma unroll
    for (int i = 0; i < 8; ++i) BRD1(pA0, pA1, e0, i); }
  int sl_prev = 0, sl_cur = 0, sl_next = SLOTB;
  #define ROT() do { sl_prev = sl_cur; sl_cur = sl_next; sl_next = (sl_next == (NSLOT - 1) * SLOTB) ? 0 : sl_next + SLOTB; } while (0)
  { const char* kb = shm + LDS_K + hi * 1024 + r32 * 16;
    #pragma unroll
    for (int d0 = 0; d0 < 4; ++d0) { const bf16x8 b0 = *reinterpret_cast<const bf16x8*>(kb + d0 * 2048); const bf16x8 b1 = *reinterpret_cast<const bf16x8*>(kb + d0 * 2048 + 512);
      pA0 = MFMA32(b0, qr[d0], pA0); pA1 = MFMA32(b1, qr[d0], pA1); } }
  #pragma unroll
  for (int r = 0; r < 16; ++r) { pA0[r] = __builtin_amdgcn_exp2f(pA0[r]); pA1[r] = __builtin_amdgcn_exp2f(pA1[r]); }
  { const int e1 = BEFF(1);
    #pragma unroll
    for (int i = 0; i < 8; ++i) BRD1(pB0, pB1, e1, i); }
  WAIT_BAR(0);
  DMA_K(3, 0); DMA_V(1, SLOTB);
  ROT();
  kload8(kf, kp0 + sl_cur);
  WAIT_BAR(2);
  s16x4 vlo[8], vhi[8]; u32x4 pw0, pw1, pw2, pw3;
  #define PKW(P, B) cvtpk_s(P[B], P[B + 1])
  #define PAF(k) __builtin_bit_cast(bf16x8, pw##k)
  #define VFR(i) (bf16x8){vlo[i][0], vlo[i][1], vlo[i][2], vlo[i][3], vhi[i][0], vhi[i][1], vhi[i][2], vhi[i][3]}
  #define PIN(x) asm volatile("" : "+v"(x))
  #define GAPA(MF, A0, A1, A2, A3, W0, W1, PW) do { MF; sacc += A0; sacc += A1; sacc += A2; sacc += A3; PIN(sacc); W0; W1; PIN(PW); SBAR(); } while (0)
  #define EX(v) __builtin_amdgcn_exp2f(v)
  #define GAPB(MF, X, B) do { MF; X[B] = EX(X[B]); X[B + 1] = EX(X[B + 1]); X[B + 2] = EX(X[B + 2]); X[B + 3] = EX(X[B + 3]); PIN(X); SBAR(); } while (0)
  #define VRD(i) do { vlo[i] = vtr(vp_ + (((i) >> 2) * 4096 + ((i) & 3) * 1024)); vhi[i] = vtr(vp_ + (((i) >> 2) * 4096 + ((i) & 3) * 1024 + 512)); } while (0)
  #define KRD(G, j) do { if (G) { kload2(kf, kp0 + sl_next, j); SBAR(); } } while (0)
  #define BRD(G, i, X0, X1) do { if (G) { BRD1(X0, X1, eff_, i); } } while (0)
  #define STEP(C0, C1, P0, P1, t, GK, GV, GL) do { SBAR(); \
    const lds_cptr vp_ = vp0 + sl_prev; \
    VRD(0); SBAR(); float sacc = (P0[0] + P0[1]); \
    GAPA(C0 = MFMA32(kf[0], qr[0], C0), P0[2], P0[3], P0[4], P0[5],     pw0[0] = PKW(P0, 0), pw0[1] = PKW(P0, 2), pw0); \
    VRD(4); SBAR(); GAPA(C1 = MFMA32(kf[1], qr[0], C1), P0[6], P0[7], P0[8], P0[9],     pw0[2] = PKW(P0, 4), pw0[3] = PKW(P0, 6), pw0); \
    VRD(1); SBAR(); GAPA(C0 = MFMA32(kf[2], qr[1], C0),   P0[10], P0[11], P0[12], P0[13], pw1[0] = PKW(P0, 8), pw1[1] = PKW(P0, 10), pw1); \
    VRD(5); SBAR(); GAPA(C1 = MFMA32(kf[3], qr[1], C1),   P0[14], P0[15], P1[0], P1[1],   pw1[2] = PKW(P0, 12), pw1[3] = PKW(P0, 14), pw1); \
    VRD(2); SBAR(); GAPA(C0 = MFMA32(kf[4], qr[2], C0),   P1[2], P1[3], P1[4], P1[5],     pw2[0] = PKW(P1, 0), pw2[1] = PKW(P1, 2), pw2); \
    VRD(6); SBAR(); GAPA(C1 = MFMA32(kf[5], qr[2], C1),   P1[6], P1[7], P1[8], P1[9],     pw2[2] = PKW(P1, 4), pw2[3] = PKW(P1, 6), pw2); \
    VRD(3); SBAR(); GAPA(C0 = MFMA32(kf[6], qr[3], C0),   P1[10], P1[11], P1[12], P1[13], pw3[0] = PKW(P1, 8), pw3[1] = PKW(P1, 10), pw3); \
    VRD(7); SBAR(); GAPA(C1 = MFMA32(kf[7], qr[3], C1),   P1[14], P1[15], 0.f, 0.f,       pw3[2] = PKW(P1, 12), pw3[3] = PKW(P1, 14), pw3); \
    l_reg += sacc; \
    if (GK) { DMA_K((t) + 3, sl_cur); } if (GV) { DMA_V((t) + 1, sl_next); } \
    const int eff_ = BEFF((t) + 1); \
    SBAR(); \
    BRD(GL, 0, P0, P1); GAPB(o[0] = MFMA32(PAF(0), VFR(0), o[0]), C0, 0); \
    BRD(GL, 1, P0, P1); GAPB(o[1] = MFMA32(PAF(0), VFR(4), o[1]), C0, 4); \
    BRD(GL, 2, P0, P1); KRD(GL, 0); GAPB(o[0] = MFMA32(PAF(1), VFR(1), o[0]), C0, 8); \
    BRD(GL, 3, P0, P1); KRD(GL, 1); GAPB(o[1] = MFMA32(PAF(1), VFR(5), o[1]), C0, 12); \
    BRD(GL, 4, P0, P1); KRD(GL, 2); GAPB(o[0] = MFMA32(PAF(2), VFR(2), o[0]), C1, 0); \
    BRD(GL, 5, P0, P1); KRD(GL, 3); GAPB(o[1] = MFMA32(PAF(2), VFR(6), o[1]), C1, 4); \
    BRD(GL, 6, P0, P1); GAPB(o[0] = MFMA32(PAF(3), VFR(3), o[0]), C1, 8); \
    BRD(GL, 7, P0, P1); GAPB(o[1] = MFMA32(PAF(3), VFR(7), o[1]), C1, 12); \
    } while (0)
  int t = 1;
  for (; t + 5 < NT; t += 2) {
    STEP(pB0, pB1, pA0, pA1, t, true, true, true);     WAIT_BAR(2); ROT();
    STEP(pA0, pA1, pB0, pB1, t + 1, true, true, true); WAIT_BAR(2); ROT();
  }
  #define ENDW(tt) do { if ((tt) + 3 < NT) { WAIT_BAR(2); } else if ((tt) + 2 < NT) { WAIT_BAR(1); } else { WAIT_BAR(0); } } while (0)
  for (; t + 1 < NT; t += 2) {
    STEP(pB0, pB1, pA0, pA1, t, (t + 3 < NT), (t + 1 < NT), (t + 1 < NT));       ENDW(t);     ROT();
    STEP(pA0, pA1, pB0, pB1, t + 1, (t + 4 < NT), (t + 2 < NT), (t + 2 < NT));   ENDW(t + 1); ROT();
  }
  STEP(pB0, pB1, pA0, pA1, NT - 1, false, false, false);
  { float sacc = pB0[0] + pB0[1];
    #pragma unroll
    for (int r = 2; r < 16; ++r) sacc += pB0[r];
    #pragma unroll
    for (int r = 0; r < 16; ++r) sacc += pB1[r];
    l_reg += sacc;
    pw0 = (u32x4){PKW(pB0, 0), PKW(pB0, 2), PKW(pB0, 4), PKW(pB0, 6)}; pw1 = (u32x4){PKW(pB0, 8), PKW(pB0, 10), PKW(pB0, 12), PKW(pB0, 14)};
    pw2 = (u32x4){PKW(pB1, 0), PKW(pB1, 2), PKW(pB1, 4), PKW(pB1, 6)}; pw3 = (u32x4){PKW(pB1, 8), PKW(pB1, 10), PKW(pB1, 12), PKW(pB1, 14)};
    SBAR(); pv(o, vb0 + sl_cur, PAF(0), PAF(1), PAF(2), PAF(3)); }
  #undef STEP
  #undef BRD
  #undef KRD
  #undef VRD
  #undef GAPB
  #undef GAPA
  { auto rr = __builtin_amdgcn_permlane32_swap(__float_as_uint(l_reg), __float_as_uint(l_reg), false, false); l_reg = __uint_as_float(rr[0]) + __uint_as_float(rr[1]); }
  if (hi == 0) wsf[32 + r32] = l_reg; asm volatile("s_waitcnt lgkmcnt(0)" ::: "memory");
  float rli[16];
  #pragma unroll
  for (int r = 0; r < 16; ++r) rli[r] = __builtin_amdgcn_rcpf(wsf[32 + crow(r, hi)]);
  bf16* Ow = O + (rowbase + q0 + wid * QBLK) * DM + h * 64;
  { bf16* stg = (bf16*)(shm + LDS_OST) + wid * 2048;
    #pragma unroll
    for (int r = 0; r < 16; ++r) { const int orow = crow(r, hi);
      #pragma unroll
      for (int d0 = 0; d0 < 2; ++d0) stg[orow * 64 + d0 * 32 + r32] = (bf16)(cvtpk_s(o[d0][r] * rli[r], 0.f) & 0xffffu); }
    asm volatile("s_waitcnt lgkmcnt(0)" ::: "memory");
    #pragma unroll
    for (int i = 0; i < 4; ++i) { const int row = i * 8 + (lane >> 3), ch = lane & 7; const u32x4 v = *(const u32x4*)(stg + row * 64 + ch * 8); ATTN_STORE16(Ow + (long)row * DM + ch * 8, v); } }
  asm volatile("s_waitcnt lgkmcnt(0)\n\ts_barrier" ::: "memory");
  #undef DMA_K
  #undef DMA_V
  #undef ROT
  #undef BEFF
  #undef BRD1
  #undef ENDW
  #undef PKW
  #undef PAF
  #undef VFR
  #undef PIN
  #undef EX
}

__device__ __forceinline__ void sb_unit(int b, int h, int qb, const bf16* Q, const bf16* __restrict__ K, const bf16* __restrict__ V, bf16* O, char* shm) {
  const int tid = threadIdx.x, lane = tid & 63, r32 = lane & 31, hi = lane >> 5; const int wid = __builtin_amdgcn_readfirstlane(tid >> 6);
  const long rowbase = (long)b * 4096; const int q0 = qb * QB;
  const bf16* Qw = Q + (rowbase + q0 + wid * QBLK) * DM + h * 64;
  const bf16* Kh = K + rowbase * DM + h * 64, *Vh = V + rowbase * DM + h * 64;
  const unsigned lds0 = (unsigned)(uintptr_t)shm;
  const lds_cptr shm3 = (lds_cptr)shm;
  const bf16* ksrc = Kh + (long)lane * DM + wid * 8;
  const bf16* vsrc = Vh + (long)(16 * (wid & 3) + (lane >> 2)) * DM + (wid >> 2) * 32 + (lane & 3) * 8;
  const unsigned kdst = lds0 + LDS_K + wid * 1024, vdst = lds0 + LDS_V + wid * 1024;
  const int NT = (q0 + QB) / KVBLK;
  #define TT(u) (NT - 1 - (u))
  #define DMA_K(u, slot) glds16(ksrc + (long)TT(u) * KVBLK * DM, (unsigned)__builtin_amdgcn_readfirstlane(kdst + (slot)))
  #define DMA_V(u, slot) glds16(vsrc + (long)TT(u) * KVBLK * DM, (unsigned)__builtin_amdgcn_readfirstlane(vdst + (slot)))
  const int vb0 = (int)(lds0 + LDS_V) + ((lane >> 4) & 1) * 32 + (lane & 3) * 8 + (4 * hi + ((lane & 15) >> 2)) * 64;
  bf16x8 kf[8];
  const lds_cptr kp0 = shm3 + LDS_K + hi * 1024 + r32 * 16; const lds_cptr vp0 = shm3 + LDS_V + ((lane >> 4) & 1) * 32 + (lane & 3) * 8 + (4 * hi + ((lane & 15) >> 2)) * 64;
  DMA_K(0, 0); DMA_V(0, 0); DMA_K(1, SLOTB);
  bf16x8 qr[4];
  #pragma unroll
  for (int d0 = 0; d0 < 4; ++d0) qr[d0] = *reinterpret_cast<const bf16x8*>(&Qw[(long)r32 * DM + d0 * 16 + hi * 8]);
  f32x16 o[2]; o[0] = f32x16{}; o[1] = f32x16{};
  const int tq = q0 + wid * QBLK + r32;
  const f32x16 zero16 = f32x16{};
  DMA_K(2, 2 * SLOTB);
  WAIT_BAR(3);
  f32x16 pA0, pA1, pB0, pB1;
  float cc = 1.0f, pf[8], rD0, rD1, G[8];
  const bool hib = hi != 0;
  #define CMASK(X0, X1, T) do { const int lim_ = tq - 64 * (T) - 4 * hi; \
      _Pragma("unroll") for (int r_ = 0; r_ < 16; ++r_) { const int kq_ = (r_ & 3) + 8 * (r_ >> 2); if (kq_ >= lim_) X0[r_] = -INFINITY; if (kq_ + 32 >= lim_) X1[r_] = -INFINITY; } } while (0)
  #define EX(v) __builtin_amdgcn_exp2f(v)
  #define PIN(x) asm volatile("" : "+v"(x))
  #define EXPG(X, B, k) do { X[B] = EX(X[B]); X[B + 1] = EX(X[B + 1]); X[B + 2] = EX(X[B + 2]); X[B + 3] = EX(X[B + 3]); \
      float g_ = 1.0f + X[B]; g_ = __builtin_fmaf(g_, X[B + 1], g_); g_ = __builtin_fmaf(g_, X[B + 2], g_); g_ = __builtin_fmaf(g_, X[B + 3], g_); G[k] = g_; } while (0)
  #define TAIL() do { float Gp_[8], W_[8]; \
      _Pragma("unroll") for (int k_ = 0; k_ < 8; ++k_) { auto rr_ = __builtin_amdgcn_permlane32_swap(__float_as_uint(G[k_]), __float_as_uint(G[k_]), false, false); \
          const float lo_ = __uint_as_float(rr_[0]), hi_ = __uint_as_float(rr_[1]); W_[k_] = lo_ * hi_; Gp_[k_] = hib ? lo_ : 1.0f; } \
      { const float p1_ = W_[0], p2_ = p1_ * W_[1], p3_ = p2_ * W_[2]; rD0 = __builtin_amdgcn_rcpf(p3_ * W_[3]); pf[0] = Gp_[0]; pf[1] = p1_ * Gp_[1]; pf[2] = p2_ * Gp_[2]; pf[3] = p3_ * Gp_[3]; } \
      { const float p1_ = W_[4], p2_ = p1_ * W_[5], p3_ = p2_ * W_[6]; rD1 = __builtin_amdgcn_rcpf(p3_ * W_[7]); pf[4] = Gp_[4]; pf[5] = p1_ * Gp_[5]; pf[6] = p2_ * Gp_[6]; pf[7] = p3_ * Gp_[7]; } } while (0)
  #define SCAN(X, B, k, cx) do { float u_ = (cx) * pf[k]; const float a0_ = u_ * X[B]; u_ += a0_; const float a1_ = u_ * X[B + 1]; u_ += a1_; const float a2_ = u_ * X[B + 2]; u_ += a2_; const float a3_ = u_ * X[B + 3]; \
      X[B] = a0_; X[B + 1] = a1_; X[B + 2] = a2_; X[B + 3] = a3_; } while (0)
  pA0 = zero16; pA1 = zero16;
  int sl_prev = 0, sl_cur = 0, sl_next = SLOTB;
  #define ROT() do { sl_prev = sl_cur; sl_cur = sl_next; sl_next = (sl_next == (NSLOT - 1) * SLOTB) ? 0 : sl_next + SLOTB; } while (0)
  { const char* kb = shm + LDS_K + hi * 1024 + r32 * 16;
    #pragma unroll
    for (int d0 = 0; d0 < 4; ++d0) { const bf16x8 b0 = *reinterpret_cast<const bf16x8*>(kb + d0 * 2048); const bf16x8 b1 = *reinterpret_cast<const bf16x8*>(kb + d0 * 2048 + 512);
      pA0 = MFMA32(b0, qr[d0], pA0); pA1 = MFMA32(b1, qr[d0], pA1); } }
  CMASK(pA0, pA1, TT(0));
  EXPG(pA0, 0, 0); EXPG(pA0, 4, 1); EXPG(pA0, 8, 2); EXPG(pA0, 12, 3); EXPG(pA1, 0, 4); EXPG(pA1, 4, 5); EXPG(pA1, 8, 6); EXPG(pA1, 12, 7); TAIL();
  WAIT_BAR(0);
  DMA_K(3, 0); DMA_V(1, SLOTB);
  ROT();
  kload8(kf, kp0 + sl_cur);
  WAIT_BAR(2);
  s16x4 vlo[8], vhi[8]; u32x4 pw0, pw1, pw2, pw3;
  #define PKW(P, B) cvtpk_s(P[B], P[B + 1])
  #define PAF(k) __builtin_bit_cast(bf16x8, pw##k)
  #define VFR(i) (bf16x8){vlo[i][0], vlo[i][1], vlo[i][2], vlo[i][3], vhi[i][0], vhi[i][1], vhi[i][2], vhi[i][3]}
  #define GAPA(MF, SC, W0, W1, PW) do { MF; SC; W0; W1; PIN(PW); SBAR(); } while (0)
  #define GAPB(MF, X, B, k) do { MF; EXPG(X, B, k); PIN(X); PIN(G[k]); SBAR(); } while (0)
  #define VRD(i) do { vlo[i] = vtr(vp_ + (((i) >> 2) * 4096 + ((i) & 3) * 1024)); vhi[i] = vtr(vp_ + (((i) >> 2) * 4096 + ((i) & 3) * 1024 + 512)); } while (0)
  #define KRD(Gd, j) do { if (Gd) { kload2(kf, kp0 + sl_next, j); SBAR(); } } while (0)
  #define STEP(C0, C1, P0, P1, u, GK, GV, GL) do { SBAR(); \
    const lds_cptr vp_ = vp0 + sl_prev; \
    const float cm_ = cc * rD1, co_ = cm_ * rD0; \
    VRD(0); SBAR(); \
    GAPA(C0 = MFMA32(kf[0], qr[0], zero16), SCAN(P0, 0, 0, co_),  pw0[0] = PKW(P0, 0), pw0[1] = PKW(P0, 2), pw0); \
    VRD(4); SBAR(); GAPA(C1 = MFMA32(kf[1], qr[0], zero16), SCAN(P0, 4, 1, co_),  pw0[2] = PKW(P0, 4), pw0[3] = PKW(P0, 6), pw0); \
    VRD(1); SBAR(); GAPA(C0 = MFMA32(kf[2], qr[1], C0), SCAN(P0, 8, 2, co_),  pw1[0] = PKW(P0, 8), pw1[1] = PKW(P0, 10), pw1); \
    VRD(5); SBAR(); GAPA(C1 = MFMA32(kf[3], qr[1], C1), SCAN(P0, 12, 3, co_), pw1[2] = PKW(P0, 12), pw1[3] = PKW(P0, 14), pw1); \
    VRD(2); SBAR(); GAPA(C0 = MFMA32(kf[4], qr[2], C0), SCAN(P1, 0, 4, cm_),  pw2[0] = PKW(P1, 0), pw2[1] = PKW(P1, 2), pw2); \
    VRD(6); SBAR(); GAPA(C1 = MFMA32(kf[5], qr[2], C1), SCAN(P1, 4, 5, cm_),  pw2[2] = PKW(P1, 4), pw2[3] = PKW(P1, 6), pw2); \
    VRD(3); SBAR(); GAPA(C0 = MFMA32(kf[6], qr[3], C0), SCAN(P1, 8, 6, cm_),  pw3[0] = PKW(P1, 8), pw3[1] = PKW(P1, 10), pw3); \
    VRD(7); SBAR(); GAPA(C1 = MFMA32(kf[7], qr[3], C1), SCAN(P1, 12, 7, cm_), pw3[2] = PKW(P1, 12), pw3[3] = PKW(P1, 14), pw3); \
    cc = co_; \
    if (GK) { DMA_K((u) + 3, sl_cur); } if (GV) { DMA_V((u) + 1, sl_next); } \
    if ((u) < 4) { CMASK(C0, C1, TT(u)); } \
    SBAR(); \
    GAPB(o[0] = MFMA32(PAF(0), VFR(0), o[0]), C0, 0, 0); \
    GAPB(o[1] = MFMA32(PAF(0), VFR(4), o[1]), C0, 4, 1); \
    KRD(GL, 0); GAPB(o[0] = MFMA32(PAF(1), VFR(1), o[0]), C0, 8, 2); \
    KRD(GL, 1); GAPB(o[1] = MFMA32(PAF(1), VFR(5), o[1]), C0, 12, 3); \
    KRD(GL, 2); GAPB(o[0] = MFMA32(PAF(2), VFR(2), o[0]), C1, 0, 4); \
    KRD(GL, 3); GAPB(o[1] = MFMA32(PAF(2), VFR(6), o[1]), C1, 4, 5); \
    GAPB(o[0] = MFMA32(PAF(3), VFR(3), o[0]), C1, 8, 6); \
    GAPB(o[1] = MFMA32(PAF(3), VFR(7), o[1]), C1, 12, 7); \
    TAIL(); SBAR(); \
    } while (0)
  int t = 1;
  for (; t + 5 < NT; t += 2) {
    STEP(pB0, pB1, pA0, pA1, t, true, true, true);     WAIT_BAR(2); ROT();
    STEP(pA0, pA1, pB0, pB1, t + 1, true, true, true); WAIT_BAR(2); ROT();
  }
  #define ENDW(tt) do { if ((tt) + 3 < NT) { WAIT_BAR(2); } else if ((tt) + 2 < NT) { WAIT_BAR(1); } else { WAIT_BAR(0); } } while (0)
  for (; t + 1 < NT; t += 2) {
    STEP(pB0, pB1, pA0, pA1, t, (t + 3 < NT), (t + 1 < NT), (t + 1 < NT));       ENDW(t);     ROT();
    STEP(pA0, pA1, pB0, pB1, t + 1, (t + 4 < NT), (t + 2 < NT), (t + 2 < NT));   ENDW(t + 1); ROT();
  }
  STEP(pB0, pB1, pA0, pA1, NT - 1, false, false, false);
  { const float cm_ = cc * rD1, co_ = cm_ * rD0;
    SCAN(pB0, 0, 0, co_); SCAN(pB0, 4, 1, co_); SCAN(pB0, 8, 2, co_); SCAN(pB0, 12, 3, co_); SCAN(pB1, 0, 4, cm_); SCAN(pB1, 4, 5, cm_); SCAN(pB1, 8, 6, cm_); SCAN(pB1, 12, 7, cm_);
    pw0 = (u32x4){PKW(pB0, 0), PKW(pB0, 2), PKW(pB0, 4), PKW(pB0, 6)}; pw1 = (u32x4){PKW(pB0, 8), PKW(pB0, 10), PKW(pB0, 12), PKW(pB0, 14)};
    pw2 = (u32x4){PKW(pB1, 0), PKW(pB1, 2), PKW(pB1, 4), PKW(pB1, 6)}; pw3 = (u32x4){PKW(pB1, 8), PKW(pB1, 10), PKW(pB1, 12), PKW(pB1, 14)};
    SBAR(); pv(o, vb0 + sl_cur, PAF(0), PAF(1), PAF(2), PAF(3)); }
  bf16* Ow = O + (rowbase + q0 + wid * QBLK) * DM + h * 64;
  { bf16* stg = (bf16*)(shm + LDS_OST) + wid * 2048;
    #pragma unroll
    for (int r = 0; r < 16; ++r) { const int orow = crow(r, hi);
      #pragma unroll
      for (int d0 = 0; d0 < 2; ++d0) stg[orow * 64 + d0 * 32 + r32] = (bf16)(cvtpk_s(o[d0][r], 0.f) & 0xffffu); }
    asm volatile("s_waitcnt lgkmcnt(0)" ::: "memory");
    #pragma unroll
    for (int i = 0; i < 4; ++i) { const int row = i * 8 + (lane >> 3), ch = lane & 7; const u32x4 v = *(const u32x4*)(stg + row * 64 + ch * 8); ATTN_STORE16(Ow + (long)row * DM + ch * 8, v); } }
  asm volatile("s_waitcnt lgkmcnt(0)\n\ts_barrier" ::: "memory");
  #undef STEP
  #undef KRD
  #undef VRD
  #undef GAPB
  #undef GAPA
  #undef DMA_K
  #undef DMA_V
  #undef ROT
  #undef CMASK
  #undef ENDW
  #undef PKW
  #undef PAF
  #undef VFR
  #undef PIN
  #undef EX
  #undef EXPG
  #undef TAIL
  #undef SCAN
  #undef TT
}
}
struct Frame {
    LAS unsigned char* lds;
    volatile LAS unsigned* MISC;
    gu32* ctl;
    int tid, lane, wave;
    int vcu, G;
    const float *x, *c, *w_ada, *b_ada, *g_mix, *w_in, *g_q, *g_k, *rel_bias, *w_br_moba, *w_br_sb, *w_out, *g_ffn, *w_rg, *b_rg, *w_re, *b_re, *w_gate, *w_up, *w_down;
    float* out;
    float *mod, *biasT, *btg, *stats, *kmean;
    bf16 *wrt_hi, *wrt_lo;
    bf16 *Win_t, *Wbra_t, *Wbrb_t, *Wout_t, *Wgu_t, *Wd_t;
    bf16 *XN, *QA, *KA, *VA, *QB, *KB, *VB, *OA, *OB, *GA, *GB, *H;
    int* tokl; float* wl; unsigned* cnt; int* inv; float* winv; bf16* Y;
};
__device__ __forceinline__ float wave_sum(float v) {
#pragma unroll
    for (int o = 1; o < 64; o <<= 1) v += __shfl_xor(v, o);
    return v;
}
__device__ __forceinline__ int lane_zero() { int z; asm volatile("v_mov_b32 %0, 0" : "=v"(z)); return z; }

__device__ __forceinline__ void p0_transpose_item(const float* W, int K, int N, bf16* WT, int k0, int n0, int drow0, LAS float* scr, int lane) {
#pragma unroll 8
    for (int i = 0; i < 32; ++i) { const int kk = 2 * i + (lane >> 5); scr[kk * 33 + (lane & 31)] = W[(size_t)(k0 + kk) * N + n0 + (lane & 31)]; }
    LDS_WAIT(); asm volatile("" ::: "memory");
    const int c = lane & 7;
#pragma unroll
    for (int j = 0; j < 4; ++j) { const int n = (lane >> 3) + 8 * j; const LAS float* s = scr + (8 * c) * 33 + n;
        v4u o; o.x = pk2(s[0 * 33], s[1 * 33]); o.y = pk2(s[2 * 33], s[3 * 33]); o.z = pk2(s[4 * 33], s[5 * 33]); o.w = pk2(s[6 * 33], s[7 * 33]);
        *(GAS v4u*)(WT + (size_t)(drow0 + n) * K + k0 + 8 * c) = o; }
    LDS_WAIT(); asm volatile("" ::: "memory");
}

__device__ __forceinline__ void p0_prologue(Frame& F) {
    {
        LAS float* sc = (LAS float*)(F.lds + RING_OFF);
        LAS float* part = (LAS float*)(F.lds + RING_OFF + 32768);
        for (int i = F.tid; i < BATCH * D; i += NWAVES * 64) { const float v = F.c[i]; sc[i] = v * fsigmoid(v); }
        __syncthreads();
        for (int chunk = F.vcu; chunk < 256; chunk += F.G) {
            const int kp = F.tid / 24, cI = F.tid % 24;
            if (kp < 21) {
                float a[8];
#pragma unroll
                for (int b = 0; b < 8; ++b) a[b] = 0.f;
                const int k0 = kp * 49, k1 = (k0 + 49 < D) ? k0 + 49 : D;
                for (int k = k0; k < k1; ++k) { const float w = F.w_ada[(size_t)k * (NMOD * D) + chunk * 24 + cI];
#pragma unroll
                    for (int b = 0; b < 8; ++b) a[b] += sc[b * D + k] * w; }
#pragma unroll
                for (int b = 0; b < 8; ++b) part[(kp * 24 + cI) * 8 + b] = a[b];
            }
            __syncthreads();
            if (F.tid < 192) { const int cI2 = F.tid % 24, b = F.tid / 24; float s = 0.f;
                for (int kp2 = 0; kp2 < 21; ++kp2) s += part[(kp2 * 24 + cI2) * 8 + b];
                const int col = chunk * 24 + cI2; F.mod[(size_t)b * (NMOD * D) + col] = s + F.b_ada[col]; }
            __syncthreads();
        }
    }
    const int gw = F.vcu * NWAVES + F.wave, NGW = F.G * NWAVES;
    for (int i = gw * 64 + F.lane; i < NH * SEQ; i += NGW * 64) { const int h = i / SEQ, n = i % SEQ; int bk;
        if (n < 16) bk = n; else { const float nf = (float)n; int lg = 16 + (int)(logf(nf / 16.0f) / 4.1588830833596715f * 16.0f); bk = lg < 31 ? lg : 31; }
        F.biasT[i] = F.rel_bias[h * 32 + bk] * LOG2E; }
    for (int i = gw * 64 + F.lane; i < (NH + 1) * (attn::BT_BYTES / 4); i += NGW * 64) { const int h = i / (attn::BT_BYTES / 4), w = i % (attn::BT_BYTES / 4); float val = -INFINITY;
        if (w < 4 * attn::BT_LEN) { const int a = w / attn::BT_LEN, xx = w % attn::BT_LEN, ri = xx + a;
            if (h == NH) { if (ri < attn::REV) val = 0.f; }
            else if (ri <= attn::REV) { const int n = attn::REV - ri; int bk; if (n < 16) bk = n; else { const float nf = (float)n; int lg = 16 + (int)(logf(nf / 16.0f) / 4.1588830833596715f * 16.0f); bk = lg < 31 ? lg : 31; }
                val = F.rel_bias[h * 32 + bk] * LOG2E; } }
        F.btg[i] = val; }
    for (int i = gw * 64 + F.lane; i < 48 * D; i += NGW * 64) { const int col = i / D, k = i % D; float v = 0.f;
        if (col < NGRP) v = F.w_rg[(size_t)k * NGRP + col]; else if (col < NGRP + NEXP) v = F.w_re[(size_t)k * NEXP + col - NGRP];
        const unsigned hb = f2bf(v); const float r = v - __uint_as_float(hb << 16); F.wrt_hi[i] = (bf16)hb; F.wrt_lo[i] = (bf16)f2bf(r); }
    LAS float* scr = (LAS float*)(F.lds + RING_OFF + F.wave * 16384);
    constexpr int I_IN = (D / 64) * (INCOLS / 32), I_BR = (WATT / 64) * (D / 32), I_OUT = (D / 64) * (D / 32), I_G = NEXP * (D / 64) * (DEXP / 32), I_D = NEXP * (DEXP / 64) * (D / 32);
    constexpr int NITEMS = I_IN + 2 * I_BR + I_OUT + 2 * I_G + I_D;
    for (int it = gw; it < NITEMS; it += NGW) {
        int r = it;
        if (r < I_IN) { const int nblk = INCOLS / 32, kb = r / nblk, nb = r % nblk, n0 = 32 * nb, t = n0 & 255;
            const int p0 = 128 * ((t >> 5) & 1) + 32 * (t >> 6);
            p0_transpose_item(F.w_in, D, INCOLS, F.Win_t, 64 * kb, n0, (n0 - t) + p0, scr, F.lane); continue; } r -= I_IN;
        if (r < I_BR) { const int nblk = D / 32, kb = r / nblk, nb = r % nblk; p0_transpose_item(F.w_br_moba, WATT, D, F.Wbra_t, 64 * kb, 32 * nb, 32 * nb, scr, F.lane); continue; } r -= I_BR;
        if (r < I_BR) { const int nblk = D / 32, kb = r / nblk, nb = r % nblk; p0_transpose_item(F.w_br_sb, WATT, D, F.Wbrb_t, 64 * kb, 32 * nb, 32 * nb, scr, F.lane); continue; } r -= I_BR;
        if (r < I_OUT) { const int nblk = D / 32, kb = r / nblk, nb = r % nblk; p0_transpose_item(F.w_out, D, D, F.Wout_t, 64 * kb, 32 * nb, 32 * nb, scr, F.lane); continue; } r -= I_OUT;
        if (r < 2 * I_G) { const int up = r >= I_G; if (up) r -= I_G; constexpr int per = (D / 64) * (DEXP / 32); const int e = r / per, q = r % per, nblk = DEXP / 32, kb = q / nblk, nb = q % nblk, n0 = 32 * nb;
            p0_transpose_item((up ? F.w_up : F.w_gate) + (size_t)e * D * DEXP, D, DEXP, F.Wgu_t, 64 * kb, n0, e * 1024 + 256 * (n0 >> 7) + (up ? 128 : 0) + (n0 & 127), scr, F.lane); continue; } r -= 2 * I_G;
        { constexpr int per = (DEXP / 64) * (D / 32); const int e = r / per, q = r % per, nblk = D / 32, kb = q / nblk, nb = q % nblk;
            p0_transpose_item(F.w_down + (size_t)e * DEXP * D, DEXP, D, F.Wd_t, 64 * kb, 32 * nb, e * 1024 + 32 * nb, scr, F.lane); }
    }
}

__device__ __forceinline__ void p1_norm(Frame& F) {
    const int gw = F.vcu * NWAVES + F.wave, NGW = F.G * NWAVES;
    for (int m = gw; m < NTOK; m += NGW) {
        const int b = m / SEQ;
        const GAS f32x4* xr = (const GAS f32x4*)(F.x + (size_t)m * D) + F.lane;
        const GAS f32x4* gr = (const GAS f32x4*)F.g_mix + F.lane;
        const GAS f32x4* shr = (const GAS f32x4*)(F.mod + (size_t)b * (NMOD * D)) + F.lane;
        const GAS f32x4* scr = (const GAS f32x4*)(F.mod + (size_t)b * (NMOD * D) + D) + F.lane;
        f32x4 v[4]; float s = 0.f;
#pragma unroll
        for (int j = 0; j < 4; ++j) { v[j] = xr[64 * j]; s += (v[j].x * v[j].x + v[j].y * v[j].y) + (v[j].z * v[j].z + v[j].w * v[j].w); }
        const float rstd = __builtin_amdgcn_rsqf(wave_sum(s) * (1.f / D) + RMS_EPS);
        GAS unsigned long long* o8 = (GAS unsigned long long*)(F.XN + (size_t)m * D) + F.lane;
#pragma unroll
        for (int j = 0; j < 4; ++j) { const f32x4 g = gr[64 * j], sh = shr[64 * j], sc = scr[64 * j]; const f32x4 y = (v[j] * rstd * g) * (sc + 1.0f) + sh;
            o8[64 * j] = (unsigned long long)pk2(y.x, y.y) | ((unsigned long long)pk2(y.z, y.w) << 32); }
    }
}

__device__ __forceinline__ float dot64(const unsigned (&q)[32], const v4u (&k)[8]) {
    float a0 = 0.f, a1 = 0.f;
#pragma unroll
    for (int i = 0; i < 8; ++i) {
        a0 += bflo(q[4 * i]) * bflo(k[i].x) + bflo(q[4 * i + 1]) * bflo(k[i].y) + bflo(q[4 * i + 2]) * bflo(k[i].z) + bflo(q[4 * i + 3]) * bflo(k[i].w);
        a1 += bfhi(q[4 * i]) * bfhi(k[i].x) + bfhi(q[4 * i + 1]) * bfhi(k[i].y) + bfhi(q[4 * i + 2]) * bfhi(k[i].z) + bfhi(q[4 * i + 3]) * bfhi(k[i].w); }
    return a0 + a1;
}
#define LOADROW(dst, p) do { _Pragma("unroll") for (int i_ = 0; i_ < 8; ++i_) dst[i_] = ((const GAS v4u*)(p))[i_]; } while (0)
#define AXPY64(o, p, v) do { _Pragma("unroll") for (int i_ = 0; i_ < 8; ++i_) { \
    o[8 * i_ + 0] += p * bflo(v[i_].x); o[8 * i_ + 1] += p * bfhi(v[i_].x); o[8 * i_ + 2] += p * bflo(v[i_].y); o[8 * i_ + 3] += p * bfhi(v[i_].y); \
    o[8 * i_ + 4] += p * bflo(v[i_].z); o[8 * i_ + 5] += p * bfhi(v[i_].z); o[8 * i_ + 6] += p * bflo(v[i_].w); o[8 * i_ + 7] += p * bfhi(v[i_].w); } } while (0)
#define STOREO(ptr, o, sc) do { _Pragma("unroll") for (int i_ = 0; i_ < 8; ++i_) { v4u w_; w_.x = pk2(o[8 * i_] * sc, o[8 * i_ + 1] * sc); w_.y = pk2(o[8 * i_ + 2] * sc, o[8 * i_ + 3] * sc); \
    w_.z = pk2(o[8 * i_ + 4] * sc, o[8 * i_ + 5] * sc); w_.w = pk2(o[8 * i_ + 6] * sc, o[8 * i_ + 7] * sc); ((GAS v4u*)(ptr))[i_] = w_; } } while (0)

__device__ __forceinline__ void moba_naive_item(Frame& F, int item) {
    const int bh = item >> 6, ch = item & 63, b = bh >> 3, h = bh & 7, lz = lane_zero();
    const int t = ch * 64 + F.lane, own = ch >> 2, tl = t & 255;
    const size_t rowb = (size_t)b * SEQ;
    unsigned q[32]; { v4u t4[8]; LOADROW(t4, F.QA + (rowb + t) * WATT + h * HD);
#pragma unroll
        for (int i = 0; i < 8; ++i) { q[4 * i] = t4[i].x; q[4 * i + 1] = t4[i].y; q[4 * i + 2] = t4[i].z; q[4 * i + 3] = t4[i].w; } }
    float v0 = -INFINITY, v1 = -INFINITY, v2 = -INFINITY; int i0 = 0, i1 = 0, i2 = 0;
    for (int j = 0; j < own; ++j) {
        const GAS f32x4* km = (const GAS f32x4*)(F.kmean + ((size_t)(b * NBLK + j) * NH + h) * HD + lz);
        float g = 0.f;
#pragma unroll
        for (int i = 0; i < 16; ++i) { const f32x4 kv = km[i]; g += bflo(q[2 * i]) * kv.x + bfhi(q[2 * i]) * kv.y + bflo(q[2 * i + 1]) * kv.z + bfhi(q[2 * i + 1]) * kv.w; }
        if (g > v0) { v2 = v1; i2 = i1; v1 = v0; i1 = i0; v0 = g; i0 = j; } else if (g > v1) { v2 = v1; i2 = i1; v1 = g; i1 = j; } else if (g > v2) { v2 = g; i2 = j; }
    }
    float m = -INFINITY, l = 0.f; float o[64];
#pragma unroll
    for (int i = 0; i < 64; ++i) o[i] = 0.f;
    const float* bt = F.biasT + h * SEQ;
    const int nsel = own < 3 ? own : 3;
    for (int sl = 0; sl < nsel; ++sl) {
        const int blk = sl == 0 ? i0 : (sl == 1 ? i1 : i2);
        const bf16* kp = F.KA + (rowb + blk * MBLK) * WATT + h * HD; const bf16* vp = F.VA + (rowb + blk * MBLK) * WATT + h * HD;
        const int dist0 = t - blk * MBLK;
        for (int s = 0; s < MBLK; ++s) {
            v4u kk[8]; LOADROW(kk, kp + (size_t)s * WATT); const float sc = dot64(q, kk) + bt[dist0 - s];
            const float mn = fmaxf(m, sc), al = __builtin_amdgcn_exp2f(m - mn), p = __builtin_amdgcn_exp2f(sc - mn);
            l = l * al + p; m = mn;
#pragma unroll
            for (int i = 0; i < 64; ++i) o[i] *= al;
            v4u vv[8]; LOADROW(vv, vp + (size_t)s * WATT); AXPY64(o, p, vv);
        }
    }
    {
        const bf16* kp = F.KA + (rowb + own * MBLK) * WATT + h * HD + lz; const bf16* vp = F.VA + (rowb + own * MBLK) * WATT + h * HD + lz;
        const int smax = (ch & 3) * 64 + 63;
        for (int s = 0; s <= smax; ++s) {
            v4u kk[8]; LOADROW(kk, kp + (size_t)s * WATT); const int dist = tl - s; const float sc = dot64(q, kk) + bt[dist > 0 ? dist : 0];
            if (dist >= 0) {
                const float mn = fmaxf(m, sc), al = __builtin_amdgcn_exp2f(m - mn), p = __builtin_amdgcn_exp2f(sc - mn);
                l = l * al + p; m = mn;
#pragma unroll
                for (int i = 0; i < 64; ++i) o[i] *= al;
                v4u vv[8]; LOADROW(vv, vp + (size_t)s * WATT); AXPY64(o, p, vv);
            }
        }
    }
    const float rl = 1.0f / l;
    STOREO(F.OA + (rowb + t) * WATT + h * HD, o, rl);
}
__device__ __forceinline__ void sb_naive_item(Frame& F, int item) {
    const int bh = item >> 6, ch = item & 63, b = bh >> 3, h = bh & 7, lz = lane_zero();
    const int t = ch * 64 + F.lane;
    const size_t rowb = (size_t)b * SEQ;
    unsigned q[32]; { v4u t4[8]; LOADROW(t4, F.QB + (rowb + t) * WATT + h * HD);
#pragma unroll
        for (int i = 0; i < 8; ++i) { q[4 * i] = t4[i].x; q[4 * i + 1] = t4[i].y; q[4 * i + 2] = t4[i].z; q[4 * i + 3] = t4[i].w; } }
    float c = 1.0f; float o[64];
#pragma unroll
    for (int i = 0; i < 64; ++i) o[i] = 0.f;
    const bf16* kp = F.KB + rowb * WATT + h * HD + lz; const bf16* vp = F.VB + rowb * WATT + h * HD + lz;
    for (int s = ch * 64 + 62; s >= 0; --s) {
        v4u kk[8]; LOADROW(kk, kp + (size_t)s * WATT); const float e = __builtin_amdgcn_exp2f(dot64(q, kk)); const float r = 1.0f / (1.0f + e);
        if (s < t) { const float a = e * r * c; c *= r; v4u vv[8]; LOADROW(vv, vp + (size_t)s * WATT); AXPY64(o, a, vv); }
    }
    STOREO(F.OB + (rowb + t) * WATT + h * HD, o, 1.0f);
}
__device__ __forceinline__ void p3_sb_naive(Frame& F) {
    const int gw = F.vcu * NWAVES + F.wave, NGW = F.G * NWAVES;
    for (int p = gw; p < 2048; p += NGW) { const int bh = p >> 5, j = p & 31;
        sb_naive_item(F, bh * 64 + j); sb_naive_item(F, bh * 64 + 63 - j); }
}
__device__ __forceinline__ void p3_moba_naive(Frame& F) {
    const int gw = F.vcu * NWAVES + F.wave, NGW = F.G * NWAVES;
    for (int p = gw; p < 2048; p += NGW) { const int bh = p >> 5, j = p & 31;
        moba_naive_item(F, bh * 64 + j); moba_naive_item(F, bh * 64 + 63 - j); }
}
__device__ __forceinline__ bool attn_deal(const Frame& F, int i, int& bh, int& qb) {
    if (F.G == 256) { if (i >= 4) return false; const int s = F.vcu & 3; bh = F.vcu >> 2; qb = (i == 0) ? s : (i == 1) ? 7 - s : (i == 2) ? 8 + s : 15 - s; return true; }
    const int u = F.vcu + i * F.G; if (u >= 1024) return false; bh = u >> 4; qb = u & 15; return true;
}
__device__ __forceinline__ void p3_sb(Frame& F) {
    __syncthreads();
    for (int k = F.tid; k < attn::BT_BYTES / 16; k += NWAVES * 64) *(LAS v4u*)(F.lds + RING_OFF + attn::LDS_BT + 16 * k) = *(const GAS v4u*)(F.btg + (size_t)NH * (attn::BT_BYTES / 4) + 4 * k);
    __syncthreads();
    int bh, qb;
    for (int i = 0; attn_deal(F, i, bh, qb); ++i) attn::sb_unit(bh >> 3, bh & 7, qb, F.QB, F.KB, F.VB, F.OB, (char*)F.lds + RING_OFF);
}
__device__ __forceinline__ void p3_moba(Frame& F) {
    int bh, qb, curh = -1;
    for (int i = 0; attn_deal(F, i, bh, qb); ++i) { const int b = bh >> 3, h = bh & 7;
        if (h != curh) { __syncthreads();
            for (int k = F.tid; k < attn::BT_BYTES / 16; k += NWAVES * 64) *(LAS v4u*)(F.lds + RING_OFF + attn::LDS_BT + 16 * k) = *(const GAS v4u*)(F.btg + (size_t)h * (attn::BT_BYTES / 4) + 4 * k);
            __syncthreads(); curh = h; }
        attn::moba_unit(b, h, qb, F.QA, F.KA, F.VA, F.OA, F.kmean, (char*)F.lds + RING_OFF); }
}
__device__ __forceinline__ void p6_route(Frame& F) {
    const int gw = F.vcu * NWAVES + F.wave, NGW = F.G * NWAVES;
    for (int m = gw; m < NTOK; m += NGW) {
        const int b = m / SEQ;
        const GAS f32x4* xr = (const GAS f32x4*)(F.out + (size_t)m * D) + F.lane;
        const GAS f32x4* gr = (const GAS f32x4*)F.g_ffn + F.lane;
        const GAS f32x4* shr = (const GAS f32x4*)(F.mod + (size_t)b * (NMOD * D) + 3 * D) + F.lane;
        const GAS f32x4* scr = (const GAS f32x4*)(F.mod + (size_t)b * (NMOD * D) + 4 * D) + F.lane;
        float ss = 0.f; { const GAS f32x4* sp = (const GAS f32x4*)(F.stats + (size_t)m * 16);
#pragma unroll
            for (int j = 0; j < 4; ++j) { const f32x4 s4 = sp[j]; ss += (s4.x + s4.y) + (s4.z + s4.w); } }
        const float rstd = __builtin_amdgcn_rsqf(ss * (1.f / D) + RMS_EPS);
        f32x4 y[4];
        GAS unsigned long long* o8 = (GAS unsigned long long*)(F.XN + (size_t)m * D) + F.lane;
#pragma unroll
        for (int j = 0; j < 4; ++j) { const f32x4 v = xr[64 * j], g = gr[64 * j], sh = shr[64 * j], sc = scr[64 * j]; y[j] = (v * rstd * g) * (sc + 1.0f) + sh;
            o8[64 * j] = (unsigned long long)pk2(y[j].x, y[j].y) | ((unsigned long long)pk2(y[j].z, y[j].w) << 32); }
        float gl[4] = {0.f, 0.f, 0.f, 0.f};
#pragma unroll
        for (int j = 0; j < 4; ++j) { const GAS f32x4* wp = (const GAS f32x4*)(F.w_rg + (size_t)(4 * F.lane + 256 * j) * NGRP);
#pragma unroll
            for (int e = 0; e < 4; ++e) { const f32x4 w = wp[e]; const float yv = y[j][e]; gl[0] += yv * w.x; gl[1] += yv * w.y; gl[2] += yv * w.z; gl[3] += yv * w.w; } }
#pragma unroll
        for (int g = 0; g < 4; ++g) gl[g] = wave_sum(gl[g]) + F.b_rg[g];
        int gi = 0; float gm = gl[0];
#pragma unroll
        for (int g = 1; g < 4; ++g) if (gl[g] > gm) { gm = gl[g]; gi = g; }
        float den = 0.f;
#pragma unroll
        for (int g = 0; g < 4; ++g) den += __expf(gl[g] - gm);
        const float gwt = 1.0f / den;
        float el[8] = {0.f, 0.f, 0.f, 0.f, 0.f, 0.f, 0.f, 0.f};
#pragma unroll
        for (int j = 0; j < 4; ++j)
#pragma unroll
            for (int e = 0; e < 4; ++e) { const GAS f32x4* wp = (const GAS f32x4*)(F.w_re + (size_t)(4 * F.lane + 256 * j + e) * NEXP + gi * EPG); const f32x4 w0 = wp[0], w1 = wp[1]; const float yv = y[j][e];
                el[0] += yv * w0.x; el[1] += yv * w0.y; el[2] += yv * w0.z; el[3] += yv * w0.w; el[4] += yv * w1.x; el[5] += yv * w1.y; el[6] += yv * w1.z; el[7] += yv * w1.w; }
#pragma unroll
        for (int k = 0; k < 8; ++k) el[k] = wave_sum(el[k]) + F.b_re[gi * EPG + k];
        int k1 = 0; float t1 = el[0];
#pragma unroll
        for (int k = 1; k < 8; ++k) if (el[k] > t1) { t1 = el[k]; k1 = k; }
        int k2 = -1; float t2 = -INFINITY;
#pragma unroll
        for (int k = 0; k < 8; ++k) if (k != k1 && el[k] > t2) { t2 = el[k]; k2 = k; }
        const float ex = __expf(t2 - t1); const float w1v = gwt / (1.0f + ex), w2v = gwt * ex / (1.0f + ex);
        if (F.lane < 2) { const int e = gi * EPG + (F.lane == 0 ? k1 : k2); const float w = F.lane == 0 ? w1v : w2v;
            const unsigned pos = __hip_atomic_fetch_add(F.cnt + (F.lane * NEXP + e) * 64, 1u, __ATOMIC_RELAXED, __HIP_MEMORY_SCOPE_AGENT);
            F.tokl[(size_t)(F.lane * NEXP + e) * LCAP + pos] = m; F.wl[(size_t)(F.lane * NEXP + e) * LCAP + pos] = w; }
    }
}
__device__ __forceinline__ void p6_route_mfma(Frame& F) {
    typedef float f32x4v __attribute__((ext_vector_type(4)));
    const int NGW = F.G * NWAVES; const int r = F.lane & 15, kg = F.lane >> 4;
    LAS float* gsT = (LAS float*)(F.lds + RING_OFF);
    LAS float* shT = (LAS float*)(F.lds + RING_OFF + 4096);
    LAS float* lg = (LAS float*)(F.lds + RING_OFF + 8192) + F.wave * (16 * 48);
    for (int rb0 = F.vcu * NWAVES; rb0 < NTOK / 16; rb0 += NGW) {
        const int rb = rb0 + F.wave; const int row0 = rb * 16, b = (rb0 * 16) / SEQ;
        __syncthreads();
        for (int i = F.tid; i < D; i += NWAVES * 64) { gsT[i] = F.g_ffn[i] * (1.0f + F.mod[(size_t)b * (NMOD * D) + 4 * D + i]); shT[i] = F.mod[(size_t)b * (NMOD * D) + 3 * D + i]; }
        __syncthreads();
        const int row = row0 + r;
        float ss = 0.f; { const GAS f32x4* sp = (const GAS f32x4*)(F.stats + (size_t)row * 16);
#pragma unroll
            for (int j = 0; j < 4; ++j) { const f32x4 s4 = sp[j]; ss += (s4.x + s4.y) + (s4.z + s4.w); } }
        const float rstd = __builtin_amdgcn_rsqf(ss * (1.f / D) + RMS_EPS);
        f32x4v acc[3] = {{0.f, 0.f, 0.f, 0.f}, {0.f, 0.f, 0.f, 0.f}, {0.f, 0.f, 0.f, 0.f}};
        const float* xrow = F.out + (size_t)row * D + 8 * kg; bf16* orow = F.XN + (size_t)row * D + 8 * kg;
        const bf16* whp = F.wrt_hi + (size_t)r * D + 8 * kg; const bf16* wlp = F.wrt_lo + (size_t)r * D + 8 * kg;
#pragma unroll 4
        for (int ks = 0; ks < 32; ++ks) { const int k = 32 * ks;
            const f32x4 xa = *(const GAS f32x4*)(xrow + k), xb = *(const GAS f32x4*)(xrow + k + 4);
            const f32x4 ga = *(const LAS f32x4*)(gsT + k + 8 * kg), gb = *(const LAS f32x4*)(gsT + k + 8 * kg + 4), sa = *(const LAS f32x4*)(shT + k + 8 * kg), sb = *(const LAS f32x4*)(shT + k + 8 * kg + 4);
            const f32x4 ha = (xa * rstd) * ga + sa, hb = (xb * rstd) * gb + sb;
            v4u hw; hw.x = pk2(ha.x, ha.y); hw.y = pk2(ha.z, ha.w); hw.z = pk2(hb.x, hb.y); hw.w = pk2(hb.z, hb.w);
            *(GAS v4u*)(orow + k) = hw;
            v4u lw; lw.x = pk2(ha.x - bflo(hw.x), ha.y - bfhi(hw.x)); lw.y = pk2(ha.z - bflo(hw.y), ha.w - bfhi(hw.y)); lw.z = pk2(hb.x - bflo(hw.z), hb.y - bfhi(hw.z)); lw.w = pk2(hb.z - bflo(hw.w), hb.w - bfhi(hw.w));
            const bf16x8 Ah = __builtin_bit_cast(bf16x8, hw), Al = __builtin_bit_cast(bf16x8, lw);
#pragma unroll
            for (int n = 0; n < 3; ++n) { const bf16x8 Bh = *(const GAS bf16x8*)(whp + (size_t)n * 16 * D + k), Bl = *(const GAS bf16x8*)(wlp + (size_t)n * 16 * D + k);
                acc[n] = __builtin_amdgcn_mfma_f32_16x16x32_bf16(Ah, Bh, acc[n], 0, 0, 0); acc[n] = __builtin_amdgcn_mfma_f32_16x16x32_bf16(Al, Bh, acc[n], 0, 0, 0); acc[n] = __builtin_amdgcn_mfma_f32_16x16x32_bf16(Ah, Bl, acc[n], 0, 0, 0); }
        }
#pragma unroll
        for (int n = 0; n < 3; ++n)
#pragma unroll
            for (int e = 0; e < 4; ++e) lg[(4 * kg + e) * 48 + 16 * n + r] = acc[n][e];
        LDS_WAIT(); asm volatile("" ::: "memory");
        const LAS f32x4* lr = (const LAS f32x4*)(lg + r * 48);
        const f32x4 g4 = lr[0]; float gl[4] = {g4.x + F.b_rg[0], g4.y + F.b_rg[1], g4.z + F.b_rg[2], g4.w + F.b_rg[3]};
        int gi = 0; float gm = gl[0];
#pragma unroll
        for (int g = 1; g < 4; ++g) if (gl[g] > gm) { gm = gl[g]; gi = g; }
        float den = 0.f;
#pragma unroll
        for (int g = 0; g < 4; ++g) den += __expf(gl[g] - gm);
        const float gwt = 1.0f / den;
        const LAS f32x4* er = (const LAS f32x4*)(lg + r * 48 + 4 + 8 * gi); const f32x4 e0 = er[0], e1 = er[1];
        const GAS f32x4* bp = (const GAS f32x4*)(F.b_re + gi * EPG); const f32x4 b0 = bp[0], b1 = bp[1];
        const float el[8] = {e0.x + b0.x, e0.y + b0.y, e0.z + b0.z, e0.w + b0.w, e1.x + b1.x, e1.y + b1.y, e1.z + b1.z, e1.w + b1.w};
        int k1 = 0; float t1 = el[0];
#pragma unroll
        for (int k = 1; k < 8; ++k) if (el[k] > t1) { t1 = el[k]; k1 = k; }
        int k2 = -1; float t2 = -INFINITY;
#pragma unroll
        for (int k = 0; k < 8; ++k) if (k != k1 && el[k] > t2) { t2 = el[k]; k2 = k; }
        const float ex = __expf(t2 - t1); const float w1v = gwt / (1.0f + ex), w2v = gwt * ex / (1.0f + ex);
        if (F.lane < 32) { const int slot = F.lane >> 4; const int e = gi * EPG + (slot == 0 ? k1 : k2); const float w = slot == 0 ? w1v : w2v;
            const unsigned pos = __hip_atomic_fetch_add(F.cnt + (slot * NEXP + e) * 64, 1u, __ATOMIC_RELAXED, __HIP_MEMORY_SCOPE_AGENT);
            F.tokl[(size_t)(slot * NEXP + e) * LCAP + pos] = row; F.inv[row * 2 + slot] = (e << 16) | (int)pos; F.winv[row * 2 + slot] = w; }
        LDS_WAIT(); asm volatile("" ::: "memory");
    }
}
__device__ __forceinline__ void moe_tables(Frame& F) {
    LAS int* T = (LAS int*)(F.lds + TAB_OFF);
    if (F.tid < 64) T[F.tid] = (int)__hip_atomic_load(F.cnt + F.tid * 64, RLX_AGENT);
    __syncthreads();
    if (F.tid == 0) { int pa = 0, hs = 0, p0 = 0, p1 = 0;
        for (int e = 0; e < NEXP; ++e) { const int c0 = T[e], c1 = T[32 + e], ta = (c0 + c1 + 255) >> 8;
            T[64 + e] = pa; T[128 + e] = hs; T[192 + e] = p0; T[256 + e] = p1; pa += ta; hs += ta * 256; p0 += (c0 + 255) >> 8; p1 += (c1 + 255) >> 8; }
        T[64 + 32] = pa; T[128 + 32] = hs; T[192 + 32] = p0; T[256 + 32] = p1; }
    __syncthreads();
}

__device__ __forceinline__ void p9_combine(Frame& F) {
    const LAS int* T = (const LAS int*)(F.lds + TAB_OFF);
    const int gw = F.vcu * NWAVES + F.wave, NGW = F.G * NWAVES;
    for (int rb = gw; rb < NTOK / 16; rb += NGW) {
        const int row0 = rb * 16, b = row0 / SEQ;
        int rr = 0; float ww = 0.f;
        if (F.lane < 32) { const int iv = F.inv[2 * row0 + F.lane]; ww = F.winv[2 * row0 + F.lane]; const int e = iv >> 16; rr = T[128 + e] + ((F.lane & 1) ? T[e] : 0) + (iv & 0xffff); }
        const GAS f32x4* gr = (const GAS f32x4*)(F.mod + (size_t)b * (NMOD * D) + 5 * D) + F.lane;
        f32x4 gv[4];
#pragma unroll
        for (int j = 0; j < 4; ++j) gv[j] = gr[64 * j];
        for (int i0 = 0; i0 < 16; i0 += 4) {
            f32x4 xv[4][4]; v2u a[4][4], c[4][4]; float w0[4], w1[4];
#pragma unroll
            for (int q = 0; q < 4; ++q) { const int i = i0 + q; const int r0 = __shfl(rr, 2 * i), r1 = __shfl(rr, 2 * i + 1); w0[q] = __shfl(ww, 2 * i); w1[q] = __shfl(ww, 2 * i + 1);
                const GAS f32x4* xr = (const GAS f32x4*)(F.out + (size_t)(row0 + i) * D) + F.lane;
                const GAS v2u* y0 = (const GAS v2u*)(F.Y + (size_t)r0 * D) + F.lane; const GAS v2u* y1 = (const GAS v2u*)(F.Y + (size_t)r1 * D) + F.lane;
#pragma unroll
                for (int j = 0; j < 4; ++j) { xv[q][j] = xr[64 * j]; a[q][j] = y0[64 * j]; c[q][j] = y1[64 * j]; } }
#pragma unroll
            for (int q = 0; q < 4; ++q) { GAS f32x4* xr = (GAS f32x4*)(F.out + (size_t)(row0 + i0 + q) * D) + F.lane;
#pragma unroll
                for (int j = 0; j < 4; ++j) { f32x4 y; y.x = w0[q] * bflo(a[q][j].x) + w1[q] * bflo(c[q][j].x); y.y = w0[q] * bfhi(a[q][j].x) + w1[q] * bfhi(c[q][j].x); y.z = w0[q] * bflo(a[q][j].y) + w1[q] * bflo(c[q][j].y); y.w = w0[q] * bfhi(a[q][j].y) + w1[q] * bfhi(c[q][j].y);
                    xr[64 * j] = xv[q][j] + gv[j] * y; } }
        }
    }
}
#ifndef REP_PHASE
#define REP_PHASE -1
#endif
#ifndef STG_P2
#define STG_P2 0
#endif
#ifndef STG_P4
#define STG_P4 0
#endif
#ifndef STG_P5
#define STG_P5 0
#endif
#ifndef STG_P8
#define STG_P8 0
#endif
__device__ __forceinline__ void stagger_wait(int us_x_group) {
    if (us_x_group > 0) { const unsigned long long t0 = __builtin_amdgcn_s_memrealtime(); const unsigned long long ticks = (unsigned long long)us_x_group * 100ull;
        while (__builtin_amdgcn_s_memrealtime() - t0 < ticks) __builtin_amdgcn_s_sleep(16); }
}
#ifndef MK_N_LAUNCHES
#define MK_N_LAUNCHES 1
#endif
constexpr int N_PHASES = 10;
constexpr int N_LAUNCHES = MK_N_LAUNCHES;
static_assert(N_LAUNCHES == 1 || N_LAUNCHES == N_PHASES, "MK_N_LAUNCHES is 1 or N_PHASES");
struct Args { const float* in[20]; float* out; unsigned char* ws; int ph_lo, ph_hi; };
__global__ void __launch_bounds__(NWAVES * 64, 2) fwd(Args args) {
    extern __shared__ __attribute__((aligned(16))) unsigned char lds[];
    Frame F;
    F.lds = (LAS unsigned char*)lds;
    F.MISC = (volatile LAS unsigned*)(F.lds + MISC_OFF);
    F.tid = threadIdx.x; F.lane = F.tid & 63; F.wave = __builtin_amdgcn_readfirstlane(F.tid >> 6);
    F.G = gridDim.x; { const int bx = blockIdx.x; F.vcu = (F.G % 8 == 0) ? (bx % 8) * (F.G / 8) + bx / 8 : bx; }
    unsigned char* ws = args.ws;
    F.ctl = (gu32*)(ws + WS_CTL);
    F.x = args.in[0]; F.c = args.in[1]; F.w_ada = args.in[2]; F.b_ada = args.in[3]; F.g_mix = args.in[4]; F.w_in = args.in[5]; F.g_q = args.in[6]; F.g_k = args.in[7]; F.rel_bias = args.in[8];
    F.w_br_moba = args.in[9]; F.w_br_sb = args.in[10]; F.w_out = args.in[11]; F.g_ffn = args.in[12]; F.w_rg = args.in[13]; F.b_rg = args.in[14]; F.w_re = args.in[15]; F.b_re = args.in[16];
    F.w_gate = args.in[17]; F.w_up = args.in[18]; F.w_down = args.in[19]; F.out = args.out;
    F.mod = (float*)(ws + WS_MOD); F.biasT = (float*)(ws + WS_BIAS); F.btg = (float*)(ws + WS_BIAS + 128 * 1024); F.wrt_hi = (bf16*)(ws + WS_MOD + 640 * 1024); F.wrt_lo = (bf16*)(ws + WS_MOD + 736 * 1024); F.stats = (float*)(ws + WS_STATS); F.kmean = (float*)(ws + WS_CTL) + CW_KMEAN;
    F.Win_t = (bf16*)(ws + WS_WIN); F.Wbra_t = (bf16*)(ws + WS_WBRA); F.Wbrb_t = (bf16*)(ws + WS_WBRB); F.Wout_t = (bf16*)(ws + WS_WOUT); F.Wgu_t = (bf16*)(ws + WS_WGU); F.Wd_t = (bf16*)(ws + WS_WD);
    F.XN = (bf16*)(ws + WS_XN); F.QA = (bf16*)(ws + WS_QA); F.KA = (bf16*)(ws + WS_KA); F.VA = (bf16*)(ws + WS_VA); F.QB = (bf16*)(ws + WS_QB); F.KB = (bf16*)(ws + WS_KB); F.VB = (bf16*)(ws + WS_VB);
    F.OA = (bf16*)(ws + WS_XN); F.OB = (bf16*)(ws + WS_XN + 32 * MiB); F.GA = (bf16*)(ws + WS_GA); F.GB = (bf16*)(ws + WS_GB); F.H = (bf16*)(ws + WS_H);
    F.inv = (int*)(ws + WS_INV); F.winv = (float*)(ws + WS_WINV); F.Y = (bf16*)(ws + WS_Y); F.tokl = (int*)(ws + WS_TOKL); F.wl = (float*)(ws + WS_WL); F.cnt = (unsigned*)(ws + WS_CTL) + CW_CNT;
    for (int u = F.tid; u < (LDS_BYTES - LDSCTL_OFF) / 4; u += NWAVES * 64) ((LAS unsigned*)(F.lds + LDSCTL_OFF))[u] = 0u;
    __syncthreads();
    XcdBarrier bar; bar.bar = (unsigned*)(F.ctl + CW_BAR); bar.x = 0; bar.st = nullptr;
    if (N_LAUNCHES == 1) bar = xcd_barrier_post((unsigned*)(F.ctl + CW_BAR), F.MISC + 8);
#define GRID_BAR() do { if (N_LAUNCHES == 1) { xcd_barrier(bar); } } while (0)
    const int lo = args.ph_lo, hi = args.ph_hi;
#define IN(k) (lo <= (k) && (k) < hi)
#define BOTH(k) (IN(k) && IN((k) + 1))

    if (IN(0)) { p0_prologue(F); if (REP_PHASE == 0) { GRID_BAR(); p0_prologue(F); } if (BOTH(0)) GRID_BAR(); }
    if (IN(1)) { p1_norm(F); if (REP_PHASE == 1) { GRID_BAR(); p1_norm(F); } if (BOTH(1)) GRID_BAR(); }
    if (IN(2)) {
        stagger_wait(STG_P2 * (int)((blockIdx.x >> 3) & 3)); __syncthreads();
        pg8::Gemm g{F.XN, F.Win_t, D}; pg8::DenseOrder S; S.init(NTOK, INCOLS, F.G, (int)blockIdx.x);
        pg8::EpiProj E{F.QA, F.GA, F.GB, F.g_q, F.g_k, F.kmean};
        pg8::gemm_phase<pg8::EpiProj, pg8::DenseOrder, false>(F.lds + RING_OFF, g, S, E);
        if (REP_PHASE == 2) { GRID_BAR(); pg8::gemm_phase<pg8::EpiProj, pg8::DenseOrder, false>(F.lds + RING_OFF, g, S, E); }
        if (BOTH(2)) GRID_BAR();
    }
    if (IN(3)) {
#if defined(MOBA_NAIVE)
        p3_moba_naive(F);
#else
        { int nrep = (REP_PHASE == 30) ? 2 : 1; asm volatile("" : "+s"(nrep));
          for (int rep = 0; rep < nrep; ++rep) { __syncthreads(); p3_moba(F); if (REP_PHASE == 30 && rep == 0) GRID_BAR(); } }
#endif
#if defined(SB_NAIVE)
        p3_sb_naive(F);
#else
        p3_sb(F);
        if (REP_PHASE == 31) { GRID_BAR(); p3_sb(F); }
#endif
        if (BOTH(3)) GRID_BAR(); }
    if (IN(4)) {
        stagger_wait(STG_P4 * (int)((blockIdx.x >> 3) & 3)); __syncthreads();
        { pg8::Gemm g{F.OA, F.Wbra_t, WATT}; pg8::DenseOrder S; S.init(NTOK, D, F.G, (int)blockIdx.x);
          pg8::EpiBranch<0> E{F.GA, nullptr};
          pg8::gemm_phase<pg8::EpiBranch<0>, pg8::DenseOrder, false>(F.lds + RING_OFF, g, S, E); }
        { pg8::Gemm g{F.OB, F.Wbrb_t, WATT}; pg8::DenseOrder S; S.init(NTOK, D, F.G, (int)blockIdx.x);
          pg8::EpiBranch<1> E{F.GB, F.GA};
          pg8::gemm_phase<pg8::EpiBranch<1>, pg8::DenseOrder, false>(F.lds + RING_OFF, g, S, E); }
        if (REP_PHASE == 4) { GRID_BAR();
          { pg8::Gemm g{F.OA, F.Wbra_t, WATT}; pg8::DenseOrder S; S.init(NTOK, D, F.G, (int)blockIdx.x); pg8::EpiBranch<0> E{F.H, nullptr};
            pg8::gemm_phase<pg8::EpiBranch<0>, pg8::DenseOrder, false>(F.lds + RING_OFF, g, S, E); }
          { pg8::Gemm g{F.OB, F.Wbrb_t, WATT}; pg8::DenseOrder S; S.init(NTOK, D, F.G, (int)blockIdx.x); pg8::EpiBranch<1> E{F.H, F.GA};
            pg8::gemm_phase<pg8::EpiBranch<1>, pg8::DenseOrder, false>(F.lds + RING_OFF, g, S, E); } }
        if (BOTH(4)) GRID_BAR();
    }
    if (IN(5)) {
        stagger_wait(STG_P5 * (int)((blockIdx.x >> 3) & 3)); __syncthreads();
        pg8::Gemm g{F.GB, F.Wout_t, D}; pg8::DenseOrder S; S.init(NTOK, D, F.G, (int)blockIdx.x);
        pg8::EpiResid E{F.x, F.out, F.mod + 2 * D, F.stats};
        pg8::gemm_phase<pg8::EpiResid, pg8::DenseOrder, false>(F.lds + RING_OFF, g, S, E);
        if (REP_PHASE == 5) { GRID_BAR(); pg8::gemm_phase<pg8::EpiResid, pg8::DenseOrder, false>(F.lds + RING_OFF, g, S, E); }
        if (BOTH(5)) GRID_BAR();
    }
    if (IN(6)) {
#if defined(ROUTE_VALU)
        p6_route(F);
#else
        __syncthreads(); p6_route_mfma(F);
#endif
        if (REP_PHASE == 6) { GRID_BAR(); Frame F2 = F; F2.cnt = (unsigned*)(ws + WS_CTL) + CW_CNT + 4096 * 4; F2.tokl = (int*)(ws + WS_GA); F2.wl = (float*)(ws + WS_GA + 16 * MiB); F2.XN = (bf16*)(ws + WS_GB); p6_route_mfma(F2); }
        if (BOTH(6)) GRID_BAR(); }
    if (IN(7)) {
        moe_tables(F);
        pg8::Gemm g{F.XN, F.Wgu_t, D}; pg8::GateUpOrder S{(const LAS int*)(F.lds + TAB_OFF), F.tokl, F.G, (int)blockIdx.x};
        pg8::EpiGateUp E{F.H};
        pg8::gemm_phase<pg8::EpiGateUp, pg8::GateUpOrder, true>(F.lds + RING_OFF, g, S, E);
        if (REP_PHASE == 7) { GRID_BAR(); pg8::gemm_phase<pg8::EpiGateUp, pg8::GateUpOrder, true>(F.lds + RING_OFF, g, S, E); }
        if (BOTH(7)) GRID_BAR();
    }
    if (IN(8)) {
        moe_tables(F);
        pg8::Gemm g{F.H, F.Wd_t, DEXP}; pg8::DownAllOrder S{(const LAS int*)(F.lds + TAB_OFF), F.G, (int)blockIdx.x};
        pg8::EpiY E{F.Y};
        pg8::gemm_phase<pg8::EpiY, pg8::DownAllOrder, false>(F.lds + RING_OFF, g, S, E);
        if (REP_PHASE == 8) { GRID_BAR(); pg8::gemm_phase<pg8::EpiY, pg8::DownAllOrder, false>(F.lds + RING_OFF, g, S, E); }
        if (BOTH(8)) GRID_BAR();
    }
    if (IN(9)) { moe_tables(F); p9_combine(F); if (REP_PHASE == 9) { GRID_BAR(); Frame F2 = F; F2.out = (float*)(ws + WS_XN); p9_combine(F2); } }
#undef IN
#undef BOTH
}

extern "C" void kernel_launch(void* const* d_in, const int* in_sizes, int n_in, void* d_out, int out_size, void* d_ws, size_t ws_size, hipStream_t stream) {
    static int grid = 0;
    if (grid == 0) {
        if (n_in != 20 || in_sizes[0] != NTOK * D || out_size != NTOK * D || ws_size < WS_END) { fprintf(stderr, "kernel_launch: built for 20 inputs, x/out of %d floats, >= %zu bytes of workspace; got n_in %d, in0 %d, out %d, ws %zu; nothing launched\n", NTOK * D, (size_t)WS_END, n_in, n_in > 0 ? in_sizes[0] : -1, out_size, ws_size); grid = -1; return; }
        int dev = 0, cus = 0, per_cu = 0;
        if (hipGetDevice(&dev) != hipSuccess || hipDeviceGetAttribute(&cus, hipDeviceAttributeMultiprocessorCount, dev) != hipSuccess) { fprintf(stderr, "kernel_launch: hipGetDevice / hipDeviceGetAttribute failed\n"); grid = -1; return; }
        if (hipFuncSetAttribute((const void*)fwd, hipFuncAttributeMaxDynamicSharedMemorySize, LDS_BYTES) != hipSuccess) { fprintf(stderr, "kernel_launch: hipFuncSetAttribute failed\n"); grid = -1; return; }
        if (hipOccupancyMaxActiveBlocksPerMultiprocessor(&per_cu, (const void*)fwd, NWAVES * 64, LDS_BYTES) != hipSuccess || per_cu < 1)
            fprintf(stderr, "kernel_launch: note: the occupancy query reports %d workgroups per CU\n", per_cu);
        (void)hipGetLastError();
        grid = cus;
    }
    if (grid < 0) return;
    if (hipMemsetAsync((char*)d_ws + WS_CTL, 0, CTL_ZERO_BYTES, stream) != hipSuccess) { fprintf(stderr, "kernel_launch: hipMemsetAsync failed\n"); return; }
    Args a{};
    for (int i = 0; i < 20; ++i) a.in[i] = (const float*)d_in[i];
    a.out = (float*)d_out; a.ws = (unsigned char*)d_ws;
    for (int li = 0; li < N_LAUNCHES; ++li) {
        a.ph_lo = (N_LAUNCHES == 1) ? 0 : li; a.ph_hi = (N_LAUNCHES == 1) ? N_PHASES : li + 1;
        hipLaunchKernelGGL(fwd, dim3(grid), dim3(NWAVES * 64), LDS_BYTES, stream, a);
        const hipError_t le = hipPeekAtLastError();
        if (le != hipSuccess) { fprintf(stderr, "kernel_launch: launch %d failed: %s\n", li, hipGetErrorName(le)); break; }
    }
}
```

```cpp
#include <hip/hip_runtime.h>
#include <cstdio>
#include <cstdint>
#include <cmath>
namespace pg8 {
#define PG8_LAS __attribute__((address_space(3)))
typedef unsigned short bf16_t;
typedef short bf16x8 __attribute__((ext_vector_type(8)));
typedef float f32x4 __attribute__((ext_vector_type(4)));
typedef unsigned u32x4 __attribute__((ext_vector_type(4)));
constexpr int BM = 256, BK = 64, HALF = 128, HTB = HALF * BK * 2  , STAGE_BYTES = 8 * HTB, NXCD = 8, WGM = 8;

__host__ __device__ __forceinline__ int lds_byte(int r, int c) { const int st = (r >> 4) * 2 + (c >> 5), rr = r & 15, cc = c & 31, ob = rr * 64 + cc * 2; return st * 1024 + (ob ^ (((ob >> 9) & 1) << 5)); }
__host__ __device__ __forceinline__ void stage_rc(int b, int& R, int& C) { const int st = b / 1024, sb = b % 1024, swz = sb ^ (((sb >> 9) & 1) << 5); R = (st >> 1) * 16 + swz / 64; C = (st & 1) * 32 + (swz % 64) / 2; }
__host__ __device__ __forceinline__ int perm32(int rho) { const int n = rho >> 4, i = rho & 15; return 8 * (i >> 2) + 4 * n + (i & 3); }

struct Unit { int arow, brow, pm, pn, x0, x1; };
struct Gemm { const bf16_t* A; const bf16_t* Bt; int K; };

struct DenseOrder {
    int nM, nN, nwg, G, c;
    __device__ void init(int M, int N, int G_, int c_) { nM = M / BM; nN = N / BM; nwg = nM * nN; G = G_; c = c_; }
    __device__ bool next(int i, Unit& u) const {
        const long L = (long)i * G + c; if (L >= nwg) return false;
        int wgid = (int)L; { const int q = nwg / NXCD, r = nwg % NXCD, xcd = wgid % NXCD, off = wgid / NXCD; wgid = (xcd < r ? xcd * (q + 1) : r * (q + 1) + (xcd - r) * q) + off; }
        const int nig = WGM * nN, gid = wgid / nig, fm = gid * WGM, gsz = (nM - fm) < WGM ? (nM - fm) : WGM;
        u.pm = fm + ((wgid % nig) % gsz); u.pn = (wgid % nig) / gsz; u.arow = u.pm * BM; u.brow = u.pn * BM; u.x0 = 0; u.x1 = 0; return true;
    }
    __device__ __forceinline__ int arow_of(const Unit&, int) const { return 0; }
};

__device__ __forceinline__ unsigned cvt_pk_bf16(float lo, float hi) { unsigned r; asm volatile("v_cvt_pk_bf16_f32 %0, %1, %2" : "=v"(r) : "v"(lo), "v"(hi)); return r; }

template <class Epi, class Sched, bool GATHER, bool ALIGN_EPI = true, bool SP2 = true>
__device__ __forceinline__ void gemm_phase(PG8_LAS unsigned char* lds, const Gemm g, const Sched& S, const Epi& E) {
    const int tid = threadIdx.x, wid = __builtin_amdgcn_readfirstlane(tid >> 6), lane = tid & 63, wr = wid >> 2, wc = wid & 3, fr = lane & 15, fq = lane >> 4;
    const int K = g.K, nt = K / BK;
    unsigned voffA[2], voffB[2]; int stR[2], stC[2];
#pragma unroll
    for (int i = 0; i < 2; ++i) { int R, C; stage_rc(tid * 16 + i * 8192, R, C); const int Rb = Epi::PERM ? ((R & ~31) + perm32(R & 31)) : R;
        stR[i] = R; stC[i] = C; voffA[i] = (unsigned)(R * K + C) * 2u; voffB[i] = (unsigned)(Rb * K + C) * 2u; }
    const size_t kstep = (size_t)(BK * 2);
    const size_t hstep = (size_t)HALF * K * 2;
    const size_t rstep = (size_t)K * 2;
    const unsigned ldsw = (unsigned)wid * 1024u;
    const int aoff = lds_byte(wr * 64 + fr, fq * 8), boff = lds_byte(wc * 32 + fr, fq * 8);
#define PG8_SA(b, h) (((b) * 2 + (h)) * HTB)
#define PG8_SB(b, h) ((4 + (b) * 2 + (h)) * HTB)
#define PG8_STAGE(bufoff, gbase, voff) do { _Pragma("unroll") for (int _i = 0; _i < 2; ++_i) \
        __builtin_amdgcn_global_load_lds((const unsigned*)((const char*)(gbase) + (voff)[_i]), (PG8_LAS unsigned*)(lds + (bufoff) + ldsw + _i * 8192), 16, 0, 0); } while (0)
#define PG8_STAGE_A(bufoff, ub, h, VS) do { if constexpr (GATHER) { PG8_STAGE(bufoff, ub, VS[h]); } else { PG8_STAGE(bufoff, (ub) + (h) * hstep, voffA); } } while (0)
#define PG8_VOFFS(dst, U) do { _Pragma("unroll") for (int h_ = 0; h_ < 2; ++h_) _Pragma("unroll") for (int i_ = 0; i_ < 2; ++i_) \
        dst[h_][i_] = (unsigned)(S.arow_of(U, h_ * HALF + stR[i_]) * K + stC[i_]) * 2u; } while (0)
#define PG8_LDA(dst, b, h) do { _Pragma("unroll") for (int m = 0; m < 4; ++m) _Pragma("unroll") for (int k = 0; k < 2; ++k) dst[m][k] = *(const PG8_LAS bf16x8*)(lds + PG8_SA(b, h) + aoff + m * 2048 + k * 1024); } while (0)
#define PG8_LDB(dst, b, h) do { _Pragma("unroll") for (int n = 0; n < 2; ++n) _Pragma("unroll") for (int k = 0; k < 2; ++k) dst[n][k] = *(const PG8_LAS bf16x8*)(lds + PG8_SB(b, h) + boff + n * 2048 + k * 1024); } while (0)
#define PG8_MMA(ai, bj, At, Bt) do { __builtin_amdgcn_s_setprio(1); _Pragma("unroll") for (int m = 0; m < 4; ++m) _Pragma("unroll") for (int n = 0; n < 2; ++n) _Pragma("unroll") for (int k = 0; k < 2; ++k) \
        acc[ai][bj][m][n] = __builtin_amdgcn_mfma_f32_16x16x32_bf16(Bt[n][k], At[m][k], acc[ai][bj][m][n], 0, 0, 0); __builtin_amdgcn_s_setprio(0); } while (0)
#define PG8_WAIT_V(n) asm volatile("s_waitcnt vmcnt(" #n ")" ::: "memory")
#define PG8_WAIT_L(n) asm volatile("s_waitcnt lgkmcnt(" #n ")" ::: "memory")
#define PG8_BAR __builtin_amdgcn_s_barrier()
#define PG8_SCHED __builtin_amdgcn_sched_barrier(0)
    Unit cur, nxt; int ui = 0;
    if (!S.next(0, cur)) return;
    bool has_next = S.next(1, nxt);
    unsigned vAc[2][2], vAn[2][2];
    if constexpr (GATHER) { PG8_VOFFS(vAc, cur); if (has_next) { PG8_VOFFS(vAn, nxt); } else {
#pragma unroll
        for (int h_ = 0; h_ < 2; ++h_) { vAn[h_][0] = vAc[h_][0]; vAn[h_][1] = vAc[h_][1]; } } }
    else {
#pragma unroll
        for (int h_ = 0; h_ < 2; ++h_) { vAc[h_][0] = 0u; vAc[h_][1] = 0u; vAn[h_][0] = 0u; vAn[h_][1] = 0u; } }
    f32x4 acc[2][2][4][2];
#pragma unroll
    for (int a = 0; a < 2; ++a)
#pragma unroll
        for (int b = 0; b < 2; ++b)
#pragma unroll
            for (int m = 0; m < 4; ++m)
#pragma unroll
                for (int n = 0; n < 2; ++n) acc[a][b][m][n] = (f32x4){0.f, 0.f, 0.f, 0.f};
    bf16x8 At[4][2], B0[2][2], B1[2][2];
    const char* const A0 = (const char*)g.A;
    const char* cA = GATHER ? A0 : A0 + (size_t)cur.arow * rstep; const char* cB = (const char*)g.Bt + (size_t)cur.brow * rstep;
    if constexpr (SP2) {
        PG8_STAGE(PG8_SB(0, 0), cB, voffB); PG8_STAGE(PG8_SB(0, 1), cB + hstep, voffB); PG8_STAGE_A(PG8_SA(0, 0), cA, 0, vAc); PG8_STAGE_A(PG8_SA(0, 1), cA, 1, vAc);
        if (wr == 1) PG8_BAR;
        PG8_WAIT_V(2); PG8_BAR;
        PG8_STAGE(PG8_SB(1, 0), cB + kstep, voffB); PG8_STAGE_A(PG8_SA(1, 0), cA + kstep, 0, vAc); PG8_STAGE(PG8_SB(1, 1), cB + hstep + kstep, voffB);
        PG8_WAIT_V(6); PG8_BAR;
    } else {
        PG8_STAGE(PG8_SB(0, 0), cB, voffB); PG8_STAGE_A(PG8_SA(0, 0), cA, 0, vAc); PG8_STAGE(PG8_SB(0, 1), cB + hstep, voffB); PG8_STAGE_A(PG8_SA(0, 1), cA, 1, vAc);
        if (wr == 1) PG8_BAR;
        PG8_WAIT_V(4); PG8_BAR;
        PG8_STAGE(PG8_SB(1, 0), cB + kstep, voffB); PG8_STAGE_A(PG8_SA(1, 0), cA + kstep, 0, vAc); PG8_STAGE(PG8_SB(1, 1), cB + hstep + kstep, voffB);
        PG8_WAIT_V(6); PG8_BAR;
    }
    for (;;) {
        const char* nA = GATHER ? A0 : (has_next ? A0 + (size_t)nxt.arow * rstep : cA); const char* nB = has_next ? (const char*)g.Bt + (size_t)nxt.brow * rstep : cB;
        for (int t = 0; t < nt; t += 2) {
            const bool last = (t == nt - 2);
            const char* a1 = cA + (size_t)(t + 1) * kstep;
            const char* a2 = last ? nA : cA + (size_t)(t + 2) * kstep; const char* b2 = last ? nB : cB + (size_t)(t + 2) * kstep;
            const char* a3 = a2 + kstep; const char* b3 = b2 + kstep;
            unsigned vS[2][2];
#pragma unroll
            for (int h_ = 0; h_ < 2; ++h_) { vS[h_][0] = last ? vAn[h_][0] : vAc[h_][0]; vS[h_][1] = last ? vAn[h_][1] : vAc[h_][1]; }
            if constexpr (SP2) {
            PG8_LDB(B0, 0, 0); PG8_LDB(B1, 0, 1); PG8_SCHED; PG8_LDA(At, 0, 0); PG8_STAGE_A(PG8_SA(1, 1), a1, 1, vAc);
            PG8_WAIT_V(8); PG8_WAIT_L(0); PG8_BAR; PG8_MMA(0, 0, At, B0); PG8_MMA(0, 1, At, B1); PG8_BAR; PG8_SCHED;
            PG8_LDA(At, 0, 1); PG8_STAGE(PG8_SB(0, 0), b2, voffB); PG8_STAGE(PG8_SB(0, 1), b2 + hstep, voffB); PG8_STAGE_A(PG8_SA(0, 0), a2, 0, vS);
            PG8_WAIT_V(8); PG8_WAIT_L(0); PG8_BAR; PG8_MMA(1, 0, At, B0); PG8_MMA(1, 1, At, B1); PG8_BAR; PG8_SCHED;
            PG8_LDB(B0, 1, 0); PG8_LDB(B1, 1, 1); PG8_SCHED; PG8_LDA(At, 1, 0); PG8_STAGE_A(PG8_SA(0, 1), a2, 1, vS);
            PG8_WAIT_V(8); PG8_WAIT_L(0); PG8_BAR; PG8_MMA(0, 0, At, B0); PG8_MMA(0, 1, At, B1); PG8_BAR; PG8_SCHED;
            PG8_LDA(At, 1, 1); PG8_STAGE(PG8_SB(1, 0), b3, voffB); PG8_STAGE(PG8_SB(1, 1), b3 + hstep, voffB); PG8_STAGE_A(PG8_SA(1, 0), a3, 0, vS);
            PG8_WAIT_V(8); PG8_WAIT_L(0); PG8_BAR; PG8_MMA(1, 0, At, B0); PG8_MMA(1, 1, At, B1); PG8_BAR; PG8_SCHED;
            } else {
            PG8_LDB(B0, 0, 0); PG8_SCHED; PG8_LDA(At, 0, 0); PG8_STAGE_A(PG8_SA(1, 1), a1, 1, vAc);
            PG8_WAIT_L(8); PG8_BAR; PG8_WAIT_L(0); PG8_MMA(0, 0, At, B0); PG8_BAR; PG8_SCHED;
            PG8_LDB(B1, 0, 1); PG8_STAGE(PG8_SB(0, 0), b2, voffB);
            PG8_BAR; PG8_WAIT_L(0); PG8_MMA(0, 1, At, B1); PG8_BAR;
            PG8_LDA(At, 0, 1); PG8_STAGE_A(PG8_SA(0, 0), a2, 0, vS);
            PG8_BAR; PG8_WAIT_L(0); PG8_MMA(1, 0, At, B0); PG8_BAR; PG8_SCHED;
            PG8_STAGE(PG8_SB(0, 1), b2 + hstep, voffB);
            PG8_WAIT_V(6); PG8_BAR; PG8_MMA(1, 1, At, B1); PG8_BAR;
            PG8_LDB(B0, 1, 0); PG8_SCHED; PG8_LDA(At, 1, 0); PG8_STAGE_A(PG8_SA(0, 1), a2, 1, vS);
            PG8_WAIT_L(8); PG8_BAR; PG8_WAIT_L(0); PG8_MMA(0, 0, At, B0); PG8_BAR; PG8_SCHED;
            PG8_LDB(B1, 1, 1); PG8_STAGE(PG8_SB(1, 0), b3, voffB);
            PG8_BAR; PG8_WAIT_L(0); PG8_MMA(0, 1, At, B1); PG8_BAR;
            PG8_LDA(At, 1, 1); PG8_STAGE_A(PG8_SA(1, 0), a3, 0, vS);
            PG8_BAR; PG8_WAIT_L(0); PG8_MMA(1, 0, At, B0); PG8_BAR; PG8_SCHED;
            PG8_STAGE(PG8_SB(1, 1), b3 + hstep, voffB);
            PG8_WAIT_V(6); PG8_BAR; PG8_MMA(1, 1, At, B1); PG8_BAR;
            }
        }
        if constexpr (ALIGN_EPI) { if (wr == 0) PG8_BAR; }
        E(acc, cur, wr, wc, fr, fq);
        if (!has_next) break;
#pragma unroll
        for (int a = 0; a < 2; ++a)
#pragma unroll
            for (int b = 0; b < 2; ++b)
#pragma unroll
                for (int m = 0; m < 4; ++m)
#pragma unroll
                    for (int n = 0; n < 2; ++n) acc[a][b][m][n] = (f32x4){0.f, 0.f, 0.f, 0.f};
        cur = nxt; cA = nA; cB = nB; ++ui;
        has_next = S.next(ui + 1, nxt);
        if constexpr (GATHER) {
#pragma unroll
            for (int h_ = 0; h_ < 2; ++h_) { vAc[h_][0] = vAn[h_][0]; vAc[h_][1] = vAn[h_][1]; }
            if (has_next) { PG8_VOFFS(vAn, nxt); }
        }
        if constexpr (ALIGN_EPI) { if (wr == 1) PG8_BAR; }
    }
    PG8_WAIT_V(0);
    if constexpr (!ALIGN_EPI) { if (wr == 0) PG8_BAR; }
    PG8_BAR;
#undef PG8_SA
#undef PG8_SB
#undef PG8_STAGE
#undef PG8_STAGE_A
#undef PG8_VOFFS
#undef PG8_LDA
#undef PG8_LDB
#undef PG8_MMA
#undef PG8_WAIT_V
#undef PG8_WAIT_L
#undef PG8_BAR
#undef PG8_SCHED
}
}
constexpr int NWAVES = 8;
constexpr int BATCH = 8, SEQ = 4096, D = 1024, NTOK = BATCH * SEQ;
constexpr int HD = 64, NH = 8, WATT = NH * HD;
constexpr int INCOLS = 5120, NMOD = 6;
constexpr int MBLK = 256, NBLK = SEQ / MBLK;
constexpr int NEXP = 32, EPG = 8, NGRP = 4, DEXP = 512;
constexpr float RMS_EPS = 1e-6f;
constexpr float LOG2E = 1.4426950408889634f;
constexpr float C2 = 0.125f * 1.4426950408889634f;
constexpr int LCAP = NTOK;
constexpr int HROWS = 2 * NTOK + NEXP * 256 + 256;

constexpr size_t MiB = 1u << 20;
constexpr size_t WS_CTL = 0, CTL_ZERO_BYTES = 1 * MiB;
constexpr size_t WS_MOD = 1 * MiB;
constexpr size_t WS_BIAS = 1 * MiB + 256 * 1024;
constexpr size_t WS_STATS = 2 * MiB;
constexpr size_t WS_WIN = 4 * MiB;
constexpr size_t WS_WBRA = 14 * MiB, WS_WBRB = 15 * MiB;
constexpr size_t WS_WOUT = 16 * MiB;
constexpr size_t WS_WGU = 18 * MiB;
constexpr size_t WS_WD = 82 * MiB;
constexpr size_t WS_XN = 114 * MiB;
constexpr size_t WS_QA = 178 * MiB, WS_KA = 210 * MiB, WS_VA = 242 * MiB, WS_QB = 274 * MiB, WS_KB = 306 * MiB, WS_VB = 338 * MiB;
constexpr size_t WS_GA = 370 * MiB, WS_GB = 434 * MiB;
constexpr size_t WS_H = 178 * MiB;
constexpr size_t WS_TOKL = 306 * MiB, WS_WL = 314 * MiB;
constexpr size_t WS_INV = 314 * MiB, WS_WINV = 315 * MiB;
constexpr size_t WS_Y = 322 * MiB;
constexpr size_t WS_END = 498 * MiB;
static_assert(WS_Y + (size_t)HROWS * D * 2 <= WS_END, "Y fits");
static_assert(WS_H + (size_t)HROWS * DEXP * 2 <= WS_QB && WS_TOKL + (size_t)2 * NEXP * LCAP * 4 <= WS_WL && WS_WL + (size_t)2 * NEXP * LCAP * 4 <= WS_VB, "d_ws map");
constexpr int CW_TMO = 0, CW_CODE = 1;
constexpr int CW_BAR = 4096;
constexpr int CW_CNT = 16384;
constexpr int CW_KMEAN = 65536;
static_assert((CW_KMEAN + 65536) * 4 <= (int)CTL_ZERO_BYTES && CW_CNT + 64 * 64 <= CW_KMEAN && CW_BAR + 3456 <= CW_CNT, "CTL map");

constexpr int RING_OFF = 0, RING_BYTES = 131072;
constexpr int LDSCTL_OFF = RING_BYTES, MISC_OFF = LDSCTL_OFF + 320;
constexpr int TAB_OFF = RING_BYTES + 1024;
constexpr int LDS_BYTES = 147456;
static_assert(MISC_OFF + 128 <= TAB_OFF && TAB_OFF + 2048 <= LDS_BYTES, "LDS map");

#define GAS __attribute__((address_space(1)))
#define LAS __attribute__((address_space(3)))
typedef unsigned short bf16;
typedef unsigned v4u __attribute__((ext_vector_type(4)));
typedef unsigned v2u __attribute__((ext_vector_type(2)));
typedef float f32x4 __attribute__((ext_vector_type(4)));
typedef short bf16x8 __attribute__((ext_vector_type(8)));
typedef GAS unsigned gu32;
#define RLX_AGENT __ATOMIC_RELAXED, __HIP_MEMORY_SCOPE_AGENT
#define LDS_WAIT() asm volatile("s_waitcnt lgkmcnt(0)" ::: "memory")
#define VM_WAIT() asm volatile("s_waitcnt vmcnt(0)" ::: "memory")
__device__ __forceinline__ unsigned f2bf(float f) { unsigned u = __builtin_bit_cast(unsigned, f); return (u + 0x7fffu + ((u >> 16) & 1u)) >> 16; }
__device__ __forceinline__ unsigned pk2(float lo, float hi) { return f2bf(lo) | (f2bf(hi) << 16); }
__device__ __forceinline__ float bflo(unsigned u) { return __uint_as_float(u << 16); }
__device__ __forceinline__ float bfhi(unsigned u) { return __uint_as_float(u & 0xffff0000u); }
__device__ __forceinline__ float fsigmoid(float v) { return __builtin_amdgcn_rcpf(1.0f + __builtin_amdgcn_exp2f(-v * LOG2E)); }
#define XB_TMO      128
#define XB_XCNT(j)  (256  + 64 * (j))
#define XB_XSUB(j)  (1280 + 64 * (j))
#define XB_XGEN(j)  (2304 + 64 * (j))
#define XB_TOP      3328
#define XB_TOPGEN   3392
#define XCD_BAR_WORDS 3456
#define XB_SPIN_CAP (1u << 22)

__device__ __forceinline__ unsigned xb_ld(unsigned* p)              { return __hip_atomic_load(p, __ATOMIC_RELAXED, __HIP_MEMORY_SCOPE_AGENT); }
__device__ __forceinline__ unsigned xb_add(unsigned* p, unsigned v) { return __hip_atomic_fetch_add(p, v, __ATOMIC_RELAXED, __HIP_MEMORY_SCOPE_AGENT); }
__device__ __forceinline__ unsigned xb_xcc_id() { return (unsigned)__builtin_amdgcn_s_getreg((3 << 11) | 20) & 0xFu; }
#define XB_SPIN(cond, bar) do { unsigned _sp = 0; while (cond) { __builtin_amdgcn_s_sleep(1); \
    if ((++_sp & 255u) == 0u) { if (xb_ld(&(bar)[XB_TMO])) break; if (_sp > XB_SPIN_CAP) { atomicAdd(&(bar)[XB_TMO], 1u); break; } } } } while (0)

struct XcdBarrier {
    unsigned* bar; unsigned x;
    volatile LAS unsigned* st;
};

__device__ __forceinline__ XcdBarrier xcd_barrier_post(unsigned* bar, volatile LAS unsigned* st) {
    XcdBarrier b; b.bar = bar; b.x = xb_xcc_id(); b.st = st;
    if (threadIdx.x == 0) (void)xb_add(&bar[XB_XCNT(b.x)], 1u);
    return b;
}
__device__ __forceinline__ void xcd_barrier_complete(unsigned* bar, unsigned x, unsigned& nloc, unsigned& nx) {
    const unsigned G = gridDim.x * gridDim.y * gridDim.z;
    unsigned sum, cnt, mine, sp = 0u;
    for (;;) {
        sum = 0u; cnt = 0u; mine = 0u;
#pragma unroll
        for (unsigned j = 0; j < 16; ++j) { const unsigned c = xb_ld(&bar[XB_XCNT(j)]); sum += c; cnt += (c > 0u) ? 1u : 0u; mine = (j == x) ? c : mine; }
        if (sum == G) break;
        __builtin_amdgcn_s_sleep(1);
        if ((++sp & 255u) == 0u) { if (xb_ld(&bar[XB_TMO])) break; if (sp > XB_SPIN_CAP) { atomicAdd(&bar[XB_TMO], 1u); break; } }
    }
    nloc = mine > 0u ? mine : 1u; nx = cnt > 0u ? cnt : 1u;
}

__device__ __forceinline__ void xcd_barrier(const XcdBarrier& b) {
    asm volatile("s_waitcnt vmcnt(0)" ::: "memory");
    __syncthreads();
    if (threadIdx.x == 0) {
        unsigned* bar = b.bar;
        __builtin_amdgcn_s_waitcnt(0);
        unsigned nloc = b.st[0], nx = b.st[1];
        if (nloc == 0u) { xcd_barrier_complete(bar, b.x, nloc, nx); b.st[0] = nloc; b.st[1] = nx; }
        const unsigned old = xb_add(&bar[XB_XSUB(b.x)], 1u);
        const unsigned gen = old / nloc;
        if (old + 1u == (gen + 1u) * nloc) {
            __builtin_amdgcn_fence(__ATOMIC_RELEASE, "agent");
            asm volatile("s_waitcnt vmcnt(0)" ::: "memory");
            const unsigned og = xb_add(&bar[XB_TOP], 1u);
            const unsigned tg = og / nx;
            if (og + 1u == (tg + 1u) * nx) xb_add(&bar[XB_TOPGEN], 1u);
            else XB_SPIN(xb_ld(&bar[XB_TOPGEN]) == tg, bar);
            __builtin_amdgcn_fence(__ATOMIC_ACQUIRE, "agent");
            xb_add(&bar[XB_XGEN(b.x)], 1u);
            asm volatile("s_waitcnt vmcnt(0)" ::: "memory");
        } else {
            XB_SPIN(xb_ld(&bar[XB_XGEN(b.x)]) == gen, bar);
            __builtin_amdgcn_fence(__ATOMIC_ACQUIRE, "agent");
            asm volatile("s_waitcnt vmcnt(0)" ::: "memory");
        }
    }
    __syncthreads();
}
#ifndef BR_MB
#define BR_MB 2
#endif
#ifndef RS_MB
#define RS_MB 2
#endif
#ifndef DN_MB
#define DN_MB 2
#endif
namespace pg8 {
struct EpiProj {
    static constexpr bool PERM = true;
    bf16_t* qkv;
    bf16_t* ga; bf16_t* gb;
    const float* gq; const float* gk;
    float* kmean;
    __device__ __forceinline__ void operator()(const f32x4 (&acc)[2][2][4][2], const Unit& u, int wr, int wc, int fr, int fq) const {
        const int pn = u.pn; const int row0 = u.pm * BM + wr * 64 + fr;
        if (pn < 4) {
            const bool isq = pn < 2; const float* gv = isq ? gq : gk; const float post = isq ? C2 : 1.0f;
            bf16_t* base = qkv + (size_t)(pn >> 1) * ((size_t)NTOK * WATT) + (pn & 1) * 256 + wc * 64 + 8 * fq;
            float g[2][2][4];
#pragma unroll
            for (int bj = 0; bj < 2; ++bj)
#pragma unroll
                for (int n = 0; n < 2; ++n) { const f32x4 t = *(const f32x4*)(gv + 32 * bj + 8 * fq + 4 * n); g[bj][n][0] = t[0] * post; g[bj][n][1] = t[1] * post; g[bj][n][2] = t[2] * post; g[bj][n][3] = t[3] * post; }
            float cs[2][2][4];
#pragma unroll
            for (int bj = 0; bj < 2; ++bj)
#pragma unroll
                for (int n = 0; n < 2; ++n)
#pragma unroll
                    for (int e = 0; e < 4; ++e) cs[bj][n][e] = 0.f;
#pragma unroll
            for (int ai = 0; ai < 2; ++ai)
#pragma unroll
                for (int m = 0; m < 4; ++m) {
                    float ss = 0.f;
#pragma unroll
                    for (int bj = 0; bj < 2; ++bj)
#pragma unroll
                        for (int n = 0; n < 2; ++n) { const f32x4 x = acc[ai][bj][m][n]; ss += (x[0] * x[0] + x[1] * x[1]) + (x[2] * x[2] + x[3] * x[3]); }
                    ss += __shfl_xor(ss, 16); ss += __shfl_xor(ss, 32);
                    const float rstd = __builtin_amdgcn_rsqf(ss * (1.0f / 64.0f) + RMS_EPS);
                    bf16_t* rowp = base + (size_t)(row0 + ai * HALF + m * 16) * WATT;
#pragma unroll
                    for (int bj = 0; bj < 2; ++bj) { float o[2][4];
#pragma unroll
                        for (int n = 0; n < 2; ++n)
#pragma unroll
                            for (int e = 0; e < 4; ++e) { o[n][e] = acc[ai][bj][m][n][e] * rstd * g[bj][n][e]; cs[bj][n][e] += o[n][e]; }
                        u32x4 w; w.x = cvt_pk_bf16(o[0][0], o[0][1]); w.y = cvt_pk_bf16(o[0][2], o[0][3]); w.z = cvt_pk_bf16(o[1][0], o[1][1]); w.w = cvt_pk_bf16(o[1][2], o[1][3]);
                        *(u32x4*)(rowp + 32 * bj) = w; }
                }
            if (!isq) {
#pragma unroll
                for (int bj = 0; bj < 2; ++bj)
#pragma unroll
                    for (int n = 0; n < 2; ++n)
#pragma unroll
                        for (int e = 0; e < 4; ++e) { float v = cs[bj][n][e]; v += __shfl_xor(v, 1); v += __shfl_xor(v, 2); v += __shfl_xor(v, 4); v += __shfl_xor(v, 8); cs[bj][n][e] = v; }
                if (fr == 0) { float* kp = kmean + ((size_t)u.pm * NH + (pn & 1) * 4 + wc) * HD + 8 * fq;
#pragma unroll
                    for (int bj = 0; bj < 2; ++bj)
#pragma unroll
                        for (int n = 0; n < 2; ++n)
#pragma unroll
                            for (int e = 0; e < 4; ++e) atomicAdd(kp + 32 * bj + 4 * n + e, cs[bj][n][e]); }
            }
        } else {
            const bool isg = pn >= 12; const float sc = (pn == 6 || pn == 7) ? C2 : 1.0f;
            bf16_t* base; int ldc;
            if (isg) { base = (pn < 16 ? ga : gb) + (pn & 3) * 256 + wc * 64 + 8 * fq; ldc = D; }
            else { base = qkv + (size_t)(pn >> 1) * ((size_t)NTOK * WATT) + (pn & 1) * 256 + wc * 64 + 8 * fq; ldc = WATT; }
#pragma unroll
            for (int ai = 0; ai < 2; ++ai)
#pragma unroll
                for (int m = 0; m < 4; ++m) { bf16_t* rowp = base + (size_t)(row0 + ai * HALF + m * 16) * ldc;
#pragma unroll
                    for (int bj = 0; bj < 2; ++bj) { f32x4 v0 = acc[ai][bj][m][0], v1 = acc[ai][bj][m][1];
                        if (isg) {
#pragma unroll
                            for (int e = 0; e < 4; ++e) { v0[e] = __builtin_amdgcn_rcpf(1.0f + __builtin_amdgcn_exp2f(-v0[e] * LOG2E)); v1[e] = __builtin_amdgcn_rcpf(1.0f + __builtin_amdgcn_exp2f(-v1[e] * LOG2E)); } }
                        else { v0 = v0 * sc; v1 = v1 * sc; }
                        u32x4 w; w.x = cvt_pk_bf16(v0[0], v0[1]); w.y = cvt_pk_bf16(v0[2], v0[3]); w.z = cvt_pk_bf16(v1[0], v1[1]); w.w = cvt_pk_bf16(v1[2], v1[3]);
                        *(u32x4*)(rowp + 32 * bj) = w; } }
        }
    }
};

template <int MODE> struct EpiBranch {
    static constexpr bool PERM = true;
    bf16_t* sg; const bf16_t* tin;
    __device__ __forceinline__ void operator()(const f32x4 (&acc)[2][2][4][2], const Unit& u, int wr, int wc, int fr, int fq) const {
        const int row0 = u.pm * BM + wr * 64 + fr, col0 = u.pn * BM + wc * 32 + 8 * fq;
#pragma unroll
        for (int ai = 0; ai < 2; ++ai)
#pragma unroll
        for (int mb = 0; mb < 4; mb += BR_MB) { u32x4 gw[4][2], tw[4][2];
#pragma unroll
            for (int m = mb; m < mb + BR_MB; ++m) { const size_t off = (size_t)(row0 + ai * HALF + m * 16) * D + col0;
#pragma unroll
                for (int bj = 0; bj < 2; ++bj) { gw[m][bj] = *(const u32x4*)(sg + off + bj * HALF); if (MODE == 1) tw[m][bj] = *(const u32x4*)(tin + off + bj * HALF); else tw[m][bj] = (u32x4){0u, 0u, 0u, 0u}; } }
#pragma unroll
            for (int m = mb; m < mb + BR_MB; ++m) { const size_t off = (size_t)(row0 + ai * HALF + m * 16) * D + col0;
#pragma unroll
                for (int bj = 0; bj < 2; ++bj) { const u32x4 g = gw[m][bj], t = tw[m][bj];
                    const f32x4 v0 = acc[ai][bj][m][0], v1 = acc[ai][bj][m][1]; float o[8];
                    o[0] = bflo(g.x) * v0[0]; o[1] = bfhi(g.x) * v0[1]; o[2] = bflo(g.y) * v0[2]; o[3] = bfhi(g.y) * v0[3];
                    o[4] = bflo(g.z) * v1[0]; o[5] = bfhi(g.z) * v1[1]; o[6] = bflo(g.w) * v1[2]; o[7] = bfhi(g.w) * v1[3];
                    if (MODE == 1) { o[0] += bflo(t.x); o[1] += bfhi(t.x); o[2] += bflo(t.y); o[3] += bfhi(t.y); o[4] += bflo(t.z); o[5] += bfhi(t.z); o[6] += bflo(t.w); o[7] += bfhi(t.w); }
                    u32x4 w; w.x = cvt_pk_bf16(o[0], o[1]); w.y = cvt_pk_bf16(o[2], o[3]); w.z = cvt_pk_bf16(o[4], o[5]); w.w = cvt_pk_bf16(o[6], o[7]);
                    *(u32x4*)(sg + off + bj * HALF) = w; } } }
    }
};

struct EpiResid {
    static constexpr bool PERM = false;
    const float* x; float* out; const float* gt;
    float* stats;
    __device__ __forceinline__ void operator()(const f32x4 (&acc)[2][2][4][2], const Unit& u, int wr, int wc, int fr, int fq) const {
        const int row0 = u.pm * BM + wr * 64 + fr, col0 = u.pn * BM + wc * 32 + 4 * fq; const int b = (u.pm * BM) / SEQ;
        f32x4 gv[2][2];
#pragma unroll
        for (int bj = 0; bj < 2; ++bj)
#pragma unroll
            for (int n = 0; n < 2; ++n) gv[bj][n] = *(const f32x4*)(gt + (size_t)b * (NMOD * D) + col0 + bj * HALF + n * 16);
#pragma unroll
        for (int ai = 0; ai < 2; ++ai)
#pragma unroll
        for (int mb = 0; mb < 4; mb += RS_MB) { f32x4 xv[4][2][2];
#pragma unroll
            for (int m = mb; m < mb + RS_MB; ++m) { const size_t off = (size_t)(row0 + ai * HALF + m * 16) * D + col0;
#pragma unroll
                for (int bj = 0; bj < 2; ++bj)
#pragma unroll
                    for (int n = 0; n < 2; ++n) xv[m][bj][n] = *(const f32x4*)(x + off + bj * HALF + n * 16); }
#pragma unroll
            for (int m = mb; m < mb + RS_MB; ++m) { const int row = row0 + ai * HALF + m * 16; const size_t off = (size_t)row * D + col0; float ss = 0.f;
#pragma unroll
                for (int bj = 0; bj < 2; ++bj)
#pragma unroll
                    for (int n = 0; n < 2; ++n) { const f32x4 o = xv[m][bj][n] + gv[bj][n] * acc[ai][bj][m][n];
                        *(f32x4*)(out + off + bj * HALF + n * 16) = o; ss += (o[0] * o[0] + o[1] * o[1]) + (o[2] * o[2] + o[3] * o[3]); }
                ss += __shfl_xor(ss, 16); ss += __shfl_xor(ss, 32);
                if (fq == 0) stats[(size_t)row * 16 + u.pn * 4 + wc] = ss; } }
    }
};

struct EpiGateUp {
    static constexpr bool PERM = true;
    bf16_t* H;
    __device__ __forceinline__ void operator()(const f32x4 (&acc)[2][2][4][2], const Unit& u, int wr, int wc, int fr, int fq) const {
        bf16_t* base = H + (size_t)(u.arow + wr * 64 + fr) * DEXP + u.pn * 128 + wc * 32 + 8 * fq;
#pragma unroll
        for (int ai = 0; ai < 2; ++ai)
#pragma unroll
            for (int m = 0; m < 4; ++m) { float o[8];
#pragma unroll
                for (int n = 0; n < 2; ++n)
#pragma unroll
                    for (int e = 0; e < 4; ++e) { const float gg = acc[ai][0][m][n][e], uu = acc[ai][1][m][n][e]; o[4 * n + e] = gg * __builtin_amdgcn_rcpf(1.0f + __builtin_amdgcn_exp2f(-gg * LOG2E)) * uu; }
                u32x4 w; w.x = cvt_pk_bf16(o[0], o[1]); w.y = cvt_pk_bf16(o[2], o[3]); w.z = cvt_pk_bf16(o[4], o[5]); w.w = cvt_pk_bf16(o[6], o[7]);
                *(u32x4*)(base + (size_t)(ai * HALF + m * 16) * DEXP) = w; }
    }
};

struct EpiDown {
    static constexpr bool PERM = false;
    float* out; const float* gt;
    const int* tl; const float* wl;
    __device__ __forceinline__ void operator()(const f32x4 (&acc)[2][2][4][2], const Unit& u, int wr, int wc, int fr, int fq) const {
        const int col0 = u.pn * BM + wc * 32 + 4 * fq;
        int tok[2][4]; float wv[2][4];
#pragma unroll
        for (int ai = 0; ai < 2; ++ai)
#pragma unroll
            for (int m = 0; m < 4; ++m) { const int r = ai * HALF + wr * 64 + m * 16 + fr; const int rr = r < u.x1 ? r : u.x1 - 1; tok[ai][m] = tl[u.x0 + rr]; wv[ai][m] = wl[u.x0 + rr]; }
#pragma unroll
        for (int ai = 0; ai < 2; ++ai)
#pragma unroll
        for (int mb = 0; mb < 4; mb += DN_MB) { f32x4 ov[4][2][2];
#pragma unroll
            for (int m = mb; m < mb + DN_MB; ++m) { const float* op = out + (size_t)tok[ai][m] * D + col0;
#pragma unroll
                for (int bj = 0; bj < 2; ++bj)
#pragma unroll
                    for (int n = 0; n < 2; ++n) ov[m][bj][n] = *(const f32x4*)(op + bj * HALF + n * 16); }
#pragma unroll
            for (int m = mb; m < mb + DN_MB; ++m) { const int r = ai * HALF + wr * 64 + m * 16 + fr; const int tk = tok[ai][m]; const float* gp = gt + (size_t)(tk / SEQ) * (NMOD * D) + col0; f32x4 gv[2][2];
#pragma unroll
                for (int bj = 0; bj < 2; ++bj)
#pragma unroll
                    for (int n = 0; n < 2; ++n) gv[bj][n] = *(const f32x4*)(gp + bj * HALF + n * 16);
                if (r < u.x1) { float* op = out + (size_t)tk * D + col0; const float w = wv[ai][m];
#pragma unroll
                    for (int bj = 0; bj < 2; ++bj)
#pragma unroll
                        for (int n = 0; n < 2; ++n) *(f32x4*)(op + bj * HALF + n * 16) = ov[m][bj][n] + gv[bj][n] * (acc[ai][bj][m][n] * w); } } }
    }
};

struct EpiY {
    static constexpr bool PERM = true;
    bf16_t* Y;
    __device__ __forceinline__ void operator()(const f32x4 (&acc)[2][2][4][2], const Unit& u, int wr, int wc, int fr, int fq) const {
        bf16_t* base = Y + (size_t)(u.arow + wr * 64 + fr) * D + u.pn * BM + wc * 32 + 8 * fq;
#pragma unroll
        for (int ai = 0; ai < 2; ++ai)
#pragma unroll
            for (int m = 0; m < 4; ++m) { bf16_t* rowp = base + (size_t)(ai * HALF + m * 16) * D;
#pragma unroll
                for (int bj = 0; bj < 2; ++bj) { const f32x4 v0 = acc[ai][bj][m][0], v1 = acc[ai][bj][m][1];
                    u32x4 w; w.x = cvt_pk_bf16(v0[0], v0[1]); w.y = cvt_pk_bf16(v0[2], v0[3]); w.z = cvt_pk_bf16(v1[0], v1[1]); w.w = cvt_pk_bf16(v1[2], v1[3]);
                    *(u32x4*)(rowp + bj * HALF) = w; } }
    }
};
struct EpiNull {
    static constexpr bool PERM = false;
    bf16_t* dummy;
    __device__ __forceinline__ void operator()(const f32x4 (&acc)[2][2][4][2], const Unit& u, int wr, int wc, int fr, int fq) const {
        f32x4 s = {0.f, 0.f, 0.f, 0.f};
#pragma unroll
        for (int ai = 0; ai < 2; ++ai)
#pragma unroll
            for (int bj = 0; bj < 2; ++bj)
#pragma unroll
                for (int m = 0; m < 4; ++m)
#pragma unroll
                    for (int n = 0; n < 2; ++n) s += acc[ai][bj][m][n];
        *(f32x4*)((float*)dummy + (size_t)(blockIdx.x * 512 + threadIdx.x) * 4) = s;
    }
};
struct GateUpOrder {
    const PG8_LAS int* T; const int* tokl; int G, c;
    __device__ bool next(int i, Unit& u) const {
        const int L = i * G + c; const int total = T[64 + 32] * 4; if (L >= total) return false;
        const int rt = L >> 2; int e = 0; while (T[64 + e + 1] <= rt) ++e;
        const int lt = rt - T[64 + e];
        u.pm = lt; u.pn = L & 3; u.x0 = e; u.x1 = 0; u.arow = T[128 + e] + lt * 256; u.brow = e * 1024 + (L & 3) * 256; return true;
    }
    __device__ __forceinline__ int arow_of(const Unit& u, int r) const {
        const int idx = u.pm * 256 + r, c0 = T[u.x0], c1 = T[32 + u.x0];
        int tok = 0;
        if (idx < c0) tok = tokl[(size_t)u.x0 * LCAP + idx]; else if (idx < c0 + c1) tok = tokl[(size_t)(NEXP + u.x0) * LCAP + idx - c0];
        return tok;
    }
};
struct DownAllOrder {
    const PG8_LAS int* T; int G, c;
    __device__ bool next(int i, Unit& u) const {
        const int L = i * G + c; const int total = T[64 + 32] * 4; if (L >= total) return false;
        const int rt = L >> 2; int e = 0; while (T[64 + e + 1] <= rt) ++e;
        const int lt = rt - T[64 + e];
        u.pm = lt; u.pn = L & 3; u.x0 = e; u.x1 = 0; u.arow = T[128 + e] + lt * 256; u.brow = e * 1024 + (L & 3) * 256; return true;
    }
    __device__ __forceinline__ int arow_of(const Unit&, int) const { return 0; }
};
template <int SLOT> struct DownOrder {
    const PG8_LAS int* T; int G, c;
    __device__ bool next(int i, Unit& u) const {
        const int PO = SLOT ? 256 : 192; const int L = i * G + c; const int total = T[PO + 32] * 4; if (L >= total) return false;
        const int rt = L >> 2; int e = 0; while (T[PO + e + 1] <= rt) ++e;
        const int lt = rt - T[PO + e]; const int cs = T[SLOT * 32 + e]; const int rem = cs - lt * 256;
        u.pm = lt; u.pn = L & 3; u.x0 = (SLOT * NEXP + e) * LCAP + lt * 256; u.x1 = rem < 256 ? rem : 256;
        u.arow = T[128 + e] + (SLOT ? T[e] : 0) + lt * 256; u.brow = e * 1024 + (L & 3) * 256; return true;
    }
    __device__ __forceinline__ int arow_of(const Unit&, int) const { return 0; }
};
}
namespace attn {
using bf16x8 = __attribute__((ext_vector_type(8))) short;
using s16x4 = __attribute__((ext_vector_type(4))) short;
using f32x16 = __attribute__((ext_vector_type(16))) float;
using f32x4v = __attribute__((ext_vector_type(4))) float;
using u32x4 = __attribute__((ext_vector_type(4))) unsigned;
typedef unsigned short bf16;
constexpr int DM = 512, QBLK = 32, NW = 8, QB = 256, KVBLK = 64;
constexpr int NSLOT = 3, SLOTB = 8192;
constexpr int LDS_K = 0, LDS_V = NSLOT * SLOTB, LDS_WS = 2 * NSLOT * SLOTB, LDS_OST = LDS_WS + NW * 64 * 4, LDS_BT = LDS_OST + NW * 4096;
constexpr int REV = 896, BT_LEN = 1168, COPYB = BT_LEN * 4, NEG_OFF = 4 * COPYB, BT_BYTES = NEG_OFF + 256;
constexpr int LDS_BYTES = LDS_BT + BT_BYTES;
static_assert(BT_LEN >= REV + 256 + 8 + 3 && COPYB % 16 == 0 && LDS_BT % 16 == 0, "bias image");
#define SBAR() __builtin_amdgcn_sched_barrier(0)
#define WAIT_BAR(N) asm volatile("s_waitcnt vmcnt(" #N ") lgkmcnt(0)\n\ts_barrier":::"memory")
typedef __attribute__((address_space(3))) const char* lds_cptr;
typedef short v4i16_t __attribute__((ext_vector_type(4)));
typedef float f32x2_t __attribute__((ext_vector_type(2))); typedef __bf16 bf16x2_t __attribute__((ext_vector_type(2)));
__device__ __forceinline__ int crow(int r, int hi) { return (r & 3) + 8 * (r >> 2) + 4 * hi; }
__device__ __forceinline__ void glds16(const void* gsrc, unsigned lds_dst) { unsigned keep;
  asm volatile("s_mov_b32 %0, m0\n\ts_mov_b32 m0, %2\n\ts_nop 0\n\tglobal_load_lds_dwordx4 %1, off\n\ts_mov_b32 m0, %0" : "=&s"(keep) : "v"(gsrc), "s"(lds_dst) : "memory"); }
__device__ __forceinline__ unsigned cvtpk_s(float lo, float hi) { f32x2_t v = {lo, hi}; bf16x2_t b = __builtin_convertvector(v, bf16x2_t); return __builtin_bit_cast(unsigned, b); }
__device__ __forceinline__ void kload8(bf16x8* kf, lds_cptr kp) {
  kf[0] = *(const __attribute__((address_space(3))) bf16x8*)(kp);        kf[1] = *(const __attribute__((address_space(3))) bf16x8*)(kp + 512);
  kf[2] = *(const __attribute__((address_space(3))) bf16x8*)(kp + 2048); kf[3] = *(const __attribute__((address_space(3))) bf16x8*)(kp + 2560);
  kf[4] = *(const __attribute__((address_space(3))) bf16x8*)(kp + 4096); kf[5] = *(const __attribute__((address_space(3))) bf16x8*)(kp + 4608);
  kf[6] = *(const __attribute__((address_space(3))) bf16x8*)(kp + 6144); kf[7] = *(const __attribute__((address_space(3))) bf16x8*)(kp + 6656);
}
__device__ __forceinline__ void kload2(bf16x8* kf, lds_cptr kp, int j) { kf[2 * j] = *(const __attribute__((address_space(3))) bf16x8*)(kp + j * 2048); kf[2 * j + 1] = *(const __attribute__((address_space(3))) bf16x8*)(kp + j * 2048 + 512); }
__device__ __forceinline__ s16x4 vtr(lds_cptr p) { return __builtin_bit_cast(s16x4, __builtin_amdgcn_ds_read_tr16_b64_v4i16((__attribute__((address_space(3))) v4i16_t*)p)); }
__device__ __forceinline__ f32x4v ldsf4(lds_cptr p) { return *(const __attribute__((address_space(3))) f32x4v*)p; }
#define MFMA32(a, b, c) __builtin_amdgcn_mfma_f32_32x32x16_bf16(a, b, c, 0, 0, 0)
__device__ __forceinline__ void pv(f32x16* o, int vb, bf16x8 pa0, bf16x8 pa1, bf16x8 pa2, bf16x8 pa3) {
  #pragma unroll
  for (int d0 = 0; d0 < 2; ++d0) { s16x4 lo[4], hi[4];
    #pragma unroll
    for (int ks = 0; ks < 4; ++ks) {
      asm volatile("ds_read_b64_tr_b16 %0,%1 offset:%c2" : "=&v"(lo[ks]) : "v"(vb), "i"(d0 * 4096 + ks * 1024) : "memory");
      asm volatile("ds_read_b64_tr_b16 %0,%1 offset:%c2" : "=&v"(hi[ks]) : "v"(vb), "i"(d0 * 4096 + ks * 1024 + 512) : "memory"); }
    asm volatile("s_waitcnt lgkmcnt(0)" ::: "memory"); SBAR();
    #define PK(k) (bf16x8){lo[k][0], lo[k][1], lo[k][2], lo[k][3], hi[k][0], hi[k][1], hi[k][2], hi[k][3]}
    o[d0] = MFMA32(pa0, PK(0), o[d0]); o[d0] = MFMA32(pa1, PK(1), o[d0]); o[d0] = MFMA32(pa2, PK(2), o[d0]); o[d0] = MFMA32(pa3, PK(3), o[d0]);
    #undef PK
  }
}
#define ATTN_STORE16(p, v) (*(u32x4*)(p) = (v))

__device__ __forceinline__ void moba_unit(int b, int h, int qb, const bf16* Q, const bf16* __restrict__ K, const bf16* __restrict__ V, bf16* O, const float* __restrict__ ksum, char* shm) {
  const int tid = threadIdx.x, lane = tid & 63, r32 = lane & 31, hi = lane >> 5; const int wid = __builtin_amdgcn_readfirstlane(tid >> 6);
  const long rowbase = (long)b * 4096; const int q0 = qb * QB;
  const bf16* Qw = Q + (rowbase + q0 + wid * QBLK) * DM + h * 64;
  const bf16* Kh = K + rowbase * DM + h * 64, *Vh = V + rowbase * DM + h * 64;
  const unsigned lds0 = (unsigned)(uintptr_t)shm;
  float* wsf = (float*)(shm + LDS_WS) + wid * 64;
  const lds_cptr shm3 = (lds_cptr)shm;
  if (tid < 128) { const int j = tid >> 3, c = tid & 7; f32x4v a = {0.f, 0.f, 0.f, 0.f}, bq = {0.f, 0.f, 0.f, 0.f};
    if (j < qb) { const f32x4v* kp = (const f32x4v*)(ksum + ((size_t)(b * 16 + j) * 8 + h) * 64 + c * 8); a = kp[0]; bq = kp[1]; }
    const float v[8] = {a[0], a[1], a[2], a[3], bq[0], bq[1], bq[2], bq[3]}; unsigned hw[4], lw[4];
    #pragma unroll
    for (int i = 0; i < 4; ++i) { const unsigned hp = cvtpk_s(v[2 * i], v[2 * i + 1]); const float r0 = v[2 * i] - __uint_as_float(hp << 16), r1 = v[2 * i + 1] - __uint_as_float(hp & 0xffff0000u); hw[i] = hp; lw[i] = cvtpk_s(r0, r1); }
    *(__attribute__((address_space(3))) u32x4*)(shm3 + LDS_OST + c * 1024 + j * 16) = (u32x4){hw[0], hw[1], hw[2], hw[3]};
    *(__attribute__((address_space(3))) u32x4*)(shm3 + LDS_OST + 8192 + c * 1024 + j * 16) = (u32x4){lw[0], lw[1], lw[2], lw[3]}; }
  asm volatile("s_waitcnt vmcnt(0)" ::: "memory");
  const bf16* ksrc = Kh + (long)lane * DM + wid * 8;
  const bf16* vsrc = Vh + (long)(16 * (wid & 3) + (lane >> 2)) * DM + (wid >> 2) * 32 + (lane & 3) * 8;
  const unsigned kdst = lds0 + LDS_K + wid * 1024, vdst = lds0 + LDS_V + wid * 1024;
  #define DMA_K(t, slot) glds16(ksrc + (long)(t) * KVBLK * DM, (unsigned)__builtin_amdgcn_readfirstlane(kdst + (slot)))
  #define DMA_V(t, slot) glds16(vsrc + (long)(t) * KVBLK * DM, (unsigned)__builtin_amdgcn_readfirstlane(vdst + (slot)))
  const int vb0 = (int)(lds0 + LDS_V) + ((lane >> 4) & 1) * 32 + (lane & 3) * 8 + (4 * hi + ((lane & 15) >> 2)) * 64;
  bf16x8 kf[8];
  const lds_cptr kp0 = shm3 + LDS_K + hi * 1024 + r32 * 16; const lds_cptr vp0 = shm3 + LDS_V + ((lane >> 4) & 1) * 32 + (lane & 3) * 8 + (4 * hi + ((lane & 15) >> 2)) * 64;
  const int NT = (q0 + QB) / KVBLK;
  DMA_K(0, 0); DMA_V(0, 0); DMA_K(1, SLOTB);
  bf16x8 qr[4];
  #pragma unroll
  for (int d0 = 0; d0 < 4; ++d0) qr[d0] = *reinterpret_cast<const bf16x8*>(&Qw[(long)r32 * DM + d0 * 16 + hi * 8]);
  float l_reg = 0.f; f32x16 o[2]; o[0] = f32x16{}; o[1] = f32x16{};
  const int tq = q0 + wid * QBLK + r32, acp = (REV - tq) & 3;
  const int cbase = LDS_BT + acp * COPYB; int baddr = cbase + 4 * (REV - tq + 4 * hi - acp);
  DMA_K(2, 2 * SLOTB);
  WAIT_BAR(3);
  unsigned selmask;
  { f32x16 ga = f32x16{};
    #pragma unroll
    for (int d0 = 0; d0 < 4; ++d0) { const bf16x8 ah = *(const __attribute__((address_space(3))) bf16x8*)(shm3 + LDS_OST + hi * 1024 + r32 * 16 + d0 * 2048);
      const bf16x8 al = *(const __attribute__((address_space(3))) bf16x8*)(shm3 + LDS_OST + 8192 + hi * 1024 + r32 * 16 + d0 * 2048);
      ga = MFMA32(ah, qr[d0], ga); ga = MFMA32(al, qr[d0], ga); }
    float G[16];
    #pragma unroll
    for (int r = 0; r < 8; ++r) { auto rr = __builtin_amdgcn_permlane32_swap(__float_as_uint(ga[r]), __float_as_uint(ga[r]), false, false);
      G[(r & 3) + 8 * (r >> 2)] = __uint_as_float(rr[0]); G[(r & 3) + 8 * (r >> 2) + 4] = __uint_as_float(rr[1]); }
    #pragma unroll
    for (int j = 0; j < 16; ++j) if (j >= qb) G[j] = -INFINITY;
    selmask = 1u << qb;
    #pragma unroll
    for (int pass = 0; pass < 3; ++pass) { float best = -INFINITY; int bi = 16;
      #pragma unroll
      for (int j = 0; j < 16; ++j) if (G[j] > best) { best = G[j]; bi = j; }
      if (bi < 16) selmask |= 1u << bi;
      #pragma unroll
      for (int j = 0; j < 16; ++j) if (j == bi) G[j] = -INFINITY; }
  }
  f32x16 pA0, pA1, pB0, pB1;
  #define BEFF(T) (((selmask >> ((T) >> 2)) & 1u) ? (baddr + 256 * (T) > cbase ? baddr + 256 * (T) : cbase) : (LDS_BT + NEG_OFF))
  #define BRD1(X0, X1, eff, i) do { const f32x4v bv_ = ldsf4(shm3 + (eff) + ((i) < 4 ? 32 * (i) : 128 + 32 * ((i) - 4))); \
      if ((i) < 4) { X0[4 * (i)] = bv_[0]; X0[4 * (i) + 1] = bv_[1]; X0[4 * (i) + 2] = bv_[2]; X0[4 * (i) + 3] = bv_[3]; } \
      else { X1[4 * ((i) - 4)] = bv_[0]; X1[4 * ((i) - 4) + 1] = bv_[1]; X1[4 * ((i) - 4) + 2] = bv_[2]; X1[4 * ((i) - 4) + 3] = bv_[3]; } } while (0)
  { const int e0 = BEFF(0);
    #pragma unroll
    for (int i = 0; i < 8; ++i) BRD1(pA0, pA1, e0, i); }
  int sl_prev = 0, sl_cur = 0, sl_next = SLOTB;
  #define ROT() do { sl_prev = sl_cur; sl_cur = sl_next; sl_next = (sl_next == (NSLOT - 1) * SLOTB) ? 0 : sl_next + SLOTB; } while (0)
  { const char* kb = shm + LDS_K + hi * 1024 + r32 * 16;
    #pragma unroll
    for (int d0 = 0; d0 < 4; ++d0) { const bf16x8 b0 = *reinterpret_cast<const bf16x8*>(kb + d0 * 2048); const bf16x8 b1 = *reinterpret_cast<const bf16x8*>(kb + d0 * 2048 + 512);
      pA0 = MFMA32(b0, qr[d0], pA0); pA1 = MFMA32(b1, qr[d0], pA1); } }
  #pragma unroll
  for (int r = 0; r < 16; ++r) { pA0[r] = __builtin_amdgcn_exp2f(pA0[r]); pA1[r] = __builtin_amdgcn_exp2f(pA1[r]); }
  { const int e1 = BEFF(1);
    #pragma unroll
    for (int i = 0; i < 8; ++i) BRD1(pB0, pB1, e1, i); }
  WAIT_BAR(0);
  DMA_K(3, 0); DMA_V(1, SLOTB);
  ROT();
  kload8(kf, kp0 + sl_cur);
  WAIT_BAR(2);
  s16x4 vlo[8], vhi[8]; u32x4 pw0, pw1, pw2, pw3;
  #define PKW(P, B) cvtpk_s(P[B], P[B + 1])
  #define PAF(k) __builtin_bit_cast(bf16x8, pw##k)
  #define VFR(i) (bf16x8){vlo[i][0], vlo[i][1], vlo[i][2], vlo[i][3], vhi[i][0], vhi[i][1], vhi[i][2], vhi[i][3]}
  #define PIN(x) asm volatile("" : "+v"(x))
  #define GAPA(MF, A0, A1, A2, A3, W0, W1, PW) do { MF; sacc += A0; sacc += A1; sacc += A2; sacc += A3; PIN(sacc); W0; W1; PIN(PW); SBAR(); } while (0)
  #define EX(v) __builtin_amdgcn_exp2f(v)
  #define GAPB(MF, X, B) do { MF; X[B] = EX(X[B]); X[B + 1] = EX(X[B + 1]); X[B + 2] = EX(X[B + 2]); X[B + 3] = EX(X[B + 3]); PIN(X); SBAR(); } while (0)
  #define VRD(i) do { vlo[i] = vtr(vp_ + (((i) >> 2) * 4096 + ((i) & 3) * 1024)); vhi[i] = vtr(vp_ + (((i) >> 2) * 4096 + ((i) & 3) * 1024 + 512)); } while (0)
  #define KRD(G, j) do { if (G) { kload2(kf, kp0 + sl_next, j); SBAR(); } } while (0)
  #define BRD(G, i, X0, X1) do { if (G) { BRD1(X0, X1, eff_, i); } } while (0)
  #define STEP(C0, C1, P0, P1, t, GK, GV, GL) do { SBAR(); \
    const lds_cptr vp_ = vp0 + sl_prev; \
    VRD(0); SBAR(); float sacc = (P0[0] + P0[1]); \
    GAPA(C0 = MFMA32(kf[0], qr[0], C0), P0[2], P0[3], P0[4], P0[5],     pw0[0] = PKW(P0, 0), pw0[1] = PKW(P0, 2), pw0); \
    VRD(4); SBAR(); GAPA(C1 = MFMA32(kf[1], qr[0], C1), P0[6], P0[7], P0[8], P0[9],     pw0[2] = PKW(P0, 4), pw0[3] = PKW(P0, 6), pw0); \
    VRD(1); SBAR(); GAPA(C0 = MFMA32(kf[2], qr[1], C0),   P0[10], P0[11], P0[12], P0[13], pw1[0] = PKW(P0, 8), pw1[1] = PKW(P0, 10), pw1); \
    VRD(5); SBAR(); GAPA(C1 = MFMA32(kf[3], qr[1], C1),   P0[14], P0[15], P1[0], P1[1],   pw1[2] = PKW(P0, 12), pw1[3] = PKW(P0, 14), pw1); \
    VRD(2); SBAR(); GAPA(C0 = MFMA32(kf[4], qr[2], C0),   P1[2], P1[3], P1[4], P1[5],     pw2[0] = PKW(P1, 0), pw2[1] = PKW(P1, 2), pw2); \
    VRD(6); SBAR(); GAPA(C1 = MFMA32(kf[5], qr[2], C1),   P1[6], P1[7], P1[8], P1[9],     pw2[2] = PKW(P1, 4), pw2[3] = PKW(P1, 6), pw2); \
    VRD(3); SBAR(); GAPA(C0 = MFMA32(kf[6], qr[3], C0),   P1[10], P1[11], P1[12], P1[13], pw3[0] = PKW(P1, 8), pw3[1] = PKW(P1, 10), pw3); \
    VRD(7); SBAR(); GAPA(C1 = MFMA32(kf[7], qr[3], C1),   P1[14], P1[15], 0.f, 0.f,       pw3[2] = PKW(P1, 12), pw3[3] = PKW(P1, 14), pw3); \
    l_reg += sacc; \
    if (GK) { DMA_K((t) + 3, sl_cur); } if (GV) { DMA_V((t) + 1, sl_next); } \
    const int eff_ = BEFF((t) + 1); \
    SBAR(); \
    BRD(GL, 0, P0, P1); GAPB(o[0] = MFMA32(PAF(0), VFR(0), o[0]), C0, 0); \
    BRD(GL, 1, P0, P1); GAPB(o[1] = MFMA32(PAF(0), VFR(4), o[1]), C0, 4); \
    BRD(GL, 2, P0, P1); KRD(GL, 0); GAPB(o[0] = MFMA32(PAF(1), VFR(1), o[0]), C0, 8); \
    BRD(GL, 3, P0, P1); KRD(GL, 1); GAPB(o[1] = MFMA32(PAF(1), VFR(5), o[1]), C0, 12); \
    BRD(GL, 4, P0, P1); KRD(GL, 2); GAPB(o[0] = MFMA32(PAF(2), VFR(2), o[0]), C1, 0); \
    BRD(GL, 5, P0, P1); KRD(GL, 3); GAPB(o[1] = MFMA32(PAF(2), VFR(6), o[1]), C1, 4); \
    BRD(GL, 6, P0, P1); GAPB(o[0] = MFMA32(PAF(3), VFR(3), o[0]), C1, 8); \
    BRD(GL, 7, P0, P1); GAPB(o[1] = MFMA32(PAF(3), VFR(7), o[1]), C1, 12); \
    } while (0)
  int t = 1;
  for (; t + 5 < NT; t += 2) {
    STEP(pB0, pB1, pA0, pA1, t, true, true, true);     WAIT_BAR(2); ROT();
    STEP(pA0, pA1, pB0, pB1, t + 1, true, true, true); WAIT_BAR(2); ROT();
  }
  #define ENDW(tt) do { if ((tt) + 3 < NT) { WAIT_BAR(2); } else if ((tt) + 2 < NT) { WAIT_BAR(1); } else { WAIT_BAR(0); } } while (0)
  for (; t + 1 < NT; t += 2) {
    STEP(pB0, pB1, pA0, pA1, t, (t + 3 < NT), (t + 1 < NT), (t + 1 < NT));       ENDW(t);     ROT();
    STEP(pA0, pA1, pB0, pB1, t + 1, (t + 4 < NT), (t + 2 < NT), (t + 2 < NT));   ENDW(t + 1); ROT();
  }
  STEP(pB0, pB1, pA0, pA1, NT - 1, false, false, false);
  { float sacc = pB0[0] + pB0[1];
    #pragma unroll
    for (int r = 2; r < 16; ++r) sacc += pB0[r];
    #pragma unroll
    for (int r = 0; r < 16; ++r) sacc += pB1[r];
    l_reg += sacc;
    pw0 = (u32x4){PKW(pB0, 0), PKW(pB0, 2), PKW(pB0, 4), PKW(pB0, 6)}; pw1 = (u32x4){PKW(pB0, 8), PKW(pB0, 10), PKW(pB0, 12), PKW(pB0, 14)};
    pw2 = (u32x4){PKW(pB1, 0), PKW(pB1, 2), PKW(pB1, 4), PKW(pB1, 6)}; pw3 = (u32x4){PKW(pB1, 8), PKW(pB1, 10), PKW(pB1, 12), PKW(pB1, 14)};
    SBAR(); pv(o, vb0 + sl_cur, PAF(0), PAF(1), PAF(2), PAF(3)); }
  #undef STEP
  #undef BRD
  #undef KRD
  #undef VRD
  #undef GAPB
  #undef GAPA
  { auto rr = __builtin_amdgcn_permlane32_swap(__float_as_uint(l_reg), __float_as_uint(l_reg), false, false); l_reg = __uint_as_float(rr[0]) + __uint_as_float(rr[1]); }
  if (hi == 0) wsf[32 + r32] = l_reg; asm volatile("s_waitcnt lgkmcnt(0)" ::: "memory");
  float rli[16];
  #pragma unroll
  for (int r = 0; r < 16; ++r) rli[r] = __builtin_amdgcn_rcpf(wsf[32 + crow(r, hi)]);
  bf16* Ow = O + (rowbase + q0 + wid * QBLK) * DM + h * 64;
  { bf16* stg = (bf16*)(shm + LDS_OST) + wid * 2048;
    #pragma unroll
    for (int r = 0; r < 16; ++r) { const int orow = crow(r, hi);
      #pragma unroll
      for (int d0 = 0; d0 < 2; ++d0) stg[orow * 64 + d0 * 32 + r32] = (bf16)(cvtpk_s(o[d0][r] * rli[r], 0.f) & 0xffffu); }
    asm volatile("s_waitcnt lgkmcnt(0)" ::: "memory");
    #pragma unroll
    for (int i = 0; i < 4; ++i) { const int row = i * 8 + (lane >> 3), ch = lane & 7; const u32x4 v = *(const u32x4*)(stg + row * 64 + ch * 8); ATTN_STORE16(Ow + (long)row * DM + ch * 8, v); } }
  asm volatile("s_waitcnt lgkmcnt(0)\n\ts_barrier" ::: "memory");
  #undef DMA_K
  #undef DMA_V
  #undef ROT
  #undef BEFF
  #undef BRD1
  #undef ENDW
  #undef PKW
  #undef PAF
  #undef VFR
  #undef PIN
  #undef EX
}

__device__ __forceinline__ void sb_unit(int b, int h, int qb, const bf16* Q, const bf16* __restrict__ K, const bf16* __restrict__ V, bf16* O, char* shm) {
  const int tid = threadIdx.x, lane = tid & 63, r32 = lane & 31, hi = lane >> 5; const int wid = __builtin_amdgcn_readfirstlane(tid >> 6);
  const long rowbase = (long)b * 4096; const int q0 = qb * QB;
  const bf16* Qw = Q + (rowbase + q0 + wid * QBLK) * DM + h * 64;
  const bf16* Kh = K + rowbase * DM + h * 64, *Vh = V + rowbase * DM + h * 64;
  const unsigned lds0 = (unsigned)(uintptr_t)shm;
  const lds_cptr shm3 = (lds_cptr)shm;
  const bf16* ksrc = Kh + (long)lane * DM + wid * 8;
  const bf16* vsrc = Vh + (long)(16 * (wid & 3) + (lane >> 2)) * DM + (wid >> 2) * 32 + (lane & 3) * 8;
  const unsigned kdst = lds0 + LDS_K + wid * 1024, vdst = lds0 + LDS_V + wid * 1024;
  const int NTALL = (q0 + QB) / KVBLK;
  const int vb0 = (int)(lds0 + LDS_V) + ((lane >> 4) & 1) * 32 + (lane & 3) * 8 + (4 * hi + ((lane & 15) >> 2)) * 64;
  const lds_cptr kp0 = shm3 + LDS_K + hi * 1024 + r32 * 16; const lds_cptr vp0 = shm3 + LDS_V + ((lane >> 4) & 1) * 32 + (lane & 3) * 8 + (4 * hi + ((lane & 15) >> 2)) * 64;
  bf16x8 qr[4];
  #pragma unroll
  for (int d0 = 0; d0 < 4; ++d0) qr[d0] = *reinterpret_cast<const bf16x8*>(&Qw[(long)r32 * DM + d0 * 16 + hi * 8]);
  f32x16 o[2]; o[0] = f32x16{}; o[1] = f32x16{};
  const int tq = q0 + wid * QBLK + r32;
  const f32x16 zero16 = f32x16{};
  float cc = 1.0f;
  const bool hib = hi != 0;
  volatile __attribute__((address_space(3))) unsigned* live = (volatile __attribute__((address_space(3))) unsigned*)(shm3 + LDS_WS);
  int Thi = NTALL, Tlo = NTALL > 8 ? NTALL - 8 : 0;
  #define TT(u) (Thi - 1 - (u))
  #define DMA_K(u, slot) glds16(ksrc + (long)TT(u) * KVBLK * DM, (unsigned)__builtin_amdgcn_readfirstlane(kdst + (slot)))
  #define DMA_V(u, slot) glds16(vsrc + (long)TT(u) * KVBLK * DM, (unsigned)__builtin_amdgcn_readfirstlane(vdst + (slot)))
  #define CMASK(X0, X1, T) do { const int lim_ = tq - 64 * (T) - 4 * hi; \
      _Pragma("unroll") for (int r_ = 0; r_ < 16; ++r_) { const int kq_ = (r_ & 3) + 8 * (r_ >> 2); if (kq_ >= lim_) X0[r_] = -INFINITY; if (kq_ + 32 >= lim_) X1[r_] = -INFINITY; } } while (0)
  #define EX(v) __builtin_amdgcn_exp2f(v)
  #define PIN(x) asm volatile("" : "+v"(x))
  #define EXPG(X, B, k) do { X[B] = EX(X[B]); X[B + 1] = EX(X[B + 1]); X[B + 2] = EX(X[B + 2]); X[B + 3] = EX(X[B + 3]); \
      float g_ = 1.0f + X[B]; g_ = __builtin_fmaf(g_, X[B + 1], g_); g_ = __builtin_fmaf(g_, X[B + 2], g_); g_ = __builtin_fmaf(g_, X[B + 3], g_); G[k] = g_; } while (0)
  #define TAIL() do { float Gp_[8], W_[8]; \
      _Pragma("unroll") for (int k_ = 0; k_ < 8; ++k_) { auto rr_ = __builtin_amdgcn_permlane32_swap(__float_as_uint(G[k_]), __float_as_uint(G[k_]), false, false); \
          const float lo_ = __uint_as_float(rr_[0]), hi_ = __uint_as_float(rr_[1]); W_[k_] = lo_ * hi_; Gp_[k_] = hib ? lo_ : 1.0f; } \
      { const float p1_ = W_[0], p2_ = p1_ * W_[1], p3_ = p2_ * W_[2]; rD0 = __builtin_amdgcn_rcpf(p3_ * W_[3]); pf[0] = Gp_[0]; pf[1] = p1_ * Gp_[1]; pf[2] = p2_ * Gp_[2]; pf[3] = p3_ * Gp_[3]; } \
      { const float p1_ = W_[4], p2_ = p1_ * W_[5], p3_ = p2_ * W_[6]; rD1 = __builtin_amdgcn_rcpf(p3_ * W_[7]); pf[4] = Gp_[4]; pf[5] = p1_ * Gp_[5]; pf[6] = p2_ * Gp_[6]; pf[7] = p3_ * Gp_[7]; } } while (0)
  #define SCAN(X, B, k, cx) do { float u_ = (cx) * pf[k]; const float a0_ = u_ * X[B]; u_ += a0_; const float a1_ = u_ * X[B + 1]; u_ += a1_; const float a2_ = u_ * X[B + 2]; u_ += a2_; const float a3_ = u_ * X[B + 3]; \
      X[B] = a0_; X[B + 1] = a1_; X[B + 2] = a2_; X[B + 3] = a3_; } while (0)
  #define ROT() do { sl_prev = sl_cur; sl_cur = sl_next; sl_next = (sl_next == (NSLOT - 1) * SLOTB) ? 0 : sl_next + SLOTB; } while (0)
  #define PKW(P, B) cvtpk_s(P[B], P[B + 1])
  #define PAF(k) __builtin_bit_cast(bf16x8, pw##k)
  #define VFR(i) (bf16x8){vlo[i][0], vlo[i][1], vlo[i][2], vlo[i][3], vhi[i][0], vhi[i][1], vhi[i][2], vhi[i][3]}
  #define GAPA(MF, SC, W0, W1, PW) do { MF; SC; W0; W1; PIN(PW); SBAR(); } while (0)
  #define GAPB(MF, X, B, k) do { MF; EXPG(X, B, k); PIN(X); PIN(G[k]); SBAR(); } while (0)
  #define VRD(i) do { vlo[i] = vtr(vp_ + (((i) >> 2) * 4096 + ((i) & 3) * 1024)); vhi[i] = vtr(vp_ + (((i) >> 2) * 4096 + ((i) & 3) * 1024 + 512)); } while (0)
  #define KRD(Gd, j) do { if (Gd) { kload2(kf, kp0 + sl_next, j); SBAR(); } } while (0)
  #define STEP(C0, C1, P0, P1, u, GK, GV, GL) do { SBAR(); \
    const lds_cptr vp_ = vp0 + sl_prev; \
    const float cm_ = cc * rD1, co_ = cm_ * rD0; \
    VRD(0); SBAR(); \
    GAPA(C0 = MFMA32(kf[0], qr[0], zero16), SCAN(P0, 0, 0, co_),  pw0[0] = PKW(P0, 0), pw0[1] = PKW(P0, 2), pw0); \
    VRD(4); SBAR(); GAPA(C1 = MFMA32(kf[1], qr[0], zero16), SCAN(P0, 4, 1, co_),  pw0[2] = PKW(P0, 4), pw0[3] = PKW(P0, 6), pw0); \
    VRD(1); SBAR(); GAPA(C0 = MFMA32(kf[2], qr[1], C0), SCAN(P0, 8, 2, co_),  pw1[0] = PKW(P0, 8), pw1[1] = PKW(P0, 10), pw1); \
    VRD(5); SBAR(); GAPA(C1 = MFMA32(kf[3], qr[1], C1), SCAN(P0, 12, 3, co_), pw1[2] = PKW(P0, 12), pw1[3] = PKW(P0, 14), pw1); \
    VRD(2); SBAR(); GAPA(C0 = MFMA32(kf[4], qr[2], C0), SCAN(P1, 0, 4, cm_),  pw2[0] = PKW(P1, 0), pw2[1] = PKW(P1, 2), pw2); \
    VRD(6); SBAR(); GAPA(C1 = MFMA32(kf[5], qr[2], C1), SCAN(P1, 4, 5, cm_),  pw2[2] = PKW(P1, 4), pw2[3] = PKW(P1, 6), pw2); \
    VRD(3); SBAR(); GAPA(C0 = MFMA32(kf[6], qr[3], C0), SCAN(P1, 8, 6, cm_),  pw3[0] = PKW(P1, 8), pw3[1] = PKW(P1, 10), pw3); \
    VRD(7); SBAR(); GAPA(C1 = MFMA32(kf[7], qr[3], C1), SCAN(P1, 12, 7, cm_), pw3[2] = PKW(P1, 12), pw3[3] = PKW(P1, 14), pw3); \
    cc = co_; \
    if (GK) { DMA_K((u) + 3, sl_cur); } if (GV) { DMA_V((u) + 1, sl_next); } \
    if (TT(u) >= 4 * qb) { CMASK(C0, C1, TT(u)); } \
    SBAR(); \
    GAPB(o[0] = MFMA32(PAF(0), VFR(0), o[0]), C0, 0, 0); \
    GAPB(o[1] = MFMA32(PAF(0), VFR(4), o[1]), C0, 4, 1); \
    KRD(GL, 0); GAPB(o[0] = MFMA32(PAF(1), VFR(1), o[0]), C0, 8, 2); \
    KRD(GL, 1); GAPB(o[1] = MFMA32(PAF(1), VFR(5), o[1]), C0, 12, 3); \
    KRD(GL, 2); GAPB(o[0] = MFMA32(PAF(2), VFR(2), o[0]), C1, 0, 4); \
    KRD(GL, 3); GAPB(o[1] = MFMA32(PAF(2), VFR(6), o[1]), C1, 4, 5); \
    GAPB(o[0] = MFMA32(PAF(3), VFR(3), o[0]), C1, 8, 6); \
    GAPB(o[1] = MFMA32(PAF(3), VFR(7), o[1]), C1, 12, 7); \
    TAIL(); SBAR(); \
    } while (0)
  #define ENDW(tt) do { if ((tt) + 3 < NT) { WAIT_BAR(2); } else if ((tt) + 2 < NT) { WAIT_BAR(1); } else { WAIT_BAR(0); } } while (0)
  for (;;) {
    const int NT = Thi - Tlo;
    bf16x8 kf[8]; f32x16 pA0, pA1, pB0, pB1; float pf[8], rD0, rD1, G[8];
    DMA_K(0, 0); DMA_V(0, 0); DMA_K(1, SLOTB); DMA_K(2, 2 * SLOTB);
    WAIT_BAR(3);
    int sl_prev = 0, sl_cur = 0, sl_next = SLOTB;
    pA0 = zero16; pA1 = zero16;
    { const char* kb = shm + LDS_K + hi * 1024 + r32 * 16;
      #pragma unroll
      for (int d0 = 0; d0 < 4; ++d0) { const bf16x8 b0 = *reinterpret_cast<const bf16x8*>(kb + d0 * 2048); const bf16x8 b1 = *reinterpret_cast<const bf16x8*>(kb + d0 * 2048 + 512);
        pA0 = MFMA32(b0, qr[d0], pA0); pA1 = MFMA32(b1, qr[d0], pA1); } }
    if (TT(0) >= 4 * qb) { CMASK(pA0, pA1, TT(0)); }
    EXPG(pA0, 0, 0); EXPG(pA0, 4, 1); EXPG(pA0, 8, 2); EXPG(pA0, 12, 3); EXPG(pA1, 0, 4); EXPG(pA1, 4, 5); EXPG(pA1, 8, 6); EXPG(pA1, 12, 7); TAIL();
    WAIT_BAR(0);
    DMA_K(3, 0); DMA_V(1, SLOTB);
    ROT();
    kload8(kf, kp0 + sl_cur);
    WAIT_BAR(2);
    s16x4 vlo[8], vhi[8]; u32x4 pw0, pw1, pw2, pw3;
    int t = 1;
    for (; t + 5 < NT; t += 2) {
      STEP(pB0, pB1, pA0, pA1, t, true, true, true);     WAIT_BAR(2); ROT();
      STEP(pA0, pA1, pB0, pB1, t + 1, true, true, true); WAIT_BAR(2); ROT();
    }
    for (; t + 1 < NT; t += 2) {
      STEP(pB0, pB1, pA0, pA1, t, (t + 3 < NT), (t + 1 < NT), (t + 1 < NT));       ENDW(t);     ROT();
      STEP(pA0, pA1, pB0, pB1, t + 1, (t + 4 < NT), (t + 2 < NT), (t + 2 < NT));   ENDW(t + 1); ROT();
    }
    STEP(pB0, pB1, pA0, pA1, NT - 1, false, false, false);
    { const float cm_ = cc * rD1, co_ = cm_ * rD0;
      SCAN(pB0, 0, 0, co_); SCAN(pB0, 4, 1, co_); SCAN(pB0, 8, 2, co_); SCAN(pB0, 12, 3, co_); SCAN(pB1, 0, 4, cm_); SCAN(pB1, 4, 5, cm_); SCAN(pB1, 8, 6, cm_); SCAN(pB1, 12, 7, cm_);
      cc = co_;
      pw0 = (u32x4){PKW(pB0, 0), PKW(pB0, 2), PKW(pB0, 4), PKW(pB0, 6)}; pw1 = (u32x4){PKW(pB0, 8), PKW(pB0, 10), PKW(pB0, 12), PKW(pB0, 14)};
      pw2 = (u32x4){PKW(pB1, 0), PKW(pB1, 2), PKW(pB1, 4), PKW(pB1, 6)}; pw3 = (u32x4){PKW(pB1, 8), PKW(pB1, 10), PKW(pB1, 12), PKW(pB1, 14)};
      SBAR(); pv(o, vb0 + sl_cur, PAF(0), PAF(1), PAF(2), PAF(3)); }
    if (Tlo == 0) break;
    { const unsigned al_ = __any(cc > 5.421010862e-20f) ? 1u : 0u; if (lane == 0) live[wid] = al_; }
    asm volatile("s_waitcnt lgkmcnt(0)\n\ts_barrier" ::: "memory");
    unsigned a_ = 0u;
    #pragma unroll
    for (int w_ = 0; w_ < 8; ++w_) a_ |= live[w_];
    asm volatile("s_waitcnt lgkmcnt(0)\n\ts_barrier" ::: "memory");
#if defined(SB_FORCE_EXIT)
    break;
#endif
    if (__builtin_amdgcn_readfirstlane(a_) == 0u) break;
    Thi = Tlo; Tlo = 0;
  }
  bf16* Ow = O + (rowbase + q0 + wid * QBLK) * DM + h * 64;
  { bf16* stg = (bf16*)(shm + LDS_OST) + wid * 2048;
    #pragma unroll
    for (int r = 0; r < 16; ++r) { const int orow = crow(r, hi);
      #pragma unroll
      for (int d0 = 0; d0 < 2; ++d0) stg[orow * 64 + d0 * 32 + r32] = (bf16)(cvtpk_s(o[d0][r], 0.f) & 0xffffu); }
    asm volatile("s_waitcnt lgkmcnt(0)" ::: "memory");
    #pragma unroll
    for (int i = 0; i < 4; ++i) { const int row = i * 8 + (lane >> 3), ch = lane & 7; const u32x4 v = *(const u32x4*)(stg + row * 64 + ch * 8); ATTN_STORE16(Ow + (long)row * DM + ch * 8, v); } }
  asm volatile("s_waitcnt vmcnt(0) lgkmcnt(0)\n\ts_barrier" ::: "memory");
  #undef STEP
  #undef KRD
  #undef VRD
  #undef GAPB
  #undef GAPA
  #undef DMA_K
  #undef DMA_V
  #undef ROT
  #undef CMASK
  #undef ENDW
  #undef PKW
  #undef PAF
  #undef VFR
  #undef PIN
  #undef EX
  #undef EXPG
  #undef TAIL
  #undef SCAN
  #undef TT
}
}
struct Frame {
    LAS unsigned char* lds;
    volatile LAS unsigned* MISC;
    gu32* ctl;
    int tid, lane, wave;
    int vcu, G;
    const float *x, *c, *w_ada, *b_ada, *g_mix, *w_in, *g_q, *g_k, *rel_bias, *w_br_moba, *w_br_sb, *w_out, *g_ffn, *w_rg, *b_rg, *w_re, *b_re, *w_gate, *w_up, *w_down;
    float* out;
    float *mod, *biasT, *btg, *stats, *kmean;
    bf16 *wrt_hi, *wrt_lo;
    bf16 *Win_t, *Wbra_t, *Wbrb_t, *Wout_t, *Wgu_t, *Wd_t;
    bf16 *XN, *QA, *KA, *VA, *QB, *KB, *VB, *OA, *OB, *GA, *GB, *H;
    int* tokl; float* wl; unsigned* cnt; int* inv; float* winv; bf16* Y;
};
__device__ __forceinline__ float wave_sum(float v) {
#pragma unroll
    for (int o = 1; o < 64; o <<= 1) v += __shfl_xor(v, o);
    return v;
}
__device__ __forceinline__ int lane_zero() { int z; asm volatile("v_mov_b32 %0, 0" : "=v"(z)); return z; }

__device__ __forceinline__ void p0_transpose_item(const float* W, int K, int N, bf16* WT, int k0, int n0, int drow0, LAS float* scr, int lane) {
#pragma unroll 8
    for (int i = 0; i < 32; ++i) { const int kk = 2 * i + (lane >> 5); scr[kk * 33 + (lane & 31)] = W[(size_t)(k0 + kk) * N + n0 + (lane & 31)]; }
    LDS_WAIT(); asm volatile("" ::: "memory");
    const int c = lane & 7;
#pragma unroll
    for (int j = 0; j < 4; ++j) { const int n = (lane >> 3) + 8 * j; const LAS float* s = scr + (8 * c) * 33 + n;
        v4u o; o.x = pk2(s[0 * 33], s[1 * 33]); o.y = pk2(s[2 * 33], s[3 * 33]); o.z = pk2(s[4 * 33], s[5 * 33]); o.w = pk2(s[6 * 33], s[7 * 33]);
        *(GAS v4u*)(WT + (size_t)(drow0 + n) * K + k0 + 8 * c) = o; }
    LDS_WAIT(); asm volatile("" ::: "memory");
}

__device__ __forceinline__ void p0_prologue(Frame& F) {
    {
        LAS float* sc = (LAS float*)(F.lds + RING_OFF);
        LAS float* part = (LAS float*)(F.lds + RING_OFF + 32768);
        for (int i = F.tid; i < BATCH * D; i += NWAVES * 64) { const float v = F.c[i]; sc[i] = v * fsigmoid(v); }
        __syncthreads();
        for (int chunk = F.vcu; chunk < 256; chunk += F.G) {
            const int kp = F.tid / 24, cI = F.tid % 24;
            if (kp < 21) {
                float a[8];
#pragma unroll
                for (int b = 0; b < 8; ++b) a[b] = 0.f;
                const int k0 = kp * 49, k1 = (k0 + 49 < D) ? k0 + 49 : D;
                for (int k = k0; k < k1; ++k) { const float w = F.w_ada[(size_t)k * (NMOD * D) + chunk * 24 + cI];
#pragma unroll
                    for (int b = 0; b < 8; ++b) a[b] += sc[b * D + k] * w; }
#pragma unroll
                for (int b = 0; b < 8; ++b) part[(kp * 24 + cI) * 8 + b] = a[b];
            }
            __syncthreads();
            if (F.tid < 192) { const int cI2 = F.tid % 24, b = F.tid / 24; float s = 0.f;
                for (int kp2 = 0; kp2 < 21; ++kp2) s += part[(kp2 * 24 + cI2) * 8 + b];
                const int col = chunk * 24 + cI2; F.mod[(size_t)b * (NMOD * D) + col] = s + F.b_ada[col]; }
            __syncthreads();
        }
    }
    const int gw = F.vcu * NWAVES + F.wave, NGW = F.G * NWAVES;
    for (int i = gw * 64 + F.lane; i < NH * SEQ; i += NGW * 64) { const int h = i / SEQ, n = i % SEQ; int bk;
        if (n < 16) bk = n; else { const float nf = (float)n; int lg = 16 + (int)(logf(nf / 16.0f) / 4.1588830833596715f * 16.0f); bk = lg < 31 ? lg : 31; }
        F.biasT[i] = F.rel_bias[h * 32 + bk] * LOG2E; }
    for (int i = gw * 64 + F.lane; i < (NH + 1) * (attn::BT_BYTES / 4); i += NGW * 64) { const int h = i / (attn::BT_BYTES / 4), w = i % (attn::BT_BYTES / 4); float val = -INFINITY;
        if (w < 4 * attn::BT_LEN) { const int a = w / attn::BT_LEN, xx = w % attn::BT_LEN, ri = xx + a;
            if (h == NH) { if (ri < attn::REV) val = 0.f; }
            else if (ri <= attn::REV) { const int n = attn::REV - ri; int bk; if (n < 16) bk = n; else { const float nf = (float)n; int lg = 16 + (int)(logf(nf / 16.0f) / 4.1588830833596715f * 16.0f); bk = lg < 31 ? lg : 31; }
                val = F.rel_bias[h * 32 + bk] * LOG2E; } }
        F.btg[i] = val; }
    for (int i = gw * 64 + F.lane; i < 48 * D; i += NGW * 64) { const int col = i / D, k = i % D; float v = 0.f;
        if (col < NGRP) v = F.w_rg[(size_t)k * NGRP + col]; else if (col < NGRP + NEXP) v = F.w_re[(size_t)k * NEXP + col - NGRP];
        const unsigned hb = f2bf(v); const float r = v - __uint_as_float(hb << 16); F.wrt_hi[i] = (bf16)hb; F.wrt_lo[i] = (bf16)f2bf(r); }
    LAS float* scr = (LAS float*)(F.lds + RING_OFF + F.wave * 16384);
    constexpr int I_IN = (D / 64) * (INCOLS / 32), I_BR = (WATT / 64) * (D / 32), I_OUT = (D / 64) * (D / 32), I_G = NEXP * (D / 64) * (DEXP / 32), I_D = NEXP * (DEXP / 64) * (D / 32);
    constexpr int NITEMS = I_IN + 2 * I_BR + I_OUT + 2 * I_G + I_D;
    for (int it = gw; it < NITEMS; it += NGW) {
        int r = it;
        if (r < I_IN) { const int nblk = INCOLS / 32, kb = r / nblk, nb = r % nblk, n0 = 32 * nb, t = n0 & 255;
            const int p0 = 128 * ((t >> 5) & 1) + 32 * (t >> 6);
            p0_transpose_item(F.w_in, D, INCOLS, F.Win_t, 64 * kb, n0, (n0 - t) + p0, scr, F.lane); continue; } r -= I_IN;
        if (r < I_BR) { const int nblk = D / 32, kb = r / nblk, nb = r % nblk; p0_transpose_item(F.w_br_moba, WATT, D, F.Wbra_t, 64 * kb, 32 * nb, 32 * nb, scr, F.lane); continue; } r -= I_BR;
        if (r < I_BR) { const int nblk = D / 32, kb = r / nblk, nb = r % nblk; p0_transpose_item(F.w_br_sb, WATT, D, F.Wbrb_t, 64 * kb, 32 * nb, 32 * nb, scr, F.lane); continue; } r -= I_BR;
        if (r < I_OUT) { const int nblk = D / 32, kb = r / nblk, nb = r % nblk; p0_transpose_item(F.w_out, D, D, F.Wout_t, 64 * kb, 32 * nb, 32 * nb, scr, F.lane); continue; } r -= I_OUT;
        if (r < 2 * I_G) { const int up = r >= I_G; if (up) r -= I_G; constexpr int per = (D / 64) * (DEXP / 32); const int e = r / per, q = r % per, nblk = DEXP / 32, kb = q / nblk, nb = q % nblk, n0 = 32 * nb;
            p0_transpose_item((up ? F.w_up : F.w_gate) + (size_t)e * D * DEXP, D, DEXP, F.Wgu_t, 64 * kb, n0, e * 1024 + 256 * (n0 >> 7) + (up ? 128 : 0) + (n0 & 127), scr, F.lane); continue; } r -= 2 * I_G;
        { constexpr int per = (DEXP / 64) * (D / 32); const int e = r / per, q = r % per, nblk = D / 32, kb = q / nblk, nb = q % nblk;
            p0_transpose_item(F.w_down + (size_t)e * DEXP * D, DEXP, D, F.Wd_t, 64 * kb, 32 * nb, e * 1024 + 32 * nb, scr, F.lane); }
    }
}

__device__ __forceinline__ void p1_norm(Frame& F) {
    const int gw = F.vcu * NWAVES + F.wave, NGW = F.G * NWAVES;
    for (int m = gw; m < NTOK; m += NGW) {
        const int b = m / SEQ;
        const GAS f32x4* xr = (const GAS f32x4*)(F.x + (size_t)m * D) + F.lane;
        const GAS f32x4* gr = (const GAS f32x4*)F.g_mix + F.lane;
        const GAS f32x4* shr = (const GAS f32x4*)(F.mod + (size_t)b * (NMOD * D)) + F.lane;
        const GAS f32x4* scr = (const GAS f32x4*)(F.mod + (size_t)b * (NMOD * D) + D) + F.lane;
        f32x4 v[4]; float s = 0.f;
#pragma unroll
        for (int j = 0; j < 4; ++j) { v[j] = xr[64 * j]; s += (v[j].x * v[j].x + v[j].y * v[j].y) + (v[j].z * v[j].z + v[j].w * v[j].w); }
        const float rstd = __builtin_amdgcn_rsqf(wave_sum(s) * (1.f / D) + RMS_EPS);
        GAS unsigned long long* o8 = (GAS unsigned long long*)(F.XN + (size_t)m * D) + F.lane;
#pragma unroll
        for (int j = 0; j < 4; ++j) { const f32x4 g = gr[64 * j], sh = shr[64 * j], sc = scr[64 * j]; const f32x4 y = (v[j] * rstd * g) * (sc + 1.0f) + sh;
            o8[64 * j] = (unsigned long long)pk2(y.x, y.y) | ((unsigned long long)pk2(y.z, y.w) << 32); }
    }
}

__device__ __forceinline__ float dot64(const unsigned (&q)[32], const v4u (&k)[8]) {
    float a0 = 0.f, a1 = 0.f;
#pragma unroll
    for (int i = 0; i < 8; ++i) {
        a0 += bflo(q[4 * i]) * bflo(k[i].x) + bflo(q[4 * i + 1]) * bflo(k[i].y) + bflo(q[4 * i + 2]) * bflo(k[i].z) + bflo(q[4 * i + 3]) * bflo(k[i].w);
        a1 += bfhi(q[4 * i]) * bfhi(k[i].x) + bfhi(q[4 * i + 1]) * bfhi(k[i].y) + bfhi(q[4 * i + 2]) * bfhi(k[i].z) + bfhi(q[4 * i + 3]) * bfhi(k[i].w); }
    return a0 + a1;
}
#define LOADROW(dst, p) do { _Pragma("unroll") for (int i_ = 0; i_ < 8; ++i_) dst[i_] = ((const GAS v4u*)(p))[i_]; } while (0)
#define AXPY64(o, p, v) do { _Pragma("unroll") for (int i_ = 0; i_ < 8; ++i_) { \
    o[8 * i_ + 0] += p * bflo(v[i_].x); o[8 * i_ + 1] += p * bfhi(v[i_].x); o[8 * i_ + 2] += p * bflo(v[i_].y); o[8 * i_ + 3] += p * bfhi(v[i_].y); \
    o[8 * i_ + 4] += p * bflo(v[i_].z); o[8 * i_ + 5] += p * bfhi(v[i_].z); o[8 * i_ + 6] += p * bflo(v[i_].w); o[8 * i_ + 7] += p * bfhi(v[i_].w); } } while (0)
#define STOREO(ptr, o, sc) do { _Pragma("unroll") for (int i_ = 0; i_ < 8; ++i_) { v4u w_; w_.x = pk2(o[8 * i_] * sc, o[8 * i_ + 1] * sc); w_.y = pk2(o[8 * i_ + 2] * sc, o[8 * i_ + 3] * sc); \
    w_.z = pk2(o[8 * i_ + 4] * sc, o[8 * i_ + 5] * sc); w_.w = pk2(o[8 * i_ + 6] * sc, o[8 * i_ + 7] * sc); ((GAS v4u*)(ptr))[i_] = w_; } } while (0)

__device__ __forceinline__ void moba_naive_item(Frame& F, int item) {
    const int bh = item >> 6, ch = item & 63, b = bh >> 3, h = bh & 7, lz = lane_zero();
    const int t = ch * 64 + F.lane, own = ch >> 2, tl = t & 255;
    const size_t rowb = (size_t)b * SEQ;
    unsigned q[32]; { v4u t4[8]; LOADROW(t4, F.QA + (rowb + t) * WATT + h * HD);
#pragma unroll
        for (int i = 0; i < 8; ++i) { q[4 * i] = t4[i].x; q[4 * i + 1] = t4[i].y; q[4 * i + 2] = t4[i].z; q[4 * i + 3] = t4[i].w; } }
    float v0 = -INFINITY, v1 = -INFINITY, v2 = -INFINITY; int i0 = 0, i1 = 0, i2 = 0;
    for (int j = 0; j < own; ++j) {
        const GAS f32x4* km = (const GAS f32x4*)(F.kmean + ((size_t)(b * NBLK + j) * NH + h) * HD + lz);
        float g = 0.f;
#pragma unroll
        for (int i = 0; i < 16; ++i) { const f32x4 kv = km[i]; g += bflo(q[2 * i]) * kv.x + bfhi(q[2 * i]) * kv.y + bflo(q[2 * i + 1]) * kv.z + bfhi(q[2 * i + 1]) * kv.w; }
        if (g > v0) { v2 = v1; i2 = i1; v1 = v0; i1 = i0; v0 = g; i0 = j; } else if (g > v1) { v2 = v1; i2 = i1; v1 = g; i1 = j; } else if (g > v2) { v2 = g; i2 = j; }
    }
    float m = -INFINITY, l = 0.f; float o[64];
#pragma unroll
    for (int i = 0; i < 64; ++i) o[i] = 0.f;
    const float* bt = F.biasT + h * SEQ;
    const int nsel = own < 3 ? own : 3;
    for (int sl = 0; sl < nsel; ++sl) {
        const int blk = sl == 0 ? i0 : (sl == 1 ? i1 : i2);
        const bf16* kp = F.KA + (rowb + blk * MBLK) * WATT + h * HD; const bf16* vp = F.VA + (rowb + blk * MBLK) * WATT + h * HD;
        const int dist0 = t - blk * MBLK;
        for (int s = 0; s < MBLK; ++s) {
            v4u kk[8]; LOADROW(kk, kp + (size_t)s * WATT); const float sc = dot64(q, kk) + bt[dist0 - s];
            const float mn = fmaxf(m, sc), al = __builtin_amdgcn_exp2f(m - mn), p = __builtin_amdgcn_exp2f(sc - mn);
            l = l * al + p; m = mn;
#pragma unroll
            for (int i = 0; i < 64; ++i) o[i] *= al;
            v4u vv[8]; LOADROW(vv, vp + (size_t)s * WATT); AXPY64(o, p, vv);
        }
    }
    {
        const bf16* kp = F.KA + (rowb + own * MBLK) * WATT + h * HD + lz; const bf16* vp = F.VA + (rowb + own * MBLK) * WATT + h * HD + lz;
        const int smax = (ch & 3) * 64 + 63;
        for (int s = 0; s <= smax; ++s) {
            v4u kk[8]; LOADROW(kk, kp + (size_t)s * WATT); const int dist = tl - s; const float sc = dot64(q, kk) + bt[dist > 0 ? dist : 0];
            if (dist >= 0) {
                const float mn = fmaxf(m, sc), al = __builtin_amdgcn_exp2f(m - mn), p = __builtin_amdgcn_exp2f(sc - mn);
                l = l * al + p; m = mn;
#pragma unroll
                for (int i = 0; i < 64; ++i) o[i] *= al;
                v4u vv[8]; LOADROW(vv, vp + (size_t)s * WATT); AXPY64(o, p, vv);
            }
        }
    }
    const float rl = 1.0f / l;
    STOREO(F.OA + (rowb + t) * WATT + h * HD, o, rl);
}
__device__ __forceinline__ void sb_naive_item(Frame& F, int item) {
    const int bh = item >> 6, ch = item & 63, b = bh >> 3, h = bh & 7, lz = lane_zero();
    const int t = ch * 64 + F.lane;
    const size_t rowb = (size_t)b * SEQ;
    unsigned q[32]; { v4u t4[8]; LOADROW(t4, F.QB + (rowb + t) * WATT + h * HD);
#pragma unroll
        for (int i = 0; i < 8; ++i) { q[4 * i] = t4[i].x; q[4 * i + 1] = t4[i].y; q[4 * i + 2] = t4[i].z; q[4 * i + 3] = t4[i].w; } }
    float c = 1.0f; float o[64];
#pragma unroll
    for (int i = 0; i < 64; ++i) o[i] = 0.f;
    const bf16* kp = F.KB + rowb * WATT + h * HD + lz; const bf16* vp = F.VB + rowb * WATT + h * HD + lz;
    for (int s = ch * 64 + 62; s >= 0; --s) {
        v4u kk[8]; LOADROW(kk, kp + (size_t)s * WATT); const float e = __builtin_amdgcn_exp2f(dot64(q, kk)); const float r = 1.0f / (1.0f + e);
        if (s < t) { const float a = e * r * c; c *= r; v4u vv[8]; LOADROW(vv, vp + (size_t)s * WATT); AXPY64(o, a, vv); }
    }
    STOREO(F.OB + (rowb + t) * WATT + h * HD, o, 1.0f);
}
__device__ __forceinline__ void p3_sb_naive(Frame& F) {
    const int gw = F.vcu * NWAVES + F.wave, NGW = F.G * NWAVES;
    for (int p = gw; p < 2048; p += NGW) { const int bh = p >> 5, j = p & 31;
        sb_naive_item(F, bh * 64 + j); sb_naive_item(F, bh * 64 + 63 - j); }
}
__device__ __forceinline__ void p3_moba_naive(Frame& F) {
    const int gw = F.vcu * NWAVES + F.wave, NGW = F.G * NWAVES;
    for (int p = gw; p < 2048; p += NGW) { const int bh = p >> 5, j = p & 31;
        moba_naive_item(F, bh * 64 + j); moba_naive_item(F, bh * 64 + 63 - j); }
}
__device__ __forceinline__ bool attn_deal(const Frame& F, int i, int& bh, int& qb) {
    if (F.G == 256) { if (i >= 4) return false; const int s = F.vcu & 3; bh = F.vcu >> 2; qb = (i == 0) ? s : (i == 1) ? 7 - s : (i == 2) ? 8 + s : 15 - s; return true; }
    const int u = F.vcu + i * F.G; if (u >= 1024) return false; bh = u >> 4; qb = u & 15; return true;
}
__device__ __forceinline__ void p3_sb(Frame& F) {
    __syncthreads();
    for (int k = F.tid; k < attn::BT_BYTES / 16; k += NWAVES * 64) *(LAS v4u*)(F.lds + RING_OFF + attn::LDS_BT + 16 * k) = *(const GAS v4u*)(F.btg + (size_t)NH * (attn::BT_BYTES / 4) + 4 * k);
    __syncthreads();
    int bh, qb;
    for (int i = 0; attn_deal(F, i, bh, qb); ++i) attn::sb_unit(bh >> 3, bh & 7, qb, F.QB, F.KB, F.VB, F.OB, (char*)F.lds + RING_OFF);
}
__device__ __forceinline__ void p3_moba(Frame& F) {
    int bh, qb, curh = -1;
    for (int i = 0; attn_deal(F, i, bh, qb); ++i) { const int b = bh >> 3, h = bh & 7;
        if (h != curh) { __syncthreads();
            for (int k = F.tid; k < attn::BT_BYTES / 16; k += NWAVES * 64) *(LAS v4u*)(F.lds + RING_OFF + attn::LDS_BT + 16 * k) = *(const GAS v4u*)(F.btg + (size_t)h * (attn::BT_BYTES / 4) + 4 * k);
            __syncthreads(); curh = h; }
        attn::moba_unit(b, h, qb, F.QA, F.KA, F.VA, F.OA, F.kmean, (char*)F.lds + RING_OFF); }
}
__device__ __forceinline__ void p6_route(Frame& F) {
    const int gw = F.vcu * NWAVES + F.wave, NGW = F.G * NWAVES;
    for (int m = gw; m < NTOK; m += NGW) {
        const int b = m / SEQ;
        const GAS f32x4* xr = (const GAS f32x4*)(F.out + (size_t)m * D) + F.lane;
        const GAS f32x4* gr = (const GAS f32x4*)F.g_ffn + F.lane;
        const GAS f32x4* shr = (const GAS f32x4*)(F.mod + (size_t)b * (NMOD * D) + 3 * D) + F.lane;
        const GAS f32x4* scr = (const GAS f32x4*)(F.mod + (size_t)b * (NMOD * D) + 4 * D) + F.lane;
        float ss = 0.f; { const GAS f32x4* sp = (const GAS f32x4*)(F.stats + (size_t)m * 16);
#pragma unroll
            for (int j = 0; j < 4; ++j) { const f32x4 s4 = sp[j]; ss += (s4.x + s4.y) + (s4.z + s4.w); } }
        const float rstd = __builtin_amdgcn_rsqf(ss * (1.f / D) + RMS_EPS);
        f32x4 y[4];
        GAS unsigned long long* o8 = (GAS unsigned long long*)(F.XN + (size_t)m * D) + F.lane;
#pragma unroll
        for (int j = 0; j < 4; ++j) { const f32x4 v = xr[64 * j], g = gr[64 * j], sh = shr[64 * j], sc = scr[64 * j]; y[j] = (v * rstd * g) * (sc + 1.0f) + sh;
            o8[64 * j] = (unsigned long long)pk2(y[j].x, y[j].y) | ((unsigned long long)pk2(y[j].z, y[j].w) << 32); }
        float gl[4] = {0.f, 0.f, 0.f, 0.f};
#pragma unroll
        for (int j = 0; j < 4; ++j) { const GAS f32x4* wp = (const GAS f32x4*)(F.w_rg + (size_t)(4 * F.lane + 256 * j) * NGRP);
#pragma unroll
            for (int e = 0; e < 4; ++e) { const f32x4 w = wp[e]; const float yv = y[j][e]; gl[0] += yv * w.x; gl[1] += yv * w.y; gl[2] += yv * w.z; gl[3] += yv * w.w; } }
#pragma unroll
        for (int g = 0; g < 4; ++g) gl[g] = wave_sum(gl[g]) + F.b_rg[g];
        int gi = 0; float gm = gl[0];
#pragma unroll
        for (int g = 1; g < 4; ++g) if (gl[g] > gm) { gm = gl[g]; gi = g; }
        float den = 0.f;
#pragma unroll
        for (int g = 0; g < 4; ++g) den += __expf(gl[g] - gm);
        const float gwt = 1.0f / den;
        float el[8] = {0.f, 0.f, 0.f, 0.f, 0.f, 0.f, 0.f, 0.f};
#pragma unroll
        for (int j = 0; j < 4; ++j)
#pragma unroll
            for (int e = 0; e < 4; ++e) { const GAS f32x4* wp = (const GAS f32x4*)(F.w_re + (size_t)(4 * F.lane + 256 * j + e) * NEXP + gi * EPG); const f32x4 w0 = wp[0], w1 = wp[1]; const float yv = y[j][e];
                el[0] += yv * w0.x; el[1] += yv * w0.y; el[2] += yv * w0.z; el[3] += yv * w0.w; el[4] += yv * w1.x; el[5] += yv * w1.y; el[6] += yv * w1.z; el[7] += yv * w1.w; }
#pragma unroll
        for (int k = 0; k < 8; ++k) el[k] = wave_sum(el[k]) + F.b_re[gi * EPG + k];
        int k1 = 0; float t1 = el[0];
#pragma unroll
        for (int k = 1; k < 8; ++k) if (el[k] > t1) { t1 = el[k]; k1 = k; }
        int k2 = -1; float t2 = -INFINITY;
#pragma unroll
        for (int k = 0; k < 8; ++k) if (k != k1 && el[k] > t2) { t2 = el[k]; k2 = k; }
        const float ex = __expf(t2 - t1); const float w1v = gwt / (1.0f + ex), w2v = gwt * ex / (1.0f + ex);
        if (F.lane < 2) { const int e = gi * EPG + (F.lane == 0 ? k1 : k2); const float w = F.lane == 0 ? w1v : w2v;
            const unsigned pos = __hip_atomic_fetch_add(F.cnt + (F.lane * NEXP + e) * 64, 1u, __ATOMIC_RELAXED, __HIP_MEMORY_SCOPE_AGENT);
            F.tokl[(size_t)(F.lane * NEXP + e) * LCAP + pos] = m; F.wl[(size_t)(F.lane * NEXP + e) * LCAP + pos] = w; }
    }
}
__device__ __forceinline__ void p6_route_mfma(Frame& F) {
    typedef float f32x4v __attribute__((ext_vector_type(4)));
    const int NGW = F.G * NWAVES; const int r = F.lane & 15, kg = F.lane >> 4;
    LAS float* gsT = (LAS float*)(F.lds + RING_OFF);
    LAS float* shT = (LAS float*)(F.lds + RING_OFF + 4096);
    LAS float* lg = (LAS float*)(F.lds + RING_OFF + 8192) + F.wave * (16 * 48);
    for (int rb0 = F.vcu * NWAVES; rb0 < NTOK / 16; rb0 += NGW) {
        const int rb = rb0 + F.wave; const int row0 = rb * 16, b = (rb0 * 16) / SEQ;
        __syncthreads();
        for (int i = F.tid; i < D; i += NWAVES * 64) { gsT[i] = F.g_ffn[i] * (1.0f + F.mod[(size_t)b * (NMOD * D) + 4 * D + i]); shT[i] = F.mod[(size_t)b * (NMOD * D) + 3 * D + i]; }
        __syncthreads();
        const int row = row0 + r;
        float ss = 0.f; { const GAS f32x4* sp = (const GAS f32x4*)(F.stats + (size_t)row * 16);
#pragma unroll
            for (int j = 0; j < 4; ++j) { const f32x4 s4 = sp[j]; ss += (s4.x + s4.y) + (s4.z + s4.w); } }
        const float rstd = __builtin_amdgcn_rsqf(ss * (1.f / D) + RMS_EPS);
        f32x4v acc[3] = {{0.f, 0.f, 0.f, 0.f}, {0.f, 0.f, 0.f, 0.f}, {0.f, 0.f, 0.f, 0.f}};
        const float* xrow = F.out + (size_t)row * D + 8 * kg; bf16* orow = F.XN + (size_t)row * D + 8 * kg;
        const bf16* whp = F.wrt_hi + (size_t)r * D + 8 * kg; const bf16* wlp = F.wrt_lo + (size_t)r * D + 8 * kg;
#pragma unroll 4
        for (int ks = 0; ks < 32; ++ks) { const int k = 32 * ks;
            const f32x4 xa = *(const GAS f32x4*)(xrow + k), xb = *(const GAS f32x4*)(xrow + k + 4);
            const f32x4 ga = *(const LAS f32x4*)(gsT + k + 8 * kg), gb = *(const LAS f32x4*)(gsT + k + 8 * kg + 4), sa = *(const LAS f32x4*)(shT + k + 8 * kg), sb = *(const LAS f32x4*)(shT + k + 8 * kg + 4);
            const f32x4 ha = (xa * rstd) * ga + sa, hb = (xb * rstd) * gb + sb;
            v4u hw; hw.x = pk2(ha.x, ha.y); hw.y = pk2(ha.z, ha.w); hw.z = pk2(hb.x, hb.y); hw.w = pk2(hb.z, hb.w);
            *(GAS v4u*)(orow + k) = hw;
            v4u lw; lw.x = pk2(ha.x - bflo(hw.x), ha.y - bfhi(hw.x)); lw.y = pk2(ha.z - bflo(hw.y), ha.w - bfhi(hw.y)); lw.z = pk2(hb.x - bflo(hw.z), hb.y - bfhi(hw.z)); lw.w = pk2(hb.z - bflo(hw.w), hb.w - bfhi(hw.w));
            const bf16x8 Ah = __builtin_bit_cast(bf16x8, hw), Al = __builtin_bit_cast(bf16x8, lw);
#pragma unroll
            for (int n = 0; n < 3; ++n) { const bf16x8 Bh = *(const GAS bf16x8*)(whp + (size_t)n * 16 * D + k), Bl = *(const GAS bf16x8*)(wlp + (size_t)n * 16 * D + k);
                acc[n] = __builtin_amdgcn_mfma_f32_16x16x32_bf16(Ah, Bh, acc[n], 0, 0, 0); acc[n] = __builtin_amdgcn_mfma_f32_16x16x32_bf16(Al, Bh, acc[n], 0, 0, 0); acc[n] = __builtin_amdgcn_mfma_f32_16x16x32_bf16(Ah, Bl, acc[n], 0, 0, 0); }
        }
#pragma unroll
        for (int n = 0; n < 3; ++n)
#pragma unroll
            for (int e = 0; e < 4; ++e) lg[(4 * kg + e) * 48 + 16 * n + r] = acc[n][e];
        LDS_WAIT(); asm volatile("" ::: "memory");
        const LAS f32x4* lr = (const LAS f32x4*)(lg + r * 48);
        const f32x4 g4 = lr[0]; float gl[4] = {g4.x + F.b_rg[0], g4.y + F.b_rg[1], g4.z + F.b_rg[2], g4.w + F.b_rg[3]};
        int gi = 0; float gm = gl[0];
#pragma unroll
        for (int g = 1; g < 4; ++g) if (gl[g] > gm) { gm = gl[g]; gi = g; }
        float den = 0.f;
#pragma unroll
        for (int g = 0; g < 4; ++g) den += __expf(gl[g] - gm);
        const float gwt = 1.0f / den;
        const LAS f32x4* er = (const LAS f32x4*)(lg + r * 48 + 4 + 8 * gi); const f32x4 e0 = er[0], e1 = er[1];
        const GAS f32x4* bp = (const GAS f32x4*)(F.b_re + gi * EPG); const f32x4 b0 = bp[0], b1 = bp[1];
        const float el[8] = {e0.x + b0.x, e0.y + b0.y, e0.z + b0.z, e0.w + b0.w, e1.x + b1.x, e1.y + b1.y, e1.z + b1.z, e1.w + b1.w};
        int k1 = 0; float t1 = el[0];
#pragma unroll
        for (int k = 1; k < 8; ++k) if (el[k] > t1) { t1 = el[k]; k1 = k; }
        int k2 = -1; float t2 = -INFINITY;
#pragma unroll
        for (int k = 0; k < 8; ++k) if (k != k1 && el[k] > t2) { t2 = el[k]; k2 = k; }
        const float ex = __expf(t2 - t1); const float w1v = gwt / (1.0f + ex), w2v = gwt * ex / (1.0f + ex);
        if (F.lane < 32) { const int slot = F.lane >> 4; const int e = gi * EPG + (slot == 0 ? k1 : k2); const float w = slot == 0 ? w1v : w2v;
            const unsigned pos = __hip_atomic_fetch_add(F.cnt + (slot * NEXP + e) * 64, 1u, __ATOMIC_RELAXED, __HIP_MEMORY_SCOPE_AGENT);
            F.tokl[(size_t)(slot * NEXP + e) * LCAP + pos] = row; F.inv[row * 2 + slot] = (e << 16) | (int)pos; F.winv[row * 2 + slot] = w; }
        LDS_WAIT(); asm volatile("" ::: "memory");
    }
}
__device__ __forceinline__ void moe_tables(Frame& F) {
    LAS int* T = (LAS int*)(F.lds + TAB_OFF);
    if (F.tid < 64) T[F.tid] = (int)__hip_atomic_load(F.cnt + F.tid * 64, RLX_AGENT);
    __syncthreads();
    if (F.tid == 0) { int pa = 0, hs = 0, p0 = 0, p1 = 0;
        for (int e = 0; e < NEXP; ++e) { const int c0 = T[e], c1 = T[32 + e], ta = (c0 + c1 + 255) >> 8;
            T[64 + e] = pa; T[128 + e] = hs; T[192 + e] = p0; T[256 + e] = p1; pa += ta; hs += ta * 256; p0 += (c0 + 255) >> 8; p1 += (c1 + 255) >> 8; }
        T[64 + 32] = pa; T[128 + 32] = hs; T[192 + 32] = p0; T[256 + 32] = p1; }
    __syncthreads();
}

__device__ __forceinline__ void p9_combine(Frame& F) {
    const LAS int* T = (const LAS int*)(F.lds + TAB_OFF);
    const int gw = F.vcu * NWAVES + F.wave, NGW = F.G * NWAVES;
    for (int rb = gw; rb < NTOK / 16; rb += NGW) {
        const int row0 = rb * 16, b = row0 / SEQ;
        int rr = 0; float ww = 0.f;
        if (F.lane < 32) { const int iv = F.inv[2 * row0 + F.lane]; ww = F.winv[2 * row0 + F.lane]; const int e = iv >> 16; rr = T[128 + e] + ((F.lane & 1) ? T[e] : 0) + (iv & 0xffff); }
        const GAS f32x4* gr = (const GAS f32x4*)(F.mod + (size_t)b * (NMOD * D) + 5 * D) + F.lane;
        f32x4 gv[4];
#pragma unroll
        for (int j = 0; j < 4; ++j) gv[j] = gr[64 * j];
        for (int i0 = 0; i0 < 16; i0 += 4) {
            f32x4 xv[4][4]; v2u a[4][4], c[4][4]; float w0[4], w1[4];
#pragma unroll
            for (int q = 0; q < 4; ++q) { const int i = i0 + q; const int r0 = __shfl(rr, 2 * i), r1 = __shfl(rr, 2 * i + 1); w0[q] = __shfl(ww, 2 * i); w1[q] = __shfl(ww, 2 * i + 1);
                const GAS f32x4* xr = (const GAS f32x4*)(F.out + (size_t)(row0 + i) * D) + F.lane;
                const GAS v2u* y0 = (const GAS v2u*)(F.Y + (size_t)r0 * D) + F.lane; const GAS v2u* y1 = (const GAS v2u*)(F.Y + (size_t)r1 * D) + F.lane;
#pragma unroll
                for (int j = 0; j < 4; ++j) { xv[q][j] = xr[64 * j]; a[q][j] = y0[64 * j]; c[q][j] = y1[64 * j]; } }
#pragma unroll
            for (int q = 0; q < 4; ++q) { GAS f32x4* xr = (GAS f32x4*)(F.out + (size_t)(row0 + i0 + q) * D) + F.lane;
#pragma unroll
                for (int j = 0; j < 4; ++j) { f32x4 y; y.x = w0[q] * bflo(a[q][j].x) + w1[q] * bflo(c[q][j].x); y.y = w0[q] * bfhi(a[q][j].x) + w1[q] * bfhi(c[q][j].x); y.z = w0[q] * bflo(a[q][j].y) + w1[q] * bflo(c[q][j].y); y.w = w0[q] * bfhi(a[q][j].y) + w1[q] * bfhi(c[q][j].y);
                    xr[64 * j] = xv[q][j] + gv[j] * y; } }
        }
    }
}
#ifndef REP_PHASE
#define REP_PHASE -1
#endif
#ifndef STG_P2
#define STG_P2 0
#endif
#ifndef STG_P4
#define STG_P4 0
#endif
#ifndef STG_P5
#define STG_P5 0
#endif
#ifndef STG_P8
#define STG_P8 0
#endif
__device__ __forceinline__ void stagger_wait(int us_x_group) {
    if (us_x_group > 0) { const unsigned long long t0 = __builtin_amdgcn_s_memrealtime(); const unsigned long long ticks = (unsigned long long)us_x_group * 100ull;
        while (__builtin_amdgcn_s_memrealtime() - t0 < ticks) __builtin_amdgcn_s_sleep(16); }
}
#ifndef MK_N_LAUNCHES
#define MK_N_LAUNCHES 1
#endif
constexpr int N_PHASES = 10;
constexpr int N_LAUNCHES = MK_N_LAUNCHES;
static_assert(N_LAUNCHES == 1 || N_LAUNCHES == N_PHASES, "MK_N_LAUNCHES is 1 or N_PHASES");
struct Args { const float* in[20]; float* out; unsigned char* ws; int ph_lo, ph_hi; };
__global__ void __launch_bounds__(NWAVES * 64, 2) fwd(Args args) {
    extern __shared__ __attribute__((aligned(16))) unsigned char lds[];
    Frame F;
    F.lds = (LAS unsigned char*)lds;
    F.MISC = (volatile LAS unsigned*)(F.lds + MISC_OFF);
    F.tid = threadIdx.x; F.lane = F.tid & 63; F.wave = __builtin_amdgcn_readfirstlane(F.tid >> 6);
    F.G = gridDim.x; { const int bx = blockIdx.x; F.vcu = (F.G % 8 == 0) ? (bx % 8) * (F.G / 8) + bx / 8 : bx; }
    unsigned char* ws = args.ws;
    F.ctl = (gu32*)(ws + WS_CTL);
    F.x = args.in[0]; F.c = args.in[1]; F.w_ada = args.in[2]; F.b_ada = args.in[3]; F.g_mix = args.in[4]; F.w_in = args.in[5]; F.g_q = args.in[6]; F.g_k = args.in[7]; F.rel_bias = args.in[8];
    F.w_br_moba = args.in[9]; F.w_br_sb = args.in[10]; F.w_out = args.in[11]; F.g_ffn = args.in[12]; F.w_rg = args.in[13]; F.b_rg = args.in[14]; F.w_re = args.in[15]; F.b_re = args.in[16];
    F.w_gate = args.in[17]; F.w_up = args.in[18]; F.w_down = args.in[19]; F.out = args.out;
    F.mod = (float*)(ws + WS_MOD); F.biasT = (float*)(ws + WS_BIAS); F.btg = (float*)(ws + WS_BIAS + 128 * 1024); F.wrt_hi = (bf16*)(ws + WS_MOD + 640 * 1024); F.wrt_lo = (bf16*)(ws + WS_MOD + 736 * 1024); F.stats = (float*)(ws + WS_STATS); F.kmean = (float*)(ws + WS_CTL) + CW_KMEAN;
    F.Win_t = (bf16*)(ws + WS_WIN); F.Wbra_t = (bf16*)(ws + WS_WBRA); F.Wbrb_t = (bf16*)(ws + WS_WBRB); F.Wout_t = (bf16*)(ws + WS_WOUT); F.Wgu_t = (bf16*)(ws + WS_WGU); F.Wd_t = (bf16*)(ws + WS_WD);
    F.XN = (bf16*)(ws + WS_XN); F.QA = (bf16*)(ws + WS_QA); F.KA = (bf16*)(ws + WS_KA); F.VA = (bf16*)(ws + WS_VA); F.QB = (bf16*)(ws + WS_QB); F.KB = (bf16*)(ws + WS_KB); F.VB = (bf16*)(ws + WS_VB);
    F.OA = (bf16*)(ws + WS_XN); F.OB = (bf16*)(ws + WS_XN + 32 * MiB); F.GA = (bf16*)(ws + WS_GA); F.GB = (bf16*)(ws + WS_GB); F.H = (bf16*)(ws + WS_H);
    F.inv = (int*)(ws + WS_INV); F.winv = (float*)(ws + WS_WINV); F.Y = (bf16*)(ws + WS_Y); F.tokl = (int*)(ws + WS_TOKL); F.wl = (float*)(ws + WS_WL); F.cnt = (unsigned*)(ws + WS_CTL) + CW_CNT;
    for (int u = F.tid; u < (LDS_BYTES - LDSCTL_OFF) / 4; u += NWAVES * 64) ((LAS unsigned*)(F.lds + LDSCTL_OFF))[u] = 0u;
    __syncthreads();
    XcdBarrier bar; bar.bar = (unsigned*)(F.ctl + CW_BAR); bar.x = 0; bar.st = nullptr;
    if (N_LAUNCHES == 1) bar = xcd_barrier_post((unsigned*)(F.ctl + CW_BAR), F.MISC + 8);
#define GRID_BAR() do { if (N_LAUNCHES == 1) { xcd_barrier(bar); } } while (0)
    const int lo = args.ph_lo, hi = args.ph_hi;
#define IN(k) (lo <= (k) && (k) < hi)
#define BOTH(k) (IN(k) && IN((k) + 1))

    if (IN(0)) { p0_prologue(F); if (REP_PHASE == 0) { GRID_BAR(); p0_prologue(F); } if (BOTH(0)) GRID_BAR(); }
    if (IN(1)) { p1_norm(F); if (REP_PHASE == 1) { GRID_BAR(); p1_norm(F); } if (BOTH(1)) GRID_BAR(); }
    if (IN(2)) {
        stagger_wait(STG_P2 * (int)((blockIdx.x >> 3) & 3)); __syncthreads();
        pg8::Gemm g{F.XN, F.Win_t, D}; pg8::DenseOrder S; S.init(NTOK, INCOLS, F.G, (int)blockIdx.x);
        pg8::EpiProj E{F.QA, F.GA, F.GB, F.g_q, F.g_k, F.kmean};
        pg8::gemm_phase<pg8::EpiProj, pg8::DenseOrder, false>(F.lds + RING_OFF, g, S, E);
        if (REP_PHASE == 2) { GRID_BAR(); pg8::gemm_phase<pg8::EpiProj, pg8::DenseOrder, false>(F.lds + RING_OFF, g, S, E); }
        if (BOTH(2)) GRID_BAR();
    }
    if (IN(3)) {
#if defined(MOBA_NAIVE)
        p3_moba_naive(F);
#else
        { int nrep = (REP_PHASE == 30) ? 2 : 1; asm volatile("" : "+s"(nrep));
          for (int rep = 0; rep < nrep; ++rep) { __syncthreads(); p3_moba(F); if (REP_PHASE == 30 && rep == 0) GRID_BAR(); } }
#endif
#if defined(SB_NAIVE)
        p3_sb_naive(F);
#else
        p3_sb(F);
        if (REP_PHASE == 31) { GRID_BAR(); p3_sb(F); }
#endif
        if (BOTH(3)) GRID_BAR(); }
    if (IN(4)) {
        stagger_wait(STG_P4 * (int)((blockIdx.x >> 3) & 3)); __syncthreads();
        { pg8::Gemm g{F.OA, F.Wbra_t, WATT}; pg8::DenseOrder S; S.init(NTOK, D, F.G, (int)blockIdx.x);
          pg8::EpiBranch<0> E{F.GA, nullptr};
          pg8::gemm_phase<pg8::EpiBranch<0>, pg8::DenseOrder, false>(F.lds + RING_OFF, g, S, E); }
        { pg8::Gemm g{F.OB, F.Wbrb_t, WATT}; pg8::DenseOrder S; S.init(NTOK, D, F.G, (int)blockIdx.x);
          pg8::EpiBranch<1> E{F.GB, F.GA};
          pg8::gemm_phase<pg8::EpiBranch<1>, pg8::DenseOrder, false>(F.lds + RING_OFF, g, S, E); }
        if (REP_PHASE == 4) { GRID_BAR();
          { pg8::Gemm g{F.OA, F.Wbra_t, WATT}; pg8::DenseOrder S; S.init(NTOK, D, F.G, (int)blockIdx.x); pg8::EpiBranch<0> E{F.H, nullptr};
            pg8::gemm_phase<pg8::EpiBranch<0>, pg8::DenseOrder, false>(F.lds + RING_OFF, g, S, E); }
          { pg8::Gemm g{F.OB, F.Wbrb_t, WATT}; pg8::DenseOrder S; S.init(NTOK, D, F.G, (int)blockIdx.x); pg8::EpiBranch<1> E{F.H, F.GA};
            pg8::gemm_phase<pg8::EpiBranch<1>, pg8::DenseOrder, false>(F.lds + RING_OFF, g, S, E); } }
        if (BOTH(4)) GRID_BAR();
    }
    if (IN(5)) {
        stagger_wait(STG_P5 * (int)((blockIdx.x >> 3) & 3)); __syncthreads();
        pg8::Gemm g{F.GB, F.Wout_t, D}; pg8::DenseOrder S; S.init(NTOK, D, F.G, (int)blockIdx.x);
        pg8::EpiResid E{F.x, F.out, F.mod + 2 * D, F.stats};
        pg8::gemm_phase<pg8::EpiResid, pg8::DenseOrder, false>(F.lds + RING_OFF, g, S, E);
        if (REP_PHASE == 5) { GRID_BAR(); pg8::gemm_phase<pg8::EpiResid, pg8::DenseOrder, false>(F.lds + RING_OFF, g, S, E); }
        if (BOTH(5)) GRID_BAR();
    }
    if (IN(6)) {
#if defined(ROUTE_VALU)
        p6_route(F);
#else
        __syncthreads(); p6_route_mfma(F);
#endif
        if (REP_PHASE == 6) { GRID_BAR(); Frame F2 = F; F2.cnt = (unsigned*)(ws + WS_CTL) + CW_CNT + 4096 * 4; F2.tokl = (int*)(ws + WS_GA); F2.wl = (float*)(ws + WS_GA + 16 * MiB); F2.XN = (bf16*)(ws + WS_GB); p6_route_mfma(F2); }
        if (BOTH(6)) GRID_BAR(); }
    if (IN(7)) {
        moe_tables(F);
        pg8::Gemm g{F.XN, F.Wgu_t, D}; pg8::GateUpOrder S{(const LAS int*)(F.lds + TAB_OFF), F.tokl, F.G, (int)blockIdx.x};
        pg8::EpiGateUp E{F.H};
        pg8::gemm_phase<pg8::EpiGateUp, pg8::GateUpOrder, true>(F.lds + RING_OFF, g, S, E);
        if (REP_PHASE == 7) { GRID_BAR(); pg8::gemm_phase<pg8::EpiGateUp, pg8::GateUpOrder, true>(F.lds + RING_OFF, g, S, E); }
        if (BOTH(7)) GRID_BAR();
    }
    if (IN(8)) {
        moe_tables(F);
        pg8::Gemm g{F.H, F.Wd_t, DEXP}; pg8::DownAllOrder S{(const LAS int*)(F.lds + TAB_OFF), F.G, (int)blockIdx.x};
        pg8::EpiY E{F.Y};
        pg8::gemm_phase<pg8::EpiY, pg8::DownAllOrder, false>(F.lds + RING_OFF, g, S, E);
        if (REP_PHASE == 8) { GRID_BAR(); pg8::gemm_phase<pg8::EpiY, pg8::DownAllOrder, false>(F.lds + RING_OFF, g, S, E); }
        if (BOTH(8)) GRID_BAR();
    }
    if (IN(9)) { moe_tables(F); p9_combine(F); if (REP_PHASE == 9) { GRID_BAR(); Frame F2 = F; F2.out = (float*)(ws + WS_XN); p9_combine(F2); } }
#undef IN
#undef BOTH
}

extern "C" void kernel_launch(void* const* d_in, const int* in_sizes, int n_in, void* d_out, int out_size, void* d_ws, size_t ws_size, hipStream_t stream) {
    static int grid = 0;
    if (grid == 0) {
        if (n_in != 20 || in_sizes[0] != NTOK * D || out_size != NTOK * D || ws_size < WS_END) { fprintf(stderr, "kernel_launch: built for 20 inputs, x/out of %d floats, >= %zu bytes of workspace; got n_in %d, in0 %d, out %d, ws %zu; nothing launched\n", NTOK * D, (size_t)WS_END, n_in, n_in > 0 ? in_sizes[0] : -1, out_size, ws_size); grid = -1; return; }
        int dev = 0, cus = 0, per_cu = 0;
        if (hipGetDevice(&dev) != hipSuccess || hipDeviceGetAttribute(&cus, hipDeviceAttributeMultiprocessorCount, dev) != hipSuccess) { fprintf(stderr, "kernel_launch: hipGetDevice / hipDeviceGetAttribute failed\n"); grid = -1; return; }
        if (hipFuncSetAttribute((const void*)fwd, hipFuncAttributeMaxDynamicSharedMemorySize, LDS_BYTES) != hipSuccess) { fprintf(stderr, "kernel_launch: hipFuncSetAttribute failed\n"); grid = -1; return; }
        if (hipOccupancyMaxActiveBlocksPerMultiprocessor(&per_cu, (const void*)fwd, NWAVES * 64, LDS_BYTES) != hipSuccess || per_cu < 1)
            fprintf(stderr, "kernel_launch: note: the occupancy query reports %d workgroups per CU\n", per_cu);
        (void)hipGetLastError();
        grid = cus;
    }
    if (grid < 0) return;
    if (hipMemsetAsync((char*)d_ws + WS_CTL, 0, CTL_ZERO_BYTES, stream) != hipSuccess) { fprintf(stderr, "kernel_launch: hipMemsetAsync failed\n"); return; }
    Args a{};
    for (int i = 0; i < 20; ++i) a.in[i] = (const float*)d_in[i];
    a.out = (float*)d_out; a.ws = (unsigned char*)d_ws;
    for (int li = 0; li < N_LAUNCHES; ++li) {
        a.ph_lo = (N_LAUNCHES == 1) ? 0 : li; a.ph_hi = (N_LAUNCHES == 1) ? N_PHASES : li + 1;
        hipLaunchKernelGGL(fwd, dim3(grid), dim3(NWAVES * 64), LDS_BYTES, stream, a);
        const hipError_t le = hipPeekAtLastError();
        if (le != hipSuccess) { fprintf(stderr, "kernel_launch: launch %d failed: %s\n", li, hipGetErrorName(le)); break; }
    }
}
```

```cpp
#include <hip/hip_runtime.h>
#include <cstdio>
#include <cstdint>
#include <cmath>
#if defined(PROBE_EPI)
#ifndef PROBE_BLK
#define PROBE_BLK 0
#endif
__device__ unsigned long long g_probe[4];
#endif
namespace pg8 {
#define PG8_LAS __attribute__((address_space(3)))
typedef unsigned short bf16_t;
typedef short bf16x8 __attribute__((ext_vector_type(8)));
typedef float f32x4 __attribute__((ext_vector_type(4)));
typedef unsigned u32x4 __attribute__((ext_vector_type(4)));
constexpr int BM = 256, BK = 64, HALF = 128, HTB = HALF * BK * 2  , STAGE_BYTES = 8 * HTB, NXCD = 8, WGM = 8;

__host__ __device__ __forceinline__ int lds_byte(int r, int c) { const int st = (r >> 4) * 2 + (c >> 5), rr = r & 15, cc = c & 31, ob = rr * 64 + cc * 2; return st * 1024 + (ob ^ (((ob >> 9) & 1) << 5)); }
__host__ __device__ __forceinline__ void stage_rc(int b, int& R, int& C) { const int st = b / 1024, sb = b % 1024, swz = sb ^ (((sb >> 9) & 1) << 5); R = (st >> 1) * 16 + swz / 64; C = (st & 1) * 32 + (swz % 64) / 2; }
__host__ __device__ __forceinline__ int perm32(int rho) { const int n = rho >> 4, i = rho & 15; return 8 * (i >> 2) + 4 * n + (i & 3); }

struct Unit { int arow, brow, pm, pn, x0, x1; };
struct Gemm { const bf16_t* A; const bf16_t* Bt; int K; };

struct DenseOrder {
    int nM, nN, nwg, G, c;
    __device__ void init(int M, int N, int G_, int c_) { nM = M / BM; nN = N / BM; nwg = nM * nN; G = G_; c = c_; }
    __device__ bool next(int i, Unit& u) const {
        const long L = (long)i * G + c; if (L >= nwg) return false;
        int wgid = (int)L; { const int q = nwg / NXCD, r = nwg % NXCD, xcd = wgid % NXCD, off = wgid / NXCD; wgid = (xcd < r ? xcd * (q + 1) : r * (q + 1) + (xcd - r) * q) + off; }
        const int nig = WGM * nN, gid = wgid / nig, fm = gid * WGM, gsz = (nM - fm) < WGM ? (nM - fm) : WGM;
        u.pm = fm + ((wgid % nig) % gsz); u.pn = (wgid % nig) / gsz; u.arow = u.pm * BM; u.brow = u.pn * BM; u.x0 = 0; u.x1 = 0; return true;
    }
    __device__ __forceinline__ int arow_of(const Unit&, int) const { return 0; }
};

__device__ __forceinline__ unsigned cvt_pk_bf16(float lo, float hi) { unsigned r; asm volatile("v_cvt_pk_bf16_f32 %0, %1, %2" : "=v"(r) : "v"(lo), "v"(hi)); return r; }

template <class Epi, class Sched, bool GATHER, bool ALIGN_EPI = true, bool SP2 = true>
__device__ __forceinline__ void gemm_phase(PG8_LAS unsigned char* lds, const Gemm g, const Sched& S, const Epi& E) {
    const int tid = threadIdx.x, wid = __builtin_amdgcn_readfirstlane(tid >> 6), lane = tid & 63, wr = wid >> 2, wc = wid & 3, fr = lane & 15, fq = lane >> 4;
    const int K = g.K, nt = K / BK;
    unsigned voffA[2], voffB[2]; int stR[2], stC[2];
#pragma unroll
    for (int i = 0; i < 2; ++i) { int R, C; stage_rc(tid * 16 + i * 8192, R, C); const int Rb = Epi::PERM ? ((R & ~31) + perm32(R & 31)) : R;
        stR[i] = R; stC[i] = C; voffA[i] = (unsigned)(R * K + C) * 2u; voffB[i] = (unsigned)(Rb * K + C) * 2u; }
    const size_t kstep = (size_t)(BK * 2);
    const size_t hstep = (size_t)HALF * K * 2;
    const size_t rstep = (size_t)K * 2;
    const unsigned ldsw = (unsigned)wid * 1024u;
    const int aoff = lds_byte(wr * 64 + fr, fq * 8), boff = lds_byte(wc * 32 + fr, fq * 8);
#define PG8_SA(b, h) (((b) * 2 + (h)) * HTB)
#define PG8_SB(b, h) ((4 + (b) * 2 + (h)) * HTB)
#define PG8_STAGE(bufoff, gbase, voff) do { _Pragma("unroll") for (int _i = 0; _i < 2; ++_i) \
        __builtin_amdgcn_global_load_lds((const unsigned*)((const char*)(gbase) + (voff)[_i]), (PG8_LAS unsigned*)(lds + (bufoff) + ldsw + _i * 8192), 16, 0, 0); } while (0)
#define PG8_STAGE_A(bufoff, ub, h, VS) do { if constexpr (GATHER) { PG8_STAGE(bufoff, ub, VS[h]); } else { PG8_STAGE(bufoff, (ub) + (h) * hstep, voffA); } } while (0)
#define PG8_VOFFS(dst, U) do { _Pragma("unroll") for (int h_ = 0; h_ < 2; ++h_) _Pragma("unroll") for (int i_ = 0; i_ < 2; ++i_) \
        dst[h_][i_] = (unsigned)(S.arow_of(U, h_ * HALF + stR[i_]) * K + stC[i_]) * 2u; } while (0)
#define PG8_LDA(dst, b, h) do { _Pragma("unroll") for (int m = 0; m < 4; ++m) _Pragma("unroll") for (int k = 0; k < 2; ++k) dst[m][k] = *(const PG8_LAS bf16x8*)(lds + PG8_SA(b, h) + aoff + m * 2048 + k * 1024); } while (0)
#define PG8_LDB(dst, b, h) do { _Pragma("unroll") for (int n = 0; n < 2; ++n) _Pragma("unroll") for (int k = 0; k < 2; ++k) dst[n][k] = *(const PG8_LAS bf16x8*)(lds + PG8_SB(b, h) + boff + n * 2048 + k * 1024); } while (0)
#define PG8_MMA(ai, bj, At, Bt) do { __builtin_amdgcn_s_setprio(1); _Pragma("unroll") for (int m = 0; m < 4; ++m) _Pragma("unroll") for (int n = 0; n < 2; ++n) _Pragma("unroll") for (int k = 0; k < 2; ++k) \
        acc[ai][bj][m][n] = __builtin_amdgcn_mfma_f32_16x16x32_bf16(Bt[n][k], At[m][k], acc[ai][bj][m][n], 0, 0, 0); __builtin_amdgcn_s_setprio(0); } while (0)
#define PG8_WAIT_V(n) asm volatile("s_waitcnt vmcnt(" #n ")" ::: "memory")
#define PG8_WAIT_L(n) asm volatile("s_waitcnt lgkmcnt(" #n ")" ::: "memory")
#define PG8_BAR __builtin_amdgcn_s_barrier()
#define PG8_SCHED __builtin_amdgcn_sched_barrier(0)
    Unit cur, nxt; int ui = 0;
    if (!S.next(0, cur)) return;
    bool has_next = S.next(1, nxt);
    unsigned vAc[2][2], vAn[2][2];
    if constexpr (GATHER) { PG8_VOFFS(vAc, cur); if (has_next) { PG8_VOFFS(vAn, nxt); } else {
#pragma unroll
        for (int h_ = 0; h_ < 2; ++h_) { vAn[h_][0] = vAc[h_][0]; vAn[h_][1] = vAc[h_][1]; } } }
    else {
#pragma unroll
        for (int h_ = 0; h_ < 2; ++h_) { vAc[h_][0] = 0u; vAc[h_][1] = 0u; vAn[h_][0] = 0u; vAn[h_][1] = 0u; } }
    f32x4 acc[2][2][4][2];
#pragma unroll
    for (int a = 0; a < 2; ++a)
#pragma unroll
        for (int b = 0; b < 2; ++b)
#pragma unroll
            for (int m = 0; m < 4; ++m)
#pragma unroll
                for (int n = 0; n < 2; ++n) acc[a][b][m][n] = (f32x4){0.f, 0.f, 0.f, 0.f};
    bf16x8 At[4][2], B0[2][2], B1[2][2];
    const char* const A0 = (const char*)g.A;
    const char* cA = GATHER ? A0 : A0 + (size_t)cur.arow * rstep; const char* cB = (const char*)g.Bt + (size_t)cur.brow * rstep;
    if constexpr (SP2) {
        PG8_STAGE(PG8_SB(0, 0), cB, voffB); PG8_STAGE(PG8_SB(0, 1), cB + hstep, voffB); PG8_STAGE_A(PG8_SA(0, 0), cA, 0, vAc); PG8_STAGE_A(PG8_SA(0, 1), cA, 1, vAc);
        if (wr == 1) PG8_BAR;
        PG8_WAIT_V(2); PG8_BAR;
        PG8_STAGE(PG8_SB(1, 0), cB + kstep, voffB); PG8_STAGE_A(PG8_SA(1, 0), cA + kstep, 0, vAc); PG8_STAGE(PG8_SB(1, 1), cB + hstep + kstep, voffB);
        PG8_WAIT_V(6); PG8_BAR;
    } else {
        PG8_STAGE(PG8_SB(0, 0), cB, voffB); PG8_STAGE_A(PG8_SA(0, 0), cA, 0, vAc); PG8_STAGE(PG8_SB(0, 1), cB + hstep, voffB); PG8_STAGE_A(PG8_SA(0, 1), cA, 1, vAc);
        if (wr == 1) PG8_BAR;
        PG8_WAIT_V(4); PG8_BAR;
        PG8_STAGE(PG8_SB(1, 0), cB + kstep, voffB); PG8_STAGE_A(PG8_SA(1, 0), cA + kstep, 0, vAc); PG8_STAGE(PG8_SB(1, 1), cB + hstep + kstep, voffB);
        PG8_WAIT_V(6); PG8_BAR;
    }
    for (;;) {
        const char* nA = GATHER ? A0 : (has_next ? A0 + (size_t)nxt.arow * rstep : cA); const char* nB = has_next ? (const char*)g.Bt + (size_t)nxt.brow * rstep : cB;
        for (int t = 0; t < nt; t += 2) {
            const bool last = (t == nt - 2);
            const char* a1 = cA + (size_t)(t + 1) * kstep;
            const char* a2 = last ? nA : cA + (size_t)(t + 2) * kstep; const char* b2 = last ? nB : cB + (size_t)(t + 2) * kstep;
            const char* a3 = a2 + kstep; const char* b3 = b2 + kstep;
            if constexpr (Epi::MIDK) { if (t == nt / 2) E.mid(acc, cur, wr, wc, fr, fq); }
            unsigned vS[2][2];
#pragma unroll
            for (int h_ = 0; h_ < 2; ++h_) { vS[h_][0] = last ? vAn[h_][0] : vAc[h_][0]; vS[h_][1] = last ? vAn[h_][1] : vAc[h_][1]; }
            if constexpr (SP2) {
            PG8_LDB(B0, 0, 0); PG8_LDB(B1, 0, 1); PG8_SCHED; PG8_LDA(At, 0, 0); PG8_STAGE_A(PG8_SA(1, 1), a1, 1, vAc);
            PG8_WAIT_V(8); PG8_WAIT_L(0); PG8_BAR;
#if defined(PROBE_EPI)
            if (Epi::PSLOT && t == 0 && ui > 0 && blockIdx.x == PROBE_BLK && tid == 0) { g_probe[1] += __builtin_amdgcn_s_memrealtime() - g_probe[2]; }
#endif
 PG8_MMA(0, 0, At, B0); PG8_MMA(0, 1, At, B1); PG8_BAR; PG8_SCHED;
            PG8_LDA(At, 0, 1); PG8_STAGE(PG8_SB(0, 0), b2, voffB); PG8_STAGE(PG8_SB(0, 1), b2 + hstep, voffB); PG8_STAGE_A(PG8_SA(0, 0), a2, 0, vS);
            PG8_WAIT_V(8); PG8_WAIT_L(0); PG8_BAR; PG8_MMA(1, 0, At, B0); PG8_MMA(1, 1, At, B1); PG8_BAR; PG8_SCHED;
            PG8_LDB(B0, 1, 0); PG8_LDB(B1, 1, 1); PG8_SCHED; PG8_LDA(At, 1, 0); PG8_STAGE_A(PG8_SA(0, 1), a2, 1, vS);
            PG8_WAIT_V(8); PG8_WAIT_L(0); PG8_BAR; PG8_MMA(0, 0, At, B0); PG8_MMA(0, 1, At, B1); PG8_BAR; PG8_SCHED;
            PG8_LDA(At, 1, 1); PG8_STAGE(PG8_SB(1, 0), b3, voffB); PG8_STAGE(PG8_SB(1, 1), b3 + hstep, voffB); PG8_STAGE_A(PG8_SA(1, 0), a3, 0, vS);
            PG8_WAIT_V(8); PG8_WAIT_L(0); PG8_BAR; PG8_MMA(1, 0, At, B0); PG8_MMA(1, 1, At, B1); PG8_BAR; PG8_SCHED;
            } else {
            PG8_LDB(B0, 0, 0); PG8_SCHED; PG8_LDA(At, 0, 0); PG8_STAGE_A(PG8_SA(1, 1), a1, 1, vAc);
            PG8_WAIT_L(8); PG8_BAR; PG8_WAIT_L(0); PG8_MMA(0, 0, At, B0); PG8_BAR; PG8_SCHED;
            PG8_LDB(B1, 0, 1); PG8_STAGE(PG8_SB(0, 0), b2, voffB);
            PG8_BAR; PG8_WAIT_L(0); PG8_MMA(0, 1, At, B1); PG8_BAR;
            PG8_LDA(At, 0, 1); PG8_STAGE_A(PG8_SA(0, 0), a2, 0, vS);
            PG8_BAR; PG8_WAIT_L(0); PG8_MMA(1, 0, At, B0); PG8_BAR; PG8_SCHED;
            PG8_STAGE(PG8_SB(0, 1), b2 + hstep, voffB);
            PG8_WAIT_V(6); PG8_BAR; PG8_MMA(1, 1, At, B1); PG8_BAR;
            PG8_LDB(B0, 1, 0); PG8_SCHED; PG8_LDA(At, 1, 0); PG8_STAGE_A(PG8_SA(0, 1), a2, 1, vS);
            PG8_WAIT_L(8); PG8_BAR; PG8_WAIT_L(0); PG8_MMA(0, 0, At, B0); PG8_BAR; PG8_SCHED;
            PG8_LDB(B1, 1, 1); PG8_STAGE(PG8_SB(1, 0), b3, voffB);
            PG8_BAR; PG8_WAIT_L(0); PG8_MMA(0, 1, At, B1); PG8_BAR;
            PG8_LDA(At, 1, 1); PG8_STAGE_A(PG8_SA(1, 0), a3, 0, vS);
            PG8_BAR; PG8_WAIT_L(0); PG8_MMA(1, 0, At, B0); PG8_BAR; PG8_SCHED;
            PG8_STAGE(PG8_SB(1, 1), b3 + hstep, voffB);
            PG8_WAIT_V(6); PG8_BAR; PG8_MMA(1, 1, At, B1); PG8_BAR;
            }
        }
#if defined(PROBE_EPI)
        unsigned long long pt0_ = 0ull; if (Epi::PSLOT && blockIdx.x == PROBE_BLK && tid == 0) pt0_ = __builtin_amdgcn_s_memrealtime();
#endif
        if constexpr (ALIGN_EPI) { if (wr == 0) PG8_BAR; }
        E(acc, cur, wr, wc, fr, fq);
#if defined(PROBE_EPI)
        if (Epi::PSLOT && blockIdx.x == PROBE_BLK && tid == 0) { const unsigned long long pt1_ = __builtin_amdgcn_s_memrealtime(); g_probe[0] += pt1_ - pt0_; g_probe[2] = pt1_; g_probe[3] += 1ull; }
#endif
        if (!has_next) break;
#pragma unroll
        for (int a = 0; a < 2; ++a)
#pragma unroll
            for (int b = 0; b < 2; ++b)
#pragma unroll
                for (int m = 0; m < 4; ++m)
#pragma unroll
                    for (int n = 0; n < 2; ++n) acc[a][b][m][n] = (f32x4){0.f, 0.f, 0.f, 0.f};
        cur = nxt; cA = nA; cB = nB; ++ui;
        has_next = S.next(ui + 1, nxt);
        if constexpr (GATHER) {
#pragma unroll
            for (int h_ = 0; h_ < 2; ++h_) { vAc[h_][0] = vAn[h_][0]; vAc[h_][1] = vAn[h_][1]; }
            if (has_next) { PG8_VOFFS(vAn, nxt); }
        }
        if constexpr (ALIGN_EPI) { if (wr == 1) PG8_BAR; }
    }
    PG8_WAIT_V(0);
    if constexpr (!ALIGN_EPI) { if (wr == 0) PG8_BAR; }
    PG8_BAR;
#undef PG8_SA
#undef PG8_SB
#undef PG8_STAGE
#undef PG8_STAGE_A
#undef PG8_VOFFS
#undef PG8_LDA
#undef PG8_LDB
#undef PG8_MMA
#undef PG8_WAIT_V
#undef PG8_WAIT_L
#undef PG8_BAR
#undef PG8_SCHED
}
}
constexpr int NWAVES = 8;
constexpr int BATCH = 8, SEQ = 4096, D = 1024, NTOK = BATCH * SEQ;
constexpr int HD = 64, NH = 8, WATT = NH * HD;
constexpr int INCOLS = 5120, NMOD = 6;
constexpr int MBLK = 256, NBLK = SEQ / MBLK;
constexpr int NEXP = 32, EPG = 8, NGRP = 4, DEXP = 512;
constexpr float RMS_EPS = 1e-6f;
constexpr float LOG2E = 1.4426950408889634f;
constexpr float C2 = 0.125f * 1.4426950408889634f;
constexpr int LCAP = NTOK;
constexpr int HROWS = 2 * NTOK + NEXP * 256 + 256;

constexpr size_t MiB = 1u << 20;
constexpr size_t WS_CTL = 0, CTL_ZERO_BYTES = 1 * MiB;
constexpr size_t WS_MOD = 1 * MiB;
constexpr size_t WS_BIAS = 1 * MiB + 256 * 1024;
constexpr size_t WS_STATS = 2 * MiB;
constexpr size_t WS_WIN = 4 * MiB;
constexpr size_t WS_WBRA = 14 * MiB, WS_WBRB = 15 * MiB;
constexpr size_t WS_WOUT = 16 * MiB;
constexpr size_t WS_WGU = 18 * MiB;
constexpr size_t WS_WD = 82 * MiB;
constexpr size_t WS_XN = 114 * MiB;
constexpr size_t WS_QA = 178 * MiB, WS_KA = 210 * MiB, WS_VA = 242 * MiB, WS_QB = 274 * MiB, WS_KB = 306 * MiB, WS_VB = 338 * MiB;
constexpr size_t WS_GA = 370 * MiB, WS_GB = 434 * MiB;
constexpr size_t WS_H = 178 * MiB;
constexpr size_t WS_TOKL = 306 * MiB, WS_WL = 314 * MiB;
constexpr size_t WS_INV = 314 * MiB, WS_WINV = 315 * MiB;
constexpr size_t WS_Y = 322 * MiB;
constexpr size_t WS_END = 498 * MiB;
static_assert(WS_Y + (size_t)HROWS * D * 2 <= WS_END, "Y fits");
static_assert(WS_H + (size_t)HROWS * DEXP * 2 <= WS_QB && WS_TOKL + (size_t)2 * NEXP * LCAP * 4 <= WS_WL && WS_WL + (size_t)2 * NEXP * LCAP * 4 <= WS_VB, "d_ws map");
constexpr int CW_TMO = 0, CW_CODE = 1;
constexpr int CW_BAR = 4096;
constexpr int CW_CNT = 16384;
constexpr int CW_KMEAN = 65536;
static_assert((CW_KMEAN + 65536) * 4 <= (int)CTL_ZERO_BYTES && CW_CNT + 64 * 64 <= CW_KMEAN && CW_BAR + 3456 <= CW_CNT, "CTL map");

constexpr int RING_OFF = 0, RING_BYTES = 131072;
constexpr int LDSCTL_OFF = RING_BYTES, MISC_OFF = LDSCTL_OFF + 320;
constexpr int TAB_OFF = RING_BYTES + 1024;
constexpr int LDS_BYTES = 147456;
static_assert(MISC_OFF + 128 <= TAB_OFF && TAB_OFF + 2048 <= LDS_BYTES, "LDS map");

#define GAS __attribute__((address_space(1)))
#define LAS __attribute__((address_space(3)))
typedef unsigned short bf16;
typedef unsigned v4u __attribute__((ext_vector_type(4)));
typedef unsigned v2u __attribute__((ext_vector_type(2)));
typedef float f32x4 __attribute__((ext_vector_type(4)));
typedef short bf16x8 __attribute__((ext_vector_type(8)));
typedef GAS unsigned gu32;
#define RLX_AGENT __ATOMIC_RELAXED, __HIP_MEMORY_SCOPE_AGENT
#define LDS_WAIT() asm volatile("s_waitcnt lgkmcnt(0)" ::: "memory")
#define VM_WAIT() asm volatile("s_waitcnt vmcnt(0)" ::: "memory")
__device__ __forceinline__ unsigned f2bf(float f) { unsigned u = __builtin_bit_cast(unsigned, f); return (u + 0x7fffu + ((u >> 16) & 1u)) >> 16; }
__device__ __forceinline__ unsigned pk2(float lo, float hi) { return f2bf(lo) | (f2bf(hi) << 16); }
__device__ __forceinline__ float bflo(unsigned u) { return __uint_as_float(u << 16); }
__device__ __forceinline__ float bfhi(unsigned u) { return __uint_as_float(u & 0xffff0000u); }
__device__ __forceinline__ float fsigmoid(float v) { return __builtin_amdgcn_rcpf(1.0f + __builtin_amdgcn_exp2f(-v * LOG2E)); }
#define XB_TMO      128
#define XB_XCNT(j)  (256  + 64 * (j))
#define XB_XSUB(j)  (1280 + 64 * (j))
#define XB_XGEN(j)  (2304 + 64 * (j))
#define XB_TOP      3328
#define XB_TOPGEN   3392
#define XCD_BAR_WORDS 3456
#define XB_SPIN_CAP (1u << 22)

__device__ __forceinline__ unsigned xb_ld(unsigned* p)              { return __hip_atomic_load(p, __ATOMIC_RELAXED, __HIP_MEMORY_SCOPE_AGENT); }
__device__ __forceinline__ unsigned xb_add(unsigned* p, unsigned v) { return __hip_atomic_fetch_add(p, v, __ATOMIC_RELAXED, __HIP_MEMORY_SCOPE_AGENT); }
__device__ __forceinline__ unsigned xb_xcc_id() { return (unsigned)__builtin_amdgcn_s_getreg((3 << 11) | 20) & 0xFu; }
#define XB_SPIN(cond, bar) do { unsigned _sp = 0; while (cond) { __builtin_amdgcn_s_sleep(1); \
    if ((++_sp & 255u) == 0u) { if (xb_ld(&(bar)[XB_TMO])) break; if (_sp > XB_SPIN_CAP) { atomicAdd(&(bar)[XB_TMO], 1u); break; } } } } while (0)

struct XcdBarrier {
    unsigned* bar; unsigned x;
    volatile LAS unsigned* st;
};

__device__ __forceinline__ XcdBarrier xcd_barrier_post(unsigned* bar, volatile LAS unsigned* st) {
    XcdBarrier b; b.bar = bar; b.x = xb_xcc_id(); b.st = st;
    if (threadIdx.x == 0) (void)xb_add(&bar[XB_XCNT(b.x)], 1u);
    return b;
}
__device__ __forceinline__ void xcd_barrier_complete(unsigned* bar, unsigned x, unsigned& nloc, unsigned& nx) {
    const unsigned G = gridDim.x * gridDim.y * gridDim.z;
    unsigned sum, cnt, mine, sp = 0u;
    for (;;) {
        sum = 0u; cnt = 0u; mine = 0u;
#pragma unroll
        for (unsigned j = 0; j < 16; ++j) { const unsigned c = xb_ld(&bar[XB_XCNT(j)]); sum += c; cnt += (c > 0u) ? 1u : 0u; mine = (j == x) ? c : mine; }
        if (sum == G) break;
        __builtin_amdgcn_s_sleep(1);
        if ((++sp & 255u) == 0u) { if (xb_ld(&bar[XB_TMO])) break; if (sp > XB_SPIN_CAP) { atomicAdd(&bar[XB_TMO], 1u); break; } }
    }
    nloc = mine > 0u ? mine : 1u; nx = cnt > 0u ? cnt : 1u;
}

__device__ __forceinline__ void xcd_barrier(const XcdBarrier& b) {
    asm volatile("s_waitcnt vmcnt(0)" ::: "memory");
    __syncthreads();
    if (threadIdx.x == 0) {
        unsigned* bar = b.bar;
        __builtin_amdgcn_s_waitcnt(0);
        unsigned nloc = b.st[0], nx = b.st[1];
        if (nloc == 0u) { xcd_barrier_complete(bar, b.x, nloc, nx); b.st[0] = nloc; b.st[1] = nx; }
        const unsigned old = xb_add(&bar[XB_XSUB(b.x)], 1u);
        const unsigned gen = old / nloc;
        if (old + 1u == (gen + 1u) * nloc) {
            __builtin_amdgcn_fence(__ATOMIC_RELEASE, "agent");
            asm volatile("s_waitcnt vmcnt(0)" ::: "memory");
            const unsigned og = xb_add(&bar[XB_TOP], 1u);
            const unsigned tg = og / nx;
            if (og + 1u == (tg + 1u) * nx) xb_add(&bar[XB_TOPGEN], 1u);
            else XB_SPIN(xb_ld(&bar[XB_TOPGEN]) == tg, bar);
            __builtin_amdgcn_fence(__ATOMIC_ACQUIRE, "agent");
            xb_add(&bar[XB_XGEN(b.x)], 1u);
            asm volatile("s_waitcnt vmcnt(0)" ::: "memory");
        } else {
            XB_SPIN(xb_ld(&bar[XB_XGEN(b.x)]) == gen, bar);
            __builtin_amdgcn_fence(__ATOMIC_ACQUIRE, "agent");
            asm volatile("s_waitcnt vmcnt(0)" ::: "memory");
        }
    }
    __syncthreads();
}
#ifndef BR_MB
#define BR_MB 2
#endif
#ifndef RS_MB
#define RS_MB 2
#endif
#ifndef DN_MB
#define DN_MB 2
#endif
namespace pg8 {
struct EpiProj {
    static constexpr bool PERM = true, MIDK = false; static constexpr int PSLOT = 1;
    bf16_t* qkv;
    bf16_t* ga; bf16_t* gb;
    const float* gq; const float* gk;
    float* kmean;
    __device__ __forceinline__ void operator()(const f32x4 (&acc)[2][2][4][2], const Unit& u, int wr, int wc, int fr, int fq) const {
        const int pn = u.pn; const int row0 = u.pm * BM + wr * 64 + fr;
        if (pn < 4) {
            const bool isq = pn < 2; const float* gv = isq ? gq : gk; const float post = isq ? C2 : 1.0f;
            bf16_t* base = qkv + (size_t)(pn >> 1) * ((size_t)NTOK * WATT) + (pn & 1) * 256 + wc * 64 + 8 * fq;
            float g[2][2][4];
#pragma unroll
            for (int bj = 0; bj < 2; ++bj)
#pragma unroll
                for (int n = 0; n < 2; ++n) { const f32x4 t = *(const f32x4*)(gv + 32 * bj + 8 * fq + 4 * n); g[bj][n][0] = t[0] * post; g[bj][n][1] = t[1] * post; g[bj][n][2] = t[2] * post; g[bj][n][3] = t[3] * post; }
            float cs[2][2][4];
#pragma unroll
            for (int bj = 0; bj < 2; ++bj)
#pragma unroll
                for (int n = 0; n < 2; ++n)
#pragma unroll
                    for (int e = 0; e < 4; ++e) cs[bj][n][e] = 0.f;
#pragma unroll
            for (int ai = 0; ai < 2; ++ai)
#pragma unroll
                for (int m = 0; m < 4; ++m) {
                    float ss = 0.f;
#pragma unroll
                    for (int bj = 0; bj < 2; ++bj)
#pragma unroll
                        for (int n = 0; n < 2; ++n) { const f32x4 x = acc[ai][bj][m][n]; ss += (x[0] * x[0] + x[1] * x[1]) + (x[2] * x[2] + x[3] * x[3]); }
                    ss += __shfl_xor(ss, 16); ss += __shfl_xor(ss, 32);
                    const float rstd = __builtin_amdgcn_rsqf(ss * (1.0f / 64.0f) + RMS_EPS);
                    bf16_t* rowp = base + (size_t)(row0 + ai * HALF + m * 16) * WATT;
#pragma unroll
                    for (int bj = 0; bj < 2; ++bj) { float o[2][4];
#pragma unroll
                        for (int n = 0; n < 2; ++n)
#pragma unroll
                            for (int e = 0; e < 4; ++e) { o[n][e] = acc[ai][bj][m][n][e] * rstd * g[bj][n][e]; cs[bj][n][e] += o[n][e]; }
                        u32x4 w; w.x = cvt_pk_bf16(o[0][0], o[0][1]); w.y = cvt_pk_bf16(o[0][2], o[0][3]); w.z = cvt_pk_bf16(o[1][0], o[1][1]); w.w = cvt_pk_bf16(o[1][2], o[1][3]);
                        *(u32x4*)(rowp + 32 * bj) = w; }
                }
            if (!isq) {
#pragma unroll
                for (int bj = 0; bj < 2; ++bj)
#pragma unroll
                    for (int n = 0; n < 2; ++n)
#pragma unroll
                        for (int e = 0; e < 4; ++e) { float v = cs[bj][n][e]; v += __shfl_xor(v, 1); v += __shfl_xor(v, 2); v += __shfl_xor(v, 4); v += __shfl_xor(v, 8); cs[bj][n][e] = v; }
                if (fr == 0) { float* kp = kmean + ((size_t)u.pm * NH + (pn & 1) * 4 + wc) * HD + 8 * fq;
#pragma unroll
                    for (int bj = 0; bj < 2; ++bj)
#pragma unroll
                        for (int n = 0; n < 2; ++n)
#pragma unroll
                            for (int e = 0; e < 4; ++e) atomicAdd(kp + 32 * bj + 4 * n + e, cs[bj][n][e]); }
            }
        } else {
            const bool isg = pn >= 12; const float sc = (pn == 6 || pn == 7) ? C2 : 1.0f;
            bf16_t* base; int ldc;
            if (isg) { base = (pn < 16 ? ga : gb) + (pn & 3) * 256 + wc * 64 + 8 * fq; ldc = D; }
            else { base = qkv + (size_t)(pn >> 1) * ((size_t)NTOK * WATT) + (pn & 1) * 256 + wc * 64 + 8 * fq; ldc = WATT; }
#pragma unroll
            for (int ai = 0; ai < 2; ++ai)
#pragma unroll
                for (int m = 0; m < 4; ++m) { bf16_t* rowp = base + (size_t)(row0 + ai * HALF + m * 16) * ldc;
#pragma unroll
                    for (int bj = 0; bj < 2; ++bj) { f32x4 v0 = acc[ai][bj][m][0], v1 = acc[ai][bj][m][1];
                        if (isg) {
#pragma unroll
                            for (int e = 0; e < 4; ++e) { v0[e] = __builtin_amdgcn_rcpf(1.0f + __builtin_amdgcn_exp2f(-v0[e] * LOG2E)); v1[e] = __builtin_amdgcn_rcpf(1.0f + __builtin_amdgcn_exp2f(-v1[e] * LOG2E)); } }
                        else { v0 = v0 * sc; v1 = v1 * sc; }
                        u32x4 w; w.x = cvt_pk_bf16(v0[0], v0[1]); w.y = cvt_pk_bf16(v0[2], v0[3]); w.z = cvt_pk_bf16(v1[0], v1[1]); w.w = cvt_pk_bf16(v1[2], v1[3]);
                        *(u32x4*)(rowp + 32 * bj) = w; } }
        }
    }
};

template <int MODE> struct EpiBranch {
    static constexpr bool PERM = true, MIDK = false; static constexpr int PSLOT = 0;
    bf16_t* sg; const bf16_t* tin;
    __device__ __forceinline__ void operator()(const f32x4 (&acc)[2][2][4][2], const Unit& u, int wr, int wc, int fr, int fq) const {
        const int row0 = u.pm * BM + wr * 64 + fr, col0 = u.pn * BM + wc * 32 + 8 * fq;
#pragma unroll
        for (int ai = 0; ai < 2; ++ai)
#pragma unroll
        for (int mb = 0; mb < 4; mb += BR_MB) { u32x4 gw[4][2], tw[4][2];
#pragma unroll
            for (int m = mb; m < mb + BR_MB; ++m) { const size_t off = (size_t)(row0 + ai * HALF + m * 16) * D + col0;
#pragma unroll
                for (int bj = 0; bj < 2; ++bj) { gw[m][bj] = *(const u32x4*)(sg + off + bj * HALF); if (MODE == 1) tw[m][bj] = *(const u32x4*)(tin + off + bj * HALF); else tw[m][bj] = (u32x4){0u, 0u, 0u, 0u}; } }
#pragma unroll
            for (int m = mb; m < mb + BR_MB; ++m) { const size_t off = (size_t)(row0 + ai * HALF + m * 16) * D + col0;
#pragma unroll
                for (int bj = 0; bj < 2; ++bj) { const u32x4 g = gw[m][bj], t = tw[m][bj];
                    const f32x4 v0 = acc[ai][bj][m][0], v1 = acc[ai][bj][m][1]; float o[8];
                    o[0] = bflo(g.x) * v0[0]; o[1] = bfhi(g.x) * v0[1]; o[2] = bflo(g.y) * v0[2]; o[3] = bfhi(g.y) * v0[3];
                    o[4] = bflo(g.z) * v1[0]; o[5] = bfhi(g.z) * v1[1]; o[6] = bflo(g.w) * v1[2]; o[7] = bfhi(g.w) * v1[3];
                    if (MODE == 1) { o[0] += bflo(t.x); o[1] += bfhi(t.x); o[2] += bflo(t.y); o[3] += bfhi(t.y); o[4] += bflo(t.z); o[5] += bfhi(t.z); o[6] += bflo(t.w); o[7] += bfhi(t.w); }
                    u32x4 w; w.x = cvt_pk_bf16(o[0], o[1]); w.y = cvt_pk_bf16(o[2], o[3]); w.z = cvt_pk_bf16(o[4], o[5]); w.w = cvt_pk_bf16(o[6], o[7]);
                    *(u32x4*)(sg + off + bj * HALF) = w; } } }
    }
};

struct EpiMerge {
    static constexpr bool PERM = true, MIDK = true; static constexpr int PSLOT = 0;
    const bf16_t* sga; bf16_t* sgb;
    __device__ __forceinline__ void mid(f32x4 (&acc)[2][2][4][2], const Unit& u, int wr, int wc, int fr, int fq) const {
        int oz; asm volatile("v_mov_b32 %0, 0" : "=v"(oz));
        const int row0 = u.pm * BM + wr * 64 + fr + oz, col0 = u.pn * BM + wc * 32 + 8 * fq;
#pragma unroll
        for (int ai = 0; ai < 2; ++ai)
#pragma unroll
            for (int m = 0; m < 4; ++m) { const size_t off = (size_t)(row0 + ai * HALF + m * 16) * D + col0;
#pragma unroll
                for (int bj = 0; bj < 2; ++bj) { const u32x4 a = *(const u32x4*)(sga + off + bj * HALF), b = *(const u32x4*)(sgb + off + bj * HALF); f32x4& v0 = acc[ai][bj][m][0]; f32x4& v1 = acc[ai][bj][m][1];
                    v0[0] *= bflo(a.x) * __builtin_amdgcn_rcpf(bflo(b.x)); v0[1] *= bfhi(a.x) * __builtin_amdgcn_rcpf(bfhi(b.x)); v0[2] *= bflo(a.y) * __builtin_amdgcn_rcpf(bflo(b.y)); v0[3] *= bfhi(a.y) * __builtin_amdgcn_rcpf(bfhi(b.y));
                    v1[0] *= bflo(a.z) * __builtin_amdgcn_rcpf(bflo(b.z)); v1[1] *= bfhi(a.z) * __builtin_amdgcn_rcpf(bfhi(b.z)); v1[2] *= bflo(a.w) * __builtin_amdgcn_rcpf(bflo(b.w)); v1[3] *= bfhi(a.w) * __builtin_amdgcn_rcpf(bfhi(b.w)); }
                asm volatile("" : "+v"(acc[ai][0][m][0]), "+v"(acc[ai][0][m][1]), "+v"(acc[ai][1][m][0]), "+v"(acc[ai][1][m][1]) :: "memory"); }
    }
    __device__ __forceinline__ void operator()(const f32x4 (&acc)[2][2][4][2], const Unit& u, int wr, int wc, int fr, int fq) const {
        const int row0 = u.pm * BM + wr * 64 + fr, col0 = u.pn * BM + wc * 32 + 8 * fq;
#pragma unroll
        for (int ai = 0; ai < 2; ++ai)
#pragma unroll
            for (int mb = 0; mb < 4; mb += 2) { u32x4 gb[2][2];
#pragma unroll
                for (int mm = 0; mm < 2; ++mm) { const size_t off = (size_t)(row0 + ai * HALF + (mb + mm) * 16) * D + col0;
#pragma unroll
                    for (int bj = 0; bj < 2; ++bj) gb[mm][bj] = *(const u32x4*)(sgb + off + bj * HALF); }
#pragma unroll
                for (int mm = 0; mm < 2; ++mm) { const size_t off = (size_t)(row0 + ai * HALF + (mb + mm) * 16) * D + col0;
#pragma unroll
                    for (int bj = 0; bj < 2; ++bj) { const u32x4 b = gb[mm][bj]; const f32x4 v0 = acc[ai][bj][mb + mm][0], v1 = acc[ai][bj][mb + mm][1];
                        u32x4 w; w.x = cvt_pk_bf16(bflo(b.x) * v0[0], bfhi(b.x) * v0[1]); w.y = cvt_pk_bf16(bflo(b.y) * v0[2], bfhi(b.y) * v0[3]); w.z = cvt_pk_bf16(bflo(b.z) * v1[0], bfhi(b.z) * v1[1]); w.w = cvt_pk_bf16(bflo(b.w) * v1[2], bfhi(b.w) * v1[3]);
                        *(u32x4*)(sgb + off + bj * HALF) = w; } } }
    }
};

struct EpiResid {
    static constexpr bool PERM = false, MIDK = false; static constexpr int PSLOT = 0;
    const float* x; float* out; const float* gt;
    float* stats;
    __device__ __forceinline__ void operator()(const f32x4 (&acc)[2][2][4][2], const Unit& u, int wr, int wc, int fr, int fq) const {
        const int row0 = u.pm * BM + wr * 64 + fr, col0 = u.pn * BM + wc * 32 + 4 * fq; const int b = (u.pm * BM) / SEQ;
        f32x4 gv[2][2];
#pragma unroll
        for (int bj = 0; bj < 2; ++bj)
#pragma unroll
            for (int n = 0; n < 2; ++n) gv[bj][n] = *(const f32x4*)(gt + (size_t)b * (NMOD * D) + col0 + bj * HALF + n * 16);
#pragma unroll
        for (int ai = 0; ai < 2; ++ai)
#pragma unroll
        for (int mb = 0; mb < 4; mb += RS_MB) { f32x4 xv[4][2][2];
#pragma unroll
            for (int m = mb; m < mb + RS_MB; ++m) { const size_t off = (size_t)(row0 + ai * HALF + m * 16) * D + col0;
#pragma unroll
                for (int bj = 0; bj < 2; ++bj)
#pragma unroll
                    for (int n = 0; n < 2; ++n) xv[m][bj][n] = *(const f32x4*)(x + off + bj * HALF + n * 16); }
#pragma unroll
            for (int m = mb; m < mb + RS_MB; ++m) { const int row = row0 + ai * HALF + m * 16; const size_t off = (size_t)row * D + col0; float ss = 0.f;
#pragma unroll
                for (int bj = 0; bj < 2; ++bj)
#pragma unroll
                    for (int n = 0; n < 2; ++n) { const f32x4 o = xv[m][bj][n] + gv[bj][n] * acc[ai][bj][m][n];
                        *(f32x4*)(out + off + bj * HALF + n * 16) = o; ss += (o[0] * o[0] + o[1] * o[1]) + (o[2] * o[2] + o[3] * o[3]); }
                ss += __shfl_xor(ss, 16); ss += __shfl_xor(ss, 32);
                if (fq == 0) stats[(size_t)row * 16 + u.pn * 4 + wc] = ss; } }
    }
};

struct EpiGateUp {
    static constexpr bool PERM = true, MIDK = false; static constexpr int PSLOT = 0;
    bf16_t* H;
    __device__ __forceinline__ void operator()(const f32x4 (&acc)[2][2][4][2], const Unit& u, int wr, int wc, int fr, int fq) const {
        bf16_t* base = H + (size_t)(u.arow + wr * 64 + fr) * DEXP + u.pn * 128 + wc * 32 + 8 * fq;
#pragma unroll
        for (int ai = 0; ai < 2; ++ai)
#pragma unroll
            for (int m = 0; m < 4; ++m) { float o[8];
#pragma unroll
                for (int n = 0; n < 2; ++n)
#pragma unroll
                    for (int e = 0; e < 4; ++e) { const float gg = acc[ai][0][m][n][e], uu = acc[ai][1][m][n][e]; o[4 * n + e] = gg * __builtin_amdgcn_rcpf(1.0f + __builtin_amdgcn_exp2f(-gg * LOG2E)) * uu; }
                u32x4 w; w.x = cvt_pk_bf16(o[0], o[1]); w.y = cvt_pk_bf16(o[2], o[3]); w.z = cvt_pk_bf16(o[4], o[5]); w.w = cvt_pk_bf16(o[6], o[7]);
                *(u32x4*)(base + (size_t)(ai * HALF + m * 16) * DEXP) = w; }
    }
};

struct EpiDown {
    static constexpr bool PERM = false, MIDK = false; static constexpr int PSLOT = 0;
    float* out; const float* gt;
    const int* tl; const float* wl;
    __device__ __forceinline__ void operator()(const f32x4 (&acc)[2][2][4][2], const Unit& u, int wr, int wc, int fr, int fq) const {
        const int col0 = u.pn * BM + wc * 32 + 4 * fq;
        int tok[2][4]; float wv[2][4];
#pragma unroll
        for (int ai = 0; ai < 2; ++ai)
#pragma unroll
            for (int m = 0; m < 4; ++m) { const int r = ai * HALF + wr * 64 + m * 16 + fr; const int rr = r < u.x1 ? r : u.x1 - 1; tok[ai][m] = tl[u.x0 + rr]; wv[ai][m] = wl[u.x0 + rr]; }
#pragma unroll
        for (int ai = 0; ai < 2; ++ai)
#pragma unroll
        for (int mb = 0; mb < 4; mb += DN_MB) { f32x4 ov[4][2][2];
#pragma unroll
            for (int m = mb; m < mb + DN_MB; ++m) { const float* op = out + (size_t)tok[ai][m] * D + col0;
#pragma unroll
                for (int bj = 0; bj < 2; ++bj)
#pragma unroll
                    for (int n = 0; n < 2; ++n) ov[m][bj][n] = *(const f32x4*)(op + bj * HALF + n * 16); }
#pragma unroll
            for (int m = mb; m < mb + DN_MB; ++m) { const int r = ai * HALF + wr * 64 + m * 16 + fr; const int tk = tok[ai][m]; const float* gp = gt + (size_t)(tk / SEQ) * (NMOD * D) + col0; f32x4 gv[2][2];
#pragma unroll
                for (int bj = 0; bj < 2; ++bj)
#pragma unroll
                    for (int n = 0; n < 2; ++n) gv[bj][n] = *(const f32x4*)(gp + bj * HALF + n * 16);
                if (r < u.x1) { float* op = out + (size_t)tk * D + col0; const float w = wv[ai][m];
#pragma unroll
                    for (int bj = 0; bj < 2; ++bj)
#pragma unroll
                        for (int n = 0; n < 2; ++n) *(f32x4*)(op + bj * HALF + n * 16) = ov[m][bj][n] + gv[bj][n] * (acc[ai][bj][m][n] * w); } } }
    }
};

struct EpiY {
    static constexpr bool PERM = true, MIDK = false; static constexpr int PSLOT = 0;
    bf16_t* Y;
    __device__ __forceinline__ void operator()(const f32x4 (&acc)[2][2][4][2], const Unit& u, int wr, int wc, int fr, int fq) const {
        bf16_t* base = Y + (size_t)(u.arow + wr * 64 + fr) * D + u.pn * BM + wc * 32 + 8 * fq;
#pragma unroll
        for (int ai = 0; ai < 2; ++ai)
#pragma unroll
            for (int m = 0; m < 4; ++m) { bf16_t* rowp = base + (size_t)(ai * HALF + m * 16) * D;
#pragma unroll
                for (int bj = 0; bj < 2; ++bj) { const f32x4 v0 = acc[ai][bj][m][0], v1 = acc[ai][bj][m][1];
                    u32x4 w; w.x = cvt_pk_bf16(v0[0], v0[1]); w.y = cvt_pk_bf16(v0[2], v0[3]); w.z = cvt_pk_bf16(v1[0], v1[1]); w.w = cvt_pk_bf16(v1[2], v1[3]);
                    *(u32x4*)(rowp + bj * HALF) = w; } }
    }
};
struct EpiNull {
    static constexpr bool PERM = false, MIDK = false; static constexpr int PSLOT = 0;
    bf16_t* dummy;
    __device__ __forceinline__ void operator()(const f32x4 (&acc)[2][2][4][2], const Unit& u, int wr, int wc, int fr, int fq) const {
        f32x4 s = {0.f, 0.f, 0.f, 0.f};
#pragma unroll
        for (int ai = 0; ai < 2; ++ai)
#pragma unroll
            for (int bj = 0; bj < 2; ++bj)
#pragma unroll
                for (int m = 0; m < 4; ++m)
#pragma unroll
                    for (int n = 0; n < 2; ++n) s += acc[ai][bj][m][n];
        *(f32x4*)((float*)dummy + (size_t)(blockIdx.x * 512 + threadIdx.x) * 4) = s;
    }
};
struct GateUpOrder {
    const PG8_LAS int* T; const int* tokl; int G, c;
    __device__ bool next(int i, Unit& u) const {
        const int L = i * G + c; const int total = T[64 + 32] * 4; if (L >= total) return false;
        const int rt = L >> 2; int e = 0; while (T[64 + e + 1] <= rt) ++e;
        const int lt = rt - T[64 + e];
        u.pm = lt; u.pn = L & 3; u.x0 = e; u.x1 = 0; u.arow = T[128 + e] + lt * 256; u.brow = e * 1024 + (L & 3) * 256; return true;
    }
    __device__ __forceinline__ int arow_of(const Unit& u, int r) const {
        const int idx = u.pm * 256 + r, c0 = T[u.x0], c1 = T[32 + u.x0];
        int tok = 0;
        if (idx < c0) tok = tokl[(size_t)u.x0 * LCAP + idx]; else if (idx < c0 + c1) tok = tokl[(size_t)(NEXP + u.x0) * LCAP + idx - c0];
        return tok;
    }
};
struct DownAllOrder {
    const PG8_LAS int* T; int G, c;
    __device__ bool next(int i, Unit& u) const {
        const int L = i * G + c; const int total = T[64 + 32] * 4; if (L >= total) return false;
        const int rt = L >> 2; int e = 0; while (T[64 + e + 1] <= rt) ++e;
        const int lt = rt - T[64 + e];
        u.pm = lt; u.pn = L & 3; u.x0 = e; u.x1 = 0; u.arow = T[128 + e] + lt * 256; u.brow = e * 1024 + (L & 3) * 256; return true;
    }
    __device__ __forceinline__ int arow_of(const Unit&, int) const { return 0; }
};
template <int SLOT> struct DownOrder {
    const PG8_LAS int* T; int G, c;
    __device__ bool next(int i, Unit& u) const {
        const int PO = SLOT ? 256 : 192; const int L = i * G + c; const int total = T[PO + 32] * 4; if (L >= total) return false;
        const int rt = L >> 2; int e = 0; while (T[PO + e + 1] <= rt) ++e;
        const int lt = rt - T[PO + e]; const int cs = T[SLOT * 32 + e]; const int rem = cs - lt * 256;
        u.pm = lt; u.pn = L & 3; u.x0 = (SLOT * NEXP + e) * LCAP + lt * 256; u.x1 = rem < 256 ? rem : 256;
        u.arow = T[128 + e] + (SLOT ? T[e] : 0) + lt * 256; u.brow = e * 1024 + (L & 3) * 256; return true;
    }
    __device__ __forceinline__ int arow_of(const Unit&, int) const { return 0; }
};
}
namespace attn {
using bf16x8 = __attribute__((ext_vector_type(8))) short;
using s16x4 = __attribute__((ext_vector_type(4))) short;
using f32x16 = __attribute__((ext_vector_type(16))) float;
using f32x4v = __attribute__((ext_vector_type(4))) float;
using u32x4 = __attribute__((ext_vector_type(4))) unsigned;
typedef unsigned short bf16;
constexpr int DM = 512, QBLK = 32, NW = 8, QB = 256, KVBLK = 64;
constexpr int NSLOT = 3, SLOTB = 8192;
constexpr int LDS_K = 0, LDS_V = NSLOT * SLOTB, LDS_WS = 2 * NSLOT * SLOTB, LDS_OST = LDS_WS + NW * 64 * 4, LDS_BT = LDS_OST + NW * 4096;
constexpr int REV = 896, BT_LEN = 1168, COPYB = BT_LEN * 4, NEG_OFF = 4 * COPYB, BT_BYTES = NEG_OFF + 256;
constexpr int LDS_BYTES = LDS_BT + BT_BYTES;
static_assert(BT_LEN >= REV + 256 + 8 + 3 && COPYB % 16 == 0 && LDS_BT % 16 == 0, "bias image");
#define SBAR() __builtin_amdgcn_sched_barrier(0)
#define WAIT_BAR(N) asm volatile("s_waitcnt vmcnt(" #N ") lgkmcnt(0)\n\ts_barrier":::"memory")
typedef __attribute__((address_space(3))) const char* lds_cptr;
typedef short v4i16_t __attribute__((ext_vector_type(4)));
typedef float f32x2_t __attribute__((ext_vector_type(2))); typedef __bf16 bf16x2_t __attribute__((ext_vector_type(2)));
__device__ __forceinline__ int crow(int r, int hi) { return (r & 3) + 8 * (r >> 2) + 4 * hi; }
__device__ __forceinline__ void glds16(const void* gsrc, unsigned lds_dst) { unsigned keep;
  asm volatile("s_mov_b32 %0, m0\n\ts_mov_b32 m0, %2\n\ts_nop 0\n\tglobal_load_lds_dwordx4 %1, off\n\ts_mov_b32 m0, %0" : "=&s"(keep) : "v"(gsrc), "s"(lds_dst) : "memory"); }
__device__ __forceinline__ unsigned cvtpk_s(float lo, float hi) { f32x2_t v = {lo, hi}; bf16x2_t b = __builtin_convertvector(v, bf16x2_t); return __builtin_bit_cast(unsigned, b); }
__device__ __forceinline__ void kload8(bf16x8* kf, lds_cptr kp) {
  kf[0] = *(const __attribute__((address_space(3))) bf16x8*)(kp);        kf[1] = *(const __attribute__((address_space(3))) bf16x8*)(kp + 512);
  kf[2] = *(const __attribute__((address_space(3))) bf16x8*)(kp + 2048); kf[3] = *(const __attribute__((address_space(3))) bf16x8*)(kp + 2560);
  kf[4] = *(const __attribute__((address_space(3))) bf16x8*)(kp + 4096); kf[5] = *(const __attribute__((address_space(3))) bf16x8*)(kp + 4608);
  kf[6] = *(const __attribute__((address_space(3))) bf16x8*)(kp + 6144); kf[7] = *(const __attribute__((address_space(3))) bf16x8*)(kp + 6656);
}
__device__ __forceinline__ void kload2(bf16x8* kf, lds_cptr kp, int j) { kf[2 * j] = *(const __attribute__((address_space(3))) bf16x8*)(kp + j * 2048); kf[2 * j + 1] = *(const __attribute__((address_space(3))) bf16x8*)(kp + j * 2048 + 512); }
__device__ __forceinline__ s16x4 vtr(lds_cptr p) { return __builtin_bit_cast(s16x4, __builtin_amdgcn_ds_read_tr16_b64_v4i16((__attribute__((address_space(3))) v4i16_t*)p)); }
__device__ __forceinline__ f32x4v ldsf4(lds_cptr p) { return *(const __attribute__((address_space(3))) f32x4v*)p; }
#define MFMA32(a, b, c) __builtin_amdgcn_mfma_f32_32x32x16_bf16(a, b, c, 0, 0, 0)
__device__ __forceinline__ void pv(f32x16* o, int vb, bf16x8 pa0, bf16x8 pa1, bf16x8 pa2, bf16x8 pa3) {
  #pragma unroll
  for (int d0 = 0; d0 < 2; ++d0) { s16x4 lo[4], hi[4];
    #pragma unroll
    for (int ks = 0; ks < 4; ++ks) {
      asm volatile("ds_read_b64_tr_b16 %0,%1 offset:%c2" : "=&v"(lo[ks]) : "v"(vb), "i"(d0 * 4096 + ks * 1024) : "memory");
      asm volatile("ds_read_b64_tr_b16 %0,%1 offset:%c2" : "=&v"(hi[ks]) : "v"(vb), "i"(d0 * 4096 + ks * 1024 + 512) : "memory"); }
    asm volatile("s_waitcnt lgkmcnt(0)" ::: "memory"); SBAR();
    #define PK(k) (bf16x8){lo[k][0], lo[k][1], lo[k][2], lo[k][3], hi[k][0], hi[k][1], hi[k][2], hi[k][3]}
    o[d0] = MFMA32(pa0, PK(0), o[d0]); o[d0] = MFMA32(pa1, PK(1), o[d0]); o[d0] = MFMA32(pa2, PK(2), o[d0]); o[d0] = MFMA32(pa3, PK(3), o[d0]);
    #undef PK
  }
}
#define ATTN_STORE16(p, v) (*(u32x4*)(p) = (v))

__device__ __forceinline__ void moba_unit(int b, int h, int qb, const bf16* Q, const bf16* __restrict__ K, const bf16* __restrict__ V, bf16* O, const float* __restrict__ ksum, char* shm, int opitch) {
  const int tid = threadIdx.x, lane = tid & 63, r32 = lane & 31, hi = lane >> 5; const int wid = __builtin_amdgcn_readfirstlane(tid >> 6);
  const long rowbase = (long)b * 4096; const int q0 = qb * QB;
  const bf16* Qw = Q + (rowbase + q0 + wid * QBLK) * DM + h * 64;
  const bf16* Kh = K + rowbase * DM + h * 64, *Vh = V + rowbase * DM + h * 64;
  const unsigned lds0 = (unsigned)(uintptr_t)shm;
  float* wsf = (float*)(shm + LDS_WS) + wid * 64;
  const lds_cptr shm3 = (lds_cptr)shm;
  if (tid < 128) { const int j = tid >> 3, c = tid & 7; f32x4v a = {0.f, 0.f, 0.f, 0.f}, bq = {0.f, 0.f, 0.f, 0.f};
    if (j < qb) { const f32x4v* kp = (const f32x4v*)(ksum + ((size_t)(b * 16 + j) * 8 + h) * 64 + c * 8); a = kp[0]; bq = kp[1]; }
    const float v[8] = {a[0], a[1], a[2], a[3], bq[0], bq[1], bq[2], bq[3]}; unsigned hw[4], lw[4];
    #pragma unroll
    for (int i = 0; i < 4; ++i) { const unsigned hp = cvtpk_s(v[2 * i], v[2 * i + 1]); const float r0 = v[2 * i] - __uint_as_float(hp << 16), r1 = v[2 * i + 1] - __uint_as_float(hp & 0xffff0000u); hw[i] = hp; lw[i] = cvtpk_s(r0, r1); }
    *(__attribute__((address_space(3))) u32x4*)(shm3 + LDS_OST + c * 1024 + j * 16) = (u32x4){hw[0], hw[1], hw[2], hw[3]};
    *(__attribute__((address_space(3))) u32x4*)(shm3 + LDS_OST + 8192 + c * 1024 + j * 16) = (u32x4){lw[0], lw[1], lw[2], lw[3]}; }
  asm volatile("s_waitcnt vmcnt(0)" ::: "memory");
  const bf16* ksrc = Kh + (long)lane * DM + wid * 8;
  const bf16* vsrc = Vh + (long)(16 * (wid & 3) + (lane >> 2)) * DM + (wid >> 2) * 32 + (lane & 3) * 8;
  const unsigned kdst = lds0 + LDS_K + wid * 1024, vdst = lds0 + LDS_V + wid * 1024;
  #define DMA_K(t, slot) glds16(ksrc + (long)(t) * KVBLK * DM, (unsigned)__builtin_amdgcn_readfirstlane(kdst + (slot)))
  #define DMA_V(t, slot) glds16(vsrc + (long)(t) * KVBLK * DM, (unsigned)__builtin_amdgcn_readfirstlane(vdst + (slot)))
  const int vb0 = (int)(lds0 + LDS_V) + ((lane >> 4) & 1) * 32 + (lane & 3) * 8 + (4 * hi + ((lane & 15) >> 2)) * 64;
  bf16x8 kf[8];
  const lds_cptr kp0 = shm3 + LDS_K + hi * 1024 + r32 * 16; const lds_cptr vp0 = shm3 + LDS_V + ((lane >> 4) & 1) * 32 + (lane & 3) * 8 + (4 * hi + ((lane & 15) >> 2)) * 64;
  const int NT = (q0 + QB) / KVBLK;
  DMA_K(0, 0); DMA_V(0, 0); DMA_K(1, SLOTB);
  bf16x8 qr[4];
  #pragma unroll
  for (int d0 = 0; d0 < 4; ++d0) qr[d0] = *reinterpret_cast<const bf16x8*>(&Qw[(long)r32 * DM + d0 * 16 + hi * 8]);
  float l_reg = 0.f; f32x16 o[2]; o[0] = f32x16{}; o[1] = f32x16{};
  const int tq = q0 + wid * QBLK + r32, acp = (REV - tq) & 3;
  const int cbase = LDS_BT + acp * COPYB; int baddr = cbase + 4 * (REV - tq + 4 * hi - acp);
  DMA_K(2, 2 * SLOTB);
  WAIT_BAR(3);
  unsigned selmask;
  { f32x16 ga = f32x16{};
    #pragma unroll
    for (int d0 = 0; d0 < 4; ++d0) { const bf16x8 ah = *(const __attribute__((address_space(3))) bf16x8*)(shm3 + LDS_OST + hi * 1024 + r32 * 16 + d0 * 2048);
      const bf16x8 al = *(const __attribute__((address_space(3))) bf16x8*)(shm3 + LDS_OST + 8192 + hi * 1024 + r32 * 16 + d0 * 2048);
      ga = MFMA32(ah, qr[d0], ga); ga = MFMA32(al, qr[d0], ga); }
    float G[16];
    #pragma unroll
    for (int r = 0; r < 8; ++r) { auto rr = __builtin_amdgcn_permlane32_swap(__float_as_uint(ga[r]), __float_as_uint(ga[r]), false, false);
      G[(r & 3) + 8 * (r >> 2)] = __uint_as_float(rr[0]); G[(r & 3) + 8 * (r >> 2) + 4] = __uint_as_float(rr[1]); }
    #pragma unroll
    for (int j = 0; j < 16; ++j) if (j >= qb) G[j] = -INFINITY;
    selmask = 1u << qb;
    #pragma unroll
    for (int pass = 0; pass < 3; ++pass) { float best = -INFINITY; int bi = 16;
      #pragma unroll
      for (int j = 0; j < 16; ++j) if (G[j] > best) { best = G[j]; bi = j; }
      if (bi < 16) selmask |= 1u << bi;
      #pragma unroll
      for (int j = 0; j < 16; ++j) if (j == bi) G[j] = -INFINITY; }
  }
  f32x16 pA0, pA1, pB0, pB1;
  #define BEFF(T) (((selmask >> ((T) >> 2)) & 1u) ? (baddr + 256 * (T) > cbase ? baddr + 256 * (T) : cbase) : (LDS_BT + NEG_OFF))
  #define BRD1(X0, X1, eff, i) do { const f32x4v bv_ = ldsf4(shm3 + (eff) + ((i) < 4 ? 32 * (i) : 128 + 32 * ((i) - 4))); \
      if ((i) < 4) { X0[4 * (i)] = bv_[0]; X0[4 * (i) + 1] = bv_[1]; X0[4 * (i) + 2] = bv_[2]; X0[4 * (i) + 3] = bv_[3]; } \
      else { X1[4 * ((i) - 4)] = bv_[0]; X1[4 * ((i) - 4) + 1] = bv_[1]; X1[4 * ((i) - 4) + 2] = bv_[2]; X1[4 * ((i) - 4) + 3] = bv_[3]; } } while (0)
  { const int e0 = BEFF(0);
    #pragma unroll
    for (int i = 0; i < 8; ++i) BRD1(pA0, pA1, e0, i); }
  int sl_prev = 0, sl_cur = 0, sl_next = SLOTB;
  #define ROT() do { sl_prev = sl_cur; sl_cur = sl_next; sl_next = (sl_next == (NSLOT - 1) * SLOTB) ? 0 : sl_next + SLOTB; } while (0)
  { const char* kb = shm + LDS_K + hi * 1024 + r32 * 16;
    #pragma unroll
    for (int d0 = 0; d0 < 4; ++d0) { const bf16x8 b0 = *reinterpret_cast<const bf16x8*>(kb + d0 * 2048); const bf16x8 b1 = *reinterpret_cast<const bf16x8*>(kb + d0 * 2048 + 512);
      pA0 = MFMA32(b0, qr[d0], pA0); pA1 = MFMA32(b1, qr[d0], pA1); } }
  #pragma unroll
  for (int r = 0; r < 16; ++r) { pA0[r] = __builtin_amdgcn_exp2f(pA0[r]); pA1[r] = __builtin_amdgcn_exp2f(pA1[r]); }
  { const int e1 = BEFF(1);
    #pragma unroll
    for (int i = 0; i < 8; ++i) BRD1(pB0, pB1, e1, i); }
  WAIT_BAR(0);
  DMA_K(3, 0); DMA_V(1, SLOTB);
  ROT();
  kload8(kf, kp0 + sl_cur);
  WAIT_BAR(2);
  s16x4 vlo[8], vhi[8]; u32x4 pw0, pw1, pw2, pw3;
  #define PKW(P, B) cvtpk_s(P[B], P[B + 1])
  #define PAF(k) __builtin_bit_cast(bf16x8, pw##k)
  #define VFR(i) (bf16x8){vlo[i][0], vlo[i][1], vlo[i][2], vlo[i][3], vhi[i][0], vhi[i][1], vhi[i][2], vhi[i][3]}
  #define PIN(x) asm volatile("" : "+v"(x))
  #define GAPA(MF, A0, A1, A2, A3, W0, W1, PW) do { MF; sacc += A0; sacc += A1; sacc += A2; sacc += A3; PIN(sacc); W0; W1; PIN(PW); SBAR(); } while (0)
  #define EX(v) __builtin_amdgcn_exp2f(v)
  #define GAPB(MF, X, B) do { MF; X[B] = EX(X[B]); X[B + 1] = EX(X[B + 1]); X[B + 2] = EX(X[B + 2]); X[B + 3] = EX(X[B + 3]); PIN(X); SBAR(); } while (0)
  #define VRD(i) do { vlo[i] = vtr(vp_ + (((i) >> 2) * 4096 + ((i) & 3) * 1024)); vhi[i] = vtr(vp_ + (((i) >> 2) * 4096 + ((i) & 3) * 1024 + 512)); } while (0)
  #define KRD(G, j) do { if (G) { kload2(kf, kp0 + sl_next, j); SBAR(); } } while (0)
  #define BRD(G, i, X0, X1) do { if (G) { BRD1(X0, X1, eff_, i); } } while (0)
  #define STEP(C0, C1, P0, P1, t, GK, GV, GL) do { SBAR(); \
    const lds_cptr vp_ = vp0 + sl_prev; \
    VRD(0); SBAR(); float sacc = (P0[0] + P0[1]); \
    GAPA(C0 = MFMA32(kf[0], qr[0], C0), P0[2], P0[3], P0[4], P0[5],     pw0[0] = PKW(P0, 0), pw0[1] = PKW(P0, 2), pw0); \
    VRD(4); SBAR(); GAPA(C1 = MFMA32(kf[1], qr[0], C1), P0[6], P0[7], P0[8], P0[9],     pw0[2] = PKW(P0, 4), pw0[3] = PKW(P0, 6), pw0); \
    VRD(1); SBAR(); GAPA(C0 = MFMA32(kf[2], qr[1], C0),   P0[10], P0[11], P0[12], P0[13], pw1[0] = PKW(P0, 8), pw1[1] = PKW(P0, 10), pw1); \
    VRD(5); SBAR(); GAPA(C1 = MFMA32(kf[3], qr[1], C1),   P0[14], P0[15], P1[0], P1[1],   pw1[2] = PKW(P0, 12), pw1[3] = PKW(P0, 14), pw1); \
    VRD(2); SBAR(); GAPA(C0 = MFMA32(kf[4], qr[2], C0),   P1[2], P1[3], P1[4], P1[5],     pw2[0] = PKW(P1, 0), pw2[1] = PKW(P1, 2), pw2); \
    VRD(6); SBAR(); GAPA(C1 = MFMA32(kf[5], qr[2], C1),   P1[6], P1[7], P1[8], P1[9],     pw2[2] = PKW(P1, 4), pw2[3] = PKW(P1, 6), pw2); \
    VRD(3); SBAR(); GAPA(C0 = MFMA32(kf[6], qr[3], C0),   P1[10], P1[11], P1[12], P1[13], pw3[0] = PKW(P1, 8), pw3[1] = PKW(P1, 10), pw3); \
    VRD(7); SBAR(); GAPA(C1 = MFMA32(kf[7], qr[3], C1),   P1[14], P1[15], 0.f, 0.f,       pw3[2] = PKW(P1, 12), pw3[3] = PKW(P1, 14), pw3); \
    l_reg += sacc; \
    if (GK) { DMA_K((t) + 3, sl_cur); } if (GV) { DMA_V((t) + 1, sl_next); } \
    const int eff_ = BEFF((t) + 1); \
    SBAR(); \
    BRD(GL, 0, P0, P1); GAPB(o[0] = MFMA32(PAF(0), VFR(0), o[0]), C0, 0); \
    BRD(GL, 1, P0, P1); GAPB(o[1] = MFMA32(PAF(0), VFR(4), o[1]), C0, 4); \
    BRD(GL, 2, P0, P1); KRD(GL, 0); GAPB(o[0] = MFMA32(PAF(1), VFR(1), o[0]), C0, 8); \
    BRD(GL, 3, P0, P1); KRD(GL, 1); GAPB(o[1] = MFMA32(PAF(1), VFR(5), o[1]), C0, 12); \
    BRD(GL, 4, P0, P1); KRD(GL, 2); GAPB(o[0] = MFMA32(PAF(2), VFR(2), o[0]), C1, 0); \
    BRD(GL, 5, P0, P1); KRD(GL, 3); GAPB(o[1] = MFMA32(PAF(2), VFR(6), o[1]), C1, 4); \
    BRD(GL, 6, P0, P1); GAPB(o[0] = MFMA32(PAF(3), VFR(3), o[0]), C1, 8); \
    BRD(GL, 7, P0, P1); GAPB(o[1] = MFMA32(PAF(3), VFR(7), o[1]), C1, 12); \
    } while (0)
  int t = 1;
  for (; t + 5 < NT; t += 2) {
    STEP(pB0, pB1, pA0, pA1, t, true, true, true);     WAIT_BAR(2); ROT();
    STEP(pA0, pA1, pB0, pB1, t + 1, true, true, true); WAIT_BAR(2); ROT();
  }
  #define ENDW(tt) do { if ((tt) + 3 < NT) { WAIT_BAR(2); } else if ((tt) + 2 < NT) { WAIT_BAR(1); } else { WAIT_BAR(0); } } while (0)
  for (; t + 1 < NT; t += 2) {
    STEP(pB0, pB1, pA0, pA1, t, (t + 3 < NT), (t + 1 < NT), (t + 1 < NT));       ENDW(t);     ROT();
    STEP(pA0, pA1, pB0, pB1, t + 1, (t + 4 < NT), (t + 2 < NT), (t + 2 < NT));   ENDW(t + 1); ROT();
  }
  STEP(pB0, pB1, pA0, pA1, NT - 1, false, false, false);
  { float sacc = pB0[0] + pB0[1];
    #pragma unroll
    for (int r = 2; r < 16; ++r) sacc += pB0[r];
    #pragma unroll
    for (int r = 0; r < 16; ++r) sacc += pB1[r];
    l_reg += sacc;
    pw0 = (u32x4){PKW(pB0, 0), PKW(pB0, 2), PKW(pB0, 4), PKW(pB0, 6)}; pw1 = (u32x4){PKW(pB0, 8), PKW(pB0, 10), PKW(pB0, 12), PKW(pB0, 14)};
    pw2 = (u32x4){PKW(pB1, 0), PKW(pB1, 2), PKW(pB1, 4), PKW(pB1, 6)}; pw3 = (u32x4){PKW(pB1, 8), PKW(pB1, 10), PKW(pB1, 12), PKW(pB1, 14)};
    SBAR(); pv(o, vb0 + sl_cur, PAF(0), PAF(1), PAF(2), PAF(3)); }
  #undef STEP
  #undef BRD
  #undef KRD
  #undef VRD
  #undef GAPB
  #undef GAPA
  { auto rr = __builtin_amdgcn_permlane32_swap(__float_as_uint(l_reg), __float_as_uint(l_reg), false, false); l_reg = __uint_as_float(rr[0]) + __uint_as_float(rr[1]); }
  if (hi == 0) wsf[32 + r32] = l_reg; asm volatile("s_waitcnt lgkmcnt(0)" ::: "memory");
  float rli[16];
  #pragma unroll
  for (int r = 0; r < 16; ++r) rli[r] = __builtin_amdgcn_rcpf(wsf[32 + crow(r, hi)]);
  bf16* Ow = O + (rowbase + q0 + wid * QBLK) * opitch + h * 64;
  { bf16* stg = (bf16*)(shm + LDS_OST) + wid * 2048;
    #pragma unroll
    for (int r = 0; r < 16; ++r) { const int orow = crow(r, hi);
      #pragma unroll
      for (int d0 = 0; d0 < 2; ++d0) stg[orow * 64 + d0 * 32 + r32] = (bf16)(cvtpk_s(o[d0][r] * rli[r], 0.f) & 0xffffu); }
    asm volatile("s_waitcnt lgkmcnt(0)" ::: "memory");
    #pragma unroll
    for (int i = 0; i < 4; ++i) { const int row = i * 8 + (lane >> 3), ch = lane & 7; const u32x4 v = *(const u32x4*)(stg + row * 64 + ch * 8); ATTN_STORE16(Ow + (long)row * opitch + ch * 8, v); } }
  asm volatile("s_waitcnt lgkmcnt(0)\n\ts_barrier" ::: "memory");
  #undef DMA_K
  #undef DMA_V
  #undef ROT
  #undef BEFF
  #undef BRD1
  #undef ENDW
  #undef PKW
  #undef PAF
  #undef VFR
  #undef PIN
  #undef EX
}

__device__ __forceinline__ void sb_unit(int b, int h, int qb, const bf16* Q, const bf16* __restrict__ K, const bf16* __restrict__ V, bf16* O, char* shm, int opitch) {
  const int tid = threadIdx.x, lane = tid & 63, r32 = lane & 31, hi = lane >> 5; const int wid = __builtin_amdgcn_readfirstlane(tid >> 6);
  const long rowbase = (long)b * 4096; const int q0 = qb * QB;
  const bf16* Qw = Q + (rowbase + q0 + wid * QBLK) * DM + h * 64;
  const bf16* Kh = K + rowbase * DM + h * 64, *Vh = V + rowbase * DM + h * 64;
  const unsigned lds0 = (unsigned)(uintptr_t)shm;
  const lds_cptr shm3 = (lds_cptr)shm;
  const bf16* ksrc = Kh + (long)lane * DM + wid * 8;
  const bf16* vsrc = Vh + (long)(16 * (wid & 3) + (lane >> 2)) * DM + (wid >> 2) * 32 + (lane & 3) * 8;
  const unsigned kdst = lds0 + LDS_K + wid * 1024, vdst = lds0 + LDS_V + wid * 1024;
  const int NTALL = (q0 + QB) / KVBLK;
  const int vb0 = (int)(lds0 + LDS_V) + ((lane >> 4) & 1) * 32 + (lane & 3) * 8 + (4 * hi + ((lane & 15) >> 2)) * 64;
  const lds_cptr kp0 = shm3 + LDS_K + hi * 1024 + r32 * 16; const lds_cptr vp0 = shm3 + LDS_V + ((lane >> 4) & 1) * 32 + (lane & 3) * 8 + (4 * hi + ((lane & 15) >> 2)) * 64;
  bf16x8 qr[4];
  #pragma unroll
  for (int d0 = 0; d0 < 4; ++d0) qr[d0] = *reinterpret_cast<const bf16x8*>(&Qw[(long)r32 * DM + d0 * 16 + hi * 8]);
  f32x16 o[2]; o[0] = f32x16{}; o[1] = f32x16{};
  const int tq = q0 + wid * QBLK + r32;
  const f32x16 zero16 = f32x16{};
  float cc = 1.0f;
  const bool hib = hi != 0;
  volatile __attribute__((address_space(3))) unsigned* live = (volatile __attribute__((address_space(3))) unsigned*)(shm3 + LDS_WS);
  int Thi = NTALL, Tlo = NTALL > 8 ? NTALL - 8 : 0;
  #define TT(u) (Thi - 1 - (u))
  #define DMA_K(u, slot) glds16(ksrc + (long)TT(u) * KVBLK * DM, (unsigned)__builtin_amdgcn_readfirstlane(kdst + (slot)))
  #define DMA_V(u, slot) glds16(vsrc + (long)TT(u) * KVBLK * DM, (unsigned)__builtin_amdgcn_readfirstlane(vdst + (slot)))
  #define CMASK(X0, X1, T) do { const int lim_ = tq - 64 * (T) - 4 * hi; \
      _Pragma("unroll") for (int r_ = 0; r_ < 16; ++r_) { const int kq_ = (r_ & 3) + 8 * (r_ >> 2); if (kq_ >= lim_) X0[r_] = -INFINITY; if (kq_ + 32 >= lim_) X1[r_] = -INFINITY; } } while (0)
  #define EX(v) __builtin_amdgcn_exp2f(v)
  #define PIN(x) asm volatile("" : "+v"(x))
  #define EXPG(X, B, k) do { X[B] = EX(X[B]); X[B + 1] = EX(X[B + 1]); X[B + 2] = EX(X[B + 2]); X[B + 3] = EX(X[B + 3]); \
      float g_ = 1.0f + X[B]; g_ = __builtin_fmaf(g_, X[B + 1], g_); g_ = __builtin_fmaf(g_, X[B + 2], g_); g_ = __builtin_fmaf(g_, X[B + 3], g_); G[k] = g_; } while (0)
  #define TAIL() do { float Gp_[8], W_[8]; \
      _Pragma("unroll") for (int k_ = 0; k_ < 8; ++k_) { auto rr_ = __builtin_amdgcn_permlane32_swap(__float_as_uint(G[k_]), __float_as_uint(G[k_]), false, false); \
          const float lo_ = __uint_as_float(rr_[0]), hi_ = __uint_as_float(rr_[1]); W_[k_] = lo_ * hi_; Gp_[k_] = hib ? lo_ : 1.0f; } \
      { const float p1_ = W_[0], p2_ = p1_ * W_[1], p3_ = p2_ * W_[2]; rD0 = __builtin_amdgcn_rcpf(p3_ * W_[3]); pf[0] = Gp_[0]; pf[1] = p1_ * Gp_[1]; pf[2] = p2_ * Gp_[2]; pf[3] = p3_ * Gp_[3]; } \
      { const float p1_ = W_[4], p2_ = p1_ * W_[5], p3_ = p2_ * W_[6]; rD1 = __builtin_amdgcn_rcpf(p3_ * W_[7]); pf[4] = Gp_[4]; pf[5] = p1_ * Gp_[5]; pf[6] = p2_ * Gp_[6]; pf[7] = p3_ * Gp_[7]; } } while (0)
  #define SCAN(X, B, k, cx) do { float u_ = (cx) * pf[k]; const float a0_ = u_ * X[B]; u_ += a0_; const float a1_ = u_ * X[B + 1]; u_ += a1_; const float a2_ = u_ * X[B + 2]; u_ += a2_; const float a3_ = u_ * X[B + 3]; \
      X[B] = a0_; X[B + 1] = a1_; X[B + 2] = a2_; X[B + 3] = a3_; } while (0)
  #define ROT() do { sl_prev = sl_cur; sl_cur = sl_next; sl_next = (sl_next == (NSLOT - 1) * SLOTB) ? 0 : sl_next + SLOTB; } while (0)
  #define PKW(P, B) cvtpk_s(P[B], P[B + 1])
  #define PAF(k) __builtin_bit_cast(bf16x8, pw##k)
  #define VFR(i) (bf16x8){vlo[i][0], vlo[i][1], vlo[i][2], vlo[i][3], vhi[i][0], vhi[i][1], vhi[i][2], vhi[i][3]}
  #define GAPA(MF, SC, W0, W1, PW) do { MF; SC; W0; W1; PIN(PW); SBAR(); } while (0)
  #define GAPB(MF, X, B, k) do { MF; EXPG(X, B, k); PIN(X); PIN(G[k]); SBAR(); } while (0)
  #define VRD(i) do { vlo[i] = vtr(vp_ + (((i) >> 2) * 4096 + ((i) & 3) * 1024)); vhi[i] = vtr(vp_ + (((i) >> 2) * 4096 + ((i) & 3) * 1024 + 512)); } while (0)
  #define KRD(Gd, j) do { if (Gd) { kload2(kf, kp0 + sl_next, j); SBAR(); } } while (0)
  #define STEP(C0, C1, P0, P1, u, GK, GV, GL) do { SBAR(); \
    const lds_cptr vp_ = vp0 + sl_prev; \
    const float cm_ = cc * rD1, co_ = cm_ * rD0; \
    VRD(0); SBAR(); \
    GAPA(C0 = MFMA32(kf[0], qr[0], zero16), SCAN(P0, 0, 0, co_),  pw0[0] = PKW(P0, 0), pw0[1] = PKW(P0, 2), pw0); \
    VRD(4); SBAR(); GAPA(C1 = MFMA32(kf[1], qr[0], zero16), SCAN(P0, 4, 1, co_),  pw0[2] = PKW(P0, 4), pw0[3] = PKW(P0, 6), pw0); \
    VRD(1); SBAR(); GAPA(C0 = MFMA32(kf[2], qr[1], C0), SCAN(P0, 8, 2, co_),  pw1[0] = PKW(P0, 8), pw1[1] = PKW(P0, 10), pw1); \
    VRD(5); SBAR(); GAPA(C1 = MFMA32(kf[3], qr[1], C1), SCAN(P0, 12, 3, co_), pw1[2] = PKW(P0, 12), pw1[3] = PKW(P0, 14), pw1); \
    VRD(2); SBAR(); GAPA(C0 = MFMA32(kf[4], qr[2], C0), SCAN(P1, 0, 4, cm_),  pw2[0] = PKW(P1, 0), pw2[1] = PKW(P1, 2), pw2); \
    VRD(6); SBAR(); GAPA(C1 = MFMA32(kf[5], qr[2], C1), SCAN(P1, 4, 5, cm_),  pw2[2] = PKW(P1, 4), pw2[3] = PKW(P1, 6), pw2); \
    VRD(3); SBAR(); GAPA(C0 = MFMA32(kf[6], qr[3], C0), SCAN(P1, 8, 6, cm_),  pw3[0] = PKW(P1, 8), pw3[1] = PKW(P1, 10), pw3); \
    VRD(7); SBAR(); GAPA(C1 = MFMA32(kf[7], qr[3], C1), SCAN(P1, 12, 7, cm_), pw3[2] = PKW(P1, 12), pw3[3] = PKW(P1, 14), pw3); \
    cc = co_; \
    if (GK) { DMA_K((u) + 3, sl_cur); } if (GV) { DMA_V((u) + 1, sl_next); } \
    if (TT(u) >= 4 * qb) { CMASK(C0, C1, TT(u)); } \
    SBAR(); \
    GAPB(o[0] = MFMA32(PAF(0), VFR(0), o[0]), C0, 0, 0); \
    GAPB(o[1] = MFMA32(PAF(0), VFR(4), o[1]), C0, 4, 1); \
    KRD(GL, 0); GAPB(o[0] = MFMA32(PAF(1), VFR(1), o[0]), C0, 8, 2); \
    KRD(GL, 1); GAPB(o[1] = MFMA32(PAF(1), VFR(5), o[1]), C0, 12, 3); \
    KRD(GL, 2); GAPB(o[0] = MFMA32(PAF(2), VFR(2), o[0]), C1, 0, 4); \
    KRD(GL, 3); GAPB(o[1] = MFMA32(PAF(2), VFR(6), o[1]), C1, 4, 5); \
    GAPB(o[0] = MFMA32(PAF(3), VFR(3), o[0]), C1, 8, 6); \
    GAPB(o[1] = MFMA32(PAF(3), VFR(7), o[1]), C1, 12, 7); \
    TAIL(); SBAR(); \
    } while (0)
  #define ENDW(tt) do { if ((tt) + 3 < NT) { WAIT_BAR(2); } else if ((tt) + 2 < NT) { WAIT_BAR(1); } else { WAIT_BAR(0); } } while (0)
  for (;;) {
    const int NT = Thi - Tlo;
    bf16x8 kf[8]; f32x16 pA0, pA1, pB0, pB1; float pf[8], rD0, rD1, G[8];
    DMA_K(0, 0); DMA_V(0, 0); DMA_K(1, SLOTB); DMA_K(2, 2 * SLOTB);
    WAIT_BAR(3);
    int sl_prev = 0, sl_cur = 0, sl_next = SLOTB;
    pA0 = zero16; pA1 = zero16;
    { const char* kb = shm + LDS_K + hi * 1024 + r32 * 16;
      #pragma unroll
      for (int d0 = 0; d0 < 4; ++d0) { const bf16x8 b0 = *reinterpret_cast<const bf16x8*>(kb + d0 * 2048); const bf16x8 b1 = *reinterpret_cast<const bf16x8*>(kb + d0 * 2048 + 512);
        pA0 = MFMA32(b0, qr[d0], pA0); pA1 = MFMA32(b1, qr[d0], pA1); } }
    if (TT(0) >= 4 * qb) { CMASK(pA0, pA1, TT(0)); }
    EXPG(pA0, 0, 0); EXPG(pA0, 4, 1); EXPG(pA0, 8, 2); EXPG(pA0, 12, 3); EXPG(pA1, 0, 4); EXPG(pA1, 4, 5); EXPG(pA1, 8, 6); EXPG(pA1, 12, 7); TAIL();
    WAIT_BAR(0);
    DMA_K(3, 0); DMA_V(1, SLOTB);
    ROT();
    kload8(kf, kp0 + sl_cur);
    WAIT_BAR(2);
    s16x4 vlo[8], vhi[8]; u32x4 pw0, pw1, pw2, pw3;
    int t = 1;
    for (; t + 5 < NT; t += 2) {
      STEP(pB0, pB1, pA0, pA1, t, true, true, true);     WAIT_BAR(2); ROT();
      STEP(pA0, pA1, pB0, pB1, t + 1, true, true, true); WAIT_BAR(2); ROT();
    }
    for (; t + 1 < NT; t += 2) {
      STEP(pB0, pB1, pA0, pA1, t, (t + 3 < NT), (t + 1 < NT), (t + 1 < NT));       ENDW(t);     ROT();
      STEP(pA0, pA1, pB0, pB1, t + 1, (t + 4 < NT), (t + 2 < NT), (t + 2 < NT));   ENDW(t + 1); ROT();
    }
    STEP(pB0, pB1, pA0, pA1, NT - 1, false, false, false);
    { const float cm_ = cc * rD1, co_ = cm_ * rD0;
      SCAN(pB0, 0, 0, co_); SCAN(pB0, 4, 1, co_); SCAN(pB0, 8, 2, co_); SCAN(pB0, 12, 3, co_); SCAN(pB1, 0, 4, cm_); SCAN(pB1, 4, 5, cm_); SCAN(pB1, 8, 6, cm_); SCAN(pB1, 12, 7, cm_);
      cc = co_;
      pw0 = (u32x4){PKW(pB0, 0), PKW(pB0, 2), PKW(pB0, 4), PKW(pB0, 6)}; pw1 = (u32x4){PKW(pB0, 8), PKW(pB0, 10), PKW(pB0, 12), PKW(pB0, 14)};
      pw2 = (u32x4){PKW(pB1, 0), PKW(pB1, 2), PKW(pB1, 4), PKW(pB1, 6)}; pw3 = (u32x4){PKW(pB1, 8), PKW(pB1, 10), PKW(pB1, 12), PKW(pB1, 14)};
      SBAR(); pv(o, vb0 + sl_cur, PAF(0), PAF(1), PAF(2), PAF(3)); }
    if (Tlo == 0) break;
    { const unsigned al_ = __any(cc > 5.421010862e-20f) ? 1u : 0u; if (lane == 0) live[wid] = al_; }
    asm volatile("s_waitcnt lgkmcnt(0)\n\ts_barrier" ::: "memory");
    unsigned a_ = 0u;
    #pragma unroll
    for (int w_ = 0; w_ < 8; ++w_) a_ |= live[w_];
    asm volatile("s_waitcnt lgkmcnt(0)\n\ts_barrier" ::: "memory");
#if defined(SB_FORCE_EXIT)
    break;
#endif
    if (__builtin_amdgcn_readfirstlane(a_) == 0u) break;
    Thi = Tlo; Tlo = 0;
  }
  bf16* Ow = O + (rowbase + q0 + wid * QBLK) * opitch + h * 64;
  { bf16* stg = (bf16*)(shm + LDS_OST) + wid * 2048;
    #pragma unroll
    for (int r = 0; r < 16; ++r) { const int orow = crow(r, hi);
      #pragma unroll
      for (int d0 = 0; d0 < 2; ++d0) stg[orow * 64 + d0 * 32 + r32] = (bf16)(cvtpk_s(o[d0][r], 0.f) & 0xffffu); }
    asm volatile("s_waitcnt lgkmcnt(0)" ::: "memory");
    #pragma unroll
    for (int i = 0; i < 4; ++i) { const int row = i * 8 + (lane >> 3), ch = lane & 7; const u32x4 v = *(const u32x4*)(stg + row * 64 + ch * 8); ATTN_STORE16(Ow + (long)row * opitch + ch * 8, v); } }
  asm volatile("s_waitcnt vmcnt(0) lgkmcnt(0)\n\ts_barrier" ::: "memory");
  #undef STEP
  #undef KRD
  #undef VRD
  #undef GAPB
  #undef GAPA
  #undef DMA_K
  #undef DMA_V
  #undef ROT
  #undef CMASK
  #undef ENDW
  #undef PKW
  #undef PAF
  #undef VFR
  #undef PIN
  #undef EX
  #undef EXPG
  #undef TAIL
  #undef SCAN
  #undef TT
}
}
struct Frame {
    LAS unsigned char* lds;
    volatile LAS unsigned* MISC;
    gu32* ctl;
    int tid, lane, wave;
    int vcu, G;
    const float *x, *c, *w_ada, *b_ada, *g_mix, *w_in, *g_q, *g_k, *rel_bias, *w_br_moba, *w_br_sb, *w_out, *g_ffn, *w_rg, *b_rg, *w_re, *b_re, *w_gate, *w_up, *w_down;
    float* out;
    float *mod, *biasT, *btg, *stats, *kmean;
    bf16 *wrt_hi, *wrt_lo;
    bf16 *Win_t, *Wbra_t, *Wbrb_t, *Wout_t, *Wgu_t, *Wd_t;
    bf16 *XN, *QA, *KA, *VA, *QB, *KB, *VB, *OA, *OB, *GA, *GB, *H;
    int* tokl; float* wl; unsigned* cnt; int* inv; float* winv; bf16* Y;
};
__device__ __forceinline__ float wave_sum(float v) {
#pragma unroll
    for (int o = 1; o < 64; o <<= 1) v += __shfl_xor(v, o);
    return v;
}
__device__ __forceinline__ int lane_zero() { int z; asm volatile("v_mov_b32 %0, 0" : "=v"(z)); return z; }

__device__ __forceinline__ void p0_transpose_item(const float* W, int K, int N, bf16* WT, int k0, int n0, int drow0, LAS float* scr, int lane, int dk0 = 0) {
    float tv[32];
#pragma unroll
    for (int i = 0; i < 32; ++i) { const int kk = 2 * i + (lane >> 5); tv[i] = W[(size_t)(k0 + kk) * N + n0 + (lane & 31)]; }
#pragma unroll
    for (int i = 0; i < 32; ++i) { const int kk = 2 * i + (lane >> 5); scr[kk * 33 + (lane & 31)] = tv[i]; }
    LDS_WAIT(); asm volatile("" ::: "memory");
    const int c = lane & 7;
#pragma unroll
    for (int j = 0; j < 4; ++j) { const int n = (lane >> 3) + 8 * j; const LAS float* s = scr + (8 * c) * 33 + n;
        v4u o; o.x = pk2(s[0 * 33], s[1 * 33]); o.y = pk2(s[2 * 33], s[3 * 33]); o.z = pk2(s[4 * 33], s[5 * 33]); o.w = pk2(s[6 * 33], s[7 * 33]);
        *(GAS v4u*)(WT + (size_t)(drow0 + n) * K + dk0 + k0 + 8 * c) = o; }
    LDS_WAIT(); asm volatile("" ::: "memory");
}

__device__ __forceinline__ void p0_prologue(Frame& F) {
    {
        LAS float* sc = (LAS float*)(F.lds + RING_OFF);
        LAS float* part = (LAS float*)(F.lds + RING_OFF + 32768);
        for (int i = F.tid; i < BATCH * D; i += NWAVES * 64) { const float v = F.c[i]; sc[i] = v * fsigmoid(v); }
        __syncthreads();
        for (int chunk = F.vcu; chunk < 256; chunk += F.G) {
            const int kp = F.tid / 24, cI = F.tid % 24;
            if (kp < 21) {
                float a[8];
#pragma unroll
                for (int b = 0; b < 8; ++b) a[b] = 0.f;
                const int k0 = kp * 49, k1 = (k0 + 49 < D) ? k0 + 49 : D;
                for (int k = k0; k < k1; ++k) { const float w = F.w_ada[(size_t)k * (NMOD * D) + chunk * 24 + cI];
#pragma unroll
                    for (int b = 0; b < 8; ++b) a[b] += sc[b * D + k] * w; }
#pragma unroll
                for (int b = 0; b < 8; ++b) part[(kp * 24 + cI) * 8 + b] = a[b];
            }
            __syncthreads();
            if (F.tid < 192) { const int cI2 = F.tid % 24, b = F.tid / 24; float s = 0.f;
                for (int kp2 = 0; kp2 < 21; ++kp2) s += part[(kp2 * 24 + cI2) * 8 + b];
                const int col = chunk * 24 + cI2; F.mod[(size_t)b * (NMOD * D) + col] = s + F.b_ada[col]; }
            __syncthreads();
        }
    }
    const int gw = F.vcu * NWAVES + F.wave, NGW = F.G * NWAVES;
    for (int i = gw * 64 + F.lane; i < NH * SEQ; i += NGW * 64) { const int h = i / SEQ, n = i % SEQ; int bk;
        if (n < 16) bk = n; else { const float nf = (float)n; int lg = 16 + (int)(logf(nf / 16.0f) / 4.1588830833596715f * 16.0f); bk = lg < 31 ? lg : 31; }
        F.biasT[i] = F.rel_bias[h * 32 + bk] * LOG2E; }
    for (int i = gw * 64 + F.lane; i < (NH + 1) * (attn::BT_BYTES / 4); i += NGW * 64) { const int h = i / (attn::BT_BYTES / 4), w = i % (attn::BT_BYTES / 4); float val = -INFINITY;
        if (w < 4 * attn::BT_LEN) { const int a = w / attn::BT_LEN, xx = w % attn::BT_LEN, ri = xx + a;
            if (h == NH) { if (ri < attn::REV) val = 0.f; }
            else if (ri <= attn::REV) { const int n = attn::REV - ri; int bk; if (n < 16) bk = n; else { const float nf = (float)n; int lg = 16 + (int)(logf(nf / 16.0f) / 4.1588830833596715f * 16.0f); bk = lg < 31 ? lg : 31; }
                val = F.rel_bias[h * 32 + bk] * LOG2E; } }
        F.btg[i] = val; }
    for (int i = gw * 64 + F.lane; i < 48 * D; i += NGW * 64) { const int col = i / D, k = i % D; float v = 0.f;
        if (col < NGRP) v = F.w_rg[(size_t)k * NGRP + col]; else if (col < NGRP + NEXP) v = F.w_re[(size_t)k * NEXP + col - NGRP];
        const unsigned hb = f2bf(v); const float r = v - __uint_as_float(hb << 16); F.wrt_hi[i] = (bf16)hb; F.wrt_lo[i] = (bf16)f2bf(r); }
    LAS float* scr = (LAS float*)(F.lds + RING_OFF + F.wave * 16384);
    constexpr int I_IN = (D / 64) * (INCOLS / 32), I_BR = (WATT / 64) * (D / 32), I_OUT = (D / 64) * (D / 32), I_G = NEXP * (D / 64) * (DEXP / 32), I_D = NEXP * (DEXP / 64) * (D / 32);
    constexpr int NITEMS = I_IN + 2 * I_BR + I_OUT + 2 * I_G + I_D;
    for (int it = gw; it < NITEMS; it += NGW) {
        int r = it;
        if (r < I_IN) { const int nblk = INCOLS / 32, kb = r / nblk, nb = r % nblk, n0 = 32 * nb, t = n0 & 255;
            const int p0 = 128 * ((t >> 5) & 1) + 32 * (t >> 6);
            p0_transpose_item(F.w_in, D, INCOLS, F.Win_t, 64 * kb, n0, (n0 - t) + p0, scr, F.lane); continue; } r -= I_IN;
        if (r < I_BR) { const int nblk = D / 32, kb = r / nblk, nb = r % nblk; p0_transpose_item(F.w_br_moba, D, D, F.Wbra_t, 64 * kb, 32 * nb, 32 * nb, scr, F.lane, 0); continue; } r -= I_BR;
        if (r < I_BR) { const int nblk = D / 32, kb = r / nblk, nb = r % nblk; p0_transpose_item(F.w_br_sb, D, D, F.Wbra_t, 64 * kb, 32 * nb, 32 * nb, scr, F.lane, WATT); continue; } r -= I_BR;
        if (r < I_OUT) { const int nblk = D / 32, kb = r / nblk, nb = r % nblk; p0_transpose_item(F.w_out, D, D, F.Wout_t, 64 * kb, 32 * nb, 32 * nb, scr, F.lane); continue; } r -= I_OUT;
        if (r < 2 * I_G) { const int up = r >= I_G; if (up) r -= I_G; constexpr int per = (D / 64) * (DEXP / 32); const int e = r / per, q = r % per, nblk = DEXP / 32, kb = q / nblk, nb = q % nblk, n0 = 32 * nb;
            p0_transpose_item((up ? F.w_up : F.w_gate) + (size_t)e * D * DEXP, D, DEXP, F.Wgu_t, 64 * kb, n0, e * 1024 + 256 * (n0 >> 7) + (up ? 128 : 0) + (n0 & 127), scr, F.lane); continue; } r -= 2 * I_G;
        { constexpr int per = (DEXP / 64) * (D / 32); const int e = r / per, q = r % per, nblk = D / 32, kb = q / nblk, nb = q % nblk;
            p0_transpose_item(F.w_down + (size_t)e * DEXP * D, DEXP, D, F.Wd_t, 64 * kb, 32 * nb, e * 1024 + 32 * nb, scr, F.lane); }
    }
}

__device__ __forceinline__ void p1_norm(Frame& F) {
    const int gw = F.vcu * NWAVES + F.wave, NGW = F.G * NWAVES;
    for (int m = gw; m < NTOK; m += NGW) {
        const int b = m / SEQ;
        const GAS f32x4* xr = (const GAS f32x4*)(F.x + (size_t)m * D) + F.lane;
        const GAS f32x4* gr = (const GAS f32x4*)F.g_mix + F.lane;
        const GAS f32x4* shr = (const GAS f32x4*)(F.mod + (size_t)b * (NMOD * D)) + F.lane;
        const GAS f32x4* scr = (const GAS f32x4*)(F.mod + (size_t)b * (NMOD * D) + D) + F.lane;
        f32x4 v[4]; float s = 0.f;
#pragma unroll
        for (int j = 0; j < 4; ++j) { v[j] = xr[64 * j]; s += (v[j].x * v[j].x + v[j].y * v[j].y) + (v[j].z * v[j].z + v[j].w * v[j].w); }
        const float rstd = __builtin_amdgcn_rsqf(wave_sum(s) * (1.f / D) + RMS_EPS);
        GAS unsigned long long* o8 = (GAS unsigned long long*)(F.XN + (size_t)m * D) + F.lane;
#pragma unroll
        for (int j = 0; j < 4; ++j) { const f32x4 g = gr[64 * j], sh = shr[64 * j], sc = scr[64 * j]; const f32x4 y = (v[j] * rstd * g) * (sc + 1.0f) + sh;
            o8[64 * j] = (unsigned long long)pk2(y.x, y.y) | ((unsigned long long)pk2(y.z, y.w) << 32); }
    }
}

__device__ __forceinline__ float dot64(const unsigned (&q)[32], const v4u (&k)[8]) {
    float a0 = 0.f, a1 = 0.f;
#pragma unroll
    for (int i = 0; i < 8; ++i) {
        a0 += bflo(q[4 * i]) * bflo(k[i].x) + bflo(q[4 * i + 1]) * bflo(k[i].y) + bflo(q[4 * i + 2]) * bflo(k[i].z) + bflo(q[4 * i + 3]) * bflo(k[i].w);
        a1 += bfhi(q[4 * i]) * bfhi(k[i].x) + bfhi(q[4 * i + 1]) * bfhi(k[i].y) + bfhi(q[4 * i + 2]) * bfhi(k[i].z) + bfhi(q[4 * i + 3]) * bfhi(k[i].w); }
    return a0 + a1;
}
#define LOADROW(dst, p) do { _Pragma("unroll") for (int i_ = 0; i_ < 8; ++i_) dst[i_] = ((const GAS v4u*)(p))[i_]; } while (0)
#define AXPY64(o, p, v) do { _Pragma("unroll") for (int i_ = 0; i_ < 8; ++i_) { \
    o[8 * i_ + 0] += p * bflo(v[i_].x); o[8 * i_ + 1] += p * bfhi(v[i_].x); o[8 * i_ + 2] += p * bflo(v[i_].y); o[8 * i_ + 3] += p * bfhi(v[i_].y); \
    o[8 * i_ + 4] += p * bflo(v[i_].z); o[8 * i_ + 5] += p * bfhi(v[i_].z); o[8 * i_ + 6] += p * bflo(v[i_].w); o[8 * i_ + 7] += p * bfhi(v[i_].w); } } while (0)
#define STOREO(ptr, o, sc) do { _Pragma("unroll") for (int i_ = 0; i_ < 8; ++i_) { v4u w_; w_.x = pk2(o[8 * i_] * sc, o[8 * i_ + 1] * sc); w_.y = pk2(o[8 * i_ + 2] * sc, o[8 * i_ + 3] * sc); \
    w_.z = pk2(o[8 * i_ + 4] * sc, o[8 * i_ + 5] * sc); w_.w = pk2(o[8 * i_ + 6] * sc, o[8 * i_ + 7] * sc); ((GAS v4u*)(ptr))[i_] = w_; } } while (0)

__device__ __forceinline__ void moba_naive_item(Frame& F, int item) {
    const int bh = item >> 6, ch = item & 63, b = bh >> 3, h = bh & 7, lz = lane_zero();
    const int t = ch * 64 + F.lane, own = ch >> 2, tl = t & 255;
    const size_t rowb = (size_t)b * SEQ;
    unsigned q[32]; { v4u t4[8]; LOADROW(t4, F.QA + (rowb + t) * WATT + h * HD);
#pragma unroll
        for (int i = 0; i < 8; ++i) { q[4 * i] = t4[i].x; q[4 * i + 1] = t4[i].y; q[4 * i + 2] = t4[i].z; q[4 * i + 3] = t4[i].w; } }
    float v0 = -INFINITY, v1 = -INFINITY, v2 = -INFINITY; int i0 = 0, i1 = 0, i2 = 0;
    for (int j = 0; j < own; ++j) {
        const GAS f32x4* km = (const GAS f32x4*)(F.kmean + ((size_t)(b * NBLK + j) * NH + h) * HD + lz);
        float g = 0.f;
#pragma unroll
        for (int i = 0; i < 16; ++i) { const f32x4 kv = km[i]; g += bflo(q[2 * i]) * kv.x + bfhi(q[2 * i]) * kv.y + bflo(q[2 * i + 1]) * kv.z + bfhi(q[2 * i + 1]) * kv.w; }
        if (g > v0) { v2 = v1; i2 = i1; v1 = v0; i1 = i0; v0 = g; i0 = j; } else if (g > v1) { v2 = v1; i2 = i1; v1 = g; i1 = j; } else if (g > v2) { v2 = g; i2 = j; }
    }
    float m = -INFINITY, l = 0.f; float o[64];
#pragma unroll
    for (int i = 0; i < 64; ++i) o[i] = 0.f;
    const float* bt = F.biasT + h * SEQ;
    const int nsel = own < 3 ? own : 3;
    for (int sl = 0; sl < nsel; ++sl) {
        const int blk = sl == 0 ? i0 : (sl == 1 ? i1 : i2);
        const bf16* kp = F.KA + (rowb + blk * MBLK) * WATT + h * HD; const bf16* vp = F.VA + (rowb + blk * MBLK) * WATT + h * HD;
        const int dist0 = t - blk * MBLK;
        for (int s = 0; s < MBLK; ++s) {
            v4u kk[8]; LOADROW(kk, kp + (size_t)s * WATT); const float sc = dot64(q, kk) + bt[dist0 - s];
            const float mn = fmaxf(m, sc), al = __builtin_amdgcn_exp2f(m - mn), p = __builtin_amdgcn_exp2f(sc - mn);
            l = l * al + p; m = mn;
#pragma unroll
            for (int i = 0; i < 64; ++i) o[i] *= al;
            v4u vv[8]; LOADROW(vv, vp + (size_t)s * WATT); AXPY64(o, p, vv);
        }
    }
    {
        const bf16* kp = F.KA + (rowb + own * MBLK) * WATT + h * HD + lz; const bf16* vp = F.VA + (rowb + own * MBLK) * WATT + h * HD + lz;
        const int smax = (ch & 3) * 64 + 63;
        for (int s = 0; s <= smax; ++s) {
            v4u kk[8]; LOADROW(kk, kp + (size_t)s * WATT); const int dist = tl - s; const float sc = dot64(q, kk) + bt[dist > 0 ? dist : 0];
            if (dist >= 0) {
                const float mn = fmaxf(m, sc), al = __builtin_amdgcn_exp2f(m - mn), p = __builtin_amdgcn_exp2f(sc - mn);
                l = l * al + p; m = mn;
#pragma unroll
                for (int i = 0; i < 64; ++i) o[i] *= al;
                v4u vv[8]; LOADROW(vv, vp + (size_t)s * WATT); AXPY64(o, p, vv);
            }
        }
    }
    const float rl = 1.0f / l;
    STOREO(F.OA + (rowb + t) * D + h * HD, o, rl);
}
__device__ __forceinline__ void sb_naive_item(Frame& F, int item) {
    const int bh = item >> 6, ch = item & 63, b = bh >> 3, h = bh & 7, lz = lane_zero();
    const int t = ch * 64 + F.lane;
    const size_t rowb = (size_t)b * SEQ;
    unsigned q[32]; { v4u t4[8]; LOADROW(t4, F.QB + (rowb + t) * WATT + h * HD);
#pragma unroll
        for (int i = 0; i < 8; ++i) { q[4 * i] = t4[i].x; q[4 * i + 1] = t4[i].y; q[4 * i + 2] = t4[i].z; q[4 * i + 3] = t4[i].w; } }
    float c = 1.0f; float o[64];
#pragma unroll
    for (int i = 0; i < 64; ++i) o[i] = 0.f;
    const bf16* kp = F.KB + rowb * WATT + h * HD + lz; const bf16* vp = F.VB + rowb * WATT + h * HD + lz;
    for (int s = ch * 64 + 62; s >= 0; --s) {
        v4u kk[8]; LOADROW(kk, kp + (size_t)s * WATT); const float e = __builtin_amdgcn_exp2f(dot64(q, kk)); const float r = 1.0f / (1.0f + e);
        if (s < t) { const float a = e * r * c; c *= r; v4u vv[8]; LOADROW(vv, vp + (size_t)s * WATT); AXPY64(o, a, vv); }
    }
    STOREO(F.OA + (rowb + t) * D + WATT + h * HD, o, 1.0f);
}
__device__ __forceinline__ void p3_sb_naive(Frame& F) {
    const int gw = F.vcu * NWAVES + F.wave, NGW = F.G * NWAVES;
    for (int p = gw; p < 2048; p += NGW) { const int bh = p >> 5, j = p & 31;
        sb_naive_item(F, bh * 64 + j); sb_naive_item(F, bh * 64 + 63 - j); }
}
__device__ __forceinline__ void p3_moba_naive(Frame& F) {
    const int gw = F.vcu * NWAVES + F.wave, NGW = F.G * NWAVES;
    for (int p = gw; p < 2048; p += NGW) { const int bh = p >> 5, j = p & 31;
        moba_naive_item(F, bh * 64 + j); moba_naive_item(F, bh * 64 + 63 - j); }
}
__device__ __forceinline__ bool attn_deal(const Frame& F, int i, int& bh, int& qb) {
    if (F.G == 256) { if (i >= 4) return false; const int s = F.vcu & 3; bh = F.vcu >> 2; qb = (i == 0) ? s : (i == 1) ? 7 - s : (i == 2) ? 8 + s : 15 - s; return true; }
    const int u = F.vcu + i * F.G; if (u >= 1024) return false; bh = u >> 4; qb = u & 15; return true;
}
__device__ __forceinline__ void p3_sb(Frame& F) {
    __syncthreads();
    for (int k = F.tid; k < attn::BT_BYTES / 16; k += NWAVES * 64) *(LAS v4u*)(F.lds + RING_OFF + attn::LDS_BT + 16 * k) = *(const GAS v4u*)(F.btg + (size_t)NH * (attn::BT_BYTES / 4) + 4 * k);
    __syncthreads();
    int bh, qb;
    for (int i = 0; attn_deal(F, i, bh, qb); ++i) attn::sb_unit(bh >> 3, bh & 7, qb, F.QB, F.KB, F.VB, F.OA + WATT, (char*)F.lds + RING_OFF, D);
}
__device__ __forceinline__ void p3_moba(Frame& F) {
    int bh, qb, curh = -1;
    for (int i = 0; attn_deal(F, i, bh, qb); ++i) { const int b = bh >> 3, h = bh & 7;
        if (h != curh) { __syncthreads();
            for (int k = F.tid; k < attn::BT_BYTES / 16; k += NWAVES * 64) *(LAS v4u*)(F.lds + RING_OFF + attn::LDS_BT + 16 * k) = *(const GAS v4u*)(F.btg + (size_t)h * (attn::BT_BYTES / 4) + 4 * k);
            __syncthreads(); curh = h; }
        attn::moba_unit(b, h, qb, F.QA, F.KA, F.VA, F.OA, F.kmean, (char*)F.lds + RING_OFF, D); }
}
__device__ __forceinline__ void p6_route(Frame& F) {
    const int gw = F.vcu * NWAVES + F.wave, NGW = F.G * NWAVES;
    for (int m = gw; m < NTOK; m += NGW) {
        const int b = m / SEQ;
        const GAS f32x4* xr = (const GAS f32x4*)(F.out + (size_t)m * D) + F.lane;
        const GAS f32x4* gr = (const GAS f32x4*)F.g_ffn + F.lane;
        const GAS f32x4* shr = (const GAS f32x4*)(F.mod + (size_t)b * (NMOD * D) + 3 * D) + F.lane;
        const GAS f32x4* scr = (const GAS f32x4*)(F.mod + (size_t)b * (NMOD * D) + 4 * D) + F.lane;
        float ss = 0.f; { const GAS f32x4* sp = (const GAS f32x4*)(F.stats + (size_t)m * 16);
#pragma unroll
            for (int j = 0; j < 4; ++j) { const f32x4 s4 = sp[j]; ss += (s4.x + s4.y) + (s4.z + s4.w); } }
        const float rstd = __builtin_amdgcn_rsqf(ss * (1.f / D) + RMS_EPS);
        f32x4 y[4];
        GAS unsigned long long* o8 = (GAS unsigned long long*)(F.XN + (size_t)m * D) + F.lane;
#pragma unroll
        for (int j = 0; j < 4; ++j) { const f32x4 v = xr[64 * j], g = gr[64 * j], sh = shr[64 * j], sc = scr[64 * j]; y[j] = (v * rstd * g) * (sc + 1.0f) + sh;
            o8[64 * j] = (unsigned long long)pk2(y[j].x, y[j].y) | ((unsigned long long)pk2(y[j].z, y[j].w) << 32); }
        float gl[4] = {0.f, 0.f, 0.f, 0.f};
#pragma unroll
        for (int j = 0; j < 4; ++j) { const GAS f32x4* wp = (const GAS f32x4*)(F.w_rg + (size_t)(4 * F.lane + 256 * j) * NGRP);
#pragma unroll
            for (int e = 0; e < 4; ++e) { const f32x4 w = wp[e]; const float yv = y[j][e]; gl[0] += yv * w.x; gl[1] += yv * w.y; gl[2] += yv * w.z; gl[3] += yv * w.w; } }
#pragma unroll
        for (int g = 0; g < 4; ++g) gl[g] = wave_sum(gl[g]) + F.b_rg[g];
        int gi = 0; float gm = gl[0];
#pragma unroll
        for (int g = 1; g < 4; ++g) if (gl[g] > gm) { gm = gl[g]; gi = g; }
        float den = 0.f;
#pragma unroll
        for (int g = 0; g < 4; ++g) den += __expf(gl[g] - gm);
        const float gwt = 1.0f / den;
        float el[8] = {0.f, 0.f, 0.f, 0.f, 0.f, 0.f, 0.f, 0.f};
#pragma unroll
        for (int j = 0; j < 4; ++j)
#pragma unroll
            for (int e = 0; e < 4; ++e) { const GAS f32x4* wp = (const GAS f32x4*)(F.w_re + (size_t)(4 * F.lane + 256 * j + e) * NEXP + gi * EPG); const f32x4 w0 = wp[0], w1 = wp[1]; const float yv = y[j][e];
                el[0] += yv * w0.x; el[1] += yv * w0.y; el[2] += yv * w0.z; el[3] += yv * w0.w; el[4] += yv * w1.x; el[5] += yv * w1.y; el[6] += yv * w1.z; el[7] += yv * w1.w; }
#pragma unroll
        for (int k = 0; k < 8; ++k) el[k] = wave_sum(el[k]) + F.b_re[gi * EPG + k];
        int k1 = 0; float t1 = el[0];
#pragma unroll
        for (int k = 1; k < 8; ++k) if (el[k] > t1) { t1 = el[k]; k1 = k; }
        int k2 = -1; float t2 = -INFINITY;
#pragma unroll
        for (int k = 0; k < 8; ++k) if (k != k1 && el[k] > t2) { t2 = el[k]; k2 = k; }
        const float ex = __expf(t2 - t1); const float w1v = gwt / (1.0f + ex), w2v = gwt * ex / (1.0f + ex);
        if (F.lane < 2) { const int e = gi * EPG + (F.lane == 0 ? k1 : k2); const float w = F.lane == 0 ? w1v : w2v;
            const unsigned pos = __hip_atomic_fetch_add(F.cnt + (F.lane * NEXP + e) * 64, 1u, __ATOMIC_RELAXED, __HIP_MEMORY_SCOPE_AGENT);
            F.tokl[(size_t)(F.lane * NEXP + e) * LCAP + pos] = m; F.wl[(size_t)(F.lane * NEXP + e) * LCAP + pos] = w; }
    }
}
__device__ __forceinline__ void p6_route_mfma(Frame& F) {
    typedef float f32x4v __attribute__((ext_vector_type(4)));
    const int NGW = F.G * NWAVES; const int r = F.lane & 15, kg = F.lane >> 4;
    LAS float* gsT = (LAS float*)(F.lds + RING_OFF);
    LAS float* shT = (LAS float*)(F.lds + RING_OFF + 4096);
    LAS float* lg = (LAS float*)(F.lds + RING_OFF + 8192) + F.wave * (16 * 48);
    LAS unsigned char* wb = F.lds + RING_OFF + 32768;
    for (int rb0 = F.vcu * NWAVES; rb0 < NTOK / 16; rb0 += NGW) {
        const int rb = rb0 + F.wave; const int row0 = rb * 16, b = (rb0 * 16) / SEQ;
        __syncthreads();
        for (int i = F.tid; i < D; i += NWAVES * 64) { gsT[i] = F.g_ffn[i] * (1.0f + F.mod[(size_t)b * (NMOD * D) + 4 * D + i]); shT[i] = F.mod[(size_t)b * (NMOD * D) + 3 * D + i]; }
#define P6_SRC(p, kc) ((const GAS v4u*)(((p) < 1536 ? F.wrt_hi : F.wrt_lo) + (size_t)(((p) % 1536) >> 5) * D + (kc) * 256 + ((p) & 31) * 8))
#define P6_DST(p, bf) ((LAS v4u*)(wb + (bf) * 49152 + ((p) / 1536) * 24576 + (((p) % 1536) >> 5) * 512 + ((((p) & 31) ^ ((((p) % 1536) >> 5) & 15)) << 4)))
#pragma unroll
        for (int j = 0; j < 6; ++j) { const int p = F.tid + j * 512; *P6_DST(p, 0) = *P6_SRC(p, 0); }
        __syncthreads();
        const int row = row0 + r;
        float ss = 0.f; { const GAS f32x4* sp = (const GAS f32x4*)(F.stats + (size_t)row * 16);
#pragma unroll
            for (int j = 0; j < 4; ++j) { const f32x4 s4 = sp[j]; ss += (s4.x + s4.y) + (s4.z + s4.w); } }
        const float rstd = __builtin_amdgcn_rsqf(ss * (1.f / D) + RMS_EPS);
        f32x4v acc[3] = {{0.f, 0.f, 0.f, 0.f}, {0.f, 0.f, 0.f, 0.f}, {0.f, 0.f, 0.f, 0.f}};
        const float* xrow = F.out + (size_t)row * D + 8 * kg; bf16* orow = F.XN + (size_t)row * D + 8 * kg;
        for (int kc = 0; kc < 4; ++kc) {
            v4u nx[6];
            if (kc < 3) {
#pragma unroll
                for (int j = 0; j < 6; ++j) nx[j] = *P6_SRC(F.tid + j * 512, kc + 1); }
            const LAS unsigned char* wbc = wb + (kc & 1) * 49152;
#pragma unroll 4
            for (int ks = 0; ks < 8; ++ks) { const int k = 256 * kc + 32 * ks;
                const f32x4 xa = *(const GAS f32x4*)(xrow + k), xb = *(const GAS f32x4*)(xrow + k + 4);
                const f32x4 ga = *(const LAS f32x4*)(gsT + k + 8 * kg), gb = *(const LAS f32x4*)(gsT + k + 8 * kg + 4), sa = *(const LAS f32x4*)(shT + k + 8 * kg), sb = *(const LAS f32x4*)(shT + k + 8 * kg + 4);
                const f32x4 ha = (xa * rstd) * ga + sa, hb = (xb * rstd) * gb + sb;
                v4u hw; hw.x = pk2(ha.x, ha.y); hw.y = pk2(ha.z, ha.w); hw.z = pk2(hb.x, hb.y); hw.w = pk2(hb.z, hb.w);
                *(GAS v4u*)(orow + k) = hw;
                v4u lw; lw.x = pk2(ha.x - bflo(hw.x), ha.y - bfhi(hw.x)); lw.y = pk2(ha.z - bflo(hw.y), ha.w - bfhi(hw.y)); lw.z = pk2(hb.x - bflo(hw.z), hb.y - bfhi(hw.z)); lw.w = pk2(hb.z - bflo(hw.w), hb.w - bfhi(hw.w));
                const bf16x8 Ah = __builtin_bit_cast(bf16x8, hw), Al = __builtin_bit_cast(bf16x8, lw);
                const int cx = ((4 * ks + kg) ^ r) << 4;
#pragma unroll
                for (int n = 0; n < 3; ++n) { const bf16x8 Bh = *(const LAS bf16x8*)(wbc + (16 * n + r) * 512 + cx), Bl = *(const LAS bf16x8*)(wbc + 24576 + (16 * n + r) * 512 + cx);
                    acc[n] = __builtin_amdgcn_mfma_f32_16x16x32_bf16(Ah, Bh, acc[n], 0, 0, 0); acc[n] = __builtin_amdgcn_mfma_f32_16x16x32_bf16(Al, Bh, acc[n], 0, 0, 0); acc[n] = __builtin_amdgcn_mfma_f32_16x16x32_bf16(Ah, Bl, acc[n], 0, 0, 0); }
            }
            if (kc < 3) {
#pragma unroll
                for (int j = 0; j < 6; ++j) *P6_DST(F.tid + j * 512, (kc + 1) & 1) = nx[j]; }
            __syncthreads();
        }
#undef P6_SRC
#undef P6_DST
#pragma unroll
        for (int n = 0; n < 3; ++n)
#pragma unroll
            for (int e = 0; e < 4; ++e) lg[(4 * kg + e) * 48 + 16 * n + r] = acc[n][e];
        LDS_WAIT(); asm volatile("" ::: "memory");
        const LAS f32x4* lr = (const LAS f32x4*)(lg + r * 48);
        const f32x4 g4 = lr[0]; float gl[4] = {g4.x + F.b_rg[0], g4.y + F.b_rg[1], g4.z + F.b_rg[2], g4.w + F.b_rg[3]};
        int gi = 0; float gm = gl[0];
#pragma unroll
        for (int g = 1; g < 4; ++g) if (gl[g] > gm) { gm = gl[g]; gi = g; }
        float den = 0.f;
#pragma unroll
        for (int g = 0; g < 4; ++g) den += __expf(gl[g] - gm);
        const float gwt = 1.0f / den;
        const LAS f32x4* er = (const LAS f32x4*)(lg + r * 48 + 4 + 8 * gi); const f32x4 e0 = er[0], e1 = er[1];
        const GAS f32x4* bp = (const GAS f32x4*)(F.b_re + gi * EPG); const f32x4 b0 = bp[0], b1 = bp[1];
        const float el[8] = {e0.x + b0.x, e0.y + b0.y, e0.z + b0.z, e0.w + b0.w, e1.x + b1.x, e1.y + b1.y, e1.z + b1.z, e1.w + b1.w};
        int k1 = 0; float t1 = el[0];
#pragma unroll
        for (int k = 1; k < 8; ++k) if (el[k] > t1) { t1 = el[k]; k1 = k; }
        int k2 = -1; float t2 = -INFINITY;
#pragma unroll
        for (int k = 0; k < 8; ++k) if (k != k1 && el[k] > t2) { t2 = el[k]; k2 = k; }
        const float ex = __expf(t2 - t1); const float w1v = gwt / (1.0f + ex), w2v = gwt * ex / (1.0f + ex);
        if (F.lane < 32) { const int slot = F.lane >> 4; const int e = gi * EPG + (slot == 0 ? k1 : k2); const float w = slot == 0 ? w1v : w2v;
            const unsigned pos = __hip_atomic_fetch_add(F.cnt + (slot * NEXP + e) * 64, 1u, __ATOMIC_RELAXED, __HIP_MEMORY_SCOPE_AGENT);
            F.tokl[(size_t)(slot * NEXP + e) * LCAP + pos] = row; F.inv[row * 2 + slot] = (e << 16) | (int)pos; F.winv[row * 2 + slot] = w; }
        LDS_WAIT(); asm volatile("" ::: "memory");
    }
}
__device__ __forceinline__ void moe_tables(Frame& F) {
    LAS int* T = (LAS int*)(F.lds + TAB_OFF);
    if (F.tid < 64) T[F.tid] = (int)__hip_atomic_load(F.cnt + F.tid * 64, RLX_AGENT);
    __syncthreads();
    if (F.tid == 0) { int pa = 0, hs = 0, p0 = 0, p1 = 0;
        for (int e = 0; e < NEXP; ++e) { const int c0 = T[e], c1 = T[32 + e], ta = (c0 + c1 + 255) >> 8;
            T[64 + e] = pa; T[128 + e] = hs; T[192 + e] = p0; T[256 + e] = p1; pa += ta; hs += ta * 256; p0 += (c0 + 255) >> 8; p1 += (c1 + 255) >> 8; }
        T[64 + 32] = pa; T[128 + 32] = hs; T[192 + 32] = p0; T[256 + 32] = p1; }
    __syncthreads();
}

__device__ __forceinline__ void p9_combine(Frame& F) {
    const LAS int* T = (const LAS int*)(F.lds + TAB_OFF);
    const int gw = F.vcu * NWAVES + F.wave, NGW = F.G * NWAVES;
    for (int rb = gw; rb < NTOK / 16; rb += NGW) {
        const int row0 = rb * 16, b = row0 / SEQ;
        int rr = 0; float ww = 0.f;
        if (F.lane < 32) { const int iv = F.inv[2 * row0 + F.lane]; ww = F.winv[2 * row0 + F.lane]; const int e = iv >> 16; rr = T[128 + e] + ((F.lane & 1) ? T[e] : 0) + (iv & 0xffff); }
        const GAS f32x4* gr = (const GAS f32x4*)(F.mod + (size_t)b * (NMOD * D) + 5 * D) + F.lane;
        f32x4 gv[4];
#pragma unroll
        for (int j = 0; j < 4; ++j) gv[j] = gr[64 * j];
        for (int i0 = 0; i0 < 16; i0 += 4) {
            f32x4 xv[4][4]; v2u a[4][4], c[4][4]; float w0[4], w1[4];
#pragma unroll
            for (int q = 0; q < 4; ++q) { const int i = i0 + q; const int r0 = __shfl(rr, 2 * i), r1 = __shfl(rr, 2 * i + 1); w0[q] = __shfl(ww, 2 * i); w1[q] = __shfl(ww, 2 * i + 1);
                const GAS f32x4* xr = (const GAS f32x4*)(F.out + (size_t)(row0 + i) * D) + F.lane;
                const GAS v2u* y0 = (const GAS v2u*)(F.Y + (size_t)r0 * D) + F.lane; const GAS v2u* y1 = (const GAS v2u*)(F.Y + (size_t)r1 * D) + F.lane;
#pragma unroll
                for (int j = 0; j < 4; ++j) { xv[q][j] = xr[64 * j]; a[q][j] = y0[64 * j]; c[q][j] = y1[64 * j]; } }
#pragma unroll
            for (int q = 0; q < 4; ++q) { GAS f32x4* xr = (GAS f32x4*)(F.out + (size_t)(row0 + i0 + q) * D) + F.lane;
#pragma unroll
                for (int j = 0; j < 4; ++j) { f32x4 y; y.x = w0[q] * bflo(a[q][j].x) + w1[q] * bflo(c[q][j].x); y.y = w0[q] * bfhi(a[q][j].x) + w1[q] * bfhi(c[q][j].x); y.z = w0[q] * bflo(a[q][j].y) + w1[q] * bflo(c[q][j].y); y.w = w0[q] * bfhi(a[q][j].y) + w1[q] * bfhi(c[q][j].y);
                    xr[64 * j] = xv[q][j] + gv[j] * y; } }
        }
    }
}
#ifndef REP_PHASE
#define REP_PHASE -1
#endif
#ifndef STG_P2
#define STG_P2 0
#endif
#ifndef STG_P4
#define STG_P4 0
#endif
#ifndef STG_P5
#define STG_P5 0
#endif
#ifndef STG_P8
#define STG_P8 0
#endif
__device__ __forceinline__ void stagger_wait(int us_x_group) {
    if (us_x_group > 0) { const unsigned long long t0 = __builtin_amdgcn_s_memrealtime(); const unsigned long long ticks = (unsigned long long)us_x_group * 100ull;
        while (__builtin_amdgcn_s_memrealtime() - t0 < ticks) __builtin_amdgcn_s_sleep(16); }
}
#ifndef MK_N_LAUNCHES
#define MK_N_LAUNCHES 1
#endif
constexpr int N_PHASES = 10;
constexpr int N_LAUNCHES = MK_N_LAUNCHES;
static_assert(N_LAUNCHES == 1 || N_LAUNCHES == N_PHASES, "MK_N_LAUNCHES is 1 or N_PHASES");
struct Args { const float* in[20]; float* out; unsigned char* ws; int ph_lo, ph_hi; };
__global__ void __launch_bounds__(NWAVES * 64, 2) fwd(Args args) {
    extern __shared__ __attribute__((aligned(16))) unsigned char lds[];
    Frame F;
    F.lds = (LAS unsigned char*)lds;
    F.MISC = (volatile LAS unsigned*)(F.lds + MISC_OFF);
    F.tid = threadIdx.x; F.lane = F.tid & 63; F.wave = __builtin_amdgcn_readfirstlane(F.tid >> 6);
    F.G = gridDim.x; { const int bx = blockIdx.x; F.vcu = (F.G % 8 == 0) ? (bx % 8) * (F.G / 8) + bx / 8 : bx; }
    unsigned char* ws = args.ws;
    F.ctl = (gu32*)(ws + WS_CTL);
    F.x = args.in[0]; F.c = args.in[1]; F.w_ada = args.in[2]; F.b_ada = args.in[3]; F.g_mix = args.in[4]; F.w_in = args.in[5]; F.g_q = args.in[6]; F.g_k = args.in[7]; F.rel_bias = args.in[8];
    F.w_br_moba = args.in[9]; F.w_br_sb = args.in[10]; F.w_out = args.in[11]; F.g_ffn = args.in[12]; F.w_rg = args.in[13]; F.b_rg = args.in[14]; F.w_re = args.in[15]; F.b_re = args.in[16];
    F.w_gate = args.in[17]; F.w_up = args.in[18]; F.w_down = args.in[19]; F.out = args.out;
    F.mod = (float*)(ws + WS_MOD); F.biasT = (float*)(ws + WS_BIAS); F.btg = (float*)(ws + WS_BIAS + 128 * 1024); F.wrt_hi = (bf16*)(ws + WS_MOD + 640 * 1024); F.wrt_lo = (bf16*)(ws + WS_MOD + 736 * 1024); F.stats = (float*)(ws + WS_STATS); F.kmean = (float*)(ws + WS_CTL) + CW_KMEAN;
    F.Win_t = (bf16*)(ws + WS_WIN); F.Wbra_t = (bf16*)(ws + WS_WBRA); F.Wbrb_t = (bf16*)(ws + WS_WBRB); F.Wout_t = (bf16*)(ws + WS_WOUT); F.Wgu_t = (bf16*)(ws + WS_WGU); F.Wd_t = (bf16*)(ws + WS_WD);
    F.XN = (bf16*)(ws + WS_XN); F.QA = (bf16*)(ws + WS_QA); F.KA = (bf16*)(ws + WS_KA); F.VA = (bf16*)(ws + WS_VA); F.QB = (bf16*)(ws + WS_QB); F.KB = (bf16*)(ws + WS_KB); F.VB = (bf16*)(ws + WS_VB);
    F.OA = (bf16*)(ws + WS_XN); F.OB = (bf16*)(ws + WS_XN + 32 * MiB); F.GA = (bf16*)(ws + WS_GA); F.GB = (bf16*)(ws + WS_GB); F.H = (bf16*)(ws + WS_H);
    F.inv = (int*)(ws + WS_INV); F.winv = (float*)(ws + WS_WINV); F.Y = (bf16*)(ws + WS_Y); F.tokl = (int*)(ws + WS_TOKL); F.wl = (float*)(ws + WS_WL); F.cnt = (unsigned*)(ws + WS_CTL) + CW_CNT;
    for (int u = F.tid; u < (LDS_BYTES - LDSCTL_OFF) / 4; u += NWAVES * 64) ((LAS unsigned*)(F.lds + LDSCTL_OFF))[u] = 0u;
    __syncthreads();
    XcdBarrier bar; bar.bar = (unsigned*)(F.ctl + CW_BAR); bar.x = 0; bar.st = nullptr;
    if (N_LAUNCHES == 1) bar = xcd_barrier_post((unsigned*)(F.ctl + CW_BAR), F.MISC + 8);
#define GRID_BAR() do { if (N_LAUNCHES == 1) { xcd_barrier(bar); } } while (0)
    const int lo = args.ph_lo, hi = args.ph_hi;
#define IN(k) (lo <= (k) && (k) < hi)
#define BOTH(k) (IN(k) && IN((k) + 1))

    if (IN(0)) { p0_prologue(F); if (REP_PHASE == 0) { GRID_BAR(); p0_prologue(F); } if (BOTH(0)) GRID_BAR(); }
    if (IN(1)) { p1_norm(F); if (REP_PHASE == 1) { GRID_BAR(); p1_norm(F); } if (BOTH(1)) GRID_BAR(); }
    if (IN(2)) {
        stagger_wait(STG_P2 * (int)((blockIdx.x >> 3) & 3)); __syncthreads();
        pg8::Gemm g{F.XN, F.Win_t, D}; pg8::DenseOrder S; S.init(NTOK, INCOLS, F.G, (int)blockIdx.x);
        pg8::EpiProj E{F.QA, F.GA, F.GB, F.g_q, F.g_k, F.kmean};
        pg8::gemm_phase<pg8::EpiProj, pg8::DenseOrder, false>(F.lds + RING_OFF, g, S, E);
        if (REP_PHASE == 2) { GRID_BAR(); pg8::gemm_phase<pg8::EpiProj, pg8::DenseOrder, false>(F.lds + RING_OFF, g, S, E); }
        if (BOTH(2)) GRID_BAR();
    }
    if (IN(3)) {
#if defined(MOBA_NAIVE)
        p3_moba_naive(F);
#else
        { int nrep = (REP_PHASE == 30) ? 2 : 1; asm volatile("" : "+s"(nrep));
          for (int rep = 0; rep < nrep; ++rep) { __syncthreads(); p3_moba(F); if (REP_PHASE == 30 && rep == 0) GRID_BAR(); } }
#endif
#if defined(SB_NAIVE)
        p3_sb_naive(F);
#else
        p3_sb(F);
        if (REP_PHASE == 31) { GRID_BAR(); p3_sb(F); }
#endif
        if (BOTH(3)) GRID_BAR(); }
    if (IN(4)) {
        __syncthreads();
        pg8::Gemm g{F.OA, F.Wbra_t, D}; pg8::DenseOrder S; S.init(NTOK, D, F.G, (int)blockIdx.x);
        pg8::EpiMerge E{F.GA, F.GB};
        pg8::gemm_phase<pg8::EpiMerge, pg8::DenseOrder, false>(F.lds + RING_OFF, g, S, E);
        if (BOTH(4)) GRID_BAR();
    }
    if (IN(5)) {
        stagger_wait(STG_P5 * (int)((blockIdx.x >> 3) & 3)); __syncthreads();
        pg8::Gemm g{F.GB, F.Wout_t, D}; pg8::DenseOrder S; S.init(NTOK, D, F.G, (int)blockIdx.x);
        pg8::EpiResid E{F.x, F.out, F.mod + 2 * D, F.stats};
        pg8::gemm_phase<pg8::EpiResid, pg8::DenseOrder, false>(F.lds + RING_OFF, g, S, E);
        if (REP_PHASE == 5) { GRID_BAR(); pg8::gemm_phase<pg8::EpiResid, pg8::DenseOrder, false>(F.lds + RING_OFF, g, S, E); }
        if (BOTH(5)) GRID_BAR();
    }
    if (IN(6)) {
#if defined(ROUTE_VALU)
        p6_route(F);
#else
        __syncthreads(); p6_route_mfma(F);
#endif
        if (REP_PHASE == 6) { GRID_BAR(); Frame F2 = F; F2.cnt = (unsigned*)(ws + WS_CTL) + CW_CNT + 4096 * 4; F2.tokl = (int*)(ws + WS_GA); F2.wl = (float*)(ws + WS_GA + 16 * MiB); F2.XN = (bf16*)(ws + WS_GB); p6_route_mfma(F2); }
        if (BOTH(6)) GRID_BAR(); }
    if (IN(7)) {
        moe_tables(F);
        pg8::Gemm g{F.XN, F.Wgu_t, D}; pg8::GateUpOrder S{(const LAS int*)(F.lds + TAB_OFF), F.tokl, F.G, (int)blockIdx.x};
        pg8::EpiGateUp E{F.H};
        pg8::gemm_phase<pg8::EpiGateUp, pg8::GateUpOrder, true>(F.lds + RING_OFF, g, S, E);
        if (REP_PHASE == 7) { GRID_BAR(); pg8::gemm_phase<pg8::EpiGateUp, pg8::GateUpOrder, true>(F.lds + RING_OFF, g, S, E); }
        if (BOTH(7)) GRID_BAR();
    }
    if (IN(8)) {
        moe_tables(F);
        pg8::Gemm g{F.H, F.Wd_t, DEXP}; pg8::DownAllOrder S{(const LAS int*)(F.lds + TAB_OFF), F.G, (int)blockIdx.x};
        pg8::EpiY E{F.Y};
        pg8::gemm_phase<pg8::EpiY, pg8::DownAllOrder, false>(F.lds + RING_OFF, g, S, E);
        if (REP_PHASE == 8) { GRID_BAR(); pg8::gemm_phase<pg8::EpiY, pg8::DownAllOrder, false>(F.lds + RING_OFF, g, S, E); }
        if (BOTH(8)) GRID_BAR();
    }
    if (IN(9)) { moe_tables(F); p9_combine(F); if (REP_PHASE == 9) { GRID_BAR(); Frame F2 = F; F2.out = (float*)(ws + WS_XN); p9_combine(F2); } }
#if defined(PROBE_EPI)
    __syncthreads();
    if (IN(9) && blockIdx.x == PROBE_BLK && F.tid == 0) { const float n = (float)g_probe[3]; const float v = (PROBE_EPI == 1) ? (float)g_probe[0] * 0.01f / n : (float)g_probe[1] * 0.01f / (n - 1.0f); F.out[12345] += 1.0f + 0.2f * v; }
#endif
#undef IN
#undef BOTH
}

extern "C" void kernel_launch(void* const* d_in, const int* in_sizes, int n_in, void* d_out, int out_size, void* d_ws, size_t ws_size, hipStream_t stream) {
    static int grid = 0;
    if (grid == 0) {
        if (n_in != 20 || in_sizes[0] != NTOK * D || out_size != NTOK * D || ws_size < WS_END) { fprintf(stderr, "kernel_launch: built for 20 inputs, x/out of %d floats, >= %zu bytes of workspace; got n_in %d, in0 %d, out %d, ws %zu; nothing launched\n", NTOK * D, (size_t)WS_END, n_in, n_in > 0 ? in_sizes[0] : -1, out_size, ws_size); grid = -1; return; }
        int dev = 0, cus = 0, per_cu = 0;
        if (hipGetDevice(&dev) != hipSuccess || hipDeviceGetAttribute(&cus, hipDeviceAttributeMultiprocessorCount, dev) != hipSuccess) { fprintf(stderr, "kernel_launch: hipGetDevice / hipDeviceGetAttribute failed\n"); grid = -1; return; }
        if (hipFuncSetAttribute((const void*)fwd, hipFuncAttributeMaxDynamicSharedMemorySize, LDS_BYTES) != hipSuccess) { fprintf(stderr, "kernel_launch: hipFuncSetAttribute failed\n"); grid = -1; return; }
        if (hipOccupancyMaxActiveBlocksPerMultiprocessor(&per_cu, (const void*)fwd, NWAVES * 64, LDS_BYTES) != hipSuccess || per_cu < 1)
            fprintf(stderr, "kernel_launch: note: the occupancy query reports %d workgroups per CU\n", per_cu);
        (void)hipGetLastError();
        grid = cus;
    }
    if (grid < 0) return;
    if (hipMemsetAsync((char*)d_ws + WS_CTL, 0, CTL_ZERO_BYTES, stream) != hipSuccess) { fprintf(stderr, "kernel_launch: hipMemsetAsync failed\n"); return; }
    Args a{};
    for (int i = 0; i < 20; ++i) a.in[i] = (const float*)d_in[i];
    a.out = (float*)d_out; a.ws = (unsigned char*)d_ws;
    for (int li = 0; li < N_LAUNCHES; ++li) {
        a.ph_lo = (N_LAUNCHES == 1) ? 0 : li; a.ph_hi = (N_LAUNCHES == 1) ? N_PHASES : li + 1;
        hipLaunchKernelGGL(fwd, dim3(grid), dim3(NWAVES * 64), LDS_BYTES, stream, a);
        const hipError_t le = hipPeekAtLastError();
        if (le != hipSuccess) { fprintf(stderr, "kernel_launch: launch %d failed: %s\n", li, hipGetErrorName(le)); break; }
    }
}
```

```cpp
#include <hip/hip_runtime.h>
#include <cstdio>
#include <cstdint>
#include <cmath>
#if defined(PROBE_EPI)
#ifndef PROBE_BLK
#define PROBE_BLK 0
#endif
__device__ unsigned long long g_probe[4];
#endif
namespace pg8 {
#define PG8_LAS __attribute__((address_space(3)))
typedef unsigned short bf16_t;
typedef short bf16x8 __attribute__((ext_vector_type(8)));
typedef float f32x4 __attribute__((ext_vector_type(4)));
typedef unsigned u32x4 __attribute__((ext_vector_type(4)));
constexpr int BM = 256, BK = 64, HALF = 128, HTB = HALF * BK * 2  , STAGE_BYTES = 8 * HTB, NXCD = 8, WGM = 8;

__host__ __device__ __forceinline__ int lds_byte(int r, int c) { const int st = (r >> 4) * 2 + (c >> 5), rr = r & 15, cc = c & 31, ob = rr * 64 + cc * 2; return st * 1024 + (ob ^ (((ob >> 9) & 1) << 5)); }
__host__ __device__ __forceinline__ void stage_rc(int b, int& R, int& C) { const int st = b / 1024, sb = b % 1024, swz = sb ^ (((sb >> 9) & 1) << 5); R = (st >> 1) * 16 + swz / 64; C = (st & 1) * 32 + (swz % 64) / 2; }
__host__ __device__ __forceinline__ int perm32(int rho) { const int n = rho >> 4, i = rho & 15; return 8 * (i >> 2) + 4 * n + (i & 3); }

struct Unit { int arow, brow, pm, pn, x0, x1; };
struct Gemm { const bf16_t* A; const bf16_t* Bt; int K; };

struct DenseOrder {
    int nM, nN, nwg, G, c;
    __device__ void init(int M, int N, int G_, int c_) { nM = M / BM; nN = N / BM; nwg = nM * nN; G = G_; c = c_; }
    __device__ bool next(int i, Unit& u) const {
        const long L = (long)i * G + c; if (L >= nwg) return false;
        int wgid = (int)L; { const int q = nwg / NXCD, r = nwg % NXCD, xcd = wgid % NXCD, off = wgid / NXCD; wgid = (xcd < r ? xcd * (q + 1) : r * (q + 1) + (xcd - r) * q) + off; }
        const int nig = WGM * nN, gid = wgid / nig, fm = gid * WGM, gsz = (nM - fm) < WGM ? (nM - fm) : WGM;
        u.pm = fm + ((wgid % nig) % gsz); u.pn = (wgid % nig) / gsz; u.arow = u.pm * BM; u.brow = u.pn * BM; u.x0 = 0; u.x1 = 0; return true;
    }
    __device__ __forceinline__ int arow_of(const Unit&, int) const { return 0; }
};

__device__ __forceinline__ unsigned cvt_pk_bf16(float lo, float hi) { unsigned r; asm volatile("v_cvt_pk_bf16_f32 %0, %1, %2" : "=v"(r) : "v"(lo), "v"(hi)); return r; }

template <class Epi, class Sched, bool GATHER, bool ALIGN_EPI = true, bool SP2 = true>
__device__ __forceinline__ void gemm_phase(PG8_LAS unsigned char* lds, const Gemm g, const Sched& S, const Epi& E) {
    const int tid = threadIdx.x, wid = __builtin_amdgcn_readfirstlane(tid >> 6), lane = tid & 63, wr = wid >> 2, wc = wid & 3, fr = lane & 15, fq = lane >> 4;
    const int K = g.K, nt = K / BK;
    unsigned voffA[2], voffB[2]; int stR[2], stC[2];
#pragma unroll
    for (int i = 0; i < 2; ++i) { int R, C; stage_rc(tid * 16 + i * 8192, R, C); const int Rb = Epi::PERM ? ((R & ~31) + perm32(R & 31)) : R;
        stR[i] = R; stC[i] = C; voffA[i] = (unsigned)(R * K + C) * 2u; voffB[i] = (unsigned)(Rb * K + C) * 2u; }
    const size_t kstep = (size_t)(BK * 2);
    const size_t hstep = (size_t)HALF * K * 2;
    const size_t rstep = (size_t)K * 2;
    const unsigned ldsw = (unsigned)wid * 1024u;
    const int aoff = lds_byte(wr * 64 + fr, fq * 8), boff = lds_byte(wc * 32 + fr, fq * 8);
#define PG8_SA(b, h) (((b) * 2 + (h)) * HTB)
#define PG8_SB(b, h) ((4 + (b) * 2 + (h)) * HTB)
#define PG8_STAGE(bufoff, gbase, voff) do { _Pragma("unroll") for (int _i = 0; _i < 2; ++_i) \
        __builtin_amdgcn_global_load_lds((const unsigned*)((const char*)(gbase) + (voff)[_i]), (PG8_LAS unsigned*)(lds + (bufoff) + ldsw + _i * 8192), 16, 0, 0); } while (0)
#define PG8_STAGE_A(bufoff, ub, h, VS) do { if constexpr (GATHER) { PG8_STAGE(bufoff, ub, VS[h]); } else { PG8_STAGE(bufoff, (ub) + (h) * hstep, voffA); } } while (0)
#define PG8_VOFFS(dst, U) do { _Pragma("unroll") for (int h_ = 0; h_ < 2; ++h_) _Pragma("unroll") for (int i_ = 0; i_ < 2; ++i_) \
        dst[h_][i_] = (unsigned)(S.arow_of(U, h_ * HALF + stR[i_]) * K + stC[i_]) * 2u; } while (0)
#define PG8_LDA(dst, b, h) do { _Pragma("unroll") for (int m = 0; m < 4; ++m) _Pragma("unroll") for (int k = 0; k < 2; ++k) dst[m][k] = *(const PG8_LAS bf16x8*)(lds + PG8_SA(b, h) + aoff + m * 2048 + k * 1024); } while (0)
#define PG8_LDB(dst, b, h) do { _Pragma("unroll") for (int n = 0; n < 2; ++n) _Pragma("unroll") for (int k = 0; k < 2; ++k) dst[n][k] = *(const PG8_LAS bf16x8*)(lds + PG8_SB(b, h) + boff + n * 2048 + k * 1024); } while (0)
#define PG8_MMA(ai, bj, At, Bt) do { __builtin_amdgcn_s_setprio(1); _Pragma("unroll") for (int m = 0; m < 4; ++m) _Pragma("unroll") for (int n = 0; n < 2; ++n) _Pragma("unroll") for (int k = 0; k < 2; ++k) \
        acc[ai][bj][m][n] = __builtin_amdgcn_mfma_f32_16x16x32_bf16(Bt[n][k], At[m][k], acc[ai][bj][m][n], 0, 0, 0); __builtin_amdgcn_s_setprio(0); } while (0)
#define PG8_WAIT_V(n) asm volatile("s_waitcnt vmcnt(" #n ")" ::: "memory")
#define PG8_WAIT_L(n) asm volatile("s_waitcnt lgkmcnt(" #n ")" ::: "memory")
#define PG8_BAR __builtin_amdgcn_s_barrier()
#define PG8_SCHED __builtin_amdgcn_sched_barrier(0)
    Unit cur, nxt; int ui = 0;
    if (!S.next(0, cur)) return;
    bool has_next = S.next(1, nxt);
    unsigned vAc[2][2], vAn[2][2];
    if constexpr (GATHER) { PG8_VOFFS(vAc, cur); if (has_next) { PG8_VOFFS(vAn, nxt); } else {
#pragma unroll
        for (int h_ = 0; h_ < 2; ++h_) { vAn[h_][0] = vAc[h_][0]; vAn[h_][1] = vAc[h_][1]; } } }
    else {
#pragma unroll
        for (int h_ = 0; h_ < 2; ++h_) { vAc[h_][0] = 0u; vAc[h_][1] = 0u; vAn[h_][0] = 0u; vAn[h_][1] = 0u; } }
    f32x4 acc[2][2][4][2];
#pragma unroll
    for (int a = 0; a < 2; ++a)
#pragma unroll
        for (int b = 0; b < 2; ++b)
#pragma unroll
            for (int m = 0; m < 4; ++m)
#pragma unroll
                for (int n = 0; n < 2; ++n) acc[a][b][m][n] = (f32x4){0.f, 0.f, 0.f, 0.f};
    bf16x8 At[4][2], B0[2][2], B1[2][2];
    const char* const A0 = (const char*)g.A;
    const char* cA = GATHER ? A0 : A0 + (size_t)cur.arow * rstep; const char* cB = (const char*)g.Bt + (size_t)cur.brow * rstep;
    if constexpr (SP2) {
        PG8_STAGE(PG8_SB(0, 0), cB, voffB); PG8_STAGE(PG8_SB(0, 1), cB + hstep, voffB); PG8_STAGE_A(PG8_SA(0, 0), cA, 0, vAc); PG8_STAGE_A(PG8_SA(0, 1), cA, 1, vAc);
        if (wr == 1) PG8_BAR;
        PG8_WAIT_V(2); PG8_BAR;
        PG8_STAGE(PG8_SB(1, 0), cB + kstep, voffB); PG8_STAGE_A(PG8_SA(1, 0), cA + kstep, 0, vAc); PG8_STAGE(PG8_SB(1, 1), cB + hstep + kstep, voffB);
        PG8_WAIT_V(6); PG8_BAR;
    } else {
        PG8_STAGE(PG8_SB(0, 0), cB, voffB); PG8_STAGE_A(PG8_SA(0, 0), cA, 0, vAc); PG8_STAGE(PG8_SB(0, 1), cB + hstep, voffB); PG8_STAGE_A(PG8_SA(0, 1), cA, 1, vAc);
        if (wr == 1) PG8_BAR;
        PG8_WAIT_V(4); PG8_BAR;
        PG8_STAGE(PG8_SB(1, 0), cB + kstep, voffB); PG8_STAGE_A(PG8_SA(1, 0), cA + kstep, 0, vAc); PG8_STAGE(PG8_SB(1, 1), cB + hstep + kstep, voffB);
        PG8_WAIT_V(6); PG8_BAR;
    }
    for (;;) {
        const char* nA = GATHER ? A0 : (has_next ? A0 + (size_t)nxt.arow * rstep : cA); const char* nB = has_next ? (const char*)g.Bt + (size_t)nxt.brow * rstep : cB;
        for (int t = 0; t < nt; t += 2) {
            const bool last = (t == nt - 2);
            const char* a1 = cA + (size_t)(t + 1) * kstep;
            const char* a2 = last ? nA : cA + (size_t)(t + 2) * kstep; const char* b2 = last ? nB : cB + (size_t)(t + 2) * kstep;
            const char* a3 = a2 + kstep; const char* b3 = b2 + kstep;
            if constexpr (Epi::MIDK) { if (t == nt / 2) E.mid(acc, cur, wr, wc, fr, fq); }
            unsigned vS[2][2];
#pragma unroll
            for (int h_ = 0; h_ < 2; ++h_) { vS[h_][0] = last ? vAn[h_][0] : vAc[h_][0]; vS[h_][1] = last ? vAn[h_][1] : vAc[h_][1]; }
            if constexpr (SP2) {
            PG8_LDB(B0, 0, 0); PG8_LDB(B1, 0, 1); PG8_SCHED; PG8_LDA(At, 0, 0); PG8_STAGE_A(PG8_SA(1, 1), a1, 1, vAc);
            PG8_WAIT_V(8); PG8_WAIT_L(0); PG8_BAR;
#if defined(PROBE_EPI)
            if (Epi::PSLOT && t == 0 && ui > 0 && blockIdx.x == PROBE_BLK && tid == 0) { g_probe[1] += __builtin_amdgcn_s_memrealtime() - g_probe[2]; }
#endif
 PG8_MMA(0, 0, At, B0); PG8_MMA(0, 1, At, B1); PG8_BAR; PG8_SCHED;
            PG8_LDA(At, 0, 1); PG8_STAGE(PG8_SB(0, 0), b2, voffB); PG8_STAGE(PG8_SB(0, 1), b2 + hstep, voffB); PG8_STAGE_A(PG8_SA(0, 0), a2, 0, vS);
            PG8_WAIT_V(8); PG8_WAIT_L(0); PG8_BAR; PG8_MMA(1, 0, At, B0); PG8_MMA(1, 1, At, B1); PG8_BAR; PG8_SCHED;
            PG8_LDB(B0, 1, 0); PG8_LDB(B1, 1, 1); PG8_SCHED; PG8_LDA(At, 1, 0); PG8_STAGE_A(PG8_SA(0, 1), a2, 1, vS);
            PG8_WAIT_V(8); PG8_WAIT_L(0); PG8_BAR; PG8_MMA(0, 0, At, B0); PG8_MMA(0, 1, At, B1); PG8_BAR; PG8_SCHED;
            PG8_LDA(At, 1, 1); PG8_STAGE(PG8_SB(1, 0), b3, voffB); PG8_STAGE(PG8_SB(1, 1), b3 + hstep, voffB); PG8_STAGE_A(PG8_SA(1, 0), a3, 0, vS);
            PG8_WAIT_V(8); PG8_WAIT_L(0); PG8_BAR; PG8_MMA(1, 0, At, B0); PG8_MMA(1, 1, At, B1); PG8_BAR; PG8_SCHED;
            } else {
            PG8_LDB(B0, 0, 0); PG8_SCHED; PG8_LDA(At, 0, 0); PG8_STAGE_A(PG8_SA(1, 1), a1, 1, vAc);
            PG8_WAIT_L(8); PG8_BAR; PG8_WAIT_L(0); PG8_MMA(0, 0, At, B0); PG8_BAR; PG8_SCHED;
            PG8_LDB(B1, 0, 1); PG8_STAGE(PG8_SB(0, 0), b2, voffB);
            PG8_BAR; PG8_WAIT_L(0); PG8_MMA(0, 1, At, B1); PG8_BAR;
            PG8_LDA(At, 0, 1); PG8_STAGE_A(PG8_SA(0, 0), a2, 0, vS);
            PG8_BAR; PG8_WAIT_L(0); PG8_MMA(1, 0, At, B0); PG8_BAR; PG8_SCHED;
            PG8_STAGE(PG8_SB(0, 1), b2 + hstep, voffB);
            PG8_WAIT_V(6); PG8_BAR; PG8_MMA(1, 1, At, B1); PG8_BAR;
            PG8_LDB(B0, 1, 0); PG8_SCHED; PG8_LDA(At, 1, 0); PG8_STAGE_A(PG8_SA(0, 1), a2, 1, vS);
            PG8_WAIT_L(8); PG8_BAR; PG8_WAIT_L(0); PG8_MMA(0, 0, At, B0); PG8_BAR; PG8_SCHED;
            PG8_LDB(B1, 1, 1); PG8_STAGE(PG8_SB(1, 0), b3, voffB);
            PG8_BAR; PG8_WAIT_L(0); PG8_MMA(0, 1, At, B1); PG8_BAR;
            PG8_LDA(At, 1, 1); PG8_STAGE_A(PG8_SA(1, 0), a3, 0, vS);
            PG8_BAR; PG8_WAIT_L(0); PG8_MMA(1, 0, At, B0); PG8_BAR; PG8_SCHED;
            PG8_STAGE(PG8_SB(1, 1), b3 + hstep, voffB);
            PG8_WAIT_V(6); PG8_BAR; PG8_MMA(1, 1, At, B1); PG8_BAR;
            }
        }
#if defined(PROBE_EPI)
        unsigned long long pt0_ = 0ull; if (Epi::PSLOT && blockIdx.x == PROBE_BLK && tid == 0) pt0_ = __builtin_amdgcn_s_memrealtime();
#endif
        if constexpr (ALIGN_EPI) { if (wr == 0) PG8_BAR; }
        E(acc, cur, wr, wc, fr, fq);
#if defined(PROBE_EPI)
        if (Epi::PSLOT && blockIdx.x == PROBE_BLK && tid == 0) { const unsigned long long pt1_ = __builtin_amdgcn_s_memrealtime(); g_probe[0] += pt1_ - pt0_; g_probe[2] = pt1_; g_probe[3] += 1ull; }
#endif
        if (!has_next) break;
#pragma unroll
        for (int a = 0; a < 2; ++a)
#pragma unroll
            for (int b = 0; b < 2; ++b)
#pragma unroll
                for (int m = 0; m < 4; ++m)
#pragma unroll
                    for (int n = 0; n < 2; ++n) acc[a][b][m][n] = (f32x4){0.f, 0.f, 0.f, 0.f};
        cur = nxt; cA = nA; cB = nB; ++ui;
        has_next = S.next(ui + 1, nxt);
        if constexpr (GATHER) {
#pragma unroll
            for (int h_ = 0; h_ < 2; ++h_) { vAc[h_][0] = vAn[h_][0]; vAc[h_][1] = vAn[h_][1]; }
            if (has_next) { PG8_VOFFS(vAn, nxt); }
        }
        if constexpr (ALIGN_EPI) { if (wr == 1) PG8_BAR; }
    }
    PG8_WAIT_V(0);
    if constexpr (!ALIGN_EPI) { if (wr == 0) PG8_BAR; }
    PG8_BAR;
#undef PG8_SA
#undef PG8_SB
#undef PG8_STAGE
#undef PG8_STAGE_A
#undef PG8_VOFFS
#undef PG8_LDA
#undef PG8_LDB
#undef PG8_MMA
#undef PG8_WAIT_V
#undef PG8_WAIT_L
#undef PG8_BAR
#undef PG8_SCHED
}
}
constexpr int NWAVES = 8;
constexpr int BATCH = 8, SEQ = 4096, D = 1024, NTOK = BATCH * SEQ;
constexpr int HD = 64, NH = 8, WATT = NH * HD;
constexpr int INCOLS = 5120, NMOD = 6;
constexpr int MBLK = 256, NBLK = SEQ / MBLK;
constexpr int NEXP = 32, EPG = 8, NGRP = 4, DEXP = 512;
constexpr float RMS_EPS = 1e-6f;
constexpr float LOG2E = 1.4426950408889634f;
constexpr float C2 = 0.125f * 1.4426950408889634f;
constexpr int LCAP = NTOK;
constexpr int HROWS = 2 * NTOK + NEXP * 256 + 256;

constexpr size_t MiB = 1u << 20;
constexpr size_t WS_CTL = 0, CTL_ZERO_BYTES = 1 * MiB;
constexpr size_t WS_MOD = 1 * MiB;
constexpr size_t WS_BIAS = 1 * MiB + 256 * 1024;
constexpr size_t WS_STATS = 2 * MiB;
constexpr size_t WS_WIN = 4 * MiB;
constexpr size_t WS_WBRA = 14 * MiB, WS_WBRB = 15 * MiB;
constexpr size_t WS_WOUT = 16 * MiB;
constexpr size_t WS_WGU = 18 * MiB;
constexpr size_t WS_WD = 82 * MiB;
constexpr size_t WS_XN = 114 * MiB;
constexpr size_t WS_QA = 178 * MiB, WS_KA = 210 * MiB, WS_VA = 242 * MiB, WS_QB = 274 * MiB, WS_KB = 306 * MiB, WS_VB = 338 * MiB;
constexpr size_t WS_GA = 370 * MiB, WS_GB = 434 * MiB;
constexpr size_t WS_H = 178 * MiB;
constexpr size_t WS_TOKL = 306 * MiB, WS_WL = 314 * MiB;
constexpr size_t WS_INV = 314 * MiB, WS_WINV = 315 * MiB;
constexpr size_t WS_Y = 322 * MiB;
constexpr size_t WS_END = 498 * MiB;
static_assert(WS_Y + (size_t)HROWS * D * 2 <= WS_END, "Y fits");
static_assert(WS_H + (size_t)HROWS * DEXP * 2 <= WS_QB && WS_TOKL + (size_t)2 * NEXP * LCAP * 4 <= WS_WL && WS_WL + (size_t)2 * NEXP * LCAP * 4 <= WS_VB, "d_ws map");
constexpr int CW_TMO = 0, CW_CODE = 1;
constexpr int CW_BAR = 4096;
constexpr int CW_QATT = 8192, CW_QCONV = 8192 + 64;
constexpr int CW_CNT = 16384;
constexpr int CW_KMEAN = 65536;
static_assert((CW_KMEAN + 65536) * 4 <= (int)CTL_ZERO_BYTES && CW_CNT + 64 * 64 <= CW_KMEAN && CW_BAR + 3456 <= CW_CNT, "CTL map");

constexpr int RING_OFF = 0, RING_BYTES = 131072;
constexpr int LDSCTL_OFF = RING_BYTES, MISC_OFF = LDSCTL_OFF + 320;
constexpr int TAB_OFF = RING_BYTES + 1024;
constexpr int LDS_BYTES = 147456;
static_assert(MISC_OFF + 128 <= TAB_OFF && TAB_OFF + 2048 <= LDS_BYTES, "LDS map");

#define GAS __attribute__((address_space(1)))
#define LAS __attribute__((address_space(3)))
typedef unsigned short bf16;
typedef unsigned v4u __attribute__((ext_vector_type(4)));
typedef unsigned v2u __attribute__((ext_vector_type(2)));
typedef float f32x4 __attribute__((ext_vector_type(4)));
typedef short bf16x8 __attribute__((ext_vector_type(8)));
typedef GAS unsigned gu32;
#define RLX_AGENT __ATOMIC_RELAXED, __HIP_MEMORY_SCOPE_AGENT
#define LDS_WAIT() asm volatile("s_waitcnt lgkmcnt(0)" ::: "memory")
#define VM_WAIT() asm volatile("s_waitcnt vmcnt(0)" ::: "memory")
__device__ __forceinline__ unsigned f2bf(float f) { unsigned u = __builtin_bit_cast(unsigned, f); return (u + 0x7fffu + ((u >> 16) & 1u)) >> 16; }
__device__ __forceinline__ unsigned pk2(float lo, float hi) { return f2bf(lo) | (f2bf(hi) << 16); }
__device__ __forceinline__ float bflo(unsigned u) { return __uint_as_float(u << 16); }
__device__ __forceinline__ float bfhi(unsigned u) { return __uint_as_float(u & 0xffff0000u); }
__device__ __forceinline__ float fsigmoid(float v) { return __builtin_amdgcn_rcpf(1.0f + __builtin_amdgcn_exp2f(-v * LOG2E)); }
#define XB_TMO      128
#define XB_XCNT(j)  (256  + 64 * (j))
#define XB_XSUB(j)  (1280 + 64 * (j))
#define XB_XGEN(j)  (2304 + 64 * (j))
#define XB_TOP      3328
#define XB_TOPGEN   3392
#define XCD_BAR_WORDS 3456
#define XB_SPIN_CAP (1u << 22)

__device__ __forceinline__ unsigned xb_ld(unsigned* p)              { return __hip_atomic_load(p, __ATOMIC_RELAXED, __HIP_MEMORY_SCOPE_AGENT); }
__device__ __forceinline__ unsigned xb_add(unsigned* p, unsigned v) { return __hip_atomic_fetch_add(p, v, __ATOMIC_RELAXED, __HIP_MEMORY_SCOPE_AGENT); }
__device__ __forceinline__ unsigned xb_xcc_id() { return (unsigned)__builtin_amdgcn_s_getreg((3 << 11) | 20) & 0xFu; }
#define XB_SPIN(cond, bar) do { unsigned _sp = 0; while (cond) { __builtin_amdgcn_s_sleep(1); \
    if ((++_sp & 255u) == 0u) { if (xb_ld(&(bar)[XB_TMO])) break; if (_sp > XB_SPIN_CAP) { atomicAdd(&(bar)[XB_TMO], 1u); break; } } } } while (0)

struct XcdBarrier {
    unsigned* bar; unsigned x;
    volatile LAS unsigned* st;
};

__device__ __forceinline__ XcdBarrier xcd_barrier_post(unsigned* bar, volatile LAS unsigned* st) {
    XcdBarrier b; b.bar = bar; b.x = xb_xcc_id(); b.st = st;
    if (threadIdx.x == 0) (void)xb_add(&bar[XB_XCNT(b.x)], 1u);
    return b;
}
__device__ __forceinline__ void xcd_barrier_complete(unsigned* bar, unsigned x, unsigned& nloc, unsigned& nx) {
    const unsigned G = gridDim.x * gridDim.y * gridDim.z;
    unsigned sum, cnt, mine, sp = 0u;
    for (;;) {
        sum = 0u; cnt = 0u; mine = 0u;
#pragma unroll
        for (unsigned j = 0; j < 16; ++j) { const unsigned c = xb_ld(&bar[XB_XCNT(j)]); sum += c; cnt += (c > 0u) ? 1u : 0u; mine = (j == x) ? c : mine; }
        if (sum == G) break;
        __builtin_amdgcn_s_sleep(1);
        if ((++sp & 255u) == 0u) { if (xb_ld(&bar[XB_TMO])) break; if (sp > XB_SPIN_CAP) { atomicAdd(&bar[XB_TMO], 1u); break; } }
    }
    nloc = mine > 0u ? mine : 1u; nx = cnt > 0u ? cnt : 1u;
}

__device__ __forceinline__ void xcd_barrier(const XcdBarrier& b) {
    asm volatile("s_waitcnt vmcnt(0)" ::: "memory");
    __syncthreads();
    if (threadIdx.x == 0) {
        unsigned* bar = b.bar;
        __builtin_amdgcn_s_waitcnt(0);
        unsigned nloc = b.st[0], nx = b.st[1];
        if (nloc == 0u) { xcd_barrier_complete(bar, b.x, nloc, nx); b.st[0] = nloc; b.st[1] = nx; }
        const unsigned old = xb_add(&bar[XB_XSUB(b.x)], 1u);
        const unsigned gen = old / nloc;
        if (old + 1u == (gen + 1u) * nloc) {
            __builtin_amdgcn_fence(__ATOMIC_RELEASE, "agent");
            asm volatile("s_waitcnt vmcnt(0)" ::: "memory");
            const unsigned og = xb_add(&bar[XB_TOP], 1u);
            const unsigned tg = og / nx;
            if (og + 1u == (tg + 1u) * nx) xb_add(&bar[XB_TOPGEN], 1u);
            else XB_SPIN(xb_ld(&bar[XB_TOPGEN]) == tg, bar);
            __builtin_amdgcn_fence(__ATOMIC_ACQUIRE, "agent");
            xb_add(&bar[XB_XGEN(b.x)], 1u);
            asm volatile("s_waitcnt vmcnt(0)" ::: "memory");
        } else {
            XB_SPIN(xb_ld(&bar[XB_XGEN(b.x)]) == gen, bar);
            __builtin_amdgcn_fence(__ATOMIC_ACQUIRE, "agent");
            asm volatile("s_waitcnt vmcnt(0)" ::: "memory");
        }
    }
    __syncthreads();
}
#ifndef BR_MB
#define BR_MB 2
#endif
#ifndef RS_MB
#define RS_MB 2
#endif
#ifndef DN_MB
#define DN_MB 2
#endif
namespace pg8 {
#ifndef PROBE_WHICH
#define PROBE_WHICH 0
#endif
struct EpiProj {
    static constexpr bool PERM = true, MIDK = false; static constexpr int PSLOT = (PROBE_WHICH == 2);
    bf16_t* qkv;
    bf16_t* ga; bf16_t* gb;
    const float* gq; const float* gk;
    float* kmean;
    __device__ __forceinline__ void operator()(const f32x4 (&acc)[2][2][4][2], const Unit& u, int wr, int wc, int fr, int fq) const {
        const int pn = u.pn; const int row0 = u.pm * BM + wr * 64 + fr;
        if (pn < 4) {
            const bool isq = pn < 2; const float* gv = isq ? gq : gk; const float post = isq ? C2 : 1.0f;
            bf16_t* base = qkv + (size_t)(pn >> 1) * ((size_t)NTOK * WATT) + (pn & 1) * 256 + wc * 64 + 8 * fq;
            float g[2][2][4];
#pragma unroll
            for (int bj = 0; bj < 2; ++bj)
#pragma unroll
                for (int n = 0; n < 2; ++n) { const f32x4 t = *(const f32x4*)(gv + 32 * bj + 8 * fq + 4 * n); g[bj][n][0] = t[0] * post; g[bj][n][1] = t[1] * post; g[bj][n][2] = t[2] * post; g[bj][n][3] = t[3] * post; }
            float cs[2][2][4];
#pragma unroll
            for (int bj = 0; bj < 2; ++bj)
#pragma unroll
                for (int n = 0; n < 2; ++n)
#pragma unroll
                    for (int e = 0; e < 4; ++e) cs[bj][n][e] = 0.f;
#pragma unroll
            for (int ai = 0; ai < 2; ++ai)
#pragma unroll
                for (int m = 0; m < 4; ++m) {
                    float ss = 0.f;
#pragma unroll
                    for (int bj = 0; bj < 2; ++bj)
#pragma unroll
                        for (int n = 0; n < 2; ++n) { const f32x4 x = acc[ai][bj][m][n]; ss += (x[0] * x[0] + x[1] * x[1]) + (x[2] * x[2] + x[3] * x[3]); }
                    ss += __shfl_xor(ss, 16); ss += __shfl_xor(ss, 32);
                    const float rstd = __builtin_amdgcn_rsqf(ss * (1.0f / 64.0f) + RMS_EPS);
                    bf16_t* rowp = base + (size_t)(row0 + ai * HALF + m * 16) * WATT;
#pragma unroll
                    for (int bj = 0; bj < 2; ++bj) { float o[2][4];
#pragma unroll
                        for (int n = 0; n < 2; ++n)
#pragma unroll
                            for (int e = 0; e < 4; ++e) { o[n][e] = acc[ai][bj][m][n][e] * rstd * g[bj][n][e]; cs[bj][n][e] += o[n][e]; }
                        u32x4 w; w.x = cvt_pk_bf16(o[0][0], o[0][1]); w.y = cvt_pk_bf16(o[0][2], o[0][3]); w.z = cvt_pk_bf16(o[1][0], o[1][1]); w.w = cvt_pk_bf16(o[1][2], o[1][3]);
                        *(u32x4*)(rowp + 32 * bj) = w; }
                }
            if (!isq) {
#pragma unroll
                for (int bj = 0; bj < 2; ++bj)
#pragma unroll
                    for (int n = 0; n < 2; ++n)
#pragma unroll
                        for (int e = 0; e < 4; ++e) { float v = cs[bj][n][e]; v += __shfl_xor(v, 1); v += __shfl_xor(v, 2); v += __shfl_xor(v, 4); v += __shfl_xor(v, 8); cs[bj][n][e] = v; }
                if (fr == 0) { float* kp = kmean + ((size_t)u.pm * NH + (pn & 1) * 4 + wc) * HD + 8 * fq;
#pragma unroll
                    for (int bj = 0; bj < 2; ++bj)
#pragma unroll
                        for (int n = 0; n < 2; ++n)
#pragma unroll
                            for (int e = 0; e < 4; ++e) atomicAdd(kp + 32 * bj + 4 * n + e, cs[bj][n][e]); }
            }
        } else {
            const bool isg = pn >= 12; const float sc = (pn == 6 || pn == 7) ? C2 : 1.0f;
            bf16_t* base; int ldc;
            if (isg) { base = (pn < 16 ? ga : gb) + (pn & 3) * 256 + wc * 64 + 8 * fq; ldc = D; }
            else { base = qkv + (size_t)(pn >> 1) * ((size_t)NTOK * WATT) + (pn & 1) * 256 + wc * 64 + 8 * fq; ldc = WATT; }
#pragma unroll
            for (int ai = 0; ai < 2; ++ai)
#pragma unroll
                for (int m = 0; m < 4; ++m) { bf16_t* rowp = base + (size_t)(row0 + ai * HALF + m * 16) * ldc;
#pragma unroll
                    for (int bj = 0; bj < 2; ++bj) { f32x4 v0 = acc[ai][bj][m][0], v1 = acc[ai][bj][m][1];
                        if (isg) {
#pragma unroll
                            for (int e = 0; e < 4; ++e) { v0[e] = __builtin_amdgcn_rcpf(1.0f + __builtin_amdgcn_exp2f(-v0[e] * LOG2E)); v1[e] = __builtin_amdgcn_rcpf(1.0f + __builtin_amdgcn_exp2f(-v1[e] * LOG2E)); } }
                        else { v0 = v0 * sc; v1 = v1 * sc; }
                        u32x4 w; w.x = cvt_pk_bf16(v0[0], v0[1]); w.y = cvt_pk_bf16(v0[2], v0[3]); w.z = cvt_pk_bf16(v1[0], v1[1]); w.w = cvt_pk_bf16(v1[2], v1[3]);
                        *(u32x4*)(rowp + 32 * bj) = w; } }
        }
    }
};

template <int MODE> struct EpiBranch {
    static constexpr bool PERM = true, MIDK = false; static constexpr int PSLOT = 0;
    bf16_t* sg; const bf16_t* tin;
    __device__ __forceinline__ void operator()(const f32x4 (&acc)[2][2][4][2], const Unit& u, int wr, int wc, int fr, int fq) const {
        const int row0 = u.pm * BM + wr * 64 + fr, col0 = u.pn * BM + wc * 32 + 8 * fq;
#pragma unroll
        for (int ai = 0; ai < 2; ++ai)
#pragma unroll
        for (int mb = 0; mb < 4; mb += BR_MB) { u32x4 gw[4][2], tw[4][2];
#pragma unroll
            for (int m = mb; m < mb + BR_MB; ++m) { const size_t off = (size_t)(row0 + ai * HALF + m * 16) * D + col0;
#pragma unroll
                for (int bj = 0; bj < 2; ++bj) { gw[m][bj] = *(const u32x4*)(sg + off + bj * HALF); if (MODE == 1) tw[m][bj] = *(const u32x4*)(tin + off + bj * HALF); else tw[m][bj] = (u32x4){0u, 0u, 0u, 0u}; } }
#pragma unroll
            for (int m = mb; m < mb + BR_MB; ++m) { const size_t off = (size_t)(row0 + ai * HALF + m * 16) * D + col0;
#pragma unroll
                for (int bj = 0; bj < 2; ++bj) { const u32x4 g = gw[m][bj], t = tw[m][bj];
                    const f32x4 v0 = acc[ai][bj][m][0], v1 = acc[ai][bj][m][1]; float o[8];
                    o[0] = bflo(g.x) * v0[0]; o[1] = bfhi(g.x) * v0[1]; o[2] = bflo(g.y) * v0[2]; o[3] = bfhi(g.y) * v0[3];
                    o[4] = bflo(g.z) * v1[0]; o[5] = bfhi(g.z) * v1[1]; o[6] = bflo(g.w) * v1[2]; o[7] = bfhi(g.w) * v1[3];
                    if (MODE == 1) { o[0] += bflo(t.x); o[1] += bfhi(t.x); o[2] += bflo(t.y); o[3] += bfhi(t.y); o[4] += bflo(t.z); o[5] += bfhi(t.z); o[6] += bflo(t.w); o[7] += bfhi(t.w); }
                    u32x4 w; w.x = cvt_pk_bf16(o[0], o[1]); w.y = cvt_pk_bf16(o[2], o[3]); w.z = cvt_pk_bf16(o[4], o[5]); w.w = cvt_pk_bf16(o[6], o[7]);
                    *(u32x4*)(sg + off + bj * HALF) = w; } } }
    }
};

struct EpiMerge {
    static constexpr bool PERM = true, MIDK = true; static constexpr int PSLOT = (PROBE_WHICH == 4);
    const bf16_t* sga; bf16_t* sgb;
    __device__ __forceinline__ void mid(f32x4 (&acc)[2][2][4][2], const Unit& u, int wr, int wc, int fr, int fq) const {
        int oz; asm volatile("v_mov_b32 %0, 0" : "=v"(oz));
        const int row0 = u.pm * BM + wr * 64 + fr + oz, col0 = u.pn * BM + wc * 32 + 8 * fq;
#pragma unroll
        for (int ai = 0; ai < 2; ++ai)
#pragma unroll
            for (int m = 0; m < 4; ++m) { const size_t off = (size_t)(row0 + ai * HALF + m * 16) * D + col0;
#pragma unroll
                for (int bj = 0; bj < 2; ++bj) { const u32x4 a = *(const u32x4*)(sga + off + bj * HALF), b = *(const u32x4*)(sgb + off + bj * HALF); f32x4& v0 = acc[ai][bj][m][0]; f32x4& v1 = acc[ai][bj][m][1];
                    v0[0] *= bflo(a.x) * __builtin_amdgcn_rcpf(bflo(b.x)); v0[1] *= bfhi(a.x) * __builtin_amdgcn_rcpf(bfhi(b.x)); v0[2] *= bflo(a.y) * __builtin_amdgcn_rcpf(bflo(b.y)); v0[3] *= bfhi(a.y) * __builtin_amdgcn_rcpf(bfhi(b.y));
                    v1[0] *= bflo(a.z) * __builtin_amdgcn_rcpf(bflo(b.z)); v1[1] *= bfhi(a.z) * __builtin_amdgcn_rcpf(bfhi(b.z)); v1[2] *= bflo(a.w) * __builtin_amdgcn_rcpf(bflo(b.w)); v1[3] *= bfhi(a.w) * __builtin_amdgcn_rcpf(bfhi(b.w)); }
                asm volatile("" : "+v"(acc[ai][0][m][0]), "+v"(acc[ai][0][m][1]), "+v"(acc[ai][1][m][0]), "+v"(acc[ai][1][m][1]) :: "memory"); }
    }
    __device__ __forceinline__ void operator()(const f32x4 (&acc)[2][2][4][2], const Unit& u, int wr, int wc, int fr, int fq) const {
        const int row0 = u.pm * BM + wr * 64 + fr, col0 = u.pn * BM + wc * 32 + 8 * fq;
#pragma unroll
        for (int ai = 0; ai < 2; ++ai)
#pragma unroll
            for (int mb = 0; mb < 4; mb += 2) { u32x4 gb[2][2];
#pragma unroll
                for (int mm = 0; mm < 2; ++mm) { const size_t off = (size_t)(row0 + ai * HALF + (mb + mm) * 16) * D + col0;
#pragma unroll
                    for (int bj = 0; bj < 2; ++bj) gb[mm][bj] = *(const u32x4*)(sgb + off + bj * HALF); }
#pragma unroll
                for (int mm = 0; mm < 2; ++mm) { const size_t off = (size_t)(row0 + ai * HALF + (mb + mm) * 16) * D + col0;
#pragma unroll
                    for (int bj = 0; bj < 2; ++bj) { const u32x4 b = gb[mm][bj]; const f32x4 v0 = acc[ai][bj][mb + mm][0], v1 = acc[ai][bj][mb + mm][1];
                        u32x4 w; w.x = cvt_pk_bf16(bflo(b.x) * v0[0], bfhi(b.x) * v0[1]); w.y = cvt_pk_bf16(bflo(b.y) * v0[2], bfhi(b.y) * v0[3]); w.z = cvt_pk_bf16(bflo(b.z) * v1[0], bfhi(b.z) * v1[1]); w.w = cvt_pk_bf16(bflo(b.w) * v1[2], bfhi(b.w) * v1[3]);
                        *(u32x4*)(sgb + off + bj * HALF) = w; } } }
    }
};

struct EpiResid {
    static constexpr bool PERM = false, MIDK = false; static constexpr int PSLOT = (PROBE_WHICH == 5);
    const float* x; float* out; const float* gt;
    float* stats;
    __device__ __forceinline__ void operator()(const f32x4 (&acc)[2][2][4][2], const Unit& u, int wr, int wc, int fr, int fq) const {
        const int row0 = u.pm * BM + wr * 64 + fr, col0 = u.pn * BM + wc * 32 + 4 * fq; const int b = (u.pm * BM) / SEQ;
        f32x4 gv[2][2];
#pragma unroll
        for (int bj = 0; bj < 2; ++bj)
#pragma unroll
            for (int n = 0; n < 2; ++n) gv[bj][n] = *(const f32x4*)(gt + (size_t)b * (NMOD * D) + col0 + bj * HALF + n * 16);
#pragma unroll
        for (int ai = 0; ai < 2; ++ai)
#pragma unroll
        for (int mb = 0; mb < 4; mb += RS_MB) { f32x4 xv[4][2][2];
#pragma unroll
            for (int m = mb; m < mb + RS_MB; ++m) { const size_t off = (size_t)(row0 + ai * HALF + m * 16) * D + col0;
#pragma unroll
                for (int bj = 0; bj < 2; ++bj)
#pragma unroll
                    for (int n = 0; n < 2; ++n) xv[m][bj][n] = *(const f32x4*)(x + off + bj * HALF + n * 16); }
#pragma unroll
            for (int m = mb; m < mb + RS_MB; ++m) { const int row = row0 + ai * HALF + m * 16; const size_t off = (size_t)row * D + col0; float ss = 0.f;
#pragma unroll
                for (int bj = 0; bj < 2; ++bj)
#pragma unroll
                    for (int n = 0; n < 2; ++n) { const f32x4 o = xv[m][bj][n] + gv[bj][n] * acc[ai][bj][m][n];
                        *(f32x4*)(out + off + bj * HALF + n * 16) = o; ss += (o[0] * o[0] + o[1] * o[1]) + (o[2] * o[2] + o[3] * o[3]); }
                ss += __shfl_xor(ss, 16); ss += __shfl_xor(ss, 32);
                if (fq == 0) stats[(size_t)row * 16 + u.pn * 4 + wc] = ss; } }
    }
};

struct EpiGateUp {
    static constexpr bool PERM = true, MIDK = false; static constexpr int PSLOT = (PROBE_WHICH == 7);
    bf16_t* H;
    __device__ __forceinline__ void operator()(const f32x4 (&acc)[2][2][4][2], const Unit& u, int wr, int wc, int fr, int fq) const {
        bf16_t* base = H + (size_t)(u.arow + wr * 64 + fr) * DEXP + u.pn * 128 + wc * 32 + 8 * fq;
#pragma unroll
        for (int ai = 0; ai < 2; ++ai)
#pragma unroll
            for (int m = 0; m < 4; ++m) { float o[8];
#pragma unroll
                for (int n = 0; n < 2; ++n)
#pragma unroll
                    for (int e = 0; e < 4; ++e) { const float gg = acc[ai][0][m][n][e], uu = acc[ai][1][m][n][e]; o[4 * n + e] = gg * __builtin_amdgcn_rcpf(1.0f + __builtin_amdgcn_exp2f(-gg * LOG2E)) * uu; }
                u32x4 w; w.x = cvt_pk_bf16(o[0], o[1]); w.y = cvt_pk_bf16(o[2], o[3]); w.z = cvt_pk_bf16(o[4], o[5]); w.w = cvt_pk_bf16(o[6], o[7]);
                *(u32x4*)(base + (size_t)(ai * HALF + m * 16) * DEXP) = w; }
    }
};

struct EpiDown {
    static constexpr bool PERM = false, MIDK = false; static constexpr int PSLOT = 0;
    float* out; const float* gt;
    const int* tl; const float* wl;
    __device__ __forceinline__ void operator()(const f32x4 (&acc)[2][2][4][2], const Unit& u, int wr, int wc, int fr, int fq) const {
        const int col0 = u.pn * BM + wc * 32 + 4 * fq;
        int tok[2][4]; float wv[2][4];
#pragma unroll
        for (int ai = 0; ai < 2; ++ai)
#pragma unroll
            for (int m = 0; m < 4; ++m) { const int r = ai * HALF + wr * 64 + m * 16 + fr; const int rr = r < u.x1 ? r : u.x1 - 1; tok[ai][m] = tl[u.x0 + rr]; wv[ai][m] = wl[u.x0 + rr]; }
#pragma unroll
        for (int ai = 0; ai < 2; ++ai)
#pragma unroll
        for (int mb = 0; mb < 4; mb += DN_MB) { f32x4 ov[4][2][2];
#pragma unroll
            for (int m = mb; m < mb + DN_MB; ++m) { const float* op = out + (size_t)tok[ai][m] * D + col0;
#pragma unroll
                for (int bj = 0; bj < 2; ++bj)
#pragma unroll
                    for (int n = 0; n < 2; ++n) ov[m][bj][n] = *(const f32x4*)(op + bj * HALF + n * 16); }
#pragma unroll
            for (int m = mb; m < mb + DN_MB; ++m) { const int r = ai * HALF + wr * 64 + m * 16 + fr; const int tk = tok[ai][m]; const float* gp = gt + (size_t)(tk / SEQ) * (NMOD * D) + col0; f32x4 gv[2][2];
#pragma unroll
                for (int bj = 0; bj < 2; ++bj)
#pragma unroll
                    for (int n = 0; n < 2; ++n) gv[bj][n] = *(const f32x4*)(gp + bj * HALF + n * 16);
                if (r < u.x1) { float* op = out + (size_t)tk * D + col0; const float w = wv[ai][m];
#pragma unroll
                    for (int bj = 0; bj < 2; ++bj)
#pragma unroll
                        for (int n = 0; n < 2; ++n) *(f32x4*)(op + bj * HALF + n * 16) = ov[m][bj][n] + gv[bj][n] * (acc[ai][bj][m][n] * w); } } }
    }
};

struct EpiY {
    static constexpr bool PERM = true, MIDK = false; static constexpr int PSLOT = (PROBE_WHICH == 8);
    bf16_t* Y;
    __device__ __forceinline__ void operator()(const f32x4 (&acc)[2][2][4][2], const Unit& u, int wr, int wc, int fr, int fq) const {
        bf16_t* base = Y + (size_t)(u.arow + wr * 64 + fr) * D + u.pn * BM + wc * 32 + 8 * fq;
#pragma unroll
        for (int ai = 0; ai < 2; ++ai)
#pragma unroll
            for (int m = 0; m < 4; ++m) { bf16_t* rowp = base + (size_t)(ai * HALF + m * 16) * D;
#pragma unroll
                for (int bj = 0; bj < 2; ++bj) { const f32x4 v0 = acc[ai][bj][m][0], v1 = acc[ai][bj][m][1];
                    u32x4 w; w.x = cvt_pk_bf16(v0[0], v0[1]); w.y = cvt_pk_bf16(v0[2], v0[3]); w.z = cvt_pk_bf16(v1[0], v1[1]); w.w = cvt_pk_bf16(v1[2], v1[3]);
                    *(u32x4*)(rowp + bj * HALF) = w; } }
    }
};
struct EpiNull {
    static constexpr bool PERM = false, MIDK = false; static constexpr int PSLOT = 0;
    bf16_t* dummy;
    __device__ __forceinline__ void operator()(const f32x4 (&acc)[2][2][4][2], const Unit& u, int wr, int wc, int fr, int fq) const {
        f32x4 s = {0.f, 0.f, 0.f, 0.f};
#pragma unroll
        for (int ai = 0; ai < 2; ++ai)
#pragma unroll
            for (int bj = 0; bj < 2; ++bj)
#pragma unroll
                for (int m = 0; m < 4; ++m)
#pragma unroll
                    for (int n = 0; n < 2; ++n) s += acc[ai][bj][m][n];
        *(f32x4*)((float*)dummy + (size_t)(blockIdx.x * 512 + threadIdx.x) * 4) = s;
    }
};
struct GateUpOrder {
    const PG8_LAS int* T; const int* tokl; int G, c;
    __device__ bool next(int i, Unit& u) const {
        const int L = i * G + c; const int total = T[64 + 32] * 4; if (L >= total) return false;
        const int rt = L >> 2; int e = 0; while (T[64 + e + 1] <= rt) ++e;
        const int lt = rt - T[64 + e];
        u.pm = lt; u.pn = L & 3; u.x0 = e; u.x1 = 0; u.arow = T[128 + e] + lt * 256; u.brow = e * 1024 + (L & 3) * 256; return true;
    }
    __device__ __forceinline__ int arow_of(const Unit& u, int r) const {
        const int idx = u.pm * 256 + r, c0 = T[u.x0], c1 = T[32 + u.x0];
        int tok = 0;
        if (idx < c0) tok = tokl[(size_t)u.x0 * LCAP + idx]; else if (idx < c0 + c1) tok = tokl[(size_t)(NEXP + u.x0) * LCAP + idx - c0];
        return tok;
    }
};
struct DownAllOrder {
    const PG8_LAS int* T; int G, c;
    __device__ bool next(int i, Unit& u) const {
        const int L = i * G + c; const int total = T[64 + 32] * 4; if (L >= total) return false;
        const int rt = L >> 2; int e = 0; while (T[64 + e + 1] <= rt) ++e;
        const int lt = rt - T[64 + e];
        u.pm = lt; u.pn = L & 3; u.x0 = e; u.x1 = 0; u.arow = T[128 + e] + lt * 256; u.brow = e * 1024 + (L & 3) * 256; return true;
    }
    __device__ __forceinline__ int arow_of(const Unit&, int) const { return 0; }
};
template <int SLOT> struct DownOrder {
    const PG8_LAS int* T; int G, c;
    __device__ bool next(int i, Unit& u) const {
        const int PO = SLOT ? 256 : 192; const int L = i * G + c; const int total = T[PO + 32] * 4; if (L >= total) return false;
        const int rt = L >> 2; int e = 0; while (T[PO + e + 1] <= rt) ++e;
        const int lt = rt - T[PO + e]; const int cs = T[SLOT * 32 + e]; const int rem = cs - lt * 256;
        u.pm = lt; u.pn = L & 3; u.x0 = (SLOT * NEXP + e) * LCAP + lt * 256; u.x1 = rem < 256 ? rem : 256;
        u.arow = T[128 + e] + (SLOT ? T[e] : 0) + lt * 256; u.brow = e * 1024 + (L & 3) * 256; return true;
    }
    __device__ __forceinline__ int arow_of(const Unit&, int) const { return 0; }
};
}
namespace attn {
using bf16x8 = __attribute__((ext_vector_type(8))) short;
using s16x4 = __attribute__((ext_vector_type(4))) short;
using f32x16 = __attribute__((ext_vector_type(16))) float;
using f32x4v = __attribute__((ext_vector_type(4))) float;
using u32x4 = __attribute__((ext_vector_type(4))) unsigned;
typedef unsigned short bf16;
constexpr int DM = 512, QBLK = 32, NW = 8, QB = 256, KVBLK = 64;
constexpr int NSLOT = 3, SLOTB = 8192;
constexpr int LDS_K = 0, LDS_V = NSLOT * SLOTB, LDS_WS = 2 * NSLOT * SLOTB, LDS_OST = LDS_WS + NW * 64 * 4, LDS_BT = LDS_OST + NW * 4096;
constexpr int REV = 896, BT_LEN = 1168, COPYB = BT_LEN * 4, NEG_OFF = 4 * COPYB, BT_BYTES = NEG_OFF + 256;
constexpr int LDS_BYTES = LDS_BT + BT_BYTES;
static_assert(BT_LEN >= REV + 256 + 8 + 3 && COPYB % 16 == 0 && LDS_BT % 16 == 0, "bias image");
#define SBAR() __builtin_amdgcn_sched_barrier(0)
#define WAIT_BAR(N) asm volatile("s_waitcnt vmcnt(" #N ") lgkmcnt(0)\n\ts_barrier":::"memory")
typedef __attribute__((address_space(3))) const char* lds_cptr;
typedef short v4i16_t __attribute__((ext_vector_type(4)));
typedef float f32x2_t __attribute__((ext_vector_type(2))); typedef __bf16 bf16x2_t __attribute__((ext_vector_type(2)));
__device__ __forceinline__ int crow(int r, int hi) { return (r & 3) + 8 * (r >> 2) + 4 * hi; }
__device__ __forceinline__ void glds16(const void* gsrc, unsigned lds_dst) { unsigned keep;
  asm volatile("s_mov_b32 %0, m0\n\ts_mov_b32 m0, %2\n\ts_nop 0\n\tglobal_load_lds_dwordx4 %1, off\n\ts_mov_b32 m0, %0" : "=&s"(keep) : "v"(gsrc), "s"(lds_dst) : "memory"); }
__device__ __forceinline__ unsigned cvtpk_s(float lo, float hi) { f32x2_t v = {lo, hi}; bf16x2_t b = __builtin_convertvector(v, bf16x2_t); return __builtin_bit_cast(unsigned, b); }
__device__ __forceinline__ void kload8(bf16x8* kf, lds_cptr kp) {
  kf[0] = *(const __attribute__((address_space(3))) bf16x8*)(kp);        kf[1] = *(const __attribute__((address_space(3))) bf16x8*)(kp + 512);
  kf[2] = *(const __attribute__((address_space(3))) bf16x8*)(kp + 2048); kf[3] = *(const __attribute__((address_space(3))) bf16x8*)(kp + 2560);
  kf[4] = *(const __attribute__((address_space(3))) bf16x8*)(kp + 4096); kf[5] = *(const __attribute__((address_space(3))) bf16x8*)(kp + 4608);
  kf[6] = *(const __attribute__((address_space(3))) bf16x8*)(kp + 6144); kf[7] = *(const __attribute__((address_space(3))) bf16x8*)(kp + 6656);
}
__device__ __forceinline__ void kload2(bf16x8* kf, lds_cptr kp, int j) { kf[2 * j] = *(const __attribute__((address_space(3))) bf16x8*)(kp + j * 2048); kf[2 * j + 1] = *(const __attribute__((address_space(3))) bf16x8*)(kp + j * 2048 + 512); }
__device__ __forceinline__ s16x4 vtr(lds_cptr p) { return __builtin_bit_cast(s16x4, __builtin_amdgcn_ds_read_tr16_b64_v4i16((__attribute__((address_space(3))) v4i16_t*)p)); }
__device__ __forceinline__ f32x4v ldsf4(lds_cptr p) { return *(const __attribute__((address_space(3))) f32x4v*)p; }
#define MFMA32(a, b, c) __builtin_amdgcn_mfma_f32_32x32x16_bf16(a, b, c, 0, 0, 0)
__device__ __forceinline__ void pv(f32x16* o, int vb, bf16x8 pa0, bf16x8 pa1, bf16x8 pa2, bf16x8 pa3) {
  #pragma unroll
  for (int d0 = 0; d0 < 2; ++d0) { s16x4 lo[4], hi[4];
    #pragma unroll
    for (int ks = 0; ks < 4; ++ks) {
      asm volatile("ds_read_b64_tr_b16 %0,%1 offset:%c2" : "=&v"(lo[ks]) : "v"(vb), "i"(d0 * 4096 + ks * 1024) : "memory");
      asm volatile("ds_read_b64_tr_b16 %0,%1 offset:%c2" : "=&v"(hi[ks]) : "v"(vb), "i"(d0 * 4096 + ks * 1024 + 512) : "memory"); }
    asm volatile("s_waitcnt lgkmcnt(0)" ::: "memory"); SBAR();
    #define PK(k) (bf16x8){lo[k][0], lo[k][1], lo[k][2], lo[k][3], hi[k][0], hi[k][1], hi[k][2], hi[k][3]}
    o[d0] = MFMA32(pa0, PK(0), o[d0]); o[d0] = MFMA32(pa1, PK(1), o[d0]); o[d0] = MFMA32(pa2, PK(2), o[d0]); o[d0] = MFMA32(pa3, PK(3), o[d0]);
    #undef PK
  }
}
#define ATTN_STORE16(p, v) (*(u32x4*)(p) = (v))

__device__ __forceinline__ void moba_unit(int b, int h, int qb, const bf16* Q, const bf16* __restrict__ K, const bf16* __restrict__ V, bf16* O, const float* __restrict__ ksum, char* shm, int opitch) {
  const int tid = threadIdx.x, lane = tid & 63, r32 = lane & 31, hi = lane >> 5; const int wid = __builtin_amdgcn_readfirstlane(tid >> 6);
  const long rowbase = (long)b * 4096; const int q0 = qb * QB;
  const bf16* Qw = Q + (rowbase + q0 + wid * QBLK) * DM + h * 64;
  const bf16* Kh = K + rowbase * DM + h * 64, *Vh = V + rowbase * DM + h * 64;
  const unsigned lds0 = (unsigned)(uintptr_t)shm;
  float* wsf = (float*)(shm + LDS_WS) + wid * 64;
  const lds_cptr shm3 = (lds_cptr)shm;
  if (tid < 128) { const int j = tid >> 3, c = tid & 7; f32x4v a = {0.f, 0.f, 0.f, 0.f}, bq = {0.f, 0.f, 0.f, 0.f};
    if (j < qb) { const f32x4v* kp = (const f32x4v*)(ksum + ((size_t)(b * 16 + j) * 8 + h) * 64 + c * 8); a = kp[0]; bq = kp[1]; }
    const float v[8] = {a[0], a[1], a[2], a[3], bq[0], bq[1], bq[2], bq[3]}; unsigned hw[4], lw[4];
    #pragma unroll
    for (int i = 0; i < 4; ++i) { const unsigned hp = cvtpk_s(v[2 * i], v[2 * i + 1]); const float r0 = v[2 * i] - __uint_as_float(hp << 16), r1 = v[2 * i + 1] - __uint_as_float(hp & 0xffff0000u); hw[i] = hp; lw[i] = cvtpk_s(r0, r1); }
    *(__attribute__((address_space(3))) u32x4*)(shm3 + LDS_OST + c * 1024 + j * 16) = (u32x4){hw[0], hw[1], hw[2], hw[3]};
    *(__attribute__((address_space(3))) u32x4*)(shm3 + LDS_OST + 8192 + c * 1024 + j * 16) = (u32x4){lw[0], lw[1], lw[2], lw[3]}; }
  asm volatile("s_waitcnt vmcnt(0)" ::: "memory");
  const bf16* ksrc = Kh + (long)lane * DM + wid * 8;
  const bf16* vsrc = Vh + (long)(16 * (wid & 3) + (lane >> 2)) * DM + (wid >> 2) * 32 + (lane & 3) * 8;
  const unsigned kdst = lds0 + LDS_K + wid * 1024, vdst = lds0 + LDS_V + wid * 1024;
  #define DMA_K(t, slot) glds16(ksrc + (long)(t) * KVBLK * DM, (unsigned)__builtin_amdgcn_readfirstlane(kdst + (slot)))
  #define DMA_V(t, slot) glds16(vsrc + (long)(t) * KVBLK * DM, (unsigned)__builtin_amdgcn_readfirstlane(vdst + (slot)))
  const int vb0 = (int)(lds0 + LDS_V) + ((lane >> 4) & 1) * 32 + (lane & 3) * 8 + (4 * hi + ((lane & 15) >> 2)) * 64;
  bf16x8 kf[8];
  const lds_cptr kp0 = shm3 + LDS_K + hi * 1024 + r32 * 16; const lds_cptr vp0 = shm3 + LDS_V + ((lane >> 4) & 1) * 32 + (lane & 3) * 8 + (4 * hi + ((lane & 15) >> 2)) * 64;
  const int NT = (q0 + QB) / KVBLK;
  DMA_K(0, 0); DMA_V(0, 0); DMA_K(1, SLOTB);
  bf16x8 qr[4];
  #pragma unroll
  for (int d0 = 0; d0 < 4; ++d0) qr[d0] = *reinterpret_cast<const bf16x8*>(&Qw[(long)r32 * DM + d0 * 16 + hi * 8]);
  float l_reg = 0.f; f32x16 o[2]; o[0] = f32x16{}; o[1] = f32x16{};
  const int tq = q0 + wid * QBLK + r32, acp = (REV - tq) & 3;
  const int cbase = LDS_BT + acp * COPYB; int baddr = cbase + 4 * (REV - tq + 4 * hi - acp);
  DMA_K(2, 2 * SLOTB);
  WAIT_BAR(3);
  unsigned selmask;
  { f32x16 ga = f32x16{};
    #pragma unroll
    for (int d0 = 0; d0 < 4; ++d0) { const bf16x8 ah = *(const __attribute__((address_space(3))) bf16x8*)(shm3 + LDS_OST + hi * 1024 + r32 * 16 + d0 * 2048);
      const bf16x8 al = *(const __attribute__((address_space(3))) bf16x8*)(shm3 + LDS_OST + 8192 + hi * 1024 + r32 * 16 + d0 * 2048);
      ga = MFMA32(ah, qr[d0], ga); ga = MFMA32(al, qr[d0], ga); }
    float G[16];
    #pragma unroll
    for (int r = 0; r < 8; ++r) { auto rr = __builtin_amdgcn_permlane32_swap(__float_as_uint(ga[r]), __float_as_uint(ga[r]), false, false);
      G[(r & 3) + 8 * (r >> 2)] = __uint_as_float(rr[0]); G[(r & 3) + 8 * (r >> 2) + 4] = __uint_as_float(rr[1]); }
    #pragma unroll
    for (int j = 0; j < 16; ++j) if (j >= qb) G[j] = -INFINITY;
    selmask = 1u << qb;
    #pragma unroll
    for (int pass = 0; pass < 3; ++pass) { float best = -INFINITY; int bi = 16;
      #pragma unroll
      for (int j = 0; j < 16; ++j) if (G[j] > best) { best = G[j]; bi = j; }
      if (bi < 16) selmask |= 1u << bi;
      #pragma unroll
      for (int j = 0; j < 16; ++j) if (j == bi) G[j] = -INFINITY; }
  }
  f32x16 pA0, pA1, pB0, pB1;
  #define BEFF(T) (((selmask >> ((T) >> 2)) & 1u) ? (baddr + 256 * (T) > cbase ? baddr + 256 * (T) : cbase) : (LDS_BT + NEG_OFF))
  #define BRD1(X0, X1, eff, i) do { const f32x4v bv_ = ldsf4(shm3 + (eff) + ((i) < 4 ? 32 * (i) : 128 + 32 * ((i) - 4))); \
      if ((i) < 4) { X0[4 * (i)] = bv_[0]; X0[4 * (i) + 1] = bv_[1]; X0[4 * (i) + 2] = bv_[2]; X0[4 * (i) + 3] = bv_[3]; } \
      else { X1[4 * ((i) - 4)] = bv_[0]; X1[4 * ((i) - 4) + 1] = bv_[1]; X1[4 * ((i) - 4) + 2] = bv_[2]; X1[4 * ((i) - 4) + 3] = bv_[3]; } } while (0)
  { const int e0 = BEFF(0);
    #pragma unroll
    for (int i = 0; i < 8; ++i) BRD1(pA0, pA1, e0, i); }
  int sl_prev = 0, sl_cur = 0, sl_next = SLOTB;
  #define ROT() do { sl_prev = sl_cur; sl_cur = sl_next; sl_next = (sl_next == (NSLOT - 1) * SLOTB) ? 0 : sl_next + SLOTB; } while (0)
  { const char* kb = shm + LDS_K + hi * 1024 + r32 * 16;
    #pragma unroll
    for (int d0 = 0; d0 < 4; ++d0) { const bf16x8 b0 = *reinterpret_cast<const bf16x8*>(kb + d0 * 2048); const bf16x8 b1 = *reinterpret_cast<const bf16x8*>(kb + d0 * 2048 + 512);
      pA0 = MFMA32(b0, qr[d0], pA0); pA1 = MFMA32(b1, qr[d0], pA1); } }
  #pragma unroll
  for (int r = 0; r < 16; ++r) { pA0[r] = __builtin_amdgcn_exp2f(pA0[r]); pA1[r] = __builtin_amdgcn_exp2f(pA1[r]); }
  { const int e1 = BEFF(1);
    #pragma unroll
    for (int i = 0; i < 8; ++i) BRD1(pB0, pB1, e1, i); }
  WAIT_BAR(0);
  DMA_K(3, 0); DMA_V(1, SLOTB);
  ROT();
  kload8(kf, kp0 + sl_cur);
  WAIT_BAR(2);
  s16x4 vlo[8], vhi[8]; u32x4 pw0, pw1, pw2, pw3;
  #define PKW(P, B) cvtpk_s(P[B], P[B + 1])
  #define PAF(k) __builtin_bit_cast(bf16x8, pw##k)
  #define VFR(i) (bf16x8){vlo[i][0], vlo[i][1], vlo[i][2], vlo[i][3], vhi[i][0], vhi[i][1], vhi[i][2], vhi[i][3]}
  #define PIN(x) asm volatile("" : "+v"(x))
  #define GAPA(MF, A0, A1, A2, A3, W0, W1, PW) do { MF; sacc += A0; sacc += A1; sacc += A2; sacc += A3; PIN(sacc); W0; W1; PIN(PW); SBAR(); } while (0)
  #define EX(v) __builtin_amdgcn_exp2f(v)
  #define GAPB(MF, X, B) do { MF; X[B] = EX(X[B]); X[B + 1] = EX(X[B + 1]); X[B + 2] = EX(X[B + 2]); X[B + 3] = EX(X[B + 3]); PIN(X); SBAR(); } while (0)
  #define VRD(i) do { vlo[i] = vtr(vp_ + (((i) >> 2) * 4096 + ((i) & 3) * 1024)); vhi[i] = vtr(vp_ + (((i) >> 2) * 4096 + ((i) & 3) * 1024 + 512)); } while (0)
  #define KRD(G, j) do { if (G) { kload2(kf, kp0 + sl_next, j); SBAR(); } } while (0)
  #define BRD(G, i, X0, X1) do { if (G) { BRD1(X0, X1, eff_, i); } } while (0)
  #define STEP(C0, C1, P0, P1, t, GK, GV, GL) do { SBAR(); \
    const lds_cptr vp_ = vp0 + sl_prev; \
    VRD(0); SBAR(); float sacc = (P0[0] + P0[1]); \
    GAPA(C0 = MFMA32(kf[0], qr[0], C0), P0[2], P0[3], P0[4], P0[5],     pw0[0] = PKW(P0, 0), pw0[1] = PKW(P0, 2), pw0); \
    VRD(4); SBAR(); GAPA(C1 = MFMA32(kf[1], qr[0], C1), P0[6], P0[7], P0[8], P0[9],     pw0[2] = PKW(P0, 4), pw0[3] = PKW(P0, 6), pw0); \
    VRD(1); SBAR(); GAPA(C0 = MFMA32(kf[2], qr[1], C0),   P0[10], P0[11], P0[12], P0[13], pw1[0] = PKW(P0, 8), pw1[1] = PKW(P0, 10), pw1); \
    VRD(5); SBAR(); GAPA(C1 = MFMA32(kf[3], qr[1], C1),   P0[14], P0[15], P1[0], P1[1],   pw1[2] = PKW(P0, 12), pw1[3] = PKW(P0, 14), pw1); \
    VRD(2); SBAR(); GAPA(C0 = MFMA32(kf[4], qr[2], C0),   P1[2], P1[3], P1[4], P1[5],     pw2[0] = PKW(P1, 0), pw2[1] = PKW(P1, 2), pw2); \
    VRD(6); SBAR(); GAPA(C1 = MFMA32(kf[5], qr[2], C1),   P1[6], P1[7], P1[8], P1[9],     pw2[2] = PKW(P1, 4), pw2[3] = PKW(P1, 6), pw2); \
    VRD(3); SBAR(); GAPA(C0 = MFMA32(kf[6], qr[3], C0),   P1[10], P1[11], P1[12], P1[13], pw3[0] = PKW(P1, 8), pw3[1] = PKW(P1, 10), pw3); \
    VRD(7); SBAR(); GAPA(C1 = MFMA32(kf[7], qr[3], C1),   P1[14], P1[15], 0.f, 0.f,       pw3[2] = PKW(P1, 12), pw3[3] = PKW(P1, 14), pw3); \
    l_reg += sacc; \
    if (GK) { DMA_K((t) + 3, sl_cur); } if (GV) { DMA_V((t) + 1, sl_next); } \
    const int eff_ = BEFF((t) + 1); \
    SBAR(); \
    BRD(GL, 0, P0, P1); GAPB(o[0] = MFMA32(PAF(0), VFR(0), o[0]), C0, 0); \
    BRD(GL, 1, P0, P1); GAPB(o[1] = MFMA32(PAF(0), VFR(4), o[1]), C0, 4); \
    BRD(GL, 2, P0, P1); KRD(GL, 0); GAPB(o[0] = MFMA32(PAF(1), VFR(1), o[0]), C0, 8); \
    BRD(GL, 3, P0, P1); KRD(GL, 1); GAPB(o[1] = MFMA32(PAF(1), VFR(5), o[1]), C0, 12); \
    BRD(GL, 4, P0, P1); KRD(GL, 2); GAPB(o[0] = MFMA32(PAF(2), VFR(2), o[0]), C1, 0); \
    BRD(GL, 5, P0, P1); KRD(GL, 3); GAPB(o[1] = MFMA32(PAF(2), VFR(6), o[1]), C1, 4); \
    BRD(GL, 6, P0, P1); GAPB(o[0] = MFMA32(PAF(3), VFR(3), o[0]), C1, 8); \
    BRD(GL, 7, P0, P1); GAPB(o[1] = MFMA32(PAF(3), VFR(7), o[1]), C1, 12); \
    } while (0)
  int t = 1;
  for (; t + 5 < NT; t += 2) {
    STEP(pB0, pB1, pA0, pA1, t, true, true, true);     WAIT_BAR(2); ROT();
    STEP(pA0, pA1, pB0, pB1, t + 1, true, true, true); WAIT_BAR(2); ROT();
  }
  #define ENDW(tt) do { if ((tt) + 3 < NT) { WAIT_BAR(2); } else if ((tt) + 2 < NT) { WAIT_BAR(1); } else { WAIT_BAR(0); } } while (0)
  for (; t + 1 < NT; t += 2) {
    STEP(pB0, pB1, pA0, pA1, t, (t + 3 < NT), (t + 1 < NT), (t + 1 < NT));       ENDW(t);     ROT();
    STEP(pA0, pA1, pB0, pB1, t + 1, (t + 4 < NT), (t + 2 < NT), (t + 2 < NT));   ENDW(t + 1); ROT();
  }
  STEP(pB0, pB1, pA0, pA1, NT - 1, false, false, false);
  { float sacc = pB0[0] + pB0[1];
    #pragma unroll
    for (int r = 2; r < 16; ++r) sacc += pB0[r];
    #pragma unroll
    for (int r = 0; r < 16; ++r) sacc += pB1[r];
    l_reg += sacc;
    pw0 = (u32x4){PKW(pB0, 0), PKW(pB0, 2), PKW(pB0, 4), PKW(pB0, 6)}; pw1 = (u32x4){PKW(pB0, 8), PKW(pB0, 10), PKW(pB0, 12), PKW(pB0, 14)};
    pw2 = (u32x4){PKW(pB1, 0), PKW(pB1, 2), PKW(pB1, 4), PKW(pB1, 6)}; pw3 = (u32x4){PKW(pB1, 8), PKW(pB1, 10), PKW(pB1, 12), PKW(pB1, 14)};
    SBAR(); pv(o, vb0 + sl_cur, PAF(0), PAF(1), PAF(2), PAF(3)); }
  #undef STEP
  #undef BRD
  #undef KRD
  #undef VRD
  #undef GAPB
  #undef GAPA
  { auto rr = __builtin_amdgcn_permlane32_swap(__float_as_uint(l_reg), __float_as_uint(l_reg), false, false); l_reg = __uint_as_float(rr[0]) + __uint_as_float(rr[1]); }
  if (hi == 0) wsf[32 + r32] = l_reg; asm volatile("s_waitcnt lgkmcnt(0)" ::: "memory");
  float rli[16];
  #pragma unroll
  for (int r = 0; r < 16; ++r) rli[r] = __builtin_amdgcn_rcpf(wsf[32 + crow(r, hi)]);
  bf16* Ow = O + (rowbase + q0 + wid * QBLK) * opitch + h * 64;
  { bf16* stg = (bf16*)(shm + LDS_OST) + wid * 2048;
    #pragma unroll
    for (int r = 0; r < 16; ++r) { const int orow = crow(r, hi);
      #pragma unroll
      for (int d0 = 0; d0 < 2; ++d0) stg[orow * 64 + d0 * 32 + r32] = (bf16)(cvtpk_s(o[d0][r] * rli[r], 0.f) & 0xffffu); }
    asm volatile("s_waitcnt lgkmcnt(0)" ::: "memory");
    #pragma unroll
    for (int i = 0; i < 4; ++i) { const int row = i * 8 + (lane >> 3), ch = lane & 7; const u32x4 v = *(const u32x4*)(stg + row * 64 + ch * 8); ATTN_STORE16(Ow + (long)row * opitch + ch * 8, v); } }
  asm volatile("s_waitcnt lgkmcnt(0)\n\ts_barrier" ::: "memory");
  #undef DMA_K
  #undef DMA_V
  #undef ROT
  #undef BEFF
  #undef BRD1
  #undef ENDW
  #undef PKW
  #undef PAF
  #undef VFR
  #undef PIN
  #undef EX
}

__device__ __forceinline__ void sb_unit(int b, int h, int qb, const bf16* Q, const bf16* __restrict__ K, const bf16* __restrict__ V, bf16* O, char* shm, int opitch) {
  const int tid = threadIdx.x, lane = tid & 63, r32 = lane & 31, hi = lane >> 5; const int wid = __builtin_amdgcn_readfirstlane(tid >> 6);
  const long rowbase = (long)b * 4096; const int q0 = qb * QB;
  const bf16* Qw = Q + (rowbase + q0 + wid * QBLK) * DM + h * 64;
  const bf16* Kh = K + rowbase * DM + h * 64, *Vh = V + rowbase * DM + h * 64;
  const unsigned lds0 = (unsigned)(uintptr_t)shm;
  const lds_cptr shm3 = (lds_cptr)shm;
  const bf16* ksrc = Kh + (long)lane * DM + wid * 8;
  const bf16* vsrc = Vh + (long)(16 * (wid & 3) + (lane >> 2)) * DM + (wid >> 2) * 32 + (lane & 3) * 8;
  const unsigned kdst = lds0 + LDS_K + wid * 1024, vdst = lds0 + LDS_V + wid * 1024;
  const int NTALL = (q0 + QB) / KVBLK;
  const int vb0 = (int)(lds0 + LDS_V) + ((lane >> 4) & 1) * 32 + (lane & 3) * 8 + (4 * hi + ((lane & 15) >> 2)) * 64;
  const lds_cptr kp0 = shm3 + LDS_K + hi * 1024 + r32 * 16; const lds_cptr vp0 = shm3 + LDS_V + ((lane >> 4) & 1) * 32 + (lane & 3) * 8 + (4 * hi + ((lane & 15) >> 2)) * 64;
  bf16x8 qr[4];
  #pragma unroll
  for (int d0 = 0; d0 < 4; ++d0) qr[d0] = *reinterpret_cast<const bf16x8*>(&Qw[(long)r32 * DM + d0 * 16 + hi * 8]);
  f32x16 o[2]; o[0] = f32x16{}; o[1] = f32x16{};
  const int tq = q0 + wid * QBLK + r32;
  const f32x16 zero16 = f32x16{};
  float cc = 1.0f;
  const bool hib = hi != 0;
  volatile __attribute__((address_space(3))) unsigned* live = (volatile __attribute__((address_space(3))) unsigned*)(shm3 + LDS_WS);
  int Thi = NTALL, Tlo = NTALL > 8 ? NTALL - 8 : 0;
  #define TT(u) (Thi - 1 - (u))
  #define DMA_K(u, slot) glds16(ksrc + (long)TT(u) * KVBLK * DM, (unsigned)__builtin_amdgcn_readfirstlane(kdst + (slot)))
  #define DMA_V(u, slot) glds16(vsrc + (long)TT(u) * KVBLK * DM, (unsigned)__builtin_amdgcn_readfirstlane(vdst + (slot)))
  #define CMASK(X0, X1, T) do { const int lim_ = tq - 64 * (T) - 4 * hi; \
      _Pragma("unroll") for (int r_ = 0; r_ < 16; ++r_) { const int kq_ = (r_ & 3) + 8 * (r_ >> 2); if (kq_ >= lim_) X0[r_] = -INFINITY; if (kq_ + 32 >= lim_) X1[r_] = -INFINITY; } } while (0)
  #define EX(v) __builtin_amdgcn_exp2f(v)
  #define PIN(x) asm volatile("" : "+v"(x))
  #define EXPG(X, B, k) do { X[B] = EX(X[B]); X[B + 1] = EX(X[B + 1]); X[B + 2] = EX(X[B + 2]); X[B + 3] = EX(X[B + 3]); \
      float g_ = 1.0f + X[B]; g_ = __builtin_fmaf(g_, X[B + 1], g_); g_ = __builtin_fmaf(g_, X[B + 2], g_); g_ = __builtin_fmaf(g_, X[B + 3], g_); G[k] = g_; } while (0)
  #define TAIL() do { float Gp_[8], W_[8]; \
      _Pragma("unroll") for (int k_ = 0; k_ < 8; ++k_) { auto rr_ = __builtin_amdgcn_permlane32_swap(__float_as_uint(G[k_]), __float_as_uint(G[k_]), false, false); \
          const float lo_ = __uint_as_float(rr_[0]), hi_ = __uint_as_float(rr_[1]); W_[k_] = lo_ * hi_; Gp_[k_] = hib ? lo_ : 1.0f; } \
      { const float p1_ = W_[0], p2_ = p1_ * W_[1], p3_ = p2_ * W_[2]; rD0 = __builtin_amdgcn_rcpf(p3_ * W_[3]); pf[0] = Gp_[0]; pf[1] = p1_ * Gp_[1]; pf[2] = p2_ * Gp_[2]; pf[3] = p3_ * Gp_[3]; } \
      { const float p1_ = W_[4], p2_ = p1_ * W_[5], p3_ = p2_ * W_[6]; rD1 = __builtin_amdgcn_rcpf(p3_ * W_[7]); pf[4] = Gp_[4]; pf[5] = p1_ * Gp_[5]; pf[6] = p2_ * Gp_[6]; pf[7] = p3_ * Gp_[7]; } } while (0)
  #define SCAN(X, B, k, cx) do { float u_ = (cx) * pf[k]; const float a0_ = u_ * X[B]; u_ += a0_; const float a1_ = u_ * X[B + 1]; u_ += a1_; const float a2_ = u_ * X[B + 2]; u_ += a2_; const float a3_ = u_ * X[B + 3]; \
      X[B] = a0_; X[B + 1] = a1_; X[B + 2] = a2_; X[B + 3] = a3_; } while (0)
  #define ROT() do { sl_prev = sl_cur; sl_cur = sl_next; sl_next = (sl_next == (NSLOT - 1) * SLOTB) ? 0 : sl_next + SLOTB; } while (0)
  #define PKW(P, B) cvtpk_s(P[B], P[B + 1])
  #define PAF(k) __builtin_bit_cast(bf16x8, pw##k)
  #define VFR(i) (bf16x8){vlo[i][0], vlo[i][1], vlo[i][2], vlo[i][3], vhi[i][0], vhi[i][1], vhi[i][2], vhi[i][3]}
  #define GAPA(MF, SC, W0, W1, PW) do { MF; SC; W0; W1; PIN(PW); SBAR(); } while (0)
  #define GAPB(MF, X, B, k) do { MF; EXPG(X, B, k); PIN(X); PIN(G[k]); SBAR(); } while (0)
  #define VRD(i) do { vlo[i] = vtr(vp_ + (((i) >> 2) * 4096 + ((i) & 3) * 1024)); vhi[i] = vtr(vp_ + (((i) >> 2) * 4096 + ((i) & 3) * 1024 + 512)); } while (0)
  #define KRD(Gd, j) do { if (Gd) { kload2(kf, kp0 + sl_next, j); SBAR(); } } while (0)
  #define STEP(C0, C1, P0, P1, u, GK, GV, GL) do { SBAR(); \
    const lds_cptr vp_ = vp0 + sl_prev; \
    const float cm_ = cc * rD1, co_ = cm_ * rD0; \
    VRD(0); SBAR(); \
    GAPA(C0 = MFMA32(kf[0], qr[0], zero16), SCAN(P0, 0, 0, co_),  pw0[0] = PKW(P0, 0), pw0[1] = PKW(P0, 2), pw0); \
    VRD(4); SBAR(); GAPA(C1 = MFMA32(kf[1], qr[0], zero16), SCAN(P0, 4, 1, co_),  pw0[2] = PKW(P0, 4), pw0[3] = PKW(P0, 6), pw0); \
    VRD(1); SBAR(); GAPA(C0 = MFMA32(kf[2], qr[1], C0), SCAN(P0, 8, 2, co_),  pw1[0] = PKW(P0, 8), pw1[1] = PKW(P0, 10), pw1); \
    VRD(5); SBAR(); GAPA(C1 = MFMA32(kf[3], qr[1], C1), SCAN(P0, 12, 3, co_), pw1[2] = PKW(P0, 12), pw1[3] = PKW(P0, 14), pw1); \
    VRD(2); SBAR(); GAPA(C0 = MFMA32(kf[4], qr[2], C0), SCAN(P1, 0, 4, cm_),  pw2[0] = PKW(P1, 0), pw2[1] = PKW(P1, 2), pw2); \
    VRD(6); SBAR(); GAPA(C1 = MFMA32(kf[5], qr[2], C1), SCAN(P1, 4, 5, cm_),  pw2[2] = PKW(P1, 4), pw2[3] = PKW(P1, 6), pw2); \
    VRD(3); SBAR(); GAPA(C0 = MFMA32(kf[6], qr[3], C0), SCAN(P1, 8, 6, cm_),  pw3[0] = PKW(P1, 8), pw3[1] = PKW(P1, 10), pw3); \
    VRD(7); SBAR(); GAPA(C1 = MFMA32(kf[7], qr[3], C1), SCAN(P1, 12, 7, cm_), pw3[2] = PKW(P1, 12), pw3[3] = PKW(P1, 14), pw3); \
    cc = co_; \
    if (GK) { DMA_K((u) + 3, sl_cur); } if (GV) { DMA_V((u) + 1, sl_next); } \
    if (TT(u) >= 4 * qb) { CMASK(C0, C1, TT(u)); } \
    SBAR(); \
    GAPB(o[0] = MFMA32(PAF(0), VFR(0), o[0]), C0, 0, 0); \
    GAPB(o[1] = MFMA32(PAF(0), VFR(4), o[1]), C0, 4, 1); \
    KRD(GL, 0); GAPB(o[0] = MFMA32(PAF(1), VFR(1), o[0]), C0, 8, 2); \
    KRD(GL, 1); GAPB(o[1] = MFMA32(PAF(1), VFR(5), o[1]), C0, 12, 3); \
    KRD(GL, 2); GAPB(o[0] = MFMA32(PAF(2), VFR(2), o[0]), C1, 0, 4); \
    KRD(GL, 3); GAPB(o[1] = MFMA32(PAF(2), VFR(6), o[1]), C1, 4, 5); \
    GAPB(o[0] = MFMA32(PAF(3), VFR(3), o[0]), C1, 8, 6); \
    GAPB(o[1] = MFMA32(PAF(3), VFR(7), o[1]), C1, 12, 7); \
    TAIL(); SBAR(); \
    } while (0)
  #define ENDW(tt) do { if ((tt) + 3 < NT) { WAIT_BAR(2); } else if ((tt) + 2 < NT) { WAIT_BAR(1); } else { WAIT_BAR(0); } } while (0)
  for (;;) {
    const int NT = Thi - Tlo;
    bf16x8 kf[8]; f32x16 pA0, pA1, pB0, pB1; float pf[8], rD0, rD1, G[8];
    DMA_K(0, 0); DMA_V(0, 0); DMA_K(1, SLOTB); DMA_K(2, 2 * SLOTB);
    WAIT_BAR(3);
    int sl_prev = 0, sl_cur = 0, sl_next = SLOTB;
    pA0 = zero16; pA1 = zero16;
    { const char* kb = shm + LDS_K + hi * 1024 + r32 * 16;
      #pragma unroll
      for (int d0 = 0; d0 < 4; ++d0) { const bf16x8 b0 = *reinterpret_cast<const bf16x8*>(kb + d0 * 2048); const bf16x8 b1 = *reinterpret_cast<const bf16x8*>(kb + d0 * 2048 + 512);
        pA0 = MFMA32(b0, qr[d0], pA0); pA1 = MFMA32(b1, qr[d0], pA1); } }
    if (TT(0) >= 4 * qb) { CMASK(pA0, pA1, TT(0)); }
    EXPG(pA0, 0, 0); EXPG(pA0, 4, 1); EXPG(pA0, 8, 2); EXPG(pA0, 12, 3); EXPG(pA1, 0, 4); EXPG(pA1, 4, 5); EXPG(pA1, 8, 6); EXPG(pA1, 12, 7); TAIL();
    WAIT_BAR(0);
    DMA_K(3, 0); DMA_V(1, SLOTB);
    ROT();
    kload8(kf, kp0 + sl_cur);
    WAIT_BAR(2);
    s16x4 vlo[8], vhi[8]; u32x4 pw0, pw1, pw2, pw3;
    int t = 1;
    for (; t + 5 < NT; t += 2) {
      STEP(pB0, pB1, pA0, pA1, t, true, true, true);     WAIT_BAR(2); ROT();
      STEP(pA0, pA1, pB0, pB1, t + 1, true, true, true); WAIT_BAR(2); ROT();
    }
    for (; t + 1 < NT; t += 2) {
      STEP(pB0, pB1, pA0, pA1, t, (t + 3 < NT), (t + 1 < NT), (t + 1 < NT));       ENDW(t);     ROT();
      STEP(pA0, pA1, pB0, pB1, t + 1, (t + 4 < NT), (t + 2 < NT), (t + 2 < NT));   ENDW(t + 1); ROT();
    }
    STEP(pB0, pB1, pA0, pA1, NT - 1, false, false, false);
    { const float cm_ = cc * rD1, co_ = cm_ * rD0;
      SCAN(pB0, 0, 0, co_); SCAN(pB0, 4, 1, co_); SCAN(pB0, 8, 2, co_); SCAN(pB0, 12, 3, co_); SCAN(pB1, 0, 4, cm_); SCAN(pB1, 4, 5, cm_); SCAN(pB1, 8, 6, cm_); SCAN(pB1, 12, 7, cm_);
      cc = co_;
      pw0 = (u32x4){PKW(pB0, 0), PKW(pB0, 2), PKW(pB0, 4), PKW(pB0, 6)}; pw1 = (u32x4){PKW(pB0, 8), PKW(pB0, 10), PKW(pB0, 12), PKW(pB0, 14)};
      pw2 = (u32x4){PKW(pB1, 0), PKW(pB1, 2), PKW(pB1, 4), PKW(pB1, 6)}; pw3 = (u32x4){PKW(pB1, 8), PKW(pB1, 10), PKW(pB1, 12), PKW(pB1, 14)};
      SBAR(); pv(o, vb0 + sl_cur, PAF(0), PAF(1), PAF(2), PAF(3)); }
    if (Tlo == 0) break;
    { const unsigned al_ = __any(cc > 5.421010862e-20f) ? 1u : 0u; if (lane == 0) live[wid] = al_; }
    asm volatile("s_waitcnt lgkmcnt(0)\n\ts_barrier" ::: "memory");
    unsigned a_ = 0u;
    #pragma unroll
    for (int w_ = 0; w_ < 8; ++w_) a_ |= live[w_];
    asm volatile("s_waitcnt lgkmcnt(0)\n\ts_barrier" ::: "memory");
#if defined(SB_FORCE_EXIT)
    break;
#endif
    if (__builtin_amdgcn_readfirstlane(a_) == 0u) break;
    Thi = Tlo; Tlo = 0;
  }
  bf16* Ow = O + (rowbase + q0 + wid * QBLK) * opitch + h * 64;
  { bf16* stg = (bf16*)(shm + LDS_OST) + wid * 2048;
    #pragma unroll
    for (int r = 0; r < 16; ++r) { const int orow = crow(r, hi);
      #pragma unroll
      for (int d0 = 0; d0 < 2; ++d0) stg[orow * 64 + d0 * 32 + r32] = (bf16)(cvtpk_s(o[d0][r], 0.f) & 0xffffu); }
    asm volatile("s_waitcnt lgkmcnt(0)" ::: "memory");
    #pragma unroll
    for (int i = 0; i < 4; ++i) { const int row = i * 8 + (lane >> 3), ch = lane & 7; const u32x4 v = *(const u32x4*)(stg + row * 64 + ch * 8); ATTN_STORE16(Ow + (long)row * opitch + ch * 8, v); } }
  asm volatile("s_waitcnt vmcnt(0) lgkmcnt(0)\n\ts_barrier" ::: "memory");
  #undef STEP
  #undef KRD
  #undef VRD
  #undef GAPB
  #undef GAPA
  #undef DMA_K
  #undef DMA_V
  #undef ROT
  #undef CMASK
  #undef ENDW
  #undef PKW
  #undef PAF
  #undef VFR
  #undef PIN
  #undef EX
  #undef EXPG
  #undef TAIL
  #undef SCAN
  #undef TT
}
}
struct Frame {
    LAS unsigned char* lds;
    volatile LAS unsigned* MISC;
    gu32* ctl;
    int tid, lane, wave;
    int vcu, G;
    const float *x, *c, *w_ada, *b_ada, *g_mix, *w_in, *g_q, *g_k, *rel_bias, *w_br_moba, *w_br_sb, *w_out, *g_ffn, *w_rg, *b_rg, *w_re, *b_re, *w_gate, *w_up, *w_down;
    float* out;
    float *mod, *biasT, *btg, *stats, *kmean;
    bf16 *wrt_hi, *wrt_lo;
    bf16 *Win_t, *Wbra_t, *Wbrb_t, *Wout_t, *Wgu_t, *Wd_t;
    bf16 *XN, *QA, *KA, *VA, *QB, *KB, *VB, *OA, *OB, *GA, *GB, *H;
    int* tokl; float* wl; unsigned* cnt; int* inv; float* winv; bf16* Y;
};
__device__ __forceinline__ float wave_sum(float v) {
#pragma unroll
    for (int o = 1; o < 64; o <<= 1) v += __shfl_xor(v, o);
    return v;
}
__device__ __forceinline__ int lane_zero() { int z; asm volatile("v_mov_b32 %0, 0" : "=v"(z)); return z; }

__device__ __forceinline__ void p0_transpose_item(const float* W, int K, int N, bf16* WT, int k0, int n0, int drow0, LAS float* scr, int lane, int dk0 = 0) {
    float tv[32];
#pragma unroll
    for (int i = 0; i < 32; ++i) { const int kk = 2 * i + (lane >> 5); tv[i] = W[(size_t)(k0 + kk) * N + n0 + (lane & 31)]; }
#pragma unroll
    for (int i = 0; i < 32; ++i) { const int kk = 2 * i + (lane >> 5); scr[kk * 33 + (lane & 31)] = tv[i]; }
    LDS_WAIT(); asm volatile("" ::: "memory");
    const int c = lane & 7;
#pragma unroll
    for (int j = 0; j < 4; ++j) { const int n = (lane >> 3) + 8 * j; const LAS float* s = scr + (8 * c) * 33 + n;
        v4u o; o.x = pk2(s[0 * 33], s[1 * 33]); o.y = pk2(s[2 * 33], s[3 * 33]); o.z = pk2(s[4 * 33], s[5 * 33]); o.w = pk2(s[6 * 33], s[7 * 33]);
        *(GAS v4u*)(WT + (size_t)(drow0 + n) * K + dk0 + k0 + 8 * c) = o; }
    LDS_WAIT(); asm volatile("" ::: "memory");
}

__device__ __forceinline__ void p0_prologue(Frame& F) {
    {
        LAS float* sc = (LAS float*)(F.lds + RING_OFF);
        LAS float* part = (LAS float*)(F.lds + RING_OFF + 32768);
        for (int i = F.tid; i < BATCH * D; i += NWAVES * 64) { const float v = F.c[i]; sc[i] = v * fsigmoid(v); }
        __syncthreads();
        for (int chunk = F.vcu; chunk < 256; chunk += F.G) {
            const int kp = F.tid / 24, cI = F.tid % 24;
            if (kp < 21) {
                float a[8];
#pragma unroll
                for (int b = 0; b < 8; ++b) a[b] = 0.f;
                const int k0 = kp * 49, k1 = (k0 + 49 < D) ? k0 + 49 : D;
                for (int k = k0; k < k1; ++k) { const float w = F.w_ada[(size_t)k * (NMOD * D) + chunk * 24 + cI];
#pragma unroll
                    for (int b = 0; b < 8; ++b) a[b] += sc[b * D + k] * w; }
#pragma unroll
                for (int b = 0; b < 8; ++b) part[(kp * 24 + cI) * 8 + b] = a[b];
            }
            __syncthreads();
            if (F.tid < 192) { const int cI2 = F.tid % 24, b = F.tid / 24; float s = 0.f;
                for (int kp2 = 0; kp2 < 21; ++kp2) s += part[(kp2 * 24 + cI2) * 8 + b];
                const int col = chunk * 24 + cI2; F.mod[(size_t)b * (NMOD * D) + col] = s + F.b_ada[col]; }
            __syncthreads();
        }
    }
    const int gw = F.vcu * NWAVES + F.wave, NGW = F.G * NWAVES;
    for (int i = gw * 64 + F.lane; i < NH * SEQ; i += NGW * 64) { const int h = i / SEQ, n = i % SEQ; int bk;
        if (n < 16) bk = n; else { const float nf = (float)n; int lg = 16 + (int)(logf(nf / 16.0f) / 4.1588830833596715f * 16.0f); bk = lg < 31 ? lg : 31; }
        F.biasT[i] = F.rel_bias[h * 32 + bk] * LOG2E; }
    for (int i = gw * 64 + F.lane; i < (NH + 1) * (attn::BT_BYTES / 4); i += NGW * 64) { const int h = i / (attn::BT_BYTES / 4), w = i % (attn::BT_BYTES / 4); float val = -INFINITY;
        if (w < 4 * attn::BT_LEN) { const int a = w / attn::BT_LEN, xx = w % attn::BT_LEN, ri = xx + a;
            if (h == NH) { if (ri < attn::REV) val = 0.f; }
            else if (ri <= attn::REV) { const int n = attn::REV - ri; int bk; if (n < 16) bk = n; else { const float nf = (float)n; int lg = 16 + (int)(logf(nf / 16.0f) / 4.1588830833596715f * 16.0f); bk = lg < 31 ? lg : 31; }
                val = F.rel_bias[h * 32 + bk] * LOG2E; } }
        F.btg[i] = val; }
    for (int i = gw * 64 + F.lane; i < 48 * D; i += NGW * 64) { const int col = i / D, k = i % D; float v = 0.f;
        if (col < NGRP) v = F.w_rg[(size_t)k * NGRP + col]; else if (col < NGRP + NEXP) v = F.w_re[(size_t)k * NEXP + col - NGRP];
        const unsigned hb = f2bf(v); const float r = v - __uint_as_float(hb << 16); F.wrt_hi[i] = (bf16)hb; F.wrt_lo[i] = (bf16)f2bf(r); }
    LAS float* scr = (LAS float*)(F.lds + RING_OFF + F.wave * 16384);
    constexpr int I_IN = (D / 64) * (INCOLS / 32), I_BR = (WATT / 64) * (D / 32), I_OUT = (D / 64) * (D / 32), I_G = NEXP * (D / 64) * (DEXP / 32), I_D = NEXP * (DEXP / 64) * (D / 32);
    constexpr int NITEMS = I_IN + 2 * I_BR + I_OUT;
    for (int it = gw; it < NITEMS; it += NGW) {
        int r = it;
        if (r < I_IN) { const int nblk = INCOLS / 32, kb = r / nblk, nb = r % nblk, n0 = 32 * nb, t = n0 & 255;
            const int p0 = 128 * ((t >> 5) & 1) + 32 * (t >> 6);
            p0_transpose_item(F.w_in, D, INCOLS, F.Win_t, 64 * kb, n0, (n0 - t) + p0, scr, F.lane); continue; } r -= I_IN;
        if (r < I_BR) { const int nblk = D / 32, kb = r / nblk, nb = r % nblk; p0_transpose_item(F.w_br_moba, D, D, F.Wbra_t, 64 * kb, 32 * nb, 32 * nb, scr, F.lane, 0); continue; } r -= I_BR;
        if (r < I_BR) { const int nblk = D / 32, kb = r / nblk, nb = r % nblk; p0_transpose_item(F.w_br_sb, D, D, F.Wbra_t, 64 * kb, 32 * nb, 32 * nb, scr, F.lane, WATT); continue; } r -= I_BR;
        if (r < I_OUT) { const int nblk = D / 32, kb = r / nblk, nb = r % nblk; p0_transpose_item(F.w_out, D, D, F.Wout_t, 64 * kb, 32 * nb, 32 * nb, scr, F.lane); continue; } r -= I_OUT;
        (void)r;
    }
}


constexpr int CI_G = NEXP * (D / 64) * (DEXP / 32), CI_D = NEXP * (DEXP / 64) * (D / 32), CONV_ITEMS = 2 * CI_G + CI_D, CONV_NB = 3;
struct ConvItem { const float* W; bf16* WT; int N, K, k0, n0, drow0; };
__device__ __forceinline__ ConvItem conv_item(const Frame& F, int it) {
    ConvItem c; int r = it;
    if (r < 2 * CI_G) { const int up = r >= CI_G; if (up) r -= CI_G; constexpr int per = (D / 64) * (DEXP / 32); const int e = r / per, q = r % per, nblk = DEXP / 32, kb = q / nblk, nb = q % nblk, n0 = 32 * nb;
        c.W = (up ? F.w_up : F.w_gate) + (size_t)e * D * DEXP; c.WT = F.Wgu_t; c.N = DEXP; c.K = D; c.k0 = 64 * kb; c.n0 = n0; c.drow0 = e * 1024 + 256 * (n0 >> 7) + (up ? 128 : 0) + (n0 & 127); return c; }
    r -= 2 * CI_G;
    { constexpr int per = (DEXP / 64) * (D / 32); const int e = r / per, q = r % per, nblk = D / 32, kb = q / nblk, nb = q % nblk;
        c.W = F.w_down + (size_t)e * DEXP * D; c.WT = F.Wd_t; c.N = D; c.K = DEXP; c.k0 = 64 * kb; c.n0 = 32 * nb; c.drow0 = e * 1024 + 32 * nb; return c; }
}
__device__ __forceinline__ void conv_expert_items(Frame& F) {
    LAS float* scr = (LAS float*)(F.lds + RING_OFF + F.wave * 16384);
    const int lane = F.lane;
    for (;;) {
        int it0 = 0; if (lane == 0) it0 = (int)__hip_atomic_fetch_add(F.ctl + CW_QCONV, (unsigned)CONV_NB, __ATOMIC_RELAXED, __HIP_MEMORY_SCOPE_AGENT);
        it0 = __builtin_amdgcn_readfirstlane(it0);
        if (it0 >= CONV_ITEMS) break;
        float tv[CONV_NB][32]; ConvItem ci[CONV_NB];
#pragma unroll
        for (int j = 0; j < CONV_NB; ++j) { const int it = (it0 + j < CONV_ITEMS) ? it0 + j : CONV_ITEMS - 1; ci[j] = conv_item(F, it);
#pragma unroll
            for (int i = 0; i < 32; ++i) { const int kk = 2 * i + (lane >> 5); tv[j][i] = ci[j].W[(size_t)(ci[j].k0 + kk) * ci[j].N + ci[j].n0 + (lane & 31)]; } }
#pragma unroll
        for (int j = 0; j < CONV_NB; ++j) {
#pragma unroll
            for (int i = 0; i < 32; ++i) { const int kk = 2 * i + (lane >> 5); scr[kk * 33 + (lane & 31)] = tv[j][i]; }
            LDS_WAIT(); asm volatile("" ::: "memory");
            const int c = lane & 7;
#pragma unroll
            for (int q = 0; q < 4; ++q) { const int n = (lane >> 3) + 8 * q; const LAS float* s = scr + (8 * c) * 33 + n;
                v4u o; o.x = pk2(s[0 * 33], s[1 * 33]); o.y = pk2(s[2 * 33], s[3 * 33]); o.z = pk2(s[4 * 33], s[5 * 33]); o.w = pk2(s[6 * 33], s[7 * 33]);
                *(GAS v4u*)(ci[j].WT + (size_t)(ci[j].drow0 + n) * ci[j].K + ci[j].k0 + 8 * c) = o; }
            LDS_WAIT(); asm volatile("" ::: "memory");
        }
    }
}
__device__ __forceinline__ void p1_norm(Frame& F) {
    const int gw = F.vcu * NWAVES + F.wave, NGW = F.G * NWAVES;
    for (int m = gw; m < NTOK; m += NGW) {
        const int b = m / SEQ;
        const GAS f32x4* xr = (const GAS f32x4*)(F.x + (size_t)m * D) + F.lane;
        const GAS f32x4* gr = (const GAS f32x4*)F.g_mix + F.lane;
        const GAS f32x4* shr = (const GAS f32x4*)(F.mod + (size_t)b * (NMOD * D)) + F.lane;
        const GAS f32x4* scr = (const GAS f32x4*)(F.mod + (size_t)b * (NMOD * D) + D) + F.lane;
        f32x4 v[4]; float s = 0.f;
#pragma unroll
        for (int j = 0; j < 4; ++j) { v[j] = xr[64 * j]; s += (v[j].x * v[j].x + v[j].y * v[j].y) + (v[j].z * v[j].z + v[j].w * v[j].w); }
        const float rstd = __builtin_amdgcn_rsqf(wave_sum(s) * (1.f / D) + RMS_EPS);
        GAS unsigned long long* o8 = (GAS unsigned long long*)(F.XN + (size_t)m * D) + F.lane;
#pragma unroll
        for (int j = 0; j < 4; ++j) { const f32x4 g = gr[64 * j], sh = shr[64 * j], sc = scr[64 * j]; const f32x4 y = (v[j] * rstd * g) * (sc + 1.0f) + sh;
            o8[64 * j] = (unsigned long long)pk2(y.x, y.y) | ((unsigned long long)pk2(y.z, y.w) << 32); }
    }
}

__device__ __forceinline__ float dot64(const unsigned (&q)[32], const v4u (&k)[8]) {
    float a0 = 0.f, a1 = 0.f;
#pragma unroll
    for (int i = 0; i < 8; ++i) {
        a0 += bflo(q[4 * i]) * bflo(k[i].x) + bflo(q[4 * i + 1]) * bflo(k[i].y) + bflo(q[4 * i + 2]) * bflo(k[i].z) + bflo(q[4 * i + 3]) * bflo(k[i].w);
        a1 += bfhi(q[4 * i]) * bfhi(k[i].x) + bfhi(q[4 * i + 1]) * bfhi(k[i].y) + bfhi(q[4 * i + 2]) * bfhi(k[i].z) + bfhi(q[4 * i + 3]) * bfhi(k[i].w); }
    return a0 + a1;
}
#define LOADROW(dst, p) do { _Pragma("unroll") for (int i_ = 0; i_ < 8; ++i_) dst[i_] = ((const GAS v4u*)(p))[i_]; } while (0)
#define AXPY64(o, p, v) do { _Pragma("unroll") for (int i_ = 0; i_ < 8; ++i_) { \
    o[8 * i_ + 0] += p * bflo(v[i_].x); o[8 * i_ + 1] += p * bfhi(v[i_].x); o[8 * i_ + 2] += p * bflo(v[i_].y); o[8 * i_ + 3] += p * bfhi(v[i_].y); \
    o[8 * i_ + 4] += p * bflo(v[i_].z); o[8 * i_ + 5] += p * bfhi(v[i_].z); o[8 * i_ + 6] += p * bflo(v[i_].w); o[8 * i_ + 7] += p * bfhi(v[i_].w); } } while (0)
#define STOREO(ptr, o, sc) do { _Pragma("unroll") for (int i_ = 0; i_ < 8; ++i_) { v4u w_; w_.x = pk2(o[8 * i_] * sc, o[8 * i_ + 1] * sc); w_.y = pk2(o[8 * i_ + 2] * sc, o[8 * i_ + 3] * sc); \
    w_.z = pk2(o[8 * i_ + 4] * sc, o[8 * i_ + 5] * sc); w_.w = pk2(o[8 * i_ + 6] * sc, o[8 * i_ + 7] * sc); ((GAS v4u*)(ptr))[i_] = w_; } } while (0)

__device__ __forceinline__ void moba_naive_item(Frame& F, int item) {
    const int bh = item >> 6, ch = item & 63, b = bh >> 3, h = bh & 7, lz = lane_zero();
    const int t = ch * 64 + F.lane, own = ch >> 2, tl = t & 255;
    const size_t rowb = (size_t)b * SEQ;
    unsigned q[32]; { v4u t4[8]; LOADROW(t4, F.QA + (rowb + t) * WATT + h * HD);
#pragma unroll
        for (int i = 0; i < 8; ++i) { q[4 * i] = t4[i].x; q[4 * i + 1] = t4[i].y; q[4 * i + 2] = t4[i].z; q[4 * i + 3] = t4[i].w; } }
    float v0 = -INFINITY, v1 = -INFINITY, v2 = -INFINITY; int i0 = 0, i1 = 0, i2 = 0;
    for (int j = 0; j < own; ++j) {
        const GAS f32x4* km = (const GAS f32x4*)(F.kmean + ((size_t)(b * NBLK + j) * NH + h) * HD + lz);
        float g = 0.f;
#pragma unroll
        for (int i = 0; i < 16; ++i) { const f32x4 kv = km[i]; g += bflo(q[2 * i]) * kv.x + bfhi(q[2 * i]) * kv.y + bflo(q[2 * i + 1]) * kv.z + bfhi(q[2 * i + 1]) * kv.w; }
        if (g > v0) { v2 = v1; i2 = i1; v1 = v0; i1 = i0; v0 = g; i0 = j; } else if (g > v1) { v2 = v1; i2 = i1; v1 = g; i1 = j; } else if (g > v2) { v2 = g; i2 = j; }
    }
    float m = -INFINITY, l = 0.f; float o[64];
#pragma unroll
    for (int i = 0; i < 64; ++i) o[i] = 0.f;
    const float* bt = F.biasT + h * SEQ;
    const int nsel = own < 3 ? own : 3;
    for (int sl = 0; sl < nsel; ++sl) {
        const int blk = sl == 0 ? i0 : (sl == 1 ? i1 : i2);
        const bf16* kp = F.KA + (rowb + blk * MBLK) * WATT + h * HD; const bf16* vp = F.VA + (rowb + blk * MBLK) * WATT + h * HD;
        const int dist0 = t - blk * MBLK;
        for (int s = 0; s < MBLK; ++s) {
            v4u kk[8]; LOADROW(kk, kp + (size_t)s * WATT); const float sc = dot64(q, kk) + bt[dist0 - s];
            const float mn = fmaxf(m, sc), al = __builtin_amdgcn_exp2f(m - mn), p = __builtin_amdgcn_exp2f(sc - mn);
            l = l * al + p; m = mn;
#pragma unroll
            for (int i = 0; i < 64; ++i) o[i] *= al;
            v4u vv[8]; LOADROW(vv, vp + (size_t)s * WATT); AXPY64(o, p, vv);
        }
    }
    {
        const bf16* kp = F.KA + (rowb + own * MBLK) * WATT + h * HD + lz; const bf16* vp = F.VA + (rowb + own * MBLK) * WATT + h * HD + lz;
        const int smax = (ch & 3) * 64 + 63;
        for (int s = 0; s <= smax; ++s) {
            v4u kk[8]; LOADROW(kk, kp + (size_t)s * WATT); const int dist = tl - s; const float sc = dot64(q, kk) + bt[dist > 0 ? dist : 0];
            if (dist >= 0) {
                const float mn = fmaxf(m, sc), al = __builtin_amdgcn_exp2f(m - mn), p = __builtin_amdgcn_exp2f(sc - mn);
                l = l * al + p; m = mn;
#pragma unroll
                for (int i = 0; i < 64; ++i) o[i] *= al;
                v4u vv[8]; LOADROW(vv, vp + (size_t)s * WATT); AXPY64(o, p, vv);
            }
        }
    }
    const float rl = 1.0f / l;
    STOREO(F.OA + (rowb + t) * D + h * HD, o, rl);
}
__device__ __forceinline__ void sb_naive_item(Frame& F, int item) {
    const int bh = item >> 6, ch = item & 63, b = bh >> 3, h = bh & 7, lz = lane_zero();
    const int t = ch * 64 + F.lane;
    const size_t rowb = (size_t)b * SEQ;
    unsigned q[32]; { v4u t4[8]; LOADROW(t4, F.QB + (rowb + t) * WATT + h * HD);
#pragma unroll
        for (int i = 0; i < 8; ++i) { q[4 * i] = t4[i].x; q[4 * i + 1] = t4[i].y; q[4 * i + 2] = t4[i].z; q[4 * i + 3] = t4[i].w; } }
    float c = 1.0f; float o[64];
#pragma unroll
    for (int i = 0; i < 64; ++i) o[i] = 0.f;
    const bf16* kp = F.KB + rowb * WATT + h * HD + lz; const bf16* vp = F.VB + rowb * WATT + h * HD + lz;
    for (int s = ch * 64 + 62; s >= 0; --s) {
        v4u kk[8]; LOADROW(kk, kp + (size_t)s * WATT); const float e = __builtin_amdgcn_exp2f(dot64(q, kk)); const float r = 1.0f / (1.0f + e);
        if (s < t) { const float a = e * r * c; c *= r; v4u vv[8]; LOADROW(vv, vp + (size_t)s * WATT); AXPY64(o, a, vv); }
    }
    STOREO(F.OA + (rowb + t) * D + WATT + h * HD, o, 1.0f);
}
__device__ __forceinline__ void p3_sb_naive(Frame& F) {
    const int gw = F.vcu * NWAVES + F.wave, NGW = F.G * NWAVES;
    for (int p = gw; p < 2048; p += NGW) { const int bh = p >> 5, j = p & 31;
        sb_naive_item(F, bh * 64 + j); sb_naive_item(F, bh * 64 + 63 - j); }
}
__device__ __forceinline__ void p3_moba_naive(Frame& F) {
    const int gw = F.vcu * NWAVES + F.wave, NGW = F.G * NWAVES;
    for (int p = gw; p < 2048; p += NGW) { const int bh = p >> 5, j = p & 31;
        moba_naive_item(F, bh * 64 + j); moba_naive_item(F, bh * 64 + 63 - j); }
}
constexpr int NCONV = 48;
__device__ __forceinline__ int att_pull(Frame& F) {
    volatile LAS unsigned* slot = F.MISC + 16;
    if (F.tid == 0) slot[0] = __hip_atomic_fetch_add(F.ctl + CW_QATT, 1u, __ATOMIC_RELAXED, __HIP_MEMORY_SCOPE_AGENT);
    __syncthreads(); const int u = (int)slot[0]; __syncthreads(); return u;
}
__device__ __forceinline__ void p3_mixers(Frame& F) {
    if ((int)blockIdx.x < NCONV) conv_expert_items(F);
    __syncthreads();
    int img = -1;
    for (;;) {
        const int u = att_pull(F); if (u >= 2048) break;
        const int sb = u >> 10, v = u & 1023, qb = 15 - (v >> 6), bh = v & 63, b = bh >> 3, h = bh & 7, want = sb ? NH : h;
        if (want != img) { __syncthreads();
            for (int k = F.tid; k < attn::BT_BYTES / 16; k += NWAVES * 64) *(LAS v4u*)(F.lds + RING_OFF + attn::LDS_BT + 16 * k) = *(const GAS v4u*)(F.btg + (size_t)want * (attn::BT_BYTES / 4) + 4 * k);
            __syncthreads(); img = want; }
        if (sb) attn::sb_unit(b, h, qb, F.QB, F.KB, F.VB, F.OA + WATT, (char*)F.lds + RING_OFF, D);
        else attn::moba_unit(b, h, qb, F.QA, F.KA, F.VA, F.OA, F.kmean, (char*)F.lds + RING_OFF, D);
    }
    __syncthreads();
    conv_expert_items(F);
}
__device__ __forceinline__ void p6_route(Frame& F) {
    const int gw = F.vcu * NWAVES + F.wave, NGW = F.G * NWAVES;
    for (int m = gw; m < NTOK; m += NGW) {
        const int b = m / SEQ;
        const GAS f32x4* xr = (const GAS f32x4*)(F.out + (size_t)m * D) + F.lane;
        const GAS f32x4* gr = (const GAS f32x4*)F.g_ffn + F.lane;
        const GAS f32x4* shr = (const GAS f32x4*)(F.mod + (size_t)b * (NMOD * D) + 3 * D) + F.lane;
        const GAS f32x4* scr = (const GAS f32x4*)(F.mod + (size_t)b * (NMOD * D) + 4 * D) + F.lane;
        float ss = 0.f; { const GAS f32x4* sp = (const GAS f32x4*)(F.stats + (size_t)m * 16);
#pragma unroll
            for (int j = 0; j < 4; ++j) { const f32x4 s4 = sp[j]; ss += (s4.x + s4.y) + (s4.z + s4.w); } }
        const float rstd = __builtin_amdgcn_rsqf(ss * (1.f / D) + RMS_EPS);
        f32x4 y[4];
        GAS unsigned long long* o8 = (GAS unsigned long long*)(F.XN + (size_t)m * D) + F.lane;
#pragma unroll
        for (int j = 0; j < 4; ++j) { const f32x4 v = xr[64 * j], g = gr[64 * j], sh = shr[64 * j], sc = scr[64 * j]; y[j] = (v * rstd * g) * (sc + 1.0f) + sh;
            o8[64 * j] = (unsigned long long)pk2(y[j].x, y[j].y) | ((unsigned long long)pk2(y[j].z, y[j].w) << 32); }
        float gl[4] = {0.f, 0.f, 0.f, 0.f};
#pragma unroll
        for (int j = 0; j < 4; ++j) { const GAS f32x4* wp = (const GAS f32x4*)(F.w_rg + (size_t)(4 * F.lane + 256 * j) * NGRP);
#pragma unroll
            for (int e = 0; e < 4; ++e) { const f32x4 w = wp[e]; const float yv = y[j][e]; gl[0] += yv * w.x; gl[1] += yv * w.y; gl[2] += yv * w.z; gl[3] += yv * w.w; } }
#pragma unroll
        for (int g = 0; g < 4; ++g) gl[g] = wave_sum(gl[g]) + F.b_rg[g];
        int gi = 0; float gm = gl[0];
#pragma unroll
        for (int g = 1; g < 4; ++g) if (gl[g] > gm) { gm = gl[g]; gi = g; }
        float den = 0.f;
#pragma unroll
        for (int g = 0; g < 4; ++g) den += __expf(gl[g] - gm);
        const float gwt = 1.0f / den;
        float el[8] = {0.f, 0.f, 0.f, 0.f, 0.f, 0.f, 0.f, 0.f};
#pragma unroll
        for (int j = 0; j < 4; ++j)
#pragma unroll
            for (int e = 0; e < 4; ++e) { const GAS f32x4* wp = (const GAS f32x4*)(F.w_re + (size_t)(4 * F.lane + 256 * j + e) * NEXP + gi * EPG); const f32x4 w0 = wp[0], w1 = wp[1]; const float yv = y[j][e];
                el[0] += yv * w0.x; el[1] += yv * w0.y; el[2] += yv * w0.z; el[3] += yv * w0.w; el[4] += yv * w1.x; el[5] += yv * w1.y; el[6] += yv * w1.z; el[7] += yv * w1.w; }
#pragma unroll
        for (int k = 0; k < 8; ++k) el[k] = wave_sum(el[k]) + F.b_re[gi * EPG + k];
        int k1 = 0; float t1 = el[0];
#pragma unroll
        for (int k = 1; k < 8; ++k) if (el[k] > t1) { t1 = el[k]; k1 = k; }
        int k2 = -1; float t2 = -INFINITY;
#pragma unroll
        for (int k = 0; k < 8; ++k) if (k != k1 && el[k] > t2) { t2 = el[k]; k2 = k; }
        const float ex = __expf(t2 - t1); const float w1v = gwt / (1.0f + ex), w2v = gwt * ex / (1.0f + ex);
        if (F.lane < 2) { const int e = gi * EPG + (F.lane == 0 ? k1 : k2); const float w = F.lane == 0 ? w1v : w2v;
            const unsigned pos = __hip_atomic_fetch_add(F.cnt + (F.lane * NEXP + e) * 64, 1u, __ATOMIC_RELAXED, __HIP_MEMORY_SCOPE_AGENT);
            F.tokl[(size_t)(F.lane * NEXP + e) * LCAP + pos] = m; F.wl[(size_t)(F.lane * NEXP + e) * LCAP + pos] = w; }
    }
}
__device__ __forceinline__ void p6_route_mfma(Frame& F) {
    typedef float f32x4v __attribute__((ext_vector_type(4)));
    const int NGW = F.G * NWAVES; const int r = F.lane & 15, kg = F.lane >> 4;
    LAS float* gsT = (LAS float*)(F.lds + RING_OFF);
    LAS float* shT = (LAS float*)(F.lds + RING_OFF + 4096);
    LAS float* lg = (LAS float*)(F.lds + RING_OFF + 8192) + F.wave * (16 * 48);
    LAS unsigned char* wb = F.lds + RING_OFF + 32768;
    for (int rb0 = F.vcu * NWAVES; rb0 < NTOK / 16; rb0 += NGW) {
        const int rb = rb0 + F.wave; const int row0 = rb * 16, b = (rb0 * 16) / SEQ;
        __syncthreads();
        for (int i = F.tid; i < D; i += NWAVES * 64) { gsT[i] = F.g_ffn[i] * (1.0f + F.mod[(size_t)b * (NMOD * D) + 4 * D + i]); shT[i] = F.mod[(size_t)b * (NMOD * D) + 3 * D + i]; }
#define P6_SRC(p, kc) ((const GAS v4u*)(((p) < 1536 ? F.wrt_hi : F.wrt_lo) + (size_t)(((p) % 1536) >> 5) * D + (kc) * 256 + ((p) & 31) * 8))
#define P6_DST(p, bf) ((LAS v4u*)(wb + (bf) * 49152 + ((p) / 1536) * 24576 + (((p) % 1536) >> 5) * 512 + ((((p) & 31) ^ ((((p) % 1536) >> 5) & 15)) << 4)))
#pragma unroll
        for (int j = 0; j < 6; ++j) { const int p = F.tid + j * 512; *P6_DST(p, 0) = *P6_SRC(p, 0); }
        __syncthreads();
        const int row = row0 + r;
        float ss = 0.f; { const GAS f32x4* sp = (const GAS f32x4*)(F.stats + (size_t)row * 16);
#pragma unroll
            for (int j = 0; j < 4; ++j) { const f32x4 s4 = sp[j]; ss += (s4.x + s4.y) + (s4.z + s4.w); } }
        const float rstd = __builtin_amdgcn_rsqf(ss * (1.f / D) + RMS_EPS);
        f32x4v acc[3] = {{0.f, 0.f, 0.f, 0.f}, {0.f, 0.f, 0.f, 0.f}, {0.f, 0.f, 0.f, 0.f}};
        const float* xrow = F.out + (size_t)row * D + 8 * kg; bf16* orow = F.XN + (size_t)row * D + 8 * kg;
        for (int kc = 0; kc < 4; ++kc) {
            v4u nx[6];
            if (kc < 3) {
#pragma unroll
                for (int j = 0; j < 6; ++j) nx[j] = *P6_SRC(F.tid + j * 512, kc + 1); }
            const LAS unsigned char* wbc = wb + (kc & 1) * 49152;
#pragma unroll 4
            for (int ks = 0; ks < 8; ++ks) { const int k = 256 * kc + 32 * ks;
                const f32x4 xa = *(const GAS f32x4*)(xrow + k), xb = *(const GAS f32x4*)(xrow + k + 4);
                const f32x4 ga = *(const LAS f32x4*)(gsT + k + 8 * kg), gb = *(const LAS f32x4*)(gsT + k + 8 * kg + 4), sa = *(const LAS f32x4*)(shT + k + 8 * kg), sb = *(const LAS f32x4*)(shT + k + 8 * kg + 4);
                const f32x4 ha = (xa * rstd) * ga + sa, hb = (xb * rstd) * gb + sb;
                v4u hw; hw.x = pk2(ha.x, ha.y); hw.y = pk2(ha.z, ha.w); hw.z = pk2(hb.x, hb.y); hw.w = pk2(hb.z, hb.w);
                *(GAS v4u*)(orow + k) = hw;
                v4u lw; lw.x = pk2(ha.x - bflo(hw.x), ha.y - bfhi(hw.x)); lw.y = pk2(ha.z - bflo(hw.y), ha.w - bfhi(hw.y)); lw.z = pk2(hb.x - bflo(hw.z), hb.y - bfhi(hw.z)); lw.w = pk2(hb.z - bflo(hw.w), hb.w - bfhi(hw.w));
                const bf16x8 Ah = __builtin_bit_cast(bf16x8, hw), Al = __builtin_bit_cast(bf16x8, lw);
                const int cx = ((4 * ks + kg) ^ r) << 4;
#pragma unroll
                for (int n = 0; n < 3; ++n) { const bf16x8 Bh = *(const LAS bf16x8*)(wbc + (16 * n + r) * 512 + cx), Bl = *(const LAS bf16x8*)(wbc + 24576 + (16 * n + r) * 512 + cx);
                    acc[n] = __builtin_amdgcn_mfma_f32_16x16x32_bf16(Ah, Bh, acc[n], 0, 0, 0); acc[n] = __builtin_amdgcn_mfma_f32_16x16x32_bf16(Al, Bh, acc[n], 0, 0, 0); acc[n] = __builtin_amdgcn_mfma_f32_16x16x32_bf16(Ah, Bl, acc[n], 0, 0, 0); }
            }
            if (kc < 3) {
#pragma unroll
                for (int j = 0; j < 6; ++j) *P6_DST(F.tid + j * 512, (kc + 1) & 1) = nx[j]; }
            __syncthreads();
        }
#undef P6_SRC
#undef P6_DST
#pragma unroll
        for (int n = 0; n < 3; ++n)
#pragma unroll
            for (int e = 0; e < 4; ++e) lg[(4 * kg + e) * 48 + 16 * n + r] = acc[n][e];
        LDS_WAIT(); asm volatile("" ::: "memory");
        const LAS f32x4* lr = (const LAS f32x4*)(lg + r * 48);
        const f32x4 g4 = lr[0]; float gl[4] = {g4.x + F.b_rg[0], g4.y + F.b_rg[1], g4.z + F.b_rg[2], g4.w + F.b_rg[3]};
        int gi = 0; float gm = gl[0];
#pragma unroll
        for (int g = 1; g < 4; ++g) if (gl[g] > gm) { gm = gl[g]; gi = g; }
        float den = 0.f;
#pragma unroll
        for (int g = 0; g < 4; ++g) den += __expf(gl[g] - gm);
        const float gwt = 1.0f / den;
        const LAS f32x4* er = (const LAS f32x4*)(lg + r * 48 + 4 + 8 * gi); const f32x4 e0 = er[0], e1 = er[1];
        const GAS f32x4* bp = (const GAS f32x4*)(F.b_re + gi * EPG); const f32x4 b0 = bp[0], b1 = bp[1];
        const float el[8] = {e0.x + b0.x, e0.y + b0.y, e0.z + b0.z, e0.w + b0.w, e1.x + b1.x, e1.y + b1.y, e1.z + b1.z, e1.w + b1.w};
        int k1 = 0; float t1 = el[0];
#pragma unroll
        for (int k = 1; k < 8; ++k) if (el[k] > t1) { t1 = el[k]; k1 = k; }
        int k2 = -1; float t2 = -INFINITY;
#pragma unroll
        for (int k = 0; k < 8; ++k) if (k != k1 && el[k] > t2) { t2 = el[k]; k2 = k; }
        const float ex = __expf(t2 - t1); const float w1v = gwt / (1.0f + ex), w2v = gwt * ex / (1.0f + ex);
        if (F.lane < 32) { const int slot = F.lane >> 4; const int e = gi * EPG + (slot == 0 ? k1 : k2); const float w = slot == 0 ? w1v : w2v;
            const unsigned pos = __hip_atomic_fetch_add(F.cnt + (slot * NEXP + e) * 64, 1u, __ATOMIC_RELAXED, __HIP_MEMORY_SCOPE_AGENT);
            F.tokl[(size_t)(slot * NEXP + e) * LCAP + pos] = row; F.inv[row * 2 + slot] = (e << 16) | (int)pos; F.winv[row * 2 + slot] = w; }
        LDS_WAIT(); asm volatile("" ::: "memory");
    }
}
__device__ __forceinline__ void moe_tables(Frame& F) {
    LAS int* T = (LAS int*)(F.lds + TAB_OFF);
    if (F.tid < 64) T[F.tid] = (int)__hip_atomic_load(F.cnt + F.tid * 64, RLX_AGENT);
    __syncthreads();
    if (F.tid == 0) { int pa = 0, hs = 0, p0 = 0, p1 = 0;
        for (int e = 0; e < NEXP; ++e) { const int c0 = T[e], c1 = T[32 + e], ta = (c0 + c1 + 255) >> 8;
            T[64 + e] = pa; T[128 + e] = hs; T[192 + e] = p0; T[256 + e] = p1; pa += ta; hs += ta * 256; p0 += (c0 + 255) >> 8; p1 += (c1 + 255) >> 8; }
        T[64 + 32] = pa; T[128 + 32] = hs; T[192 + 32] = p0; T[256 + 32] = p1; }
    __syncthreads();
}

__device__ __forceinline__ void p9_combine(Frame& F) {
    const LAS int* T = (const LAS int*)(F.lds + TAB_OFF);
    const int gw = F.vcu * NWAVES + F.wave, NGW = F.G * NWAVES;
    for (int rb = gw; rb < NTOK / 16; rb += NGW) {
        const int row0 = rb * 16, b = row0 / SEQ;
        int rr = 0; float ww = 0.f;
        if (F.lane < 32) { const int iv = F.inv[2 * row0 + F.lane]; ww = F.winv[2 * row0 + F.lane]; const int e = iv >> 16; rr = T[128 + e] + ((F.lane & 1) ? T[e] : 0) + (iv & 0xffff); }
        const GAS f32x4* gr = (const GAS f32x4*)(F.mod + (size_t)b * (NMOD * D) + 5 * D) + F.lane;
        f32x4 gv[4];
#pragma unroll
        for (int j = 0; j < 4; ++j) gv[j] = gr[64 * j];
        for (int i0 = 0; i0 < 16; i0 += 4) {
            f32x4 xv[4][4]; v2u a[4][4], c[4][4]; float w0[4], w1[4];
#pragma unroll
            for (int q = 0; q < 4; ++q) { const int i = i0 + q; const int r0 = __shfl(rr, 2 * i), r1 = __shfl(rr, 2 * i + 1); w0[q] = __shfl(ww, 2 * i); w1[q] = __shfl(ww, 2 * i + 1);
                const GAS f32x4* xr = (const GAS f32x4*)(F.out + (size_t)(row0 + i) * D) + F.lane;
                const GAS v2u* y0 = (const GAS v2u*)(F.Y + (size_t)r0 * D) + F.lane; const GAS v2u* y1 = (const GAS v2u*)(F.Y + (size_t)r1 * D) + F.lane;
#pragma unroll
                for (int j = 0; j < 4; ++j) { xv[q][j] = xr[64 * j]; a[q][j] = y0[64 * j]; c[q][j] = y1[64 * j]; } }
#pragma unroll
            for (int q = 0; q < 4; ++q) { GAS f32x4* xr = (GAS f32x4*)(F.out + (size_t)(row0 + i0 + q) * D) + F.lane;
#pragma unroll
                for (int j = 0; j < 4; ++j) { f32x4 y; y.x = w0[q] * bflo(a[q][j].x) + w1[q] * bflo(c[q][j].x); y.y = w0[q] * bfhi(a[q][j].x) + w1[q] * bfhi(c[q][j].x); y.z = w0[q] * bflo(a[q][j].y) + w1[q] * bflo(c[q][j].y); y.w = w0[q] * bfhi(a[q][j].y) + w1[q] * bfhi(c[q][j].y);
                    xr[64 * j] = xv[q][j] + gv[j] * y; } }
        }
    }
}
#ifndef REP_PHASE
#define REP_PHASE -1
#endif
#ifndef STG_P2
#define STG_P2 0
#endif
#ifndef STG_P4
#define STG_P4 0
#endif
#ifndef STG_P5
#define STG_P5 0
#endif
#ifndef STG_P8
#define STG_P8 0
#endif
__device__ __forceinline__ void stagger_wait(int us_x_group) {
    if (us_x_group > 0) { const unsigned long long t0 = __builtin_amdgcn_s_memrealtime(); const unsigned long long ticks = (unsigned long long)us_x_group * 100ull;
        while (__builtin_amdgcn_s_memrealtime() - t0 < ticks) __builtin_amdgcn_s_sleep(16); }
}
#ifndef MK_N_LAUNCHES
#define MK_N_LAUNCHES 1
#endif
constexpr int N_PHASES = 10;
constexpr int N_LAUNCHES = MK_N_LAUNCHES;
static_assert(N_LAUNCHES == 1 || N_LAUNCHES == N_PHASES, "MK_N_LAUNCHES is 1 or N_PHASES");
struct Args { const float* in[20]; float* out; unsigned char* ws; int ph_lo, ph_hi; };
__global__ void __launch_bounds__(NWAVES * 64, 2) fwd(Args args) {
    extern __shared__ __attribute__((aligned(16))) unsigned char lds[];
    Frame F;
    F.lds = (LAS unsigned char*)lds;
    F.MISC = (volatile LAS unsigned*)(F.lds + MISC_OFF);
    F.tid = threadIdx.x; F.lane = F.tid & 63; F.wave = __builtin_amdgcn_readfirstlane(F.tid >> 6);
    F.G = gridDim.x; { const int bx = blockIdx.x; F.vcu = (F.G % 8 == 0) ? (bx % 8) * (F.G / 8) + bx / 8 : bx; }
    unsigned char* ws = args.ws;
    F.ctl = (gu32*)(ws + WS_CTL);
    F.x = args.in[0]; F.c = args.in[1]; F.w_ada = args.in[2]; F.b_ada = args.in[3]; F.g_mix = args.in[4]; F.w_in = args.in[5]; F.g_q = args.in[6]; F.g_k = args.in[7]; F.rel_bias = args.in[8];
    F.w_br_moba = args.in[9]; F.w_br_sb = args.in[10]; F.w_out = args.in[11]; F.g_ffn = args.in[12]; F.w_rg = args.in[13]; F.b_rg = args.in[14]; F.w_re = args.in[15]; F.b_re = args.in[16];
    F.w_gate = args.in[17]; F.w_up = args.in[18]; F.w_down = args.in[19]; F.out = args.out;
    F.mod = (float*)(ws + WS_MOD); F.biasT = (float*)(ws + WS_BIAS); F.btg = (float*)(ws + WS_BIAS + 128 * 1024); F.wrt_hi = (bf16*)(ws + WS_MOD + 640 * 1024); F.wrt_lo = (bf16*)(ws + WS_MOD + 736 * 1024); F.stats = (float*)(ws + WS_STATS); F.kmean = (float*)(ws + WS_CTL) + CW_KMEAN;
    F.Win_t = (bf16*)(ws + WS_WIN); F.Wbra_t = (bf16*)(ws + WS_WBRA); F.Wbrb_t = (bf16*)(ws + WS_WBRB); F.Wout_t = (bf16*)(ws + WS_WOUT); F.Wgu_t = (bf16*)(ws + WS_WGU); F.Wd_t = (bf16*)(ws + WS_WD);
    F.XN = (bf16*)(ws + WS_XN); F.QA = (bf16*)(ws + WS_QA); F.KA = (bf16*)(ws + WS_KA); F.VA = (bf16*)(ws + WS_VA); F.QB = (bf16*)(ws + WS_QB); F.KB = (bf16*)(ws + WS_KB); F.VB = (bf16*)(ws + WS_VB);
    F.OA = (bf16*)(ws + WS_XN); F.OB = (bf16*)(ws + WS_XN + 32 * MiB); F.GA = (bf16*)(ws + WS_GA); F.GB = (bf16*)(ws + WS_GB); F.H = (bf16*)(ws + WS_H);
    F.inv = (int*)(ws + WS_INV); F.winv = (float*)(ws + WS_WINV); F.Y = (bf16*)(ws + WS_Y); F.tokl = (int*)(ws + WS_TOKL); F.wl = (float*)(ws + WS_WL); F.cnt = (unsigned*)(ws + WS_CTL) + CW_CNT;
    for (int u = F.tid; u < (LDS_BYTES - LDSCTL_OFF) / 4; u += NWAVES * 64) ((LAS unsigned*)(F.lds + LDSCTL_OFF))[u] = 0u;
    __syncthreads();
    XcdBarrier bar; bar.bar = (unsigned*)(F.ctl + CW_BAR); bar.x = 0; bar.st = nullptr;
    if (N_LAUNCHES == 1) bar = xcd_barrier_post((unsigned*)(F.ctl + CW_BAR), F.MISC + 8);
#if defined(PROBE_BAR)
    unsigned long long pb_sum = 0ull;
#define GRID_BAR() do { if (N_LAUNCHES == 1) { const unsigned long long pb0_ = __builtin_amdgcn_s_memrealtime(); xcd_barrier(bar); pb_sum += __builtin_amdgcn_s_memrealtime() - pb0_; } } while (0)
#else
#define GRID_BAR() do { if (N_LAUNCHES == 1) { xcd_barrier(bar); } } while (0)
#endif
    const int lo = args.ph_lo, hi = args.ph_hi;
#define IN(k) (lo <= (k) && (k) < hi)
#define BOTH(k) (IN(k) && IN((k) + 1))

    if (IN(0)) { p0_prologue(F); if (REP_PHASE == 0) { GRID_BAR(); p0_prologue(F); } if (BOTH(0)) GRID_BAR(); }
    if (IN(1)) { p1_norm(F); if (REP_PHASE == 1) { GRID_BAR(); p1_norm(F); } if (BOTH(1)) GRID_BAR(); }
    if (IN(2)) {
        stagger_wait(STG_P2 * (int)((blockIdx.x >> 3) & 3)); __syncthreads();
        pg8::Gemm g{F.XN, F.Win_t, D}; pg8::DenseOrder S; S.init(NTOK, INCOLS, F.G, (int)blockIdx.x);
        pg8::EpiProj E{F.QA, F.GA, F.GB, F.g_q, F.g_k, F.kmean};
        pg8::gemm_phase<pg8::EpiProj, pg8::DenseOrder, false>(F.lds + RING_OFF, g, S, E);
        if (REP_PHASE == 2) { GRID_BAR(); pg8::gemm_phase<pg8::EpiProj, pg8::DenseOrder, false>(F.lds + RING_OFF, g, S, E); }
        if (BOTH(2)) GRID_BAR();
    }
    if (IN(3)) { __syncthreads(); p3_mixers(F); if (BOTH(3)) GRID_BAR(); }
    if (IN(4)) {
        __syncthreads();
        pg8::Gemm g{F.OA, F.Wbra_t, D}; pg8::DenseOrder S; S.init(NTOK, D, F.G, (int)blockIdx.x);
        pg8::EpiMerge E{F.GA, F.GB};
        pg8::gemm_phase<pg8::EpiMerge, pg8::DenseOrder, false>(F.lds + RING_OFF, g, S, E);
        if (BOTH(4)) GRID_BAR();
    }
    if (IN(5)) {
        stagger_wait(STG_P5 * (int)((blockIdx.x >> 3) & 3)); __syncthreads();
        pg8::Gemm g{F.GB, F.Wout_t, D}; pg8::DenseOrder S; S.init(NTOK, D, F.G, (int)blockIdx.x);
        pg8::EpiResid E{F.x, F.out, F.mod + 2 * D, F.stats};
        pg8::gemm_phase<pg8::EpiResid, pg8::DenseOrder, false>(F.lds + RING_OFF, g, S, E);
        if (REP_PHASE == 5) { GRID_BAR(); pg8::gemm_phase<pg8::EpiResid, pg8::DenseOrder, false>(F.lds + RING_OFF, g, S, E); }
        if (BOTH(5)) GRID_BAR();
    }
    if (IN(6)) {
#if defined(ROUTE_VALU)
        p6_route(F);
#else
        __syncthreads(); p6_route_mfma(F);
#endif
        if (REP_PHASE == 6) { GRID_BAR(); Frame F2 = F; F2.cnt = (unsigned*)(ws + WS_CTL) + CW_CNT + 4096 * 4; F2.tokl = (int*)(ws + WS_GA); F2.wl = (float*)(ws + WS_GA + 16 * MiB); F2.XN = (bf16*)(ws + WS_GB); p6_route_mfma(F2); }
        if (BOTH(6)) GRID_BAR(); }
    if (IN(7)) {
        moe_tables(F);
        pg8::Gemm g{F.XN, F.Wgu_t, D}; pg8::GateUpOrder S{(const LAS int*)(F.lds + TAB_OFF), F.tokl, F.G, (int)blockIdx.x};
        pg8::EpiGateUp E{F.H};
        pg8::gemm_phase<pg8::EpiGateUp, pg8::GateUpOrder, true>(F.lds + RING_OFF, g, S, E);
        if (REP_PHASE == 7) { GRID_BAR(); pg8::gemm_phase<pg8::EpiGateUp, pg8::GateUpOrder, true>(F.lds + RING_OFF, g, S, E); }
        if (BOTH(7)) GRID_BAR();
    }
    if (IN(8)) {
        moe_tables(F);
        pg8::Gemm g{F.H, F.Wd_t, DEXP}; pg8::DownAllOrder S{(const LAS int*)(F.lds + TAB_OFF), F.G, (int)blockIdx.x};
        pg8::EpiY E{F.Y};
        pg8::gemm_phase<pg8::EpiY, pg8::DownAllOrder, false>(F.lds + RING_OFF, g, S, E);
        if (REP_PHASE == 8) { GRID_BAR(); pg8::gemm_phase<pg8::EpiY, pg8::DownAllOrder, false>(F.lds + RING_OFF, g, S, E); }
        if (BOTH(8)) GRID_BAR();
    }
    if (IN(9)) { moe_tables(F); p9_combine(F); if (REP_PHASE == 9) { GRID_BAR(); Frame F2 = F; F2.out = (float*)(ws + WS_XN); p9_combine(F2); } }
#if defined(PROBE_BAR)
    __syncthreads();
    if (IN(9) && (int)blockIdx.x == PROBE_BAR - 1 && F.tid == 0) F.out[(size_t)(PROBE_BAR - 1) * 16 * D + 12345] += 1.0f + 0.02f * (float)pb_sum * 0.01f;
#endif
#if defined(PROBE_EPI)
    __syncthreads();
    if (IN(9) && blockIdx.x == PROBE_BLK && F.tid == 0) { const float n = (float)g_probe[3]; const float v = (PROBE_EPI == 1) ? (float)g_probe[0] * 0.01f / n : (float)g_probe[1] * 0.01f / (n - 1.0f); F.out[12345] += 1.0f + 0.2f * v; }
#endif
#undef IN
#undef BOTH
}

extern "C" void kernel_launch(void* const* d_in, const int* in_sizes, int n_in, void* d_out, int out_size, void* d_ws, size_t ws_size, hipStream_t stream) {
    static int grid = 0;
    if (grid == 0) {
        if (n_in != 20 || in_sizes[0] != NTOK * D || out_size != NTOK * D || ws_size < WS_END) { fprintf(stderr, "kernel_launch: built for 20 inputs, x/out of %d floats, >= %zu bytes of workspace; got n_in %d, in0 %d, out %d, ws %zu; nothing launched\n", NTOK * D, (size_t)WS_END, n_in, n_in > 0 ? in_sizes[0] : -1, out_size, ws_size); grid = -1; return; }
        int dev = 0, cus = 0, per_cu = 0;
        if (hipGetDevice(&dev) != hipSuccess || hipDeviceGetAttribute(&cus, hipDeviceAttributeMultiprocessorCount, dev) != hipSuccess) { fprintf(stderr, "kernel_launch: hipGetDevice / hipDeviceGetAttribute failed\n"); grid = -1; return; }
        if (hipFuncSetAttribute((const void*)fwd, hipFuncAttributeMaxDynamicSharedMemorySize, LDS_BYTES) != hipSuccess) { fprintf(stderr, "kernel_launch: hipFuncSetAttribute failed\n"); grid = -1; return; }
        if (hipOccupancyMaxActiveBlocksPerMultiprocessor(&per_cu, (const void*)fwd, NWAVES * 64, LDS_BYTES) != hipSuccess || per_cu < 1)
            fprintf(stderr, "kernel_launch: note: the occupancy query reports %d workgroups per CU\n", per_cu);
        (void)hipGetLastError();
        grid = cus;
    }
    if (grid < 0) return;
    if (hipMemsetAsync((char*)d_ws + WS_CTL, 0, CTL_ZERO_BYTES, stream) != hipSuccess) { fprintf(stderr, "kernel_launch: hipMemsetAsync failed\n"); return; }
    Args a{};
    for (int i = 0; i < 20; ++i) a.in[i] = (const float*)d_in[i];
    a.out = (float*)d_out; a.ws = (unsigned char*)d_ws;
    for (int li = 0; li < N_LAUNCHES; ++li) {
        a.ph_lo = (N_LAUNCHES == 1) ? 0 : li; a.ph_hi = (N_LAUNCHES == 1) ? N_PHASES : li + 1;
        hipLaunchKernelGGL(fwd, dim3(grid), dim3(NWAVES * 64), LDS_BYTES, stream, a);
        const hipError_t le = hipPeekAtLastError();
        if (le != hipSuccess) { fprintf(stderr, "kernel_launch: launch %d failed: %s\n", li, hipGetErrorName(le)); break; }
    }
}
```
